# Optimizing an MI355X kernel written in HIP

```python
import jax, jax.numpy as jnp
from jax import lax
import numpy as np

D_MODEL = 1024
BATCH = 4
SEQ = 4096
DEPTH = 1

A_HEAD_DIM = 64
A_WIDTH = D_MODEL // 2
A_HEADS = A_WIDTH // A_HEAD_DIM
CHUNK = 128
B_HEAD_DIM = 64
B_WIDTH = D_MODEL // 2
B_HEADS = B_WIDTH // B_HEAD_DIM
DILATED_PATTERNS = ((128, 1), (512, 4), (2048, 16))
BAND_BLOCK = 128
MIX_WIDTH = A_WIDTH + B_WIDTH
IN_COLS = 2 * A_WIDTH + 3 * B_WIDTH
N_EXPERTS = 32
TOP_K = 4
D_EXPERT = D_MODEL
SWIGLU_ALPHA = 1.702
SWIGLU_LIMIT = 7.0
MOE_BLOCK = 128
DN_ALPHA = (2 * DEPTH) ** 0.25
DN_BETA = (8 * DEPTH) ** -0.25
LN_EPS = 1e-5

kernel_name = "hybrid_sgu_dilated_attn_moe_deepnorm"


def layer_norm(t, g, b):
    tf = t.astype(jnp.float32)
    mu = tf.mean(-1, keepdims=True)
    var = jnp.square(tf - mu).mean(-1, keepdims=True)
    return ((tf - mu) * lax.rsqrt(var + LN_EPS) * g + b).astype(t.dtype)


def rms_norm(t, g):
    tf = t.astype(jnp.float32)
    return (tf * lax.rsqrt(jnp.square(tf).mean(-1, keepdims=True) + LN_EPS) * g).astype(t.dtype)


def chunked_sgu(u, v, w_s, b_s, ln_g, ln_b):
    B, S, _ = u.shape
    nc = S // CHUNK
    vg = v.reshape(B, S, A_HEADS, A_HEAD_DIM).astype(jnp.float32)
    mu = vg.mean(-1, keepdims=True)
    var = jnp.square(vg - mu).mean(-1, keepdims=True)
    vn = ((vg - mu) * lax.rsqrt(var + LN_EPS) * ln_g.reshape(A_HEADS, A_HEAD_DIM)
          + ln_b.reshape(A_HEADS, A_HEAD_DIM)).astype(v.dtype)
    vc = vn.reshape(B, nc, CHUNK, A_HEADS, A_HEAD_DIM)
    w_causal = jnp.tril(w_s)
    gate = jnp.einsum('gts,bnsgc->bntgc', w_causal, vc) + b_s.T[None, None, :, :, None]
    return u * gate.reshape(B, S, A_WIDTH)


def dilated_band_attention(q, k, v, window, dilation):
    B, S, H, Dh = q.shape
    reach = window // dilation
    span = dilation * BAND_BLOCK
    L = -(-S // span) * span
    nb = L // span

    def to_sub(t):
        t = jnp.pad(t, ((0, 0), (0, L - S), (0, 0), (0, 0)))
        t = t.reshape(B, L // dilation, dilation, H, Dh).transpose(0, 2, 3, 1, 4)
        return t.reshape(B, dilation, H, nb, BAND_BLOCK, Dh)

    def with_prev(t):
        prev = jnp.pad(t[:, :, :, :-1], ((0, 0), (0, 0), (0, 0), (1, 0), (0, 0), (0, 0)))
        return jnp.concatenate([prev, t], axis=4)

    qs = to_sub(q)
    kk = with_prev(to_sub(k))
    vv = with_prev(to_sub(v)).astype(jnp.float32)
    s = jnp.einsum('bdhnqc,bdhnkc->bdhnqk', qs, kk, preferred_element_type=jnp.float32)
    qi = jnp.arange(BAND_BLOCK)[:, None] + BAND_BLOCK
    kj = jnp.arange(2 * BAND_BLOCK)[None, :]
    dist = qi - kj
    band = (dist >= 0) & (dist <= reach)
    first = (jnp.arange(nb) == 0)[:, None, None]
    mask = band[None] & ~(first & (kj < BAND_BLOCK)[None])
    s = jnp.where(mask, s, -jnp.inf)
    m = s.max(-1)
    p = jnp.exp(s - m[..., None])
    l = p.sum(-1)
    o = jnp.einsum('bdhnqk,bdhnkc->bdhnqc', p, vv) / l[..., None]

    def from_sub(t):
        tail = t.shape[5:]
        t = t.reshape((B, dilation, H, L // dilation) + tail)
        t = jnp.moveaxis(t, 3, 1)
        return t.reshape((B, L, H) + tail)[:, :S]

    return from_sub(o), from_sub(m), from_sub(l)


def dilated_mixture_attention(q, k, v):
    B, S, _ = q.shape
    q = (q * (B_HEAD_DIM ** -0.5)).reshape(B, S, B_HEADS, B_HEAD_DIM)
    k = k.reshape(B, S, B_HEADS, B_HEAD_DIM)
    v = v.reshape(B, S, B_HEADS, B_HEAD_DIM)
    res = [dilated_band_attention(q, k, v, w, d) for (w, d) in DILATED_PATTERNS]
    os_ = jnp.stack([r[0] for r in res], 0)
    ms = jnp.stack([r[1] for r in res], 0)
    ls = jnp.stack([r[2] for r in res], 0)
    wts = ls * jnp.exp(ms - ms.max(0, keepdims=True))
    out = (wts[..., None] * os_).sum(0) / wts.sum(0)[..., None]
    return out.reshape(B, S, B_WIDTH).astype(q.dtype)


def moe_ffn(h, w_router, b_router, w_gate, b_gate, w_up, b_up, w_down, b_down):
    B, S, D = h.shape
    T = B * S
    A = T * TOP_K
    hf = h.reshape(T, D)
    logits = jnp.dot(hf, w_router).astype(jnp.float32) + b_router.astype(jnp.float32)
    top_vals, top_idx = lax.top_k(logits, TOP_K)
    gates = jax.nn.softmax(top_vals, axis=-1)
    flat_e = top_idx.reshape(A)
    flat_tok = jnp.repeat(jnp.arange(T, dtype=jnp.int32), TOP_K)
    flat_g = gates.reshape(A)
    order = jnp.argsort(flat_e)
    se, stok, sg = flat_e[order], flat_tok[order], flat_g[order]
    counts = jnp.bincount(flat_e, length=N_EXPERTS)
    start = jnp.cumsum(counts) - counts
    pcounts = (counts + MOE_BLOCK - 1) // MOE_BLOCK * MOE_BLOCK
    pend = jnp.cumsum(pcounts)
    pstart = pend - pcounts
    dest = pstart[se] + (jnp.arange(A) - start[se])
    nblk = -(-A // MOE_BLOCK) + N_EXPERTS
    P = nblk * MOE_BLOCK
    row_tok = jnp.full((P,), T, jnp.int32).at[dest].set(stok)
    row_gate = jnp.zeros((P,), jnp.float32).at[dest].set(sg)
    block_e = jnp.clip(jnp.searchsorted(pend, jnp.arange(nblk) * MOE_BLOCK, side='right'), 0, N_EXPERTS - 1)
    h_pad = jnp.concatenate([hf, jnp.zeros((1, D), hf.dtype)], 0)

    def expert_block(args):
        tok, e = args
        xb = h_pad[tok]
        g = jnp.minimum(xb @ w_gate[e] + b_gate[e], SWIGLU_LIMIT)
        u = jnp.clip(xb @ w_up[e] + b_up[e], -SWIGLU_LIMIT, SWIGLU_LIMIT)
        act = (u + 1.0) * (g * jax.nn.sigmoid(SWIGLU_ALPHA * g))
        return act @ w_down[e] + b_down[e]

    out = lax.map(expert_block, (row_tok.reshape(nblk, MOE_BLOCK), block_e)).reshape(P, D)
    y = jnp.zeros((T + 1, D), h.dtype).at[row_tok].add((out * row_gate[:, None]).astype(h.dtype))
    return y[:T].reshape(B, S, D)


def setup_inputs(seed: int = 0) -> dict:
    key = jax.random.key(seed)
    ks = jax.random.split(key, 24)
    n = lambda i, shape: jax.random.normal(ks[i], shape, jnp.float32)
    L, D, E, F = DEPTH, D_MODEL, N_EXPERTS, D_EXPERT
    return {
        "x": n(0, (BATCH, SEQ, D)),
        "w_in": n(1, (L, D, IN_COLS)) * D ** -0.5,
        "sgu_w": n(2, (L, A_HEADS, CHUNK, CHUNK)) * CHUNK ** -0.5,
        "sgu_b": 1.0 + 0.02 * n(3, (L, A_HEADS, CHUNK)),
        "sgu_ln_g": 1.0 + 0.02 * n(4, (L, A_WIDTH)),
        "sgu_ln_b": 0.02 * n(5, (L, A_WIDTH)),
        "mix_norm_g": 1.0 + 0.02 * n(6, (L, MIX_WIDTH)),
        "w_out": n(7, (L, MIX_WIDTH, D)) * MIX_WIDTH ** -0.5 * DN_BETA,
        "ln1_g": 1.0 + 0.02 * n(8, (L, D)),
        "ln1_b": 0.02 * n(9, (L, D)),
        "w_router": n(10, (L, D, E)) * D ** -0.5,
        "b_router": 0.01 * n(11, (L, E)),
        "w_gate": n(12, (L, E, D, F)) * D ** -0.5,
        "b_gate": 0.01 * n(13, (L, E, F)),
        "w_up": n(14, (L, E, D, F)) * D ** -0.5,
        "b_up": 0.01 * n(15, (L, E, F)),
        "w_down": n(16, (L, E, F, D)) * F ** -0.5 * DN_BETA,
        "b_down": 0.01 * n(17, (L, E, D)),
        "ln2_g": 1.0 + 0.02 * n(18, (L, D)),
        "ln2_b": 0.02 * n(19, (L, D)),
    }


def reference(x, w_in, sgu_w, sgu_b, sgu_ln_g, sgu_ln_b, mix_norm_g, w_out, ln1_g, ln1_b,
              w_router, b_router, w_gate, b_gate, w_up, b_up, w_down, b_down, ln2_g, ln2_b):
    for i in range(DEPTH):
        p = x @ w_in[i]
        za = jax.nn.gelu(p[..., :2 * A_WIDTH])
        q = p[..., 2 * A_WIDTH:2 * A_WIDTH + B_WIDTH]
        k = p[..., 2 * A_WIDTH + B_WIDTH:2 * A_WIDTH + 2 * B_WIDTH]
        v = p[..., 2 * A_WIDTH + 2 * B_WIDTH:]
        a = chunked_sgu(za[..., :A_WIDTH], za[..., A_WIDTH:], sgu_w[i], sgu_b[i], sgu_ln_g[i], sgu_ln_b[i])
        b = dilated_mixture_attention(q, k, v)
        mixed = jnp.concatenate([rms_norm(a, mix_norm_g[i, :A_WIDTH]),
                                 rms_norm(b, mix_norm_g[i, A_WIDTH:])], axis=-1) @ w_out[i]
        h = layer_norm(DN_ALPHA * x + mixed, ln1_g[i], ln1_b[i])
        y = moe_ffn(h, w_router[i], b_router[i], w_gate[i], b_gate[i], w_up[i], b_up[i], w_down[i], b_down[i])
        x = layer_norm(DN_ALPHA * h + y, ln2_g[i], ln2_b[i])
    return x
```

```cpp
#include <hip/hip_runtime.h>
#include <hip/hip_cooperative_groups.h>
#include <cstdio>
#include <cstdint>
namespace cg = cooperative_groups;

#ifndef MK_N_LAUNCHES
#define MK_N_LAUNCHES 1
#endif

constexpr int BATCH = 4, SEQ = 4096, T = BATCH * SEQ, D = 1024, INC = 2560, NE = 32, FF = 1024, TOPK = 4;
constexpr int AW = 512, NGRP = 8, GD = 64, CHUNK = 128, NH = 8, HD = 64;
constexpr float LN_EPS = 1e-5f, DN_ALPHA = 1.189207115002721f;
constexpr int NSLOT = T * TOPK;
constexpr int MAXTILES = 288;
constexpr int MAXU = 12;

constexpr size_t MiB = 1u << 20;
constexpr size_t WS_CTL = 0, CTL_ZERO_BYTES = 64 * 1024;
constexpr size_t WS_LIST = 1 * MiB;
constexpr size_t WS_GATES = 3 * MiB;
constexpr size_t WS_WIN = 4 * MiB;
constexpr size_t WS_WOUT = 9 * MiB;
constexpr size_t WS_WD = 11 * MiB;
constexpr size_t WS_WGU = 75 * MiB;
constexpr size_t WS_Y = WS_WGU;
constexpr size_t WS_HB = 203 * MiB;
constexpr size_t WS_BIG = 235 * MiB;
constexpr size_t WS_XB = WS_BIG;
constexpr size_t WS_P1 = WS_BIG + 32 * MiB;
constexpr size_t WS_AMIX = WS_BIG + 112 * MiB;
constexpr size_t WS_ACT = WS_BIG;
constexpr size_t WS_RAW = 379 * MiB;
constexpr size_t WS_END = 443 * MiB;
constexpr int CW_CNT = 0;

constexpr int RING_BYTES = 131072;
constexpr int TAB_OFF = RING_BYTES + 1024;
constexpr int ROWTAB_OFF = RING_BYTES + 2048;
constexpr int LDS_BYTES = 147456;
static_assert(ROWTAB_OFF + MAXU * 1024 <= LDS_BYTES, "LDS map");

#define LAS __attribute__((address_space(3)))
typedef unsigned short bf16_t;
typedef short bf16x8 __attribute__((ext_vector_type(8)));
typedef float f32x4 __attribute__((ext_vector_type(4)));
typedef float f32x2 __attribute__((ext_vector_type(2)));
typedef unsigned u32x4 __attribute__((ext_vector_type(4)));
typedef unsigned u32x2 __attribute__((ext_vector_type(2)));

__device__ __forceinline__ unsigned cvt_pk_bf16(float lo, float hi) { unsigned r; asm volatile("v_cvt_pk_bf16_f32 %0, %1, %2" : "=v"(r) : "v"(lo), "v"(hi)); return r; }
__device__ __forceinline__ float bf_lo(unsigned w) { return __uint_as_float(w << 16); }
__device__ __forceinline__ float bf_hi(unsigned w) { return __uint_as_float(w & 0xffff0000u); }
__device__ __forceinline__ float bf1(bf16_t b) { return __uint_as_float((unsigned)b << 16); }
__device__ __forceinline__ float wave_sum(float v) {
#pragma unroll
    for (int o = 1; o < 64; o <<= 1) v += __shfl_xor(v, o);
    return v;
}
__device__ __forceinline__ float gelu_tanh(float x) {
    const float y2 = x * (1.5957691216057308f + 0.07135481627260025f * x * x);
    return x * __builtin_amdgcn_rcpf(1.0f + __builtin_amdgcn_exp2f(-1.4426950408889634f * y2));
}

namespace pg8 {
constexpr int BM = 256, BK = 64, HALF = 128, HTB = HALF * BK * 2, STAGE_BYTES = 8 * HTB;
__host__ __device__ __forceinline__ int lds_byte(int r, int c) { const int st = (r >> 4) * 2 + (c >> 5), rr = r & 15, cc = c & 31, ob = rr * 64 + cc * 2; return st * 1024 + (ob ^ (((ob >> 9) & 1) << 5)); }
__host__ __device__ __forceinline__ void stage_rc(int b, int& R, int& C) { const int st = b / 1024, sb = b % 1024, swz = sb ^ (((sb >> 9) & 1) << 5); R = (st >> 1) * 16 + swz / 64; C = (st & 1) * 32 + (swz % 64) / 2; }
__host__ __device__ __forceinline__ int perm32(int rho) { const int n = rho >> 4, i = rho & 15; return 8 * (i >> 2) + 4 * n + (i & 3); }

struct Unit { int pm, pn, pb, e, mt, ui; };
struct Gemm { const bf16_t* A; const bf16_t* Bt; int K; };

struct DenseOrder {
    int nN, nU, G, v;
    __device__ __forceinline__ bool next(int i, Unit& u) const {
        const int L = i * G + v; if (L >= nU) return false;
        u.pm = L / nN; u.pn = L % nN; u.pb = u.pn; u.e = 0; u.mt = 0; u.ui = i; return true; }
};
struct MoeOrder {
    int NPN, nU, G, v; const LAS int* tstart;
    __device__ __forceinline__ bool next(int i, Unit& u) const {
        const int L = i * G + v; if (L >= nU) return false;
        const int tl = L / NPN, pn = L % NPN; int e = 0;
#pragma unroll
        for (int j = 1; j < NE; ++j) e += (tstart[j] <= tl) ? 1 : 0;
        u.pm = tl; u.pn = pn; u.pb = e * NPN + pn; u.e = e; u.mt = tl - tstart[e]; u.ui = i; return true; }
};

template <class Epi, class Sched, bool GATHER>
__device__ __forceinline__ void gemm_phase(LAS unsigned char* lds, const LAS int* rowtab, const Gemm g, const Sched& S, const Epi& E) {
    const int tid = threadIdx.x, wid = __builtin_amdgcn_readfirstlane(tid >> 6), lane = tid & 63, wr = wid >> 2, wc = wid & 3, fr = lane & 15, fq = lane >> 4;
    const int K = g.K, nt = K / BK;
    unsigned voffA0[2], voffA1[2], voffB[2]; int Rr[2], Cc[2];
#pragma unroll
    for (int i = 0; i < 2; ++i) { int R, C; stage_rc(tid * 16 + i * 8192, R, C); const int Rb = Epi::PERM ? ((R & ~31) + perm32(R & 31)) : R; Rr[i] = R; Cc[i] = C;
        voffA0[i] = (unsigned)(R * K + C) * 2u; voffA1[i] = (unsigned)((R + HALF) * K + C) * 2u; voffB[i] = (unsigned)(Rb * K + C) * 2u; }
    const size_t kstep = (size_t)(BK * 2);
    const size_t hstep = (size_t)HALF * K * 2;
    const size_t tstep = 2 * hstep;
    const unsigned ldsw = (unsigned)wid * 1024u;
    const int aoff = lds_byte(wr * 64 + fr, fq * 8), boff = lds_byte(wc * 32 + fr, fq * 8);
#define PG8_SA(b, h) (((b) * 2 + (h)) * HTB)
#define PG8_SB(b, h) ((4 + (b) * 2 + (h)) * HTB)
#define PG8_STAGE(bufoff, gbase, voff) do { _Pragma("unroll") for (int _i = 0; _i < 2; ++_i) \
        __builtin_amdgcn_global_load_lds((const unsigned*)((const char*)(gbase) + (voff)[_i]), (LAS unsigned*)(lds + (bufoff) + ldsw + _i * 8192), 16, 0, 0); } while (0)
#define PG8_LDA(dst, b, h) do { _Pragma("unroll") for (int m = 0; m < 4; ++m) _Pragma("unroll") for (int k = 0; k < 2; ++k) dst[m][k] = *(const LAS bf16x8*)(lds + PG8_SA(b, h) + aoff + m * 2048 + k * 1024); } while (0)
#define PG8_LDB(dst, b, h) do { _Pragma("unroll") for (int n = 0; n < 2; ++n) _Pragma("unroll") for (int k = 0; k < 2; ++k) dst[n][k] = *(const LAS bf16x8*)(lds + PG8_SB(b, h) + boff + n * 2048 + k * 1024); } while (0)
#define PG8_MMA(ai, bj, At, Bt) do { __builtin_amdgcn_s_setprio(1); _Pragma("unroll") for (int m = 0; m < 4; ++m) _Pragma("unroll") for (int n = 0; n < 2; ++n) _Pragma("unroll") for (int k = 0; k < 2; ++k) \
        acc[ai][bj][m][n] = __builtin_amdgcn_mfma_f32_16x16x32_bf16(Bt[n][k], At[m][k], acc[ai][bj][m][n], 0, 0, 0); __builtin_amdgcn_s_setprio(0); } while (0)
#define PG8_WAIT_V(n) asm volatile("s_waitcnt vmcnt(" #n ")" ::: "memory")
#define PG8_WAIT_L(n) asm volatile("s_waitcnt lgkmcnt(" #n ")" ::: "memory")
#define PG8_BAR __builtin_amdgcn_s_barrier()
#define PG8_SCHED __builtin_amdgcn_sched_barrier(0)
#define PG8_LOADROWS(U) do { if constexpr (GATHER) { _Pragma("unroll") for (int _i = 0; _i < 2; ++_i) { \
        voffA0[_i] = (unsigned)rowtab[(U).ui * 256 + Rr[_i]] + (unsigned)Cc[_i] * 2u; voffA1[_i] = (unsigned)rowtab[(U).ui * 256 + HALF + Rr[_i]] + (unsigned)Cc[_i] * 2u; } } } while (0)
    Unit cur, nxt; int ui = 0;
    if (!S.next(0, cur)) return;
    f32x4 acc[2][2][4][2];
#pragma unroll
    for (int a = 0; a < 2; ++a)
#pragma unroll
        for (int b = 0; b < 2; ++b)
#pragma unroll
            for (int m = 0; m < 4; ++m)
#pragma unroll
                for (int n = 0; n < 2; ++n) acc[a][b][m][n] = (f32x4){0.f, 0.f, 0.f, 0.f};
    bf16x8 At[4][2], B0[2][2], B1[2][2];
    const char* cA = GATHER ? (const char*)g.A : (const char*)g.A + (size_t)cur.pm * tstep; const char* cB = (const char*)g.Bt + (size_t)cur.pb * tstep;
    PG8_LOADROWS(cur); PG8_WAIT_L(0);
    PG8_STAGE(PG8_SB(0, 0), cB, voffB); PG8_STAGE(PG8_SB(0, 1), cB + hstep, voffB); PG8_STAGE(PG8_SA(0, 0), cA, voffA0); PG8_STAGE(PG8_SA(0, 1), cA, voffA1);
    if (wr == 1) PG8_BAR;
    PG8_WAIT_V(2); PG8_BAR;
    PG8_STAGE(PG8_SB(1, 0), cB + kstep, voffB); PG8_STAGE(PG8_SA(1, 0), cA + kstep, voffA0); PG8_STAGE(PG8_SB(1, 1), cB + hstep + kstep, voffB);
    PG8_WAIT_V(6); PG8_BAR;
    for (;;) {
        const bool has_next = S.next(ui + 1, nxt);
        const char* nA = has_next ? (GATHER ? (const char*)g.A : (const char*)g.A + (size_t)nxt.pm * tstep) : cA; const char* nB = has_next ? (const char*)g.Bt + (size_t)nxt.pb * tstep : cB;
        for (int t = 0; t < nt; t += 2) {
            const bool last = (t == nt - 2);
            const char* a1 = cA + (size_t)(t + 1) * kstep;
            const char* a2 = last ? nA : cA + (size_t)(t + 2) * kstep; const char* b2 = last ? nB : cB + (size_t)(t + 2) * kstep;
            const char* a3 = a2 + kstep; const char* b3 = b2 + kstep;
            PG8_LDB(B0, 0, 0); PG8_LDB(B1, 0, 1); PG8_SCHED; PG8_LDA(At, 0, 0); PG8_STAGE(PG8_SA(1, 1), a1, voffA1);
            if (last && has_next) PG8_LOADROWS(nxt);
            PG8_WAIT_V(8); PG8_WAIT_L(0); PG8_BAR; PG8_MMA(0, 0, At, B0); PG8_MMA(0, 1, At, B1); PG8_BAR; PG8_SCHED;
            PG8_LDA(At, 0, 1); PG8_STAGE(PG8_SB(0, 0), b2, voffB); PG8_STAGE(PG8_SB(0, 1), b2 + hstep, voffB); PG8_STAGE(PG8_SA(0, 0), a2, voffA0);
            PG8_WAIT_V(8); PG8_WAIT_L(0); PG8_BAR; PG8_MMA(1, 0, At, B0); PG8_MMA(1, 1, At, B1); PG8_BAR; PG8_SCHED;
            PG8_LDB(B0, 1, 0); PG8_LDB(B1, 1, 1); PG8_SCHED; PG8_LDA(At, 1, 0); PG8_STAGE(PG8_SA(0, 1), a2, voffA1);
            PG8_WAIT_V(8); PG8_WAIT_L(0); PG8_BAR; PG8_MMA(0, 0, At, B0); PG8_MMA(0, 1, At, B1); PG8_BAR; PG8_SCHED;
            PG8_LDA(At, 1, 1); PG8_STAGE(PG8_SB(1, 0), b3, voffB); PG8_STAGE(PG8_SB(1, 1), b3 + hstep, voffB); PG8_STAGE(PG8_SA(1, 0), a3, voffA0);
            PG8_WAIT_V(8); PG8_WAIT_L(0); PG8_BAR; PG8_MMA(1, 0, At, B0); PG8_MMA(1, 1, At, B1); PG8_BAR; PG8_SCHED;
        }
        if (wr == 0) PG8_BAR;
        E(acc, cur, wr, wc, fr, fq);
        if (!has_next) break;
#pragma unroll
        for (int a = 0; a < 2; ++a)
#pragma unroll
            for (int b = 0; b < 2; ++b)
#pragma unroll
                for (int m = 0; m < 4; ++m)
#pragma unroll
                    for (int n = 0; n < 2; ++n) acc[a][b][m][n] = (f32x4){0.f, 0.f, 0.f, 0.f};
        cur = nxt; cA = nA; cB = nB; ++ui;
        if (wr == 1) PG8_BAR;
    }
    PG8_WAIT_V(0);
    PG8_BAR;
#undef PG8_SA
#undef PG8_SB
#undef PG8_STAGE
#undef PG8_LDA
#undef PG8_LDB
#undef PG8_MMA
#undef PG8_WAIT_V
#undef PG8_WAIT_L
#undef PG8_BAR
#undef PG8_SCHED
#undef PG8_LOADROWS
}

struct EpiP1 {
    static constexpr bool PERM = true;
    bf16_t* O;
    __device__ __forceinline__ void operator()(const f32x4 (&acc)[2][2][4][2], const Unit& u, int wr, int wc, int fr, int fq) const {
        const int row0 = u.pm * BM + wr * 64 + fr, col0 = u.pn * BM + wc * 32 + 8 * fq; const bool act = u.pn < 4;
#pragma unroll
        for (int ai = 0; ai < 2; ++ai)
#pragma unroll
            for (int m = 0; m < 4; ++m) { bf16_t* rowp = O + (size_t)(row0 + ai * HALF + m * 16) * INC + col0;
#pragma unroll
                for (int bj = 0; bj < 2; ++bj) { f32x4 v0 = acc[ai][bj][m][0], v1 = acc[ai][bj][m][1];
                    if (act) {
#pragma unroll
                        for (int j = 0; j < 4; ++j) { v0[j] = gelu_tanh(v0[j]); v1[j] = gelu_tanh(v1[j]); } }
                    u32x4 w; w.x = cvt_pk_bf16(v0[0], v0[1]); w.y = cvt_pk_bf16(v0[2], v0[3]); w.z = cvt_pk_bf16(v1[0], v1[1]); w.w = cvt_pk_bf16(v1[2], v1[3]);
                    *(u32x4*)(rowp + bj * HALF) = w; } }
    }
};
struct EpiZ {
    static constexpr bool PERM = false;
    const float* X; float* Z;
    __device__ __forceinline__ void operator()(const f32x4 (&acc)[2][2][4][2], const Unit& u, int wr, int wc, int fr, int fq) const {
        const int col0 = u.pn * BM + wc * 32 + 4 * fq;
#pragma unroll
        for (int ai = 0; ai < 2; ++ai)
#pragma unroll
            for (int m = 0; m < 4; ++m) { const size_t off = (size_t)(u.pm * BM + ai * HALF + wr * 64 + m * 16 + fr) * D + col0;
#pragma unroll
                for (int bj = 0; bj < 2; ++bj)
#pragma unroll
                    for (int n = 0; n < 2; ++n) { const f32x4 xv = *(const f32x4*)(X + off + bj * HALF + n * 16); *(f32x4*)(Z + off + bj * HALF + n * 16) = xv * DN_ALPHA + acc[ai][bj][m][n]; } }
    }
};
struct EpiSwiglu {
    static constexpr bool PERM = true;
    bf16_t* Act; const float* bg; const float* bu;
    __device__ __forceinline__ void operator()(const f32x4 (&acc)[2][2][4][2], const Unit& u, int wr, int wc, int fr, int fq) const {
        const int f0 = u.pn * HALF + wc * 32 + 8 * fq; const int row0 = u.pm * BM + wr * 64 + fr;
        const f32x4 bg0 = *(const f32x4*)(bg + u.e * FF + f0), bg1 = *(const f32x4*)(bg + u.e * FF + f0 + 4);
        const f32x4 bu0 = *(const f32x4*)(bu + u.e * FF + f0), bu1 = *(const f32x4*)(bu + u.e * FF + f0 + 4);
#pragma unroll
        for (int ai = 0; ai < 2; ++ai)
#pragma unroll
            for (int m = 0; m < 4; ++m) {
                f32x4 g0 = acc[ai][0][m][0] + bg0, g1 = acc[ai][0][m][1] + bg1, u0 = acc[ai][1][m][0] + bu0, u1 = acc[ai][1][m][1] + bu1, r0, r1;
#pragma unroll
                for (int j = 0; j < 4; ++j) {
                    const float ga = fminf(g0[j], 7.0f), gb = fminf(g1[j], 7.0f);
                    const float ua = fminf(fmaxf(u0[j], -7.0f), 7.0f), ub = fminf(fmaxf(u1[j], -7.0f), 7.0f);
                    r0[j] = (ua + 1.0f) * ga * __builtin_amdgcn_rcpf(1.0f + __builtin_amdgcn_exp2f(-1.702f * 1.4426950408889634f * ga));
                    r1[j] = (ub + 1.0f) * gb * __builtin_amdgcn_rcpf(1.0f + __builtin_amdgcn_exp2f(-1.702f * 1.4426950408889634f * gb)); }
                u32x4 w; w.x = cvt_pk_bf16(r0[0], r0[1]); w.y = cvt_pk_bf16(r0[2], r0[3]); w.z = cvt_pk_bf16(r1[0], r1[1]); w.w = cvt_pk_bf16(r1[2], r1[3]);
                *(u32x4*)(Act + (size_t)(row0 + ai * HALF + m * 16) * FF + f0) = w; }
    }
};
struct EpiScatter {
    static constexpr bool PERM = true;
    bf16_t* Y; const float* bd; const float* gates; const LAS int* rowtab;
    __device__ __forceinline__ void operator()(const f32x4 (&acc)[2][2][4][2], const Unit& u, int wr, int wc, int fr, int fq) const {
        const int c0 = u.pn * BM + wc * 32 + 8 * fq;
        f32x4 b[2][2];
#pragma unroll
        for (int bj = 0; bj < 2; ++bj)
#pragma unroll
            for (int n = 0; n < 2; ++n) b[bj][n] = *(const f32x4*)(bd + u.e * D + c0 + bj * HALF + 4 * n);
#pragma unroll
        for (int ai = 0; ai < 2; ++ai)
#pragma unroll
            for (int m = 0; m < 4; ++m) { const int slot = rowtab[u.ui * 256 + ai * HALF + wr * 64 + m * 16 + fr];
                if (slot >= 0) { const float gt = gates[slot]; bf16_t* rowp = Y + (size_t)slot * D + c0;
#pragma unroll
                    for (int bj = 0; bj < 2; ++bj) { const f32x4 v0 = (acc[ai][bj][m][0] + b[bj][0]) * gt, v1 = (acc[ai][bj][m][1] + b[bj][1]) * gt;
                        u32x4 w; w.x = cvt_pk_bf16(v0[0], v0[1]); w.y = cvt_pk_bf16(v0[2], v0[3]); w.z = cvt_pk_bf16(v1[0], v1[1]); w.w = cvt_pk_bf16(v1[2], v1[3]);
                        *(u32x4*)(rowp + bj * HALF) = w; } } }
    }
};
}

struct Args { const float* in[20]; float* out; unsigned char* ws; int ph_lo, ph_hi; };
struct Frame {
    LAS unsigned char* lds; int tid, lane, wave, G, vcu;
    const float *x, *w_in, *sgu_w, *sgu_b, *sgu_ln_g, *sgu_ln_b, *mix_g, *w_out, *ln1_g, *ln1_b, *w_router, *b_router, *w_gate, *b_gate, *w_up, *b_up, *w_down, *b_down, *ln2_g, *ln2_b;
    float* out; unsigned char* ws;
    unsigned* ctl; int* list; float* gates; bf16_t *Win_t, *Wout_t, *Wd_t, *Wgu_t, *Y, *Hb, *Xb, *P1, *Amix, *Act; float *Araw, *Braw;
};

__device__ __forceinline__ void transpose_item(const float* W, int N, int K, int k0, int n0, bf16_t* WT, size_t dst_row0, LAS float* scr, int lane) {
#pragma unroll 8
    for (int i = 0; i < 32; ++i) { const int kk = 2 * i + (lane >> 5); scr[kk * 33 + (lane & 31)] = W[(size_t)(k0 + kk) * N + n0 + (lane & 31)]; }
    asm volatile("s_waitcnt lgkmcnt(0)" ::: "memory");
    const int c = lane & 7;
#pragma unroll
    for (int j = 0; j < 4; ++j) { const int n = (lane >> 3) + 8 * j; const LAS float* s = scr + (8 * c) * 33 + n;
        u32x4 o; o.x = cvt_pk_bf16(s[0 * 33], s[1 * 33]); o.y = cvt_pk_bf16(s[2 * 33], s[3 * 33]); o.z = cvt_pk_bf16(s[4 * 33], s[5 * 33]); o.w = cvt_pk_bf16(s[6 * 33], s[7 * 33]);
        *(u32x4*)(WT + (dst_row0 + n) * K + k0 + 8 * c) = o; }
    asm volatile("s_waitcnt lgkmcnt(0)" ::: "memory");
}
__device__ __forceinline__ void p0_convert(Frame& F) {
    LAS float* scr = (LAS float*)(F.lds + F.wave * 16384);
    const int gw = F.vcu * 8 + F.wave, NGW = F.G * 8;
    constexpr int I_IN = (D / 64) * (INC / 32), I_OUT = (D / 64) * (D / 32), I_E = (D / 64) * (FF / 32);
    constexpr int NITEMS = I_IN + I_OUT + NE * 3 * I_E;
    for (int it = gw; it < NITEMS; it += NGW) {
        int r = it;
        if (r < I_IN) { const int kb = r / (INC / 32), nb = r % (INC / 32); transpose_item(F.w_in, INC, D, 64 * kb, 32 * nb, F.Win_t, (size_t)32 * nb, scr, F.lane); continue; } r -= I_IN;
        if (r < I_OUT) { const int kb = r / (D / 32), nb = r % (D / 32); transpose_item(F.w_out, D, D, 64 * kb, 32 * nb, F.Wout_t, (size_t)32 * nb, scr, F.lane); continue; } r -= I_OUT;
        const int e = r / (3 * I_E), q = r % (3 * I_E), which = q / I_E, ii = q % I_E, kb = ii / 32, nb = ii % 32, n0 = 32 * nb;
        if (which == 0) transpose_item(F.w_gate + (size_t)e * D * FF, FF, D, 64 * kb, n0, F.Wgu_t, (size_t)e * 2048 + (n0 >> 7) * 256 + (n0 & 127), scr, F.lane);
        else if (which == 1) transpose_item(F.w_up + (size_t)e * D * FF, FF, D, 64 * kb, n0, F.Wgu_t, (size_t)e * 2048 + (n0 >> 7) * 256 + 128 + (n0 & 127), scr, F.lane);
        else transpose_item(F.w_down + (size_t)e * FF * D, D, FF, 64 * kb, n0, F.Wd_t, (size_t)e * 1024 + n0, scr, F.lane);
    }
    const size_t nchunk = (size_t)T * D / 8;
    for (size_t i = (size_t)blockIdx.x * 512 + F.tid; i < nchunk; i += (size_t)F.G * 512) {
        const f32x4 a = *(const f32x4*)(F.x + i * 8), b = *(const f32x4*)(F.x + i * 8 + 4);
        u32x4 w; w.x = cvt_pk_bf16(a[0], a[1]); w.y = cvt_pk_bf16(a[2], a[3]); w.z = cvt_pk_bf16(b[0], b[1]); w.w = cvt_pk_bf16(b[2], b[3]);
        *(u32x4*)(F.Xb + i * 8) = w; }
}

__device__ __forceinline__ void p2_sgu(Frame& F) {
    LAS float* vn = (LAS float*)F.lds;
    const int tl = F.tid >> 2, cq = F.tid & 3;
    for (int unit = blockIdx.x; unit < BATCH * (SEQ / CHUNK) * NGRP; unit += F.G) {
        const int g = unit & 7, bn = unit >> 3; const size_t row = (size_t)bn * CHUNK + tl;
        const bf16_t* vp = F.P1 + row * INC + AW + g * GD + cq * 16;
        const u32x4 r0 = *(const u32x4*)vp, r1 = *(const u32x4*)(vp + 8);
        float v[16]; { const unsigned w[8] = {r0.x, r0.y, r0.z, r0.w, r1.x, r1.y, r1.z, r1.w};
#pragma unroll
            for (int j = 0; j < 8; ++j) { v[2 * j] = bf_lo(w[j]); v[2 * j + 1] = bf_hi(w[j]); } }
        float s = 0.f;
#pragma unroll
        for (int j = 0; j < 16; ++j) s += v[j];
        s += __shfl_xor(s, 1); s += __shfl_xor(s, 2); const float mu = s * (1.f / 64.f); float q = 0.f;
#pragma unroll
        for (int j = 0; j < 16; ++j) { v[j] -= mu; q += v[j] * v[j]; }
        q += __shfl_xor(q, 1); q += __shfl_xor(q, 2); const float rstd = 1.0f / sqrtf(q * (1.f / 64.f) + LN_EPS);
#pragma unroll
        for (int j = 0; j < 16; ++j) { const int c = g * GD + cq * 16 + j; vn[tl * 68 + cq * 16 + j] = v[j] * rstd * F.sgu_ln_g[c] + F.sgu_ln_b[c]; }
        __syncthreads();
        float acc[16];
#pragma unroll
        for (int j = 0; j < 16; ++j) acc[j] = 0.f;
        const float* wrow = F.sgu_w + ((size_t)g * CHUNK + tl) * CHUNK;
        for (int sI = 0; sI <= tl; ++sI) { const float wv = wrow[sI]; const LAS f32x4* vr = (const LAS f32x4*)(vn + sI * 68 + cq * 16);
#pragma unroll
            for (int j4 = 0; j4 < 4; ++j4) { const f32x4 x = vr[j4]; acc[4 * j4] += wv * x[0]; acc[4 * j4 + 1] += wv * x[1]; acc[4 * j4 + 2] += wv * x[2]; acc[4 * j4 + 3] += wv * x[3]; } }
        const float bs = F.sgu_b[g * CHUNK + tl];
        const bf16_t* up = F.P1 + row * INC + g * GD + cq * 16;
        const u32x4 u0 = *(const u32x4*)up, u1 = *(const u32x4*)(up + 8); const unsigned uw[8] = {u0.x, u0.y, u0.z, u0.w, u1.x, u1.y, u1.z, u1.w};
        float* op = F.Araw + row * AW + g * GD + cq * 16;
#pragma unroll
        for (int j = 0; j < 8; ++j) { op[2 * j] = bf_lo(uw[j]) * (acc[2 * j] + bs); op[2 * j + 1] = bf_hi(uw[j]) * (acc[2 * j + 1] + bs); }
        __syncthreads();
    }
}

__device__ __forceinline__ void p2_attn(Frame& F) {
    for (int unit = blockIdx.x; unit < BATCH * NH * (SEQ / 512); unit += F.G) {
        const int tb = unit & 7, h = (unit >> 3) & 7, b = unit >> 6; const int t = tb * 512 + F.tid;
        const bf16_t* base = F.P1 + (size_t)b * SEQ * INC + h * HD;
        float q[64], o[64];
        { const bf16_t* qp = base + (size_t)t * INC + 1024;
#pragma unroll
          for (int c = 0; c < 8; ++c) { const u32x4 r = *(const u32x4*)(qp + 8 * c); const unsigned w[4] = {r.x, r.y, r.z, r.w};
#pragma unroll
              for (int j = 0; j < 4; ++j) { q[8 * c + 2 * j] = bf_lo(w[j]) * (0.125f * 1.4426950408889634f); q[8 * c + 2 * j + 1] = bf_hi(w[j]) * (0.125f * 1.4426950408889634f); } } }
#pragma unroll
        for (int j = 0; j < 64; ++j) o[j] = 0.f;
        float m = -INFINITY, l = 0.f;
        for (int p = 0; p < 3; ++p) { const int d = (p == 0) ? 1 : (p == 1) ? 4 : 16;
            for (int j = 0; j <= 128; ++j) { const int kp = t - j * d; if (kp < 0) break;
                const bf16_t* kr = base + (size_t)kp * INC + 1536; const bf16_t* vr = base + (size_t)kp * INC + 2048;
                float s = 0.f;
#pragma unroll
                for (int c = 0; c < 8; ++c) { const u32x4 r = *(const u32x4*)(kr + 8 * c); const unsigned w[4] = {r.x, r.y, r.z, r.w};
#pragma unroll
                    for (int jj = 0; jj < 4; ++jj) { s += q[8 * c + 2 * jj] * bf_lo(w[jj]); s += q[8 * c + 2 * jj + 1] * bf_hi(w[jj]); } }
                const float mn = fmaxf(m, s), corr = __builtin_amdgcn_exp2f(m - mn), pw = __builtin_amdgcn_exp2f(s - mn);
                l = l * corr + pw; m = mn;
#pragma unroll
                for (int c = 0; c < 8; ++c) { const u32x4 r = *(const u32x4*)(vr + 8 * c); const unsigned w[4] = {r.x, r.y, r.z, r.w};
#pragma unroll
                    for (int jj = 0; jj < 4; ++jj) { o[8 * c + 2 * jj] = o[8 * c + 2 * jj] * corr + pw * bf_lo(w[jj]); o[8 * c + 2 * jj + 1] = o[8 * c + 2 * jj + 1] * corr + pw * bf_hi(w[jj]); } }
            } }
        const float il = 1.0f / l; float* op = F.Braw + ((size_t)b * SEQ + t) * AW + h * HD;
#pragma unroll
        for (int j = 0; j < 16; ++j) *(f32x4*)(op + 4 * j) = (f32x4){o[4 * j] * il, o[4 * j + 1] * il, o[4 * j + 2] * il, o[4 * j + 3] * il};
    }
}

__device__ __forceinline__ void p2_mix(Frame& F) {
    const int gw = blockIdx.x * 8 + F.wave, NGW = F.G * 8;
    for (int row = gw; row < T; row += NGW) {
        const float* ap = F.Araw + (size_t)row * AW + F.lane * 8; const float* bp = F.Braw + (size_t)row * AW + F.lane * 8;
        const f32x4 a0 = *(const f32x4*)ap, a1 = *(const f32x4*)(ap + 4), b0 = *(const f32x4*)bp, b1 = *(const f32x4*)(bp + 4);
        float sa = 0.f, sb = 0.f;
#pragma unroll
        for (int j = 0; j < 4; ++j) { sa += a0[j] * a0[j] + a1[j] * a1[j]; sb += b0[j] * b0[j] + b1[j] * b1[j]; }
        sa = wave_sum(sa); sb = wave_sum(sb);
        const float ra = 1.0f / sqrtf(sa * (1.f / AW) + LN_EPS), rb = 1.0f / sqrtf(sb * (1.f / AW) + LN_EPS);
        const f32x4 ga0 = *(const f32x4*)(F.mix_g + F.lane * 8), ga1 = *(const f32x4*)(F.mix_g + F.lane * 8 + 4), gb0 = *(const f32x4*)(F.mix_g + AW + F.lane * 8), gb1 = *(const f32x4*)(F.mix_g + AW + F.lane * 8 + 4);
        const f32x4 x0 = a0 * ra * ga0, x1 = a1 * ra * ga1, y0 = b0 * rb * gb0, y1 = b1 * rb * gb1;
        u32x4 w; w.x = cvt_pk_bf16(x0[0], x0[1]); w.y = cvt_pk_bf16(x0[2], x0[3]); w.z = cvt_pk_bf16(x1[0], x1[1]); w.w = cvt_pk_bf16(x1[2], x1[3]);
        *(u32x4*)(F.Amix + (size_t)row * D + F.lane * 8) = w;
        w.x = cvt_pk_bf16(y0[0], y0[1]); w.y = cvt_pk_bf16(y0[2], y0[3]); w.z = cvt_pk_bf16(y1[0], y1[1]); w.w = cvt_pk_bf16(y1[2], y1[3]);
        *(u32x4*)(F.Amix + (size_t)row * D + AW + F.lane * 8) = w;
    }
}

__device__ __forceinline__ void p4_route(Frame& F) {
    LAS float* wr = (LAS float*)F.lds;
    LAS int* sel_e = (LAS int*)(F.lds + RING_BYTES);
    LAS float* sel_g = (LAS float*)(F.lds + RING_BYTES + 1024);
    LAS int* lcnt = (LAS int*)(F.lds + RING_BYTES + 2048);
    LAS int* lbase = (LAS int*)(F.lds + RING_BYTES + 2048 + 128);
    for (int i = F.tid; i < D * 8; i += 512) { const int k = i >> 3, c = i & 7; const f32x4 v = *(const f32x4*)(F.w_router + (size_t)k * NE + 4 * c); *(LAS f32x4*)(wr + k * 32 + 4 * (c ^ ((k >> 1) & 7))) = v; }
    if (F.tid < 32) lcnt[F.tid] = 0;
    __syncthreads();
    const int sw = (F.lane >> 1) & 7;
    for (int chunk = blockIdx.x; chunk < T / 64; chunk += F.G) {
        for (int it = 0; it < 8; ++it) {
            const int tl = F.wave * 8 + it, row = chunk * 64 + tl;
            float* zp = F.out + (size_t)row * D;
            float h[16]; float s = 0.f;
#pragma unroll
            for (int qd = 0; qd < 16; ++qd) { h[qd] = zp[F.lane + 64 * qd]; s += h[qd]; }
            const float mu = wave_sum(s) * (1.f / D); float q = 0.f;
#pragma unroll
            for (int qd = 0; qd < 16; ++qd) { h[qd] -= mu; q += h[qd] * h[qd]; }
            const float rstd = 1.0f / sqrtf(wave_sum(q) * (1.f / D) + LN_EPS);
#pragma unroll
            for (int qd = 0; qd < 16; ++qd) { const int k = F.lane + 64 * qd; h[qd] = h[qd] * rstd * F.ln1_g[k] + F.ln1_b[k]; zp[k] = h[qd]; F.Hb[(size_t)row * D + k] = (bf16_t)(cvt_pk_bf16(h[qd], 0.f) & 0xffffu); }
            float lg[32];
#pragma unroll
            for (int e = 0; e < 32; ++e) lg[e] = 0.f;
#pragma unroll
            for (int qd = 0; qd < 16; ++qd) { const LAS float* rp = wr + (F.lane + 64 * qd) * 32;
#pragma unroll
                for (int c = 0; c < 8; ++c) { const f32x4 w = *(const LAS f32x4*)(rp + 4 * (c ^ sw)); lg[4 * c] += h[qd] * w[0]; lg[4 * c + 1] += h[qd] * w[1]; lg[4 * c + 2] += h[qd] * w[2]; lg[4 * c + 3] += h[qd] * w[3]; } }
#pragma unroll
            for (int e = 0; e < 32; ++e) lg[e] = wave_sum(lg[e]) + F.b_router[e];
            int idx[4]; float val[4]; unsigned taken = 0u;
#pragma unroll
            for (int r = 0; r < 4; ++r) { float best = -INFINITY; int bi = 0;
#pragma unroll
                for (int e = 0; e < 32; ++e) { const bool ok = !((taken >> e) & 1u) && (lg[e] > best); best = ok ? lg[e] : best; bi = ok ? e : bi; }
                idx[r] = bi; val[r] = best; taken |= 1u << bi; }
            const float e1 = __expf(val[1] - val[0]), e2 = __expf(val[2] - val[0]), e3 = __expf(val[3] - val[0]); const float inv = 1.0f / (1.0f + e1 + e2 + e3);
            if (F.lane == 0) { sel_e[tl * 4 + 0] = idx[0]; sel_e[tl * 4 + 1] = idx[1]; sel_e[tl * 4 + 2] = idx[2]; sel_e[tl * 4 + 3] = idx[3];
                sel_g[tl * 4 + 0] = inv; sel_g[tl * 4 + 1] = e1 * inv; sel_g[tl * 4 + 2] = e2 * inv; sel_g[tl * 4 + 3] = e3 * inv; }
        }
        __syncthreads();
        int myrank = 0, mye = 0;
        if (F.tid < 256) { mye = sel_e[F.tid]; myrank = atomicAdd((int*)&lcnt[mye], 1); }
        __syncthreads();
        if (F.tid < 32) { const int c = lcnt[F.tid]; lbase[F.tid] = c ? (int)__hip_atomic_fetch_add(F.ctl + CW_CNT + F.tid, (unsigned)c, __ATOMIC_RELAXED, __HIP_MEMORY_SCOPE_AGENT) : 0; lcnt[F.tid] = 0; }
        __syncthreads();
        if (F.tid < 256) { const int slot = (chunk * 64 + (F.tid >> 2)) * 4 + (F.tid & 3); F.list[mye * T + lbase[mye] + myrank] = slot; F.gates[slot] = sel_g[F.tid]; }
        __syncthreads();
    }
}

template <bool G1> __device__ __forceinline__ int moe_tables(Frame& F, int NPN) {
    LAS int* cnt = (LAS int*)(F.lds + TAB_OFF); LAS int* tstart = cnt + 32; LAS int* rowtab = (LAS int*)(F.lds + ROWTAB_OFF);
    if (F.tid < 32) cnt[F.tid] = (int)__hip_atomic_load(F.ctl + CW_CNT + F.tid, __ATOMIC_RELAXED, __HIP_MEMORY_SCOPE_AGENT);
    __syncthreads();
    if (F.tid == 0) { int acc = 0; for (int e = 0; e < NE; ++e) { tstart[e] = acc; acc += (cnt[e] + 255) >> 8; } tstart[NE] = acc; }
    __syncthreads();
    const int ntiles = tstart[NE], nU = ntiles * NPN;
    for (int i = 0; i < MAXU; ++i) { const int L = i * F.G + F.vcu; if (L >= nU) break;
        const int tl = L / NPN; int e = 0;
        for (int j = 1; j < NE; ++j) e += (tstart[j] <= tl) ? 1 : 0;
        const int mt = tl - tstart[e];
        if (F.tid < 256) { const int rank = mt * 256 + F.tid; const int slot = rank < cnt[e] ? F.list[e * T + rank] : -1;
            rowtab[i * 256 + F.tid] = G1 ? ((slot < 0 ? 0 : (slot >> 2)) * (D * 2)) : slot; } }
    __syncthreads();
    return ntiles;
}

__device__ __forceinline__ void p7_final(Frame& F) {
    const int gw = blockIdx.x * 8 + F.wave, NGW = F.G * 8;
    for (int row = gw; row < T; row += NGW) {
        float* hp = F.out + (size_t)row * D; float v[16];
#pragma unroll
        for (int j = 0; j < 2; ++j) { const f32x4 a = *(const f32x4*)(hp + 512 * j + F.lane * 8), b = *(const f32x4*)(hp + 512 * j + F.lane * 8 + 4);
#pragma unroll
            for (int i = 0; i < 4; ++i) { v[8 * j + i] = a[i] * DN_ALPHA; v[8 * j + 4 + i] = b[i] * DN_ALPHA; } }
#pragma unroll
        for (int k = 0; k < TOPK; ++k)
#pragma unroll
            for (int j = 0; j < 2; ++j) { const u32x4 r = *(const u32x4*)(F.Y + ((size_t)row * TOPK + k) * D + 512 * j + F.lane * 8); const unsigned w[4] = {r.x, r.y, r.z, r.w};
#pragma unroll
                for (int i = 0; i < 4; ++i) { v[8 * j + 2 * i] += bf_lo(w[i]); v[8 * j + 2 * i + 1] += bf_hi(w[i]); } }
        float s = 0.f;
#pragma unroll
        for (int i = 0; i < 16; ++i) s += v[i];
        const float mu = wave_sum(s) * (1.f / D); float q = 0.f;
#pragma unroll
        for (int i = 0; i < 16; ++i) { v[i] -= mu; q += v[i] * v[i]; }
        const float rstd = 1.0f / sqrtf(wave_sum(q) * (1.f / D) + LN_EPS);
#pragma unroll
        for (int j = 0; j < 2; ++j) { const int c = 512 * j + F.lane * 8;
            const f32x4 g0 = *(const f32x4*)(F.ln2_g + c), g1 = *(const f32x4*)(F.ln2_g + c + 4), b0 = *(const f32x4*)(F.ln2_b + c), b1 = *(const f32x4*)(F.ln2_b + c + 4);
            f32x4 o0, o1;
#pragma unroll
            for (int i = 0; i < 4; ++i) { o0[i] = v[8 * j + i] * rstd * g0[i] + b0[i]; o1[i] = v[8 * j + 4 + i] * rstd * g1[i] + b1[i]; }
            *(f32x4*)(hp + c) = o0; *(f32x4*)(hp + c + 4) = o1; }
    }
}

constexpr int N_PHASES = 8;
__global__ void __launch_bounds__(512, 2) mk_fwd(Args args) {
    extern __shared__ __attribute__((aligned(16))) unsigned char lds_raw[];
    Frame F;
    F.lds = (LAS unsigned char*)lds_raw; F.tid = threadIdx.x; F.lane = F.tid & 63; F.wave = __builtin_amdgcn_readfirstlane(F.tid >> 6);
    F.G = gridDim.x; { const int bx = blockIdx.x; F.vcu = (F.G % 8 == 0) ? (bx % 8) * (F.G / 8) + bx / 8 : bx; }
    F.x = args.in[0]; F.w_in = args.in[1]; F.sgu_w = args.in[2]; F.sgu_b = args.in[3]; F.sgu_ln_g = args.in[4]; F.sgu_ln_b = args.in[5]; F.mix_g = args.in[6]; F.w_out = args.in[7];
    F.ln1_g = args.in[8]; F.ln1_b = args.in[9]; F.w_router = args.in[10]; F.b_router = args.in[11]; F.w_gate = args.in[12]; F.b_gate = args.in[13]; F.w_up = args.in[14]; F.b_up = args.in[15];
    F.w_down = args.in[16]; F.b_down = args.in[17]; F.ln2_g = args.in[18]; F.ln2_b = args.in[19]; F.out = args.out; F.ws = args.ws;
    unsigned char* ws = args.ws;
    F.ctl = (unsigned*)(ws + WS_CTL); F.list = (int*)(ws + WS_LIST); F.gates = (float*)(ws + WS_GATES);
    F.Win_t = (bf16_t*)(ws + WS_WIN); F.Wout_t = (bf16_t*)(ws + WS_WOUT); F.Wd_t = (bf16_t*)(ws + WS_WD); F.Wgu_t = (bf16_t*)(ws + WS_WGU); F.Y = (bf16_t*)(ws + WS_Y);
    F.Hb = (bf16_t*)(ws + WS_HB); F.Xb = (bf16_t*)(ws + WS_XB); F.P1 = (bf16_t*)(ws + WS_P1); F.Amix = (bf16_t*)(ws + WS_AMIX); F.Act = (bf16_t*)(ws + WS_ACT);
    F.Araw = (float*)(ws + WS_RAW); F.Braw = F.Araw + (size_t)T * AW;
    const int lo = args.ph_lo, hi = args.ph_hi;
    const LAS int* rowtab = (const LAS int*)(F.lds + ROWTAB_OFF);
#define IN(k) (lo <= (k) && (k) < hi)
#define SEAM(k) do { if (IN(k) && IN((k) + 1)) { cg::this_grid().sync(); } } while (0)
    if (IN(0)) { p0_convert(F); }
    SEAM(0);
    if (IN(1)) { pg8::Gemm g{F.Xb, F.Win_t, D}; pg8::DenseOrder S{INC / 256, (T / 256) * (INC / 256), F.G, F.vcu}; pg8::EpiP1 E{F.P1};
        pg8::gemm_phase<pg8::EpiP1, pg8::DenseOrder, false>(F.lds, rowtab, g, S, E); }
    SEAM(1);
    if (IN(2)) { p2_sgu(F); p2_attn(F); }
    SEAM(2);
    if (IN(3)) { p2_mix(F); }
    SEAM(3);
    if (IN(4)) { pg8::Gemm g{F.Amix, F.Wout_t, D}; pg8::DenseOrder S{D / 256, (T / 256) * (D / 256), F.G, F.vcu}; pg8::EpiZ E{F.x, F.out};
        pg8::gemm_phase<pg8::EpiZ, pg8::DenseOrder, false>(F.lds, rowtab, g, S, E); }
    SEAM(4);
    if (IN(5)) { p4_route(F); }
    SEAM(5);
    if (IN(6)) { const int ntiles = moe_tables<true>(F, 8); pg8::Gemm g{F.Hb, F.Wgu_t, D}; pg8::MoeOrder S{8, ntiles * 8, F.G, F.vcu, (const LAS int*)(F.lds + TAB_OFF) + 32};
        pg8::EpiSwiglu E{F.Act, F.b_gate, F.b_up};
        pg8::gemm_phase<pg8::EpiSwiglu, pg8::MoeOrder, true>(F.lds, rowtab, g, S, E); }
    SEAM(6);
    if (IN(7)) { const int ntiles = moe_tables<false>(F, 4); pg8::Gemm g{F.Act, F.Wd_t, FF}; pg8::MoeOrder S{4, ntiles * 4, F.G, F.vcu, (const LAS int*)(F.lds + TAB_OFF) + 32};
        pg8::EpiScatter E{F.Y, F.b_down, F.gates, rowtab};
        pg8::gemm_phase<pg8::EpiScatter, pg8::MoeOrder, false>(F.lds, rowtab, g, S, E); }
    SEAM(7);
    if (IN(8)) { p7_final(F); }
#undef IN
#undef SEAM
}

extern "C" void kernel_launch(void* const* d_in, const int* in_sizes, int n_in, void* d_out, int out_size, void* d_ws, size_t ws_size, hipStream_t stream) {
    static int grid = 0;
    if (grid == 0) {
        if (n_in != 20 || in_sizes[0] != T * D || out_size != T * D || ws_size < WS_END) { fprintf(stderr, "kernel_launch: unexpected shapes (n_in %d, in0 %d, out %d, ws %zu)\n", n_in, n_in > 0 ? in_sizes[0] : -1, out_size, ws_size); grid = -1; return; }
        int dev = 0, cus = 0, per_cu = 0;
        hipGetDevice(&dev); hipDeviceGetAttribute(&cus, hipDeviceAttributeMultiprocessorCount, dev);
        if (hipFuncSetAttribute((const void*)mk_fwd, hipFuncAttributeMaxDynamicSharedMemorySize, LDS_BYTES) != hipSuccess) { fprintf(stderr, "kernel_launch: hipFuncSetAttribute failed\n"); grid = -1; return; }
        hipOccupancyMaxActiveBlocksPerMultiprocessor(&per_cu, (const void*)mk_fwd, 512, LDS_BYTES);
        (void)hipGetLastError();
        if (per_cu < 1) { fprintf(stderr, "kernel_launch: occupancy query says %d blocks/CU\n", per_cu); per_cu = 1; }
        grid = cus;
        if (grid != 256) fprintf(stderr, "kernel_launch: note: %d CUs (tuned for 256)\n", grid);
    }
    if (grid < 0) return;
    hipMemsetAsync((char*)d_ws + WS_CTL, 0, CTL_ZERO_BYTES, stream);
    Args a{};
    for (int i = 0; i < 20; ++i) a.in[i] = (const float*)d_in[i];
    a.out = (float*)d_out; a.ws = (unsigned char*)d_ws;
#if MK_N_LAUNCHES == 1
    a.ph_lo = 0; a.ph_hi = N_PHASES + 1;
    void* kargs[] = {&a};
    hipError_t e = hipLaunchCooperativeKernel((const void*)mk_fwd, dim3(grid), dim3(512), kargs, LDS_BYTES, stream);
    if (e != hipSuccess) fprintf(stderr, "cooperative launch failed: %s (grid %d)\n", hipGetErrorString(e), grid);
#else
    for (int p = 0; p <= N_PHASES; ++p) { a.ph_lo = p; a.ph_hi = p + 1; hipLaunchKernelGGL(mk_fwd, dim3(grid), dim3(512), LDS_BYTES, stream, a); }
#endif
}
```

```cpp
#include <hip/hip_runtime.h>
#include <hip/hip_cooperative_groups.h>
#include <cstdio>
#include <cstdint>
namespace cg = cooperative_groups;

#ifndef MK_N_LAUNCHES
#define MK_N_LAUNCHES 1
#endif

constexpr int BATCH = 4, SEQ = 4096, T = BATCH * SEQ, D = 1024, INC = 2560, NE = 32, FF = 1024, TOPK = 4;
constexpr int AW = 512, NGRP = 8, GD = 64, CHUNK = 128, NH = 8, HD = 64;
constexpr float LN_EPS = 1e-5f, DN_ALPHA = 1.189207115002721f;
constexpr int NSLOT = T * TOPK;
constexpr int MAXTILES = 288;
constexpr int MAXU = 12;

constexpr size_t MiB = 1u << 20;
constexpr size_t WS_CTL = 0, CTL_ZERO_BYTES = 64 * 1024;
constexpr size_t WS_LIST = 1 * MiB;
constexpr size_t WS_GATES = 3 * MiB;
constexpr size_t WS_WIN = 4 * MiB;
constexpr size_t WS_WOUT = 9 * MiB;
constexpr size_t WS_WD = 11 * MiB;
constexpr size_t WS_WGU = 75 * MiB;
constexpr size_t WS_Y = WS_WGU;
constexpr size_t WS_HB = 203 * MiB;
constexpr size_t WS_BIG = 235 * MiB;
constexpr size_t WS_XB = WS_BIG;
constexpr size_t WS_P1 = WS_BIG + 32 * MiB;
constexpr size_t WS_AMIX = WS_BIG + 112 * MiB;
constexpr size_t WS_ACT = WS_BIG;
constexpr size_t WS_OPART = 379 * MiB;
constexpr size_t WS_ML = 427 * MiB;
constexpr size_t WS_END = 430 * MiB;
constexpr int CW_CNT = 0;

constexpr int RING_BYTES = 131072;
constexpr int TAB_OFF = RING_BYTES + 1024;
constexpr int ROWTAB_OFF = RING_BYTES + 2048;
constexpr int LDS_BYTES = 147456;
static_assert(ROWTAB_OFF + MAXU * 1024 <= LDS_BYTES, "LDS map");

#define LAS __attribute__((address_space(3)))
typedef unsigned short bf16_t;
typedef short bf16x8 __attribute__((ext_vector_type(8)));
typedef float f32x4 __attribute__((ext_vector_type(4)));
typedef float f32x2 __attribute__((ext_vector_type(2)));
typedef unsigned u32x4 __attribute__((ext_vector_type(4)));
typedef unsigned u32x2 __attribute__((ext_vector_type(2)));

__device__ __forceinline__ unsigned cvt_pk_bf16(float lo, float hi) { unsigned r; asm volatile("v_cvt_pk_bf16_f32 %0, %1, %2" : "=v"(r) : "v"(lo), "v"(hi)); return r; }
__device__ __forceinline__ float bf_lo(unsigned w) { return __uint_as_float(w << 16); }
__device__ __forceinline__ float bf_hi(unsigned w) { return __uint_as_float(w & 0xffff0000u); }
__device__ __forceinline__ float bf1(bf16_t b) { return __uint_as_float((unsigned)b << 16); }
__device__ __forceinline__ float wave_sum(float v) {
#pragma unroll
    for (int o = 1; o < 64; o <<= 1) v += __shfl_xor(v, o);
    return v;
}
__device__ __forceinline__ float gelu_tanh(float x) {
    const float y2 = x * (1.5957691216057308f + 0.07135481627260025f * x * x);
    return x * __builtin_amdgcn_rcpf(1.0f + __builtin_amdgcn_exp2f(-1.4426950408889634f * y2));
}

namespace pg8 {
constexpr int BM = 256, BK = 64, HALF = 128, HTB = HALF * BK * 2, STAGE_BYTES = 8 * HTB;
__host__ __device__ __forceinline__ int lds_byte(int r, int c) { const int st = (r >> 4) * 2 + (c >> 5), rr = r & 15, cc = c & 31, ob = rr * 64 + cc * 2; return st * 1024 + (ob ^ (((ob >> 9) & 1) << 5)); }
__host__ __device__ __forceinline__ void stage_rc(int b, int& R, int& C) { const int st = b / 1024, sb = b % 1024, swz = sb ^ (((sb >> 9) & 1) << 5); R = (st >> 1) * 16 + swz / 64; C = (st & 1) * 32 + (swz % 64) / 2; }
__host__ __device__ __forceinline__ int perm32(int rho) { const int n = rho >> 4, i = rho & 15; return 8 * (i >> 2) + 4 * n + (i & 3); }

struct Unit { int pm, pn, pb, e, mt, ui; };
struct Gemm { const bf16_t* A; const bf16_t* Bt; int K; };

struct DenseOrder {
    int nN, nU, G, v;
    __device__ __forceinline__ bool next(int i, Unit& u) const {
        const int L = i * G + v; if (L >= nU) return false;
        u.pm = L / nN; u.pn = L % nN; u.pb = u.pn; u.e = 0; u.mt = 0; u.ui = i; return true; }
};
struct MoeOrder {
    int NPN, nU, G, v; const LAS int* tstart;
    __device__ __forceinline__ bool next(int i, Unit& u) const {
        const int L = i * G + v; if (L >= nU) return false;
        const int tl = L / NPN, pn = L % NPN; int e = 0;
#pragma unroll
        for (int j = 1; j < NE; ++j) e += (tstart[j] <= tl) ? 1 : 0;
        u.pm = tl; u.pn = pn; u.pb = e * NPN + pn; u.e = e; u.mt = tl - tstart[e]; u.ui = i; return true; }
};

template <class Epi, class Sched, bool GATHER>
__device__ __forceinline__ void gemm_phase(LAS unsigned char* lds, const LAS int* rowtab, const Gemm g, const Sched& S, const Epi& E) {
    const int tid = threadIdx.x, wid = __builtin_amdgcn_readfirstlane(tid >> 6), lane = tid & 63, wr = wid >> 2, wc = wid & 3, fr = lane & 15, fq = lane >> 4;
    const int K = g.K, nt = K / BK;
    unsigned voffA0[2], voffA1[2], voffB[2]; int Rr[2], Cc[2];
#pragma unroll
    for (int i = 0; i < 2; ++i) { int R, C; stage_rc(tid * 16 + i * 8192, R, C); const int Rb = Epi::PERM ? ((R & ~31) + perm32(R & 31)) : R; Rr[i] = R; Cc[i] = C;
        voffA0[i] = (unsigned)(R * K + C) * 2u; voffA1[i] = (unsigned)((R + HALF) * K + C) * 2u; voffB[i] = (unsigned)(Rb * K + C) * 2u; }
    const size_t kstep = (size_t)(BK * 2);
    const size_t hstep = (size_t)HALF * K * 2;
    const size_t tstep = 2 * hstep;
    const unsigned ldsw = (unsigned)wid * 1024u;
    const int aoff = lds_byte(wr * 64 + fr, fq * 8), boff = lds_byte(wc * 32 + fr, fq * 8);
#define PG8_SA(b, h) (((b) * 2 + (h)) * HTB)
#define PG8_SB(b, h) ((4 + (b) * 2 + (h)) * HTB)
#define PG8_STAGE(bufoff, gbase, voff) do { _Pragma("unroll") for (int _i = 0; _i < 2; ++_i) \
        __builtin_amdgcn_global_load_lds((const unsigned*)((const char*)(gbase) + (voff)[_i]), (LAS unsigned*)(lds + (bufoff) + ldsw + _i * 8192), 16, 0, 0); } while (0)
#define PG8_LDA(dst, b, h) do { _Pragma("unroll") for (int m = 0; m < 4; ++m) _Pragma("unroll") for (int k = 0; k < 2; ++k) dst[m][k] = *(const LAS bf16x8*)(lds + PG8_SA(b, h) + aoff + m * 2048 + k * 1024); } while (0)
#define PG8_LDB(dst, b, h) do { _Pragma("unroll") for (int n = 0; n < 2; ++n) _Pragma("unroll") for (int k = 0; k < 2; ++k) dst[n][k] = *(const LAS bf16x8*)(lds + PG8_SB(b, h) + boff + n * 2048 + k * 1024); } while (0)
#define PG8_MMA(ai, bj, At, Bt) do { __builtin_amdgcn_s_setprio(1); _Pragma("unroll") for (int m = 0; m < 4; ++m) _Pragma("unroll") for (int n = 0; n < 2; ++n) _Pragma("unroll") for (int k = 0; k < 2; ++k) \
        acc[ai][bj][m][n] = __builtin_amdgcn_mfma_f32_16x16x32_bf16(Bt[n][k], At[m][k], acc[ai][bj][m][n], 0, 0, 0); __builtin_amdgcn_s_setprio(0); } while (0)
#define PG8_WAIT_V(n) asm volatile("s_waitcnt vmcnt(" #n ")" ::: "memory")
#define PG8_WAIT_L(n) asm volatile("s_waitcnt lgkmcnt(" #n ")" ::: "memory")
#define PG8_BAR __builtin_amdgcn_s_barrier()
#define PG8_SCHED __builtin_amdgcn_sched_barrier(0)
#define PG8_LOADROWS(U) do { if constexpr (GATHER) { _Pragma("unroll") for (int _i = 0; _i < 2; ++_i) { \
        voffA0[_i] = (unsigned)rowtab[(U).ui * 256 + Rr[_i]] + (unsigned)Cc[_i] * 2u; voffA1[_i] = (unsigned)rowtab[(U).ui * 256 + HALF + Rr[_i]] + (unsigned)Cc[_i] * 2u; } } } while (0)
    Unit cur, nxt; int ui = 0;
    if (!S.next(0, cur)) return;
    f32x4 acc[2][2][4][2];
#pragma unroll
    for (int a = 0; a < 2; ++a)
#pragma unroll
        for (int b = 0; b < 2; ++b)
#pragma unroll
            for (int m = 0; m < 4; ++m)
#pragma unroll
                for (int n = 0; n < 2; ++n) acc[a][b][m][n] = (f32x4){0.f, 0.f, 0.f, 0.f};
    bf16x8 At[4][2], B0[2][2], B1[2][2];
    const char* cA = GATHER ? (const char*)g.A : (const char*)g.A + (size_t)cur.pm * tstep; const char* cB = (const char*)g.Bt + (size_t)cur.pb * tstep;
    PG8_LOADROWS(cur); PG8_WAIT_L(0);
    PG8_STAGE(PG8_SB(0, 0), cB, voffB); PG8_STAGE(PG8_SB(0, 1), cB + hstep, voffB); PG8_STAGE(PG8_SA(0, 0), cA, voffA0); PG8_STAGE(PG8_SA(0, 1), cA, voffA1);
    if (wr == 1) PG8_BAR;
    PG8_WAIT_V(2); PG8_BAR;
    PG8_STAGE(PG8_SB(1, 0), cB + kstep, voffB); PG8_STAGE(PG8_SA(1, 0), cA + kstep, voffA0); PG8_STAGE(PG8_SB(1, 1), cB + hstep + kstep, voffB);
    PG8_WAIT_V(6); PG8_BAR;
    for (;;) {
        const bool has_next = S.next(ui + 1, nxt);
        const char* nA = has_next ? (GATHER ? (const char*)g.A : (const char*)g.A + (size_t)nxt.pm * tstep) : cA; const char* nB = has_next ? (const char*)g.Bt + (size_t)nxt.pb * tstep : cB;
        for (int t = 0; t < nt; t += 2) {
            const bool last = (t == nt - 2);
            const char* a1 = cA + (size_t)(t + 1) * kstep;
            const char* a2 = last ? nA : cA + (size_t)(t + 2) * kstep; const char* b2 = last ? nB : cB + (size_t)(t + 2) * kstep;
            const char* a3 = a2 + kstep; const char* b3 = b2 + kstep;
            PG8_LDB(B0, 0, 0); PG8_LDB(B1, 0, 1); PG8_SCHED; PG8_LDA(At, 0, 0); PG8_STAGE(PG8_SA(1, 1), a1, voffA1);
            if (last && has_next) PG8_LOADROWS(nxt);
            PG8_WAIT_V(8); PG8_WAIT_L(0); PG8_BAR; PG8_MMA(0, 0, At, B0); PG8_MMA(0, 1, At, B1); PG8_BAR; PG8_SCHED;
            PG8_LDA(At, 0, 1); PG8_STAGE(PG8_SB(0, 0), b2, voffB); PG8_STAGE(PG8_SB(0, 1), b2 + hstep, voffB); PG8_STAGE(PG8_SA(0, 0), a2, voffA0);
            PG8_WAIT_V(8); PG8_WAIT_L(0); PG8_BAR; PG8_MMA(1, 0, At, B0); PG8_MMA(1, 1, At, B1); PG8_BAR; PG8_SCHED;
            PG8_LDB(B0, 1, 0); PG8_LDB(B1, 1, 1); PG8_SCHED; PG8_LDA(At, 1, 0); PG8_STAGE(PG8_SA(0, 1), a2, voffA1);
            PG8_WAIT_V(8); PG8_WAIT_L(0); PG8_BAR; PG8_MMA(0, 0, At, B0); PG8_MMA(0, 1, At, B1); PG8_BAR; PG8_SCHED;
            PG8_LDA(At, 1, 1); PG8_STAGE(PG8_SB(1, 0), b3, voffB); PG8_STAGE(PG8_SB(1, 1), b3 + hstep, voffB); PG8_STAGE(PG8_SA(1, 0), a3, voffA0);
            PG8_WAIT_V(8); PG8_WAIT_L(0); PG8_BAR; PG8_MMA(1, 0, At, B0); PG8_MMA(1, 1, At, B1); PG8_BAR; PG8_SCHED;
        }
        if (wr == 0) PG8_BAR;
        E(acc, cur, wr, wc, fr, fq);
        if (!has_next) break;
#pragma unroll
        for (int a = 0; a < 2; ++a)
#pragma unroll
            for (int b = 0; b < 2; ++b)
#pragma unroll
                for (int m = 0; m < 4; ++m)
#pragma unroll
                    for (int n = 0; n < 2; ++n) acc[a][b][m][n] = (f32x4){0.f, 0.f, 0.f, 0.f};
        cur = nxt; cA = nA; cB = nB; ++ui;
        if (wr == 1) PG8_BAR;
    }
    PG8_WAIT_V(0);
    PG8_BAR;
#undef PG8_SA
#undef PG8_SB
#undef PG8_STAGE
#undef PG8_LDA
#undef PG8_LDB
#undef PG8_MMA
#undef PG8_WAIT_V
#undef PG8_WAIT_L
#undef PG8_BAR
#undef PG8_SCHED
#undef PG8_LOADROWS
}

struct EpiP1 {
    static constexpr bool PERM = true;
    bf16_t* O;
    __device__ __forceinline__ void operator()(const f32x4 (&acc)[2][2][4][2], const Unit& u, int wr, int wc, int fr, int fq) const {
        const int row0 = u.pm * BM + wr * 64 + fr, col0 = u.pn * BM + wc * 32 + 8 * fq; const bool act = u.pn < 4;
#pragma unroll
        for (int ai = 0; ai < 2; ++ai)
#pragma unroll
            for (int m = 0; m < 4; ++m) { bf16_t* rowp = O + (size_t)(row0 + ai * HALF + m * 16) * INC + col0;
#pragma unroll
                for (int bj = 0; bj < 2; ++bj) { f32x4 v0 = acc[ai][bj][m][0], v1 = acc[ai][bj][m][1];
                    if (act) {
#pragma unroll
                        for (int j = 0; j < 4; ++j) { v0[j] = gelu_tanh(v0[j]); v1[j] = gelu_tanh(v1[j]); } }
                    u32x4 w; w.x = cvt_pk_bf16(v0[0], v0[1]); w.y = cvt_pk_bf16(v0[2], v0[3]); w.z = cvt_pk_bf16(v1[0], v1[1]); w.w = cvt_pk_bf16(v1[2], v1[3]);
                    *(u32x4*)(rowp + bj * HALF) = w; } }
    }
};
struct EpiZ {
    static constexpr bool PERM = false;
    const float* X; float* Z;
    __device__ __forceinline__ void operator()(const f32x4 (&acc)[2][2][4][2], const Unit& u, int wr, int wc, int fr, int fq) const {
        const int col0 = u.pn * BM + wc * 32 + 4 * fq;
#pragma unroll
        for (int ai = 0; ai < 2; ++ai)
#pragma unroll
            for (int m = 0; m < 4; ++m) { const size_t off = (size_t)(u.pm * BM + ai * HALF + wr * 64 + m * 16 + fr) * D + col0;
#pragma unroll
                for (int bj = 0; bj < 2; ++bj)
#pragma unroll
                    for (int n = 0; n < 2; ++n) { const f32x4 xv = *(const f32x4*)(X + off + bj * HALF + n * 16); *(f32x4*)(Z + off + bj * HALF + n * 16) = xv * DN_ALPHA + acc[ai][bj][m][n]; } }
    }
};
struct EpiSwiglu {
    static constexpr bool PERM = true;
    bf16_t* Act; const float* bg; const float* bu;
    __device__ __forceinline__ void operator()(const f32x4 (&acc)[2][2][4][2], const Unit& u, int wr, int wc, int fr, int fq) const {
        const int f0 = u.pn * HALF + wc * 32 + 8 * fq; const int row0 = u.pm * BM + wr * 64 + fr;
        const f32x4 bg0 = *(const f32x4*)(bg + u.e * FF + f0), bg1 = *(const f32x4*)(bg + u.e * FF + f0 + 4);
        const f32x4 bu0 = *(const f32x4*)(bu + u.e * FF + f0), bu1 = *(const f32x4*)(bu + u.e * FF + f0 + 4);
#pragma unroll
        for (int ai = 0; ai < 2; ++ai)
#pragma unroll
            for (int m = 0; m < 4; ++m) {
                f32x4 g0 = acc[ai][0][m][0] + bg0, g1 = acc[ai][0][m][1] + bg1, u0 = acc[ai][1][m][0] + bu0, u1 = acc[ai][1][m][1] + bu1, r0, r1;
#pragma unroll
                for (int j = 0; j < 4; ++j) {
                    const float ga = fminf(g0[j], 7.0f), gb = fminf(g1[j], 7.0f);
                    const float ua = fminf(fmaxf(u0[j], -7.0f), 7.0f), ub = fminf(fmaxf(u1[j], -7.0f), 7.0f);
                    r0[j] = (ua + 1.0f) * ga * __builtin_amdgcn_rcpf(1.0f + __builtin_amdgcn_exp2f(-1.702f * 1.4426950408889634f * ga));
                    r1[j] = (ub + 1.0f) * gb * __builtin_amdgcn_rcpf(1.0f + __builtin_amdgcn_exp2f(-1.702f * 1.4426950408889634f * gb)); }
                u32x4 w; w.x = cvt_pk_bf16(r0[0], r0[1]); w.y = cvt_pk_bf16(r0[2], r0[3]); w.z = cvt_pk_bf16(r1[0], r1[1]); w.w = cvt_pk_bf16(r1[2], r1[3]);
                *(u32x4*)(Act + (size_t)(row0 + ai * HALF + m * 16) * FF + f0) = w; }
    }
};
struct EpiScatter {
    static constexpr bool PERM = true;
    bf16_t* Y; const float* bd; const float* gates; const LAS int* rowtab;
    __device__ __forceinline__ void operator()(const f32x4 (&acc)[2][2][4][2], const Unit& u, int wr, int wc, int fr, int fq) const {
        const int c0 = u.pn * BM + wc * 32 + 8 * fq;
        f32x4 b[2][2];
#pragma unroll
        for (int bj = 0; bj < 2; ++bj)
#pragma unroll
            for (int n = 0; n < 2; ++n) b[bj][n] = *(const f32x4*)(bd + u.e * D + c0 + bj * HALF + 4 * n);
#pragma unroll
        for (int ai = 0; ai < 2; ++ai)
#pragma unroll
            for (int m = 0; m < 4; ++m) { const int slot = rowtab[u.ui * 256 + ai * HALF + wr * 64 + m * 16 + fr];
                if (slot >= 0) { const float gt = gates[slot]; bf16_t* rowp = Y + (size_t)slot * D + c0;
#pragma unroll
                    for (int bj = 0; bj < 2; ++bj) { const f32x4 v0 = (acc[ai][bj][m][0] + b[bj][0]) * gt, v1 = (acc[ai][bj][m][1] + b[bj][1]) * gt;
                        u32x4 w; w.x = cvt_pk_bf16(v0[0], v0[1]); w.y = cvt_pk_bf16(v0[2], v0[3]); w.z = cvt_pk_bf16(v1[0], v1[1]); w.w = cvt_pk_bf16(v1[2], v1[3]);
                        *(u32x4*)(rowp + bj * HALF) = w; } } }
    }
};
}

struct Args { const float* in[20]; float* out; unsigned char* ws; int ph_lo, ph_hi; };
struct Frame {
    LAS unsigned char* lds; int tid, lane, wave, G, vcu;
    const float *x, *w_in, *sgu_w, *sgu_b, *sgu_ln_g, *sgu_ln_b, *mix_g, *w_out, *ln1_g, *ln1_b, *w_router, *b_router, *w_gate, *b_gate, *w_up, *b_up, *w_down, *b_down, *ln2_g, *ln2_b;
    float* out; unsigned char* ws;
    unsigned* ctl; int* list; float* gates; bf16_t *Win_t, *Wout_t, *Wd_t, *Wgu_t, *Y, *Hb, *Xb, *P1, *Amix, *Act; bf16_t* Opart; float* ML;
};

__device__ __forceinline__ void transpose_item(const float* W, int N, int K, int k0, int n0, bf16_t* WT, size_t dst_row0, LAS float* scr, int lane) {
#pragma unroll 8
    for (int i = 0; i < 32; ++i) { const int kk = 2 * i + (lane >> 5); scr[kk * 33 + (lane & 31)] = W[(size_t)(k0 + kk) * N + n0 + (lane & 31)]; }
    asm volatile("s_waitcnt lgkmcnt(0)" ::: "memory");
    const int c = lane & 7;
#pragma unroll
    for (int j = 0; j < 4; ++j) { const int n = (lane >> 3) + 8 * j; const LAS float* s = scr + (8 * c) * 33 + n;
        u32x4 o; o.x = cvt_pk_bf16(s[0 * 33], s[1 * 33]); o.y = cvt_pk_bf16(s[2 * 33], s[3 * 33]); o.z = cvt_pk_bf16(s[4 * 33], s[5 * 33]); o.w = cvt_pk_bf16(s[6 * 33], s[7 * 33]);
        *(u32x4*)(WT + (dst_row0 + n) * K + k0 + 8 * c) = o; }
    asm volatile("s_waitcnt lgkmcnt(0)" ::: "memory");
}
__device__ __forceinline__ void p0_convert(Frame& F) {
    LAS float* scr = (LAS float*)(F.lds + F.wave * 16384);
    const int gw = F.vcu * 8 + F.wave, NGW = F.G * 8;
    constexpr int I_IN = (D / 64) * (INC / 32), I_OUT = (D / 64) * (D / 32), I_E = (D / 64) * (FF / 32);
    constexpr int NITEMS = I_IN + I_OUT + NE * 3 * I_E;
    for (int it = gw; it < NITEMS; it += NGW) {
        int r = it;
        if (r < I_IN) { const int kb = r / (INC / 32), nb = r % (INC / 32); transpose_item(F.w_in, INC, D, 64 * kb, 32 * nb, F.Win_t, (size_t)32 * nb, scr, F.lane); continue; } r -= I_IN;
        if (r < I_OUT) { const int kb = r / (D / 32), nb = r % (D / 32); transpose_item(F.w_out, D, D, 64 * kb, 32 * nb, F.Wout_t, (size_t)32 * nb, scr, F.lane); continue; } r -= I_OUT;
        const int e = r / (3 * I_E), q = r % (3 * I_E), which = q / I_E, ii = q % I_E, kb = ii / 32, nb = ii % 32, n0 = 32 * nb;
        if (which == 0) transpose_item(F.w_gate + (size_t)e * D * FF, FF, D, 64 * kb, n0, F.Wgu_t, (size_t)e * 2048 + (n0 >> 7) * 256 + (n0 & 127), scr, F.lane);
        else if (which == 1) transpose_item(F.w_up + (size_t)e * D * FF, FF, D, 64 * kb, n0, F.Wgu_t, (size_t)e * 2048 + (n0 >> 7) * 256 + 128 + (n0 & 127), scr, F.lane);
        else transpose_item(F.w_down + (size_t)e * FF * D, D, FF, 64 * kb, n0, F.Wd_t, (size_t)e * 1024 + n0, scr, F.lane);
    }
    const size_t nchunk = (size_t)T * D / 8;
    for (size_t i = (size_t)blockIdx.x * 512 + F.tid; i < nchunk; i += (size_t)F.G * 512) {
        const f32x4 a = *(const f32x4*)(F.x + i * 8), b = *(const f32x4*)(F.x + i * 8 + 4);
        u32x4 w; w.x = cvt_pk_bf16(a[0], a[1]); w.y = cvt_pk_bf16(a[2], a[3]); w.z = cvt_pk_bf16(b[0], b[1]); w.w = cvt_pk_bf16(b[2], b[3]);
        *(u32x4*)(F.Xb + i * 8) = w; }
}

typedef float f32x16 __attribute__((ext_vector_type(16)));
typedef short s16x4 __attribute__((ext_vector_type(4)));
constexpr int SG_ROW = 272, SG_WAVE = 64 * SG_ROW, SG_SSQ_OFF = 8 * SG_WAVE;
static_assert(SG_SSQ_OFF + 8 * 128 * 4 <= LDS_BYTES, "SGU LDS");
__device__ __forceinline__ void sgu_unit(Frame& F, int u) {
    const int g = F.wave, lane = F.lane, i = lane & 31, hh = lane >> 5; const size_t row0 = (size_t)u * CHUNK;
    LAS unsigned char* vt = F.lds + g * SG_WAVE; LAS float* ssq = (LAS float*)(F.lds + SG_SSQ_OFF);
#pragma unroll 1
    for (int tt = 0; tt < 2; ++tt) { const int t = lane + 64 * tt; const bf16_t* vp = F.P1 + (row0 + t) * INC + AW + g * GD;
        float v[64];
#pragma unroll
        for (int c8 = 0; c8 < 8; ++c8) { const u32x4 r = *(const u32x4*)(vp + 8 * c8); const unsigned w[4] = {r.x, r.y, r.z, r.w};
#pragma unroll
            for (int j = 0; j < 4; ++j) { v[8 * c8 + 2 * j] = bf_lo(w[j]); v[8 * c8 + 2 * j + 1] = bf_hi(w[j]); } }
        float s = 0.f;
#pragma unroll
        for (int c = 0; c < 64; ++c) s += v[c];
        const float mu = s * (1.f / 64.f); float q = 0.f;
#pragma unroll
        for (int c = 0; c < 64; ++c) { v[c] -= mu; q += v[c] * v[c]; }
        const float rstd = 1.0f / sqrtf(q * (1.f / 64.f) + LN_EPS);
#pragma unroll
        for (int c = 0; c < 64; ++c) { const float val = v[c] * rstd * F.sgu_ln_g[g * GD + c] + F.sgu_ln_b[g * GD + c];
            *(LAS bf16_t*)(vt + c * SG_ROW + t * 2) = (bf16_t)(cvt_pk_bf16(val, 0.f) & 0xffffu); } }
    asm volatile("s_waitcnt lgkmcnt(0)" ::: "memory");
    f32x16 acc[2][4];
#pragma unroll
    for (int mt = 0; mt < 2; ++mt)
#pragma unroll
        for (int nt = 0; nt < 4; ++nt)
#pragma unroll
            for (int r = 0; r < 16; ++r) acc[mt][nt][r] = 0.f;
#pragma unroll
    for (int nt = 0; nt < 4; ++nt) { const int t = 32 * nt + i;
#pragma unroll
        for (int ks = 0; ks < 2 * nt + 2; ++ks) { const int s0 = 16 * ks + 8 * hh;
            const float* wp = F.sgu_w + ((size_t)g * CHUNK + t) * CHUNK + s0; const f32x4 w0 = *(const f32x4*)wp, w1 = *(const f32x4*)(wp + 4);
            float wv[8] = {w0[0], w0[1], w0[2], w0[3], w1[0], w1[1], w1[2], w1[3]};
#pragma unroll
            for (int j = 0; j < 8; ++j) wv[j] = (s0 + j <= t) ? wv[j] : 0.f;
            u32x4 bw; bw.x = cvt_pk_bf16(wv[0], wv[1]); bw.y = cvt_pk_bf16(wv[2], wv[3]); bw.z = cvt_pk_bf16(wv[4], wv[5]); bw.w = cvt_pk_bf16(wv[6], wv[7]);
            const bf16x8 bfrag = __builtin_bit_cast(bf16x8, bw);
#pragma unroll
            for (int mt = 0; mt < 2; ++mt) { const bf16x8 afrag = *(const LAS bf16x8*)(vt + (32 * mt + i) * SG_ROW + s0 * 2);
                acc[mt][nt] = __builtin_amdgcn_mfma_f32_32x32x16_bf16(afrag, bfrag, acc[mt][nt], 0, 0, 0); } } }
#pragma unroll
    for (int nt = 0; nt < 4; ++nt) { const int t = 32 * nt + i; const float bs = F.sgu_b[g * CHUNK + t]; float ss = 0.f;
        const bf16_t* up = F.P1 + (row0 + t) * INC + g * GD + 4 * hh;
#pragma unroll
        for (int mt = 0; mt < 2; ++mt)
#pragma unroll
            for (int g4 = 0; g4 < 4; ++g4) { const u32x2 uw = *(const u32x2*)(up + 32 * mt + 8 * g4);
                const float u0 = bf_lo(uw.x), u1 = bf_hi(uw.x), u2 = bf_lo(uw.y), u3 = bf_hi(uw.y);
                float a0 = u0 * (acc[mt][nt][4 * g4] + bs), a1 = u1 * (acc[mt][nt][4 * g4 + 1] + bs), a2 = u2 * (acc[mt][nt][4 * g4 + 2] + bs), a3 = u3 * (acc[mt][nt][4 * g4 + 3] + bs);
                acc[mt][nt][4 * g4] = a0; acc[mt][nt][4 * g4 + 1] = a1; acc[mt][nt][4 * g4 + 2] = a2; acc[mt][nt][4 * g4 + 3] = a3;
                ss += (a0 * a0 + a1 * a1) + (a2 * a2 + a3 * a3); }
        ss += __shfl_xor(ss, 32);
        if (hh == 0) ssq[g * CHUNK + t] = ss; }
    __syncthreads();
#pragma unroll
    for (int nt = 0; nt < 4; ++nt) { const int t = 32 * nt + i; float tot = 0.f;
#pragma unroll
        for (int gg = 0; gg < 8; ++gg) tot += ssq[gg * CHUNK + t];
        const float rs = 1.0f / sqrtf(tot * (1.f / AW) + LN_EPS);
        bf16_t* op = F.Amix + (row0 + t) * D + g * GD + 4 * hh;
#pragma unroll
        for (int mt = 0; mt < 2; ++mt)
#pragma unroll
            for (int g4 = 0; g4 < 4; ++g4) { const f32x4 mg = *(const f32x4*)(F.mix_g + g * GD + 32 * mt + 8 * g4 + 4 * hh);
                u32x2 w; w.x = cvt_pk_bf16(acc[mt][nt][4 * g4] * rs * mg[0], acc[mt][nt][4 * g4 + 1] * rs * mg[1]); w.y = cvt_pk_bf16(acc[mt][nt][4 * g4 + 2] * rs * mg[2], acc[mt][nt][4 * g4 + 3] * rs * mg[3]);
                *(u32x2*)(op + 32 * mt + 8 * g4) = w; } }
    __syncthreads();
}

constexpr int AT_KROW = 144, AT_VROW = 776, AT_V_OFF = 384 * AT_KROW;
static_assert(AT_V_OFF + 64 * AT_VROW <= RING_BYTES, "attention LDS");
__device__ __forceinline__ void attn_unit(Frame& F, int u) {
    const int bh = u / 48, rem = u % 48, p = rem >> 4, idx = rem & 15, b = bh >> 3, h = bh & 7;
    const int d = (p == 0) ? 1 : (p == 1) ? 4 : 16, r = (p == 0) ? 0 : (p == 1) ? (idx >> 2) : idx, blk = (p == 0) ? idx : (p == 1) ? (idx & 3) : 0;
    const int q0 = blk * 256; const int lane = F.lane, i = lane & 31, hh = lane >> 5, w = F.wave;
    const bf16_t* base = F.P1 + (size_t)b * SEQ * INC + h * HD;
    LAS unsigned char* kl = F.lds; LAS unsigned char* vl = F.lds + AT_V_OFF;
#pragma unroll
    for (int it = 0; it < 6; ++it) { const int ch = F.tid + 512 * it, key = ch >> 3, c = ch & 7, s = q0 - 128 + key;
        u32x4 kv = (u32x4){0u, 0u, 0u, 0u}, vv = (u32x4){0u, 0u, 0u, 0u};
        if (s >= 0) { const bf16_t* rp = base + (size_t)(s * d + r) * INC + c * 8; kv = *(const u32x4*)(rp + 1536); vv = *(const u32x4*)(rp + 2048); }
        *(LAS u32x4*)(kl + key * AT_KROW + c * 16) = kv;
        const unsigned vw[4] = {vv.x, vv.y, vv.z, vv.w};
#pragma unroll
        for (int j = 0; j < 4; ++j) { *(LAS bf16_t*)(vl + (8 * c + 2 * j) * AT_VROW + key * 2) = (bf16_t)(vw[j] & 0xffffu); *(LAS bf16_t*)(vl + (8 * c + 2 * j + 1) * AT_VROW + key * 2) = (bf16_t)(vw[j] >> 16); } }
    const int qs = q0 + 32 * w + i; const size_t qrow = (size_t)qs * d + r;
    bf16x8 qf[4];
#pragma unroll
    for (int ks = 0; ks < 4; ++ks) qf[ks] = *(const bf16x8*)(base + qrow * INC + 1024 + 16 * ks + 8 * hh);
    __syncthreads();
    f32x16 s[5];
#pragma unroll
    for (int kt = 0; kt < 5; ++kt) { f32x16 a;
#pragma unroll
        for (int rr = 0; rr < 16; ++rr) a[rr] = 0.f;
#pragma unroll
        for (int ks = 0; ks < 4; ++ks) { const bf16x8 kf = *(const LAS bf16x8*)(kl + (32 * w + 32 * kt + i) * AT_KROW + (16 * ks + 8 * hh) * 2);
            a = __builtin_amdgcn_mfma_f32_32x32x16_bf16(kf, qf[ks], a, 0, 0, 0); }
        s[kt] = a; }
    const float sc = 0.125f * 1.4426950408889634f; const int ksub0 = q0 + 32 * w - 128;
    float m = -INFINITY;
#pragma unroll
    for (int kt = 0; kt < 5; ++kt)
#pragma unroll
        for (int rr = 0; rr < 16; ++rr) { const int kk = (rr & 3) + 8 * (rr >> 2) + 4 * hh; bool ok = (ksub0 + 32 * kt + kk) >= 0;
            if (kt == 0) ok = ok && (kk >= i);
            if (kt == 4) ok = ok && (kk <= i);
            const float v = ok ? s[kt][rr] * sc : -INFINITY; s[kt][rr] = v; m = fmaxf(m, v); }
    m = fmaxf(m, __shfl_xor(m, 32));
    float lsum = 0.f;
#pragma unroll
    for (int kt = 0; kt < 5; ++kt)
#pragma unroll
        for (int rr = 0; rr < 16; ++rr) { const float pv = __builtin_amdgcn_exp2f(s[kt][rr] - m); s[kt][rr] = pv; lsum += pv; }
    lsum += __shfl_xor(lsum, 32);
    f32x16 o[2];
#pragma unroll
    for (int dt = 0; dt < 2; ++dt)
#pragma unroll
        for (int rr = 0; rr < 16; ++rr) o[dt][rr] = 0.f;
#pragma unroll
    for (int kt = 0; kt < 5; ++kt)
#pragma unroll
        for (int s2 = 0; s2 < 2; ++s2) { u32x4 pw; pw.x = cvt_pk_bf16(s[kt][8 * s2], s[kt][8 * s2 + 1]); pw.y = cvt_pk_bf16(s[kt][8 * s2 + 2], s[kt][8 * s2 + 3]);
            pw.z = cvt_pk_bf16(s[kt][8 * s2 + 4], s[kt][8 * s2 + 5]); pw.w = cvt_pk_bf16(s[kt][8 * s2 + 6], s[kt][8 * s2 + 7]);
            const bf16x8 pb = __builtin_bit_cast(bf16x8, pw);
#pragma unroll
            for (int dt = 0; dt < 2; ++dt) { const LAS unsigned char* ap = vl + (32 * dt + i) * AT_VROW + (32 * w + 32 * kt + 16 * s2 + 4 * hh) * 2;
                const s16x4 lo = *(const LAS s16x4*)ap, hi = *(const LAS s16x4*)(ap + 16);
                const bf16x8 af = __builtin_shufflevector(lo, hi, 0, 1, 2, 3, 4, 5, 6, 7);
                o[dt] = __builtin_amdgcn_mfma_f32_32x32x16_bf16(af, pb, o[dt], 0, 0, 0); } }
    const float inv = 1.0f / lsum; const size_t orow = (size_t)b * SEQ + qrow;
    bf16_t* op = F.Opart + ((size_t)p * T + orow) * AW + h * HD + 4 * hh;
#pragma unroll
    for (int dt = 0; dt < 2; ++dt)
#pragma unroll
        for (int g4 = 0; g4 < 4; ++g4) { u32x2 wv; wv.x = cvt_pk_bf16(o[dt][4 * g4] * inv, o[dt][4 * g4 + 1] * inv); wv.y = cvt_pk_bf16(o[dt][4 * g4 + 2] * inv, o[dt][4 * g4 + 3] * inv);
            *(u32x2*)(op + 32 * dt + 8 * g4) = wv; }
    if (hh == 0) *(f32x2*)(F.ML + (((size_t)p * T + orow) * NH + h) * 2) = (f32x2){m, lsum};
    __syncthreads();
}
__device__ __forceinline__ void p2_mixers(Frame& F) {
    constexpr int NSGU = BATCH * (SEQ / CHUNK), NATT = BATCH * NH * 48;
    for (int u = blockIdx.x; u < NSGU + NATT; u += F.G) { if (u < NSGU) sgu_unit(F, u); else attn_unit(F, u - NSGU); }
}

__device__ __forceinline__ void p3_merge(Frame& F) {
    const int gw = blockIdx.x * 8 + F.wave, NGW = F.G * 8, h = F.lane >> 3;
    for (int row = gw; row < T; row += NGW) {
        f32x2 ml[3]; float mx = -INFINITY;
#pragma unroll
        for (int p = 0; p < 3; ++p) { ml[p] = *(const f32x2*)(F.ML + (((size_t)p * T + row) * NH + h) * 2); mx = fmaxf(mx, ml[p].x); }
        float wt[3], wsum = 0.f;
#pragma unroll
        for (int p = 0; p < 3; ++p) { wt[p] = ml[p].y * __builtin_amdgcn_exp2f(ml[p].x - mx); wsum += wt[p]; }
        const float iw = 1.0f / wsum; float bv[8];
#pragma unroll
        for (int j = 0; j < 8; ++j) bv[j] = 0.f;
#pragma unroll
        for (int p = 0; p < 3; ++p) { const u32x4 r = *(const u32x4*)(F.Opart + ((size_t)p * T + row) * AW + F.lane * 8); const unsigned w[4] = {r.x, r.y, r.z, r.w}; const float f = wt[p] * iw;
#pragma unroll
            for (int j = 0; j < 4; ++j) { bv[2 * j] += f * bf_lo(w[j]); bv[2 * j + 1] += f * bf_hi(w[j]); } }
        float ss = 0.f;
#pragma unroll
        for (int j = 0; j < 8; ++j) ss += bv[j] * bv[j];
        ss = wave_sum(ss); const float rs = 1.0f / sqrtf(ss * (1.f / AW) + LN_EPS);
        const f32x4 g0 = *(const f32x4*)(F.mix_g + AW + F.lane * 8), g1 = *(const f32x4*)(F.mix_g + AW + F.lane * 8 + 4);
        u32x4 w; w.x = cvt_pk_bf16(bv[0] * rs * g0[0], bv[1] * rs * g0[1]); w.y = cvt_pk_bf16(bv[2] * rs * g0[2], bv[3] * rs * g0[3]);
        w.z = cvt_pk_bf16(bv[4] * rs * g1[0], bv[5] * rs * g1[1]); w.w = cvt_pk_bf16(bv[6] * rs * g1[2], bv[7] * rs * g1[3]);
        *(u32x4*)(F.Amix + (size_t)row * D + AW + F.lane * 8) = w;
    }
}

__device__ __forceinline__ void p4_route(Frame& F) {
    LAS float* wr = (LAS float*)F.lds;
    LAS int* sel_e = (LAS int*)(F.lds + RING_BYTES);
    LAS float* sel_g = (LAS float*)(F.lds + RING_BYTES + 1024);
    LAS int* lcnt = (LAS int*)(F.lds + RING_BYTES + 2048);
    LAS int* lbase = (LAS int*)(F.lds + RING_BYTES + 2048 + 128);
    for (int i = F.tid; i < D * 8; i += 512) { const int k = i >> 3, c = i & 7; const f32x4 v = *(const f32x4*)(F.w_router + (size_t)k * NE + 4 * c); *(LAS f32x4*)(wr + k * 32 + 4 * (c ^ ((k >> 1) & 7))) = v; }
    if (F.tid < 32) lcnt[F.tid] = 0;
    __syncthreads();
    const int sw = (F.lane >> 1) & 7;
    for (int chunk = blockIdx.x; chunk < T / 64; chunk += F.G) {
        for (int it = 0; it < 8; ++it) {
            const int tl = F.wave * 8 + it, row = chunk * 64 + tl;
            float* zp = F.out + (size_t)row * D;
            float h[16]; float s = 0.f;
#pragma unroll
            for (int qd = 0; qd < 16; ++qd) { h[qd] = zp[F.lane + 64 * qd]; s += h[qd]; }
            const float mu = wave_sum(s) * (1.f / D); float q = 0.f;
#pragma unroll
            for (int qd = 0; qd < 16; ++qd) { h[qd] -= mu; q += h[qd] * h[qd]; }
            const float rstd = 1.0f / sqrtf(wave_sum(q) * (1.f / D) + LN_EPS);
#pragma unroll
            for (int qd = 0; qd < 16; ++qd) { const int k = F.lane + 64 * qd; h[qd] = h[qd] * rstd * F.ln1_g[k] + F.ln1_b[k]; zp[k] = h[qd]; F.Hb[(size_t)row * D + k] = (bf16_t)(cvt_pk_bf16(h[qd], 0.f) & 0xffffu); }
            float lg[32];
#pragma unroll
            for (int e = 0; e < 32; ++e) lg[e] = 0.f;
#pragma unroll
            for (int qd = 0; qd < 16; ++qd) { const LAS float* rp = wr + (F.lane + 64 * qd) * 32;
#pragma unroll
                for (int c = 0; c < 8; ++c) { const f32x4 w = *(const LAS f32x4*)(rp + 4 * (c ^ sw)); lg[4 * c] += h[qd] * w[0]; lg[4 * c + 1] += h[qd] * w[1]; lg[4 * c + 2] += h[qd] * w[2]; lg[4 * c + 3] += h[qd] * w[3]; } }
#pragma unroll
            for (int e = 0; e < 32; ++e) lg[e] = wave_sum(lg[e]) + F.b_router[e];
            int idx[4]; float val[4]; unsigned taken = 0u;
#pragma unroll
            for (int r = 0; r < 4; ++r) { float best = -INFINITY; int bi = 0;
#pragma unroll
                for (int e = 0; e < 32; ++e) { const bool ok = !((taken >> e) & 1u) && (lg[e] > best); best = ok ? lg[e] : best; bi = ok ? e : bi; }
                idx[r] = bi; val[r] = best; taken |= 1u << bi; }
            const float e1 = __expf(val[1] - val[0]), e2 = __expf(val[2] - val[0]), e3 = __expf(val[3] - val[0]); const float inv = 1.0f / (1.0f + e1 + e2 + e3);
            if (F.lane == 0) { sel_e[tl * 4 + 0] = idx[0]; sel_e[tl * 4 + 1] = idx[1]; sel_e[tl * 4 + 2] = idx[2]; sel_e[tl * 4 + 3] = idx[3];
                sel_g[tl * 4 + 0] = inv; sel_g[tl * 4 + 1] = e1 * inv; sel_g[tl * 4 + 2] = e2 * inv; sel_g[tl * 4 + 3] = e3 * inv; }
        }
        __syncthreads();
        int myrank = 0, mye = 0;
        if (F.tid < 256) { mye = sel_e[F.tid]; myrank = atomicAdd((int*)&lcnt[mye], 1); }
        __syncthreads();
        if (F.tid < 32) { const int c = lcnt[F.tid]; lbase[F.tid] = c ? (int)__hip_atomic_fetch_add(F.ctl + CW_CNT + F.tid, (unsigned)c, __ATOMIC_RELAXED, __HIP_MEMORY_SCOPE_AGENT) : 0; lcnt[F.tid] = 0; }
        __syncthreads();
        if (F.tid < 256) { const int slot = (chunk * 64 + (F.tid >> 2)) * 4 + (F.tid & 3); F.list[mye * T + lbase[mye] + myrank] = slot; F.gates[slot] = sel_g[F.tid]; }
        __syncthreads();
    }
}

template <bool G1> __device__ __forceinline__ int moe_tables(Frame& F, int NPN) {
    LAS int* cnt = (LAS int*)(F.lds + TAB_OFF); LAS int* tstart = cnt + 32; LAS int* rowtab = (LAS int*)(F.lds + ROWTAB_OFF);
    if (F.tid < 32) cnt[F.tid] = (int)__hip_atomic_load(F.ctl + CW_CNT + F.tid, __ATOMIC_RELAXED, __HIP_MEMORY_SCOPE_AGENT);
    __syncthreads();
    if (F.tid == 0) { int acc = 0; for (int e = 0; e < NE; ++e) { tstart[e] = acc; acc += (cnt[e] + 255) >> 8; } tstart[NE] = acc; }
    __syncthreads();
    const int ntiles = tstart[NE], nU = ntiles * NPN;
    for (int i = 0; i < MAXU; ++i) { const int L = i * F.G + F.vcu; if (L >= nU) break;
        const int tl = L / NPN; int e = 0;
        for (int j = 1; j < NE; ++j) e += (tstart[j] <= tl) ? 1 : 0;
        const int mt = tl - tstart[e];
        if (F.tid < 256) { const int rank = mt * 256 + F.tid; const int slot = rank < cnt[e] ? F.list[e * T + rank] : -1;
            rowtab[i * 256 + F.tid] = G1 ? ((slot < 0 ? 0 : (slot >> 2)) * (D * 2)) : slot; } }
    __syncthreads();
    return ntiles;
}

__device__ __forceinline__ void p7_final(Frame& F) {
    const int gw = blockIdx.x * 8 + F.wave, NGW = F.G * 8;
    for (int row = gw; row < T; row += NGW) {
        float* hp = F.out + (size_t)row * D; float v[16];
#pragma unroll
        for (int j = 0; j < 2; ++j) { const f32x4 a = *(const f32x4*)(hp + 512 * j + F.lane * 8), b = *(const f32x4*)(hp + 512 * j + F.lane * 8 + 4);
#pragma unroll
            for (int i = 0; i < 4; ++i) { v[8 * j + i] = a[i] * DN_ALPHA; v[8 * j + 4 + i] = b[i] * DN_ALPHA; } }
#pragma unroll
        for (int k = 0; k < TOPK; ++k)
#pragma unroll
            for (int j = 0; j < 2; ++j) { const u32x4 r = *(const u32x4*)(F.Y + ((size_t)row * TOPK + k) * D + 512 * j + F.lane * 8); const unsigned w[4] = {r.x, r.y, r.z, r.w};
#pragma unroll
                for (int i = 0; i < 4; ++i) { v[8 * j + 2 * i] += bf_lo(w[i]); v[8 * j + 2 * i + 1] += bf_hi(w[i]); } }
        float s = 0.f;
#pragma unroll
        for (int i = 0; i < 16; ++i) s += v[i];
        const float mu = wave_sum(s) * (1.f / D); float q = 0.f;
#pragma unroll
        for (int i = 0; i < 16; ++i) { v[i] -= mu; q += v[i] * v[i]; }
        const float rstd = 1.0f / sqrtf(wave_sum(q) * (1.f / D) + LN_EPS);
#pragma unroll
        for (int j = 0; j < 2; ++j) { const int c = 512 * j + F.lane * 8;
            const f32x4 g0 = *(const f32x4*)(F.ln2_g + c), g1 = *(const f32x4*)(F.ln2_g + c + 4), b0 = *(const f32x4*)(F.ln2_b + c), b1 = *(const f32x4*)(F.ln2_b + c + 4);
            f32x4 o0, o1;
#pragma unroll
            for (int i = 0; i < 4; ++i) { o0[i] = v[8 * j + i] * rstd * g0[i] + b0[i]; o1[i] = v[8 * j + 4 + i] * rstd * g1[i] + b1[i]; }
            *(f32x4*)(hp + c) = o0; *(f32x4*)(hp + c + 4) = o1; }
    }
}

constexpr int N_PHASES = 8;
__global__ void __launch_bounds__(512, 2) mk_fwd(Args args) {
    extern __shared__ __attribute__((aligned(16))) unsigned char lds_raw[];
    Frame F;
    F.lds = (LAS unsigned char*)lds_raw; F.tid = threadIdx.x; F.lane = F.tid & 63; F.wave = __builtin_amdgcn_readfirstlane(F.tid >> 6);
    F.G = gridDim.x; { const int bx = blockIdx.x; F.vcu = (F.G % 8 == 0) ? (bx % 8) * (F.G / 8) + bx / 8 : bx; }
    F.x = args.in[0]; F.w_in = args.in[1]; F.sgu_w = args.in[2]; F.sgu_b = args.in[3]; F.sgu_ln_g = args.in[4]; F.sgu_ln_b = args.in[5]; F.mix_g = args.in[6]; F.w_out = args.in[7];
    F.ln1_g = args.in[8]; F.ln1_b = args.in[9]; F.w_router = args.in[10]; F.b_router = args.in[11]; F.w_gate = args.in[12]; F.b_gate = args.in[13]; F.w_up = args.in[14]; F.b_up = args.in[15];
    F.w_down = args.in[16]; F.b_down = args.in[17]; F.ln2_g = args.in[18]; F.ln2_b = args.in[19]; F.out = args.out; F.ws = args.ws;
    unsigned char* ws = args.ws;
    F.ctl = (unsigned*)(ws + WS_CTL); F.list = (int*)(ws + WS_LIST); F.gates = (float*)(ws + WS_GATES);
    F.Win_t = (bf16_t*)(ws + WS_WIN); F.Wout_t = (bf16_t*)(ws + WS_WOUT); F.Wd_t = (bf16_t*)(ws + WS_WD); F.Wgu_t = (bf16_t*)(ws + WS_WGU); F.Y = (bf16_t*)(ws + WS_Y);
    F.Hb = (bf16_t*)(ws + WS_HB); F.Xb = (bf16_t*)(ws + WS_XB); F.P1 = (bf16_t*)(ws + WS_P1); F.Amix = (bf16_t*)(ws + WS_AMIX); F.Act = (bf16_t*)(ws + WS_ACT);
    F.Opart = (bf16_t*)(ws + WS_OPART); F.ML = (float*)(ws + WS_ML);
    const int lo = args.ph_lo, hi = args.ph_hi;
    const LAS int* rowtab = (const LAS int*)(F.lds + ROWTAB_OFF);
#define IN(k) (lo <= (k) && (k) < hi)
#define SEAM(k) do { if (IN(k) && IN((k) + 1)) { cg::this_grid().sync(); } } while (0)
    if (IN(0)) { p0_convert(F); }
    SEAM(0);
    if (IN(1)) { pg8::Gemm g{F.Xb, F.Win_t, D}; pg8::DenseOrder S{INC / 256, (T / 256) * (INC / 256), F.G, F.vcu}; pg8::EpiP1 E{F.P1};
        pg8::gemm_phase<pg8::EpiP1, pg8::DenseOrder, false>(F.lds, rowtab, g, S, E); }
    SEAM(1);
    if (IN(2)) { p2_mixers(F); }
    SEAM(2);
    if (IN(3)) { p3_merge(F); }
    SEAM(3);
    if (IN(4)) { pg8::Gemm g{F.Amix, F.Wout_t, D}; pg8::DenseOrder S{D / 256, (T / 256) * (D / 256), F.G, F.vcu}; pg8::EpiZ E{F.x, F.out};
        pg8::gemm_phase<pg8::EpiZ, pg8::DenseOrder, false>(F.lds, rowtab, g, S, E); }
    SEAM(4);
    if (IN(5)) { p4_route(F); }
    SEAM(5);
    if (IN(6)) { const int ntiles = moe_tables<true>(F, 8); pg8::Gemm g{F.Hb, F.Wgu_t, D}; pg8::MoeOrder S{8, ntiles * 8, F.G, F.vcu, (const LAS int*)(F.lds + TAB_OFF) + 32};
        pg8::EpiSwiglu E{F.Act, F.b_gate, F.b_up};
        pg8::gemm_phase<pg8::EpiSwiglu, pg8::MoeOrder, true>(F.lds, rowtab, g, S, E); }
    SEAM(6);
    if (IN(7)) { const int ntiles = moe_tables<false>(F, 4); pg8::Gemm g{F.Act, F.Wd_t, FF}; pg8::MoeOrder S{4, ntiles * 4, F.G, F.vcu, (const LAS int*)(F.lds + TAB_OFF) + 32};
        pg8::EpiScatter E{F.Y, F.b_down, F.gates, rowtab};
        pg8::gemm_phase<pg8::EpiScatter, pg8::MoeOrder, false>(F.lds, rowtab, g, S, E); }
    SEAM(7);
    if (IN(8)) { p7_final(F); }
#undef IN
#undef SEAM
}

extern "C" void kernel_launch(void* const* d_in, const int* in_sizes, int n_in, void* d_out, int out_size, void* d_ws, size_t ws_size, hipStream_t stream) {
    static int grid = 0;
    if (grid == 0) {
        if (n_in != 20 || in_sizes[0] != T * D || out_size != T * D || ws_size < WS_END) { fprintf(stderr, "kernel_launch: unexpected shapes (n_in %d, in0 %d, out %d, ws %zu)\n", n_in, n_in > 0 ? in_sizes[0] : -1, out_size, ws_size); grid = -1; return; }
        int dev = 0, cus = 0, per_cu = 0;
        hipGetDevice(&dev); hipDeviceGetAttribute(&cus, hipDeviceAttributeMultiprocessorCount, dev);
        if (hipFuncSetAttribute((const void*)mk_fwd, hipFuncAttributeMaxDynamicSharedMemorySize, LDS_BYTES) != hipSuccess) { fprintf(stderr, "kernel_launch: hipFuncSetAttribute failed\n"); grid = -1; return; }
        hipOccupancyMaxActiveBlocksPerMultiprocessor(&per_cu, (const void*)mk_fwd, 512, LDS_BYTES);
        (void)hipGetLastError();
        if (per_cu < 1) { fprintf(stderr, "kernel_launch: occupancy query says %d blocks/CU\n", per_cu); per_cu = 1; }
        grid = cus;
        if (grid != 256) fprintf(stderr, "kernel_launch: note: %d CUs (tuned for 256)\n", grid);
    }
    if (grid < 0) return;
    hipMemsetAsync((char*)d_ws + WS_CTL, 0, CTL_ZERO_BYTES, stream);
    Args a{};
    for (int i = 0; i < 20; ++i) a.in[i] = (const float*)d_in[i];
    a.out = (float*)d_out; a.ws = (unsigned char*)d_ws;
#if MK_N_LAUNCHES == 1
    a.ph_lo = 0; a.ph_hi = N_PHASES + 1;
    void* kargs[] = {&a};
    hipError_t e = hipLaunchCooperativeKernel((const void*)mk_fwd, dim3(grid), dim3(512), kargs, LDS_BYTES, stream);
    if (e != hipSuccess) fprintf(stderr, "cooperative launch failed: %s (grid %d)\n", hipGetErrorString(e), grid);
#else
    for (int p = 0; p <= N_PHASES; ++p) { a.ph_lo = p; a.ph_hi = p + 1; hipLaunchKernelGGL(mk_fwd, dim3(grid), dim3(512), LDS_BYTES, stream, a); }
#endif
}
```

```cpp
#include <hip/hip_runtime.h>
#include <hip/hip_cooperative_groups.h>
#include <cstdio>
#include <cstdint>
namespace cg = cooperative_groups;

#ifndef MK_N_LAUNCHES
#define MK_N_LAUNCHES 1
#endif

constexpr int BATCH = 4, SEQ = 4096, T = BATCH * SEQ, D = 1024, INC = 2560, NE = 32, FF = 1024, TOPK = 4;
constexpr int AW = 512, NGRP = 8, GD = 64, CHUNK = 128, NH = 8, HD = 64;
constexpr float LN_EPS = 1e-5f, DN_ALPHA = 1.189207115002721f;
constexpr int NSLOT = T * TOPK;
constexpr int MAXTILES = 288;
constexpr int MAXU = 12;

constexpr size_t MiB = 1u << 20;
constexpr size_t WS_CTL = 0, CTL_ZERO_BYTES = 64 * 1024;
constexpr size_t WS_LIST = 1 * MiB;
constexpr size_t WS_GATES = 3 * MiB;
constexpr size_t WS_WIN = 4 * MiB;
constexpr size_t WS_WOUT = 9 * MiB;
constexpr size_t WS_WD = 11 * MiB;
constexpr size_t WS_WGU = 75 * MiB;
constexpr size_t WS_Y = WS_WGU;
constexpr size_t WS_HB = 203 * MiB;
constexpr size_t WS_BIG = 235 * MiB;
constexpr size_t WS_XB = WS_BIG;
constexpr size_t WS_P1 = WS_BIG + 32 * MiB;
constexpr size_t WS_AMIX = WS_BIG + 112 * MiB;
constexpr size_t WS_ACT = WS_BIG;
constexpr size_t WS_OPART = 379 * MiB;
constexpr size_t WS_ML = 427 * MiB;
constexpr size_t WS_END = 430 * MiB;
constexpr int CW_BAR = 1024;
constexpr int CW_CNT = 0;

constexpr int RING_BYTES = 131072;
constexpr int TAB_OFF = RING_BYTES + 1024;
constexpr int ROWTAB_OFF = RING_BYTES + 2048;
constexpr int MISC_OFF = 147456 - 64;
constexpr int LDS_BYTES = 147456;
static_assert(ROWTAB_OFF + MAXU * 1024 <= LDS_BYTES, "LDS map");

#define LAS __attribute__((address_space(3)))
typedef unsigned short bf16_t;
typedef short bf16x8 __attribute__((ext_vector_type(8)));
typedef float f32x4 __attribute__((ext_vector_type(4)));
typedef float f32x2 __attribute__((ext_vector_type(2)));
typedef unsigned u32x4 __attribute__((ext_vector_type(4)));
typedef unsigned u32x2 __attribute__((ext_vector_type(2)));

__device__ __forceinline__ unsigned cvt_pk_bf16(float lo, float hi) { unsigned r; asm volatile("v_cvt_pk_bf16_f32 %0, %1, %2" : "=v"(r) : "v"(lo), "v"(hi)); return r; }
__device__ __forceinline__ float bf_lo(unsigned w) { return __uint_as_float(w << 16); }
__device__ __forceinline__ float bf_hi(unsigned w) { return __uint_as_float(w & 0xffff0000u); }
__device__ __forceinline__ float bf1(bf16_t b) { return __uint_as_float((unsigned)b << 16); }
__device__ __forceinline__ float wave_sum(float v) {
#pragma unroll
    for (int o = 1; o < 64; o <<= 1) v += __shfl_xor(v, o);
    return v;
}
__device__ __forceinline__ float gelu_tanh(float x) {
    const float y2 = x * (1.5957691216057308f + 0.07135481627260025f * x * x);
    return x * __builtin_amdgcn_rcpf(1.0f + __builtin_amdgcn_exp2f(-1.4426950408889634f * y2));
}

namespace pg8 {
constexpr int BM = 256, BK = 64, HALF = 128, HTB = HALF * BK * 2, STAGE_BYTES = 8 * HTB;
__host__ __device__ __forceinline__ int lds_byte(int r, int c) { const int st = (r >> 4) * 2 + (c >> 5), rr = r & 15, cc = c & 31, ob = rr * 64 + cc * 2; return st * 1024 + (ob ^ (((ob >> 9) & 1) << 5)); }
__host__ __device__ __forceinline__ void stage_rc(int b, int& R, int& C) { const int st = b / 1024, sb = b % 1024, swz = sb ^ (((sb >> 9) & 1) << 5); R = (st >> 1) * 16 + swz / 64; C = (st & 1) * 32 + (swz % 64) / 2; }
__host__ __device__ __forceinline__ int perm32(int rho) { const int n = rho >> 4, i = rho & 15; return 8 * (i >> 2) + 4 * n + (i & 3); }

struct Unit { int pm, pn, pb, e, mt, ui; };
struct Gemm { const bf16_t* A; const bf16_t* Bt; int K; };

struct DenseOrder {
    int nN, nU, G, v;
    __device__ __forceinline__ bool next(int i, Unit& u) const {
        const int L = i * G + v; if (L >= nU) return false;
        u.pm = L / nN; u.pn = L % nN; u.pb = u.pn; u.e = 0; u.mt = 0; u.ui = i; return true; }
};
struct MoeOrder {
    int NPN, nU, G, v; const LAS int* tstart;
    __device__ __forceinline__ bool next(int i, Unit& u) const {
        const int L = i * G + v; if (L >= nU) return false;
        const int tl = L / NPN, pn = L % NPN; int e = 0;
#pragma unroll
        for (int j = 1; j < NE; ++j) e += (tstart[j] <= tl) ? 1 : 0;
        u.pm = tl; u.pn = pn; u.pb = e * NPN + pn; u.e = e; u.mt = tl - tstart[e]; u.ui = i; return true; }
};

template <class Epi, class Sched, bool GATHER>
__device__ __forceinline__ void gemm_phase(LAS unsigned char* lds, const LAS int* rowtab, const Gemm g, const Sched& S, const Epi& E) {
    const int tid = threadIdx.x, wid = __builtin_amdgcn_readfirstlane(tid >> 6), lane = tid & 63, wr = wid >> 2, wc = wid & 3, fr = lane & 15, fq = lane >> 4;
    const int K = g.K, nt = K / BK;
    unsigned voffA0[2], voffA1[2], voffB[2]; int Rr[2], Cc[2];
#pragma unroll
    for (int i = 0; i < 2; ++i) { int R, C; stage_rc(tid * 16 + i * 8192, R, C); const int Rb = Epi::PERM ? ((R & ~31) + perm32(R & 31)) : R; Rr[i] = R; Cc[i] = C;
        voffA0[i] = (unsigned)(R * K + C) * 2u; voffA1[i] = (unsigned)((R + HALF) * K + C) * 2u; voffB[i] = (unsigned)(Rb * K + C) * 2u; }
    const size_t kstep = (size_t)(BK * 2);
    const size_t hstep = (size_t)HALF * K * 2;
    const size_t tstep = 2 * hstep;
    const unsigned ldsw = (unsigned)wid * 1024u;
    const int aoff = lds_byte(wr * 64 + fr, fq * 8), boff = lds_byte(wc * 32 + fr, fq * 8);
#define PG8_SA(b, h) (((b) * 2 + (h)) * HTB)
#define PG8_SB(b, h) ((4 + (b) * 2 + (h)) * HTB)
#define PG8_STAGE(bufoff, gbase, voff) do { _Pragma("unroll") for (int _i = 0; _i < 2; ++_i) \
        __builtin_amdgcn_global_load_lds((const unsigned*)((const char*)(gbase) + (voff)[_i]), (LAS unsigned*)(lds + (bufoff) + ldsw + _i * 8192), 16, 0, 0); } while (0)
#define PG8_LDA(dst, b, h) do { _Pragma("unroll") for (int m = 0; m < 4; ++m) _Pragma("unroll") for (int k = 0; k < 2; ++k) dst[m][k] = *(const LAS bf16x8*)(lds + PG8_SA(b, h) + aoff + m * 2048 + k * 1024); } while (0)
#define PG8_LDB(dst, b, h) do { _Pragma("unroll") for (int n = 0; n < 2; ++n) _Pragma("unroll") for (int k = 0; k < 2; ++k) dst[n][k] = *(const LAS bf16x8*)(lds + PG8_SB(b, h) + boff + n * 2048 + k * 1024); } while (0)
#define PG8_MMA(ai, bj, At, Bt) do { __builtin_amdgcn_s_setprio(1); _Pragma("unroll") for (int m = 0; m < 4; ++m) _Pragma("unroll") for (int n = 0; n < 2; ++n) _Pragma("unroll") for (int k = 0; k < 2; ++k) \
        acc[ai][bj][m][n] = __builtin_amdgcn_mfma_f32_16x16x32_bf16(Bt[n][k], At[m][k], acc[ai][bj][m][n], 0, 0, 0); __builtin_amdgcn_s_setprio(0); } while (0)
#define PG8_WAIT_V(n) asm volatile("s_waitcnt vmcnt(" #n ")" ::: "memory")
#define PG8_WAIT_L(n) asm volatile("s_waitcnt lgkmcnt(" #n ")" ::: "memory")
#define PG8_BAR __builtin_amdgcn_s_barrier()
#define PG8_SCHED __builtin_amdgcn_sched_barrier(0)
#define PG8_LOADROWS(U) do { if constexpr (GATHER) { _Pragma("unroll") for (int _i = 0; _i < 2; ++_i) { \
        voffA0[_i] = (unsigned)rowtab[(U).ui * 256 + Rr[_i]] + (unsigned)Cc[_i] * 2u; voffA1[_i] = (unsigned)rowtab[(U).ui * 256 + HALF + Rr[_i]] + (unsigned)Cc[_i] * 2u; } } } while (0)
    Unit cur, nxt; int ui = 0;
    if (!S.next(0, cur)) return;
    f32x4 acc[2][2][4][2];
#pragma unroll
    for (int a = 0; a < 2; ++a)
#pragma unroll
        for (int b = 0; b < 2; ++b)
#pragma unroll
            for (int m = 0; m < 4; ++m)
#pragma unroll
                for (int n = 0; n < 2; ++n) acc[a][b][m][n] = (f32x4){0.f, 0.f, 0.f, 0.f};
    bf16x8 At[4][2], B0[2][2], B1[2][2];
    const char* cA = GATHER ? (const char*)g.A : (const char*)g.A + (size_t)cur.pm * tstep; const char* cB = (const char*)g.Bt + (size_t)cur.pb * tstep;
    PG8_LOADROWS(cur); PG8_WAIT_L(0);
    PG8_STAGE(PG8_SB(0, 0), cB, voffB); PG8_STAGE(PG8_SB(0, 1), cB + hstep, voffB); PG8_STAGE(PG8_SA(0, 0), cA, voffA0); PG8_STAGE(PG8_SA(0, 1), cA, voffA1);
    if (wr == 1) PG8_BAR;
    PG8_WAIT_V(2); PG8_BAR;
    PG8_STAGE(PG8_SB(1, 0), cB + kstep, voffB); PG8_STAGE(PG8_SA(1, 0), cA + kstep, voffA0); PG8_STAGE(PG8_SB(1, 1), cB + hstep + kstep, voffB);
    PG8_WAIT_V(6); PG8_BAR;
    for (;;) {
        const bool has_next = S.next(ui + 1, nxt);
        const char* nA = has_next ? (GATHER ? (const char*)g.A : (const char*)g.A + (size_t)nxt.pm * tstep) : cA; const char* nB = has_next ? (const char*)g.Bt + (size_t)nxt.pb * tstep : cB;
        for (int t = 0; t < nt; t += 2) {
            const bool last = (t == nt - 2);
            const char* a1 = cA + (size_t)(t + 1) * kstep;
            const char* a2 = last ? nA : cA + (size_t)(t + 2) * kstep; const char* b2 = last ? nB : cB + (size_t)(t + 2) * kstep;
            const char* a3 = a2 + kstep; const char* b3 = b2 + kstep;
            PG8_LDB(B0, 0, 0); PG8_LDB(B1, 0, 1); PG8_SCHED; PG8_LDA(At, 0, 0); PG8_STAGE(PG8_SA(1, 1), a1, voffA1);
            if (last && has_next) PG8_LOADROWS(nxt);
            PG8_WAIT_V(8); PG8_WAIT_L(0); PG8_BAR; PG8_MMA(0, 0, At, B0); PG8_MMA(0, 1, At, B1); PG8_BAR; PG8_SCHED;
            PG8_LDA(At, 0, 1); PG8_STAGE(PG8_SB(0, 0), b2, voffB); PG8_STAGE(PG8_SB(0, 1), b2 + hstep, voffB); PG8_STAGE(PG8_SA(0, 0), a2, voffA0);
            PG8_WAIT_V(8); PG8_WAIT_L(0); PG8_BAR; PG8_MMA(1, 0, At, B0); PG8_MMA(1, 1, At, B1); PG8_BAR; PG8_SCHED;
            PG8_LDB(B0, 1, 0); PG8_LDB(B1, 1, 1); PG8_SCHED; PG8_LDA(At, 1, 0); PG8_STAGE(PG8_SA(0, 1), a2, voffA1);
            PG8_WAIT_V(8); PG8_WAIT_L(0); PG8_BAR; PG8_MMA(0, 0, At, B0); PG8_MMA(0, 1, At, B1); PG8_BAR; PG8_SCHED;
            PG8_LDA(At, 1, 1); PG8_STAGE(PG8_SB(1, 0), b3, voffB); PG8_STAGE(PG8_SB(1, 1), b3 + hstep, voffB); PG8_STAGE(PG8_SA(1, 0), a3, voffA0);
            PG8_WAIT_V(8); PG8_WAIT_L(0); PG8_BAR; PG8_MMA(1, 0, At, B0); PG8_MMA(1, 1, At, B1); PG8_BAR; PG8_SCHED;
        }
        if (wr == 0) PG8_BAR;
        E(acc, cur, wr, wc, fr, fq);
        if (!has_next) break;
#pragma unroll
        for (int a = 0; a < 2; ++a)
#pragma unroll
            for (int b = 0; b < 2; ++b)
#pragma unroll
                for (int m = 0; m < 4; ++m)
#pragma unroll
                    for (int n = 0; n < 2; ++n) acc[a][b][m][n] = (f32x4){0.f, 0.f, 0.f, 0.f};
        cur = nxt; cA = nA; cB = nB; ++ui;
        if (wr == 1) PG8_BAR;
    }
    PG8_WAIT_V(0);
    PG8_BAR;
#undef PG8_SA
#undef PG8_SB
#undef PG8_STAGE
#undef PG8_LDA
#undef PG8_LDB
#undef PG8_MMA
#undef PG8_WAIT_V
#undef PG8_WAIT_L
#undef PG8_BAR
#undef PG8_SCHED
#undef PG8_LOADROWS
}

struct EpiP1 {
    static constexpr bool PERM = true;
    bf16_t* O;
    __device__ __forceinline__ void operator()(const f32x4 (&acc)[2][2][4][2], const Unit& u, int wr, int wc, int fr, int fq) const {
        const int row0 = u.pm * BM + wr * 64 + fr, col0 = u.pn * BM + wc * 32 + 8 * fq; const bool act = u.pn < 4;
#pragma unroll
        for (int ai = 0; ai < 2; ++ai)
#pragma unroll
            for (int m = 0; m < 4; ++m) { bf16_t* rowp = O + (size_t)(row0 + ai * HALF + m * 16) * INC + col0;
#pragma unroll
                for (int bj = 0; bj < 2; ++bj) { f32x4 v0 = acc[ai][bj][m][0], v1 = acc[ai][bj][m][1];
                    if (act) {
#pragma unroll
                        for (int j = 0; j < 4; ++j) { v0[j] = gelu_tanh(v0[j]); v1[j] = gelu_tanh(v1[j]); } }
                    u32x4 w; w.x = cvt_pk_bf16(v0[0], v0[1]); w.y = cvt_pk_bf16(v0[2], v0[3]); w.z = cvt_pk_bf16(v1[0], v1[1]); w.w = cvt_pk_bf16(v1[2], v1[3]);
                    *(u32x4*)(rowp + bj * HALF) = w; } }
    }
};
struct EpiZ {
    static constexpr bool PERM = false;
    const float* X; float* Z;
    __device__ __forceinline__ void operator()(const f32x4 (&acc)[2][2][4][2], const Unit& u, int wr, int wc, int fr, int fq) const {
        const int col0 = u.pn * BM + wc * 32 + 4 * fq;
#pragma unroll
        for (int ai = 0; ai < 2; ++ai)
#pragma unroll
            for (int m = 0; m < 4; ++m) { const size_t off = (size_t)(u.pm * BM + ai * HALF + wr * 64 + m * 16 + fr) * D + col0;
#pragma unroll
                for (int bj = 0; bj < 2; ++bj)
#pragma unroll
                    for (int n = 0; n < 2; ++n) { const f32x4 xv = *(const f32x4*)(X + off + bj * HALF + n * 16); *(f32x4*)(Z + off + bj * HALF + n * 16) = xv * DN_ALPHA + acc[ai][bj][m][n]; } }
    }
};
struct EpiSwiglu {
    static constexpr bool PERM = true;
    bf16_t* Act; const float* bg; const float* bu;
    __device__ __forceinline__ void operator()(const f32x4 (&acc)[2][2][4][2], const Unit& u, int wr, int wc, int fr, int fq) const {
        const int f0 = u.pn * HALF + wc * 32 + 8 * fq; const int row0 = u.pm * BM + wr * 64 + fr;
        const f32x4 bg0 = *(const f32x4*)(bg + u.e * FF + f0), bg1 = *(const f32x4*)(bg + u.e * FF + f0 + 4);
        const f32x4 bu0 = *(const f32x4*)(bu + u.e * FF + f0), bu1 = *(const f32x4*)(bu + u.e * FF + f0 + 4);
#pragma unroll
        for (int ai = 0; ai < 2; ++ai)
#pragma unroll
            for (int m = 0; m < 4; ++m) {
                f32x4 g0 = acc[ai][0][m][0] + bg0, g1 = acc[ai][0][m][1] + bg1, u0 = acc[ai][1][m][0] + bu0, u1 = acc[ai][1][m][1] + bu1, r0, r1;
#pragma unroll
                for (int j = 0; j < 4; ++j) {
                    const float ga = fminf(g0[j], 7.0f), gb = fminf(g1[j], 7.0f);
                    const float ua = fminf(fmaxf(u0[j], -7.0f), 7.0f), ub = fminf(fmaxf(u1[j], -7.0f), 7.0f);
                    r0[j] = (ua + 1.0f) * ga * __builtin_amdgcn_rcpf(1.0f + __builtin_amdgcn_exp2f(-1.702f * 1.4426950408889634f * ga));
                    r1[j] = (ub + 1.0f) * gb * __builtin_amdgcn_rcpf(1.0f + __builtin_amdgcn_exp2f(-1.702f * 1.4426950408889634f * gb)); }
                u32x4 w; w.x = cvt_pk_bf16(r0[0], r0[1]); w.y = cvt_pk_bf16(r0[2], r0[3]); w.z = cvt_pk_bf16(r1[0], r1[1]); w.w = cvt_pk_bf16(r1[2], r1[3]);
                *(u32x4*)(Act + (size_t)(row0 + ai * HALF + m * 16) * FF + f0) = w; }
    }
};
struct EpiScatter {
    static constexpr bool PERM = true;
    bf16_t* Y; const float* bd; const float* gates; const LAS int* rowtab;
    __device__ __forceinline__ void operator()(const f32x4 (&acc)[2][2][4][2], const Unit& u, int wr, int wc, int fr, int fq) const {
        const int c0 = u.pn * BM + wc * 32 + 8 * fq;
        f32x4 b[2][2];
#pragma unroll
        for (int bj = 0; bj < 2; ++bj)
#pragma unroll
            for (int n = 0; n < 2; ++n) b[bj][n] = *(const f32x4*)(bd + u.e * D + c0 + bj * HALF + 4 * n);
#pragma unroll
        for (int ai = 0; ai < 2; ++ai)
#pragma unroll
            for (int m = 0; m < 4; ++m) { const int slot = rowtab[u.ui * 256 + ai * HALF + wr * 64 + m * 16 + fr];
                if (slot >= 0) { const float gt = gates[slot]; bf16_t* rowp = Y + (size_t)slot * D + c0;
#pragma unroll
                    for (int bj = 0; bj < 2; ++bj) { const f32x4 v0 = (acc[ai][bj][m][0] + b[bj][0]) * gt, v1 = (acc[ai][bj][m][1] + b[bj][1]) * gt;
                        u32x4 w; w.x = cvt_pk_bf16(v0[0], v0[1]); w.y = cvt_pk_bf16(v0[2], v0[3]); w.z = cvt_pk_bf16(v1[0], v1[1]); w.w = cvt_pk_bf16(v1[2], v1[3]);
                        *(u32x4*)(rowp + bj * HALF) = w; } } }
    }
};
}


#define XB_TMO      128
#define XB_XCNT(j)  (256  + 64 * (j))
#define XB_XSUB(j)  (1280 + 64 * (j))
#define XB_XGEN(j)  (2304 + 64 * (j))
#define XB_TOP      3328
#define XB_TOPGEN   3392
#define XCD_BAR_WORDS 3456
#define XB_SPIN_CAP (1u << 22)
__device__ __forceinline__ unsigned xb_ld(unsigned* p)              { return __hip_atomic_load(p, __ATOMIC_RELAXED, __HIP_MEMORY_SCOPE_AGENT); }
__device__ __forceinline__ unsigned xb_add(unsigned* p, unsigned v) { return __hip_atomic_fetch_add(p, v, __ATOMIC_RELAXED, __HIP_MEMORY_SCOPE_AGENT); }
__device__ __forceinline__ unsigned xb_xcc_id() { return (unsigned)__builtin_amdgcn_s_getreg((3 << 11) | 20) & 0xFu; }
#define XB_SPIN(cond, bar) do { unsigned _sp = 0; while (cond) { __builtin_amdgcn_s_sleep(1); \
    if ((++_sp & 255u) == 0u) { if (xb_ld(&(bar)[XB_TMO])) break; if (_sp > XB_SPIN_CAP) { atomicAdd(&(bar)[XB_TMO], 1u); break; } } } } while (0)
struct XcdBarrier { unsigned* bar; unsigned x; volatile LAS unsigned* st; };
__device__ __forceinline__ XcdBarrier xcd_barrier_post(unsigned* bar, volatile LAS unsigned* st) {
    XcdBarrier b; b.bar = bar; b.x = xb_xcc_id(); b.st = st;
    if (threadIdx.x == 0) (void)xb_add(&bar[XB_XCNT(b.x)], 1u);
    return b;
}
__device__ __forceinline__ void xcd_barrier_complete(unsigned* bar, unsigned x, unsigned& nloc, unsigned& nx) {
    const unsigned G = gridDim.x * gridDim.y * gridDim.z;
    unsigned sum, cnt, mine, sp = 0u;
    for (;;) {
        sum = 0u; cnt = 0u; mine = 0u;
#pragma unroll
        for (unsigned j = 0; j < 16; ++j) { const unsigned c = xb_ld(&bar[XB_XCNT(j)]); sum += c; cnt += (c > 0u) ? 1u : 0u; mine = (j == x) ? c : mine; }
        if (sum == G) break;
        __builtin_amdgcn_s_sleep(1);
        if ((++sp & 255u) == 0u) { if (xb_ld(&bar[XB_TMO])) break; if (sp > XB_SPIN_CAP) { atomicAdd(&bar[XB_TMO], 1u); break; } }
    }
    nloc = mine > 0u ? mine : 1u; nx = cnt > 0u ? cnt : 1u;
}
__device__ __forceinline__ void xcd_barrier(const XcdBarrier& b) {
    asm volatile("s_waitcnt vmcnt(0)" ::: "memory");
    __syncthreads();
    if (threadIdx.x == 0) {
        unsigned* bar = b.bar;
        __builtin_amdgcn_s_waitcnt(0);
        unsigned nloc = b.st[0], nx = b.st[1];
        if (nloc == 0u) { xcd_barrier_complete(bar, b.x, nloc, nx); b.st[0] = nloc; b.st[1] = nx; }
        const unsigned old = xb_add(&bar[XB_XSUB(b.x)], 1u);
        const unsigned gen = old / nloc;
        if (old + 1u == (gen + 1u) * nloc) {
            __builtin_amdgcn_fence(__ATOMIC_RELEASE, "agent");
            asm volatile("s_waitcnt vmcnt(0)" ::: "memory");
            const unsigned og = xb_add(&bar[XB_TOP], 1u);
            const unsigned tg = og / nx;
            if (og + 1u == (tg + 1u) * nx) xb_add(&bar[XB_TOPGEN], 1u);
            else XB_SPIN(xb_ld(&bar[XB_TOPGEN]) == tg, bar);
            __builtin_amdgcn_fence(__ATOMIC_ACQUIRE, "agent");
            xb_add(&bar[XB_XGEN(b.x)], 1u);
            asm volatile("s_waitcnt vmcnt(0)" ::: "memory");
        } else {
            XB_SPIN(xb_ld(&bar[XB_XGEN(b.x)]) == gen, bar);
            __builtin_amdgcn_fence(__ATOMIC_ACQUIRE, "agent");
            asm volatile("s_waitcnt vmcnt(0)" ::: "memory");
        }
    }
    __syncthreads();
}

struct Args { const float* in[20]; float* out; unsigned char* ws; int ph_lo, ph_hi; };
struct Frame {
    LAS unsigned char* lds; int tid, lane, wave, G, vcu;
    const float *x, *w_in, *sgu_w, *sgu_b, *sgu_ln_g, *sgu_ln_b, *mix_g, *w_out, *ln1_g, *ln1_b, *w_router, *b_router, *w_gate, *b_gate, *w_up, *b_up, *w_down, *b_down, *ln2_g, *ln2_b;
    float* out; unsigned char* ws;
    unsigned* ctl; int* list; float* gates; bf16_t *Win_t, *Wout_t, *Wd_t, *Wgu_t, *Y, *Hb, *Xb, *P1, *Amix, *Act; bf16_t* Opart; float* ML;
};

__device__ __forceinline__ void transpose_item(const float* W, int N, int K, int k0, int n0, bf16_t* WT, size_t dst_row0, LAS float* scr, int lane) {
#pragma unroll 8
    for (int i = 0; i < 32; ++i) { const int kk = 2 * i + (lane >> 5); scr[kk * 33 + (lane & 31)] = W[(size_t)(k0 + kk) * N + n0 + (lane & 31)]; }
    asm volatile("s_waitcnt lgkmcnt(0)" ::: "memory");
    const int c = lane & 7;
#pragma unroll
    for (int j = 0; j < 4; ++j) { const int n = (lane >> 3) + 8 * j; const LAS float* s = scr + (8 * c) * 33 + n;
        u32x4 o; o.x = cvt_pk_bf16(s[0 * 33], s[1 * 33]); o.y = cvt_pk_bf16(s[2 * 33], s[3 * 33]); o.z = cvt_pk_bf16(s[4 * 33], s[5 * 33]); o.w = cvt_pk_bf16(s[6 * 33], s[7 * 33]);
        *(u32x4*)(WT + (dst_row0 + n) * K + k0 + 8 * c) = o; }
    asm volatile("s_waitcnt lgkmcnt(0)" ::: "memory");
}
__device__ __forceinline__ void p0_convert(Frame& F) {
    LAS float* scr = (LAS float*)(F.lds + F.wave * 16384);
    const int gw = F.vcu * 8 + F.wave, NGW = F.G * 8;
    constexpr int I_IN = (D / 64) * (INC / 32), I_OUT = (D / 64) * (D / 32), I_E = (D / 64) * (FF / 32);
    constexpr int NITEMS = I_IN + I_OUT + NE * 3 * I_E;
    for (int it = gw; it < NITEMS; it += NGW) {
        int r = it;
        if (r < I_IN) { const int kb = r / (INC / 32), nb = r % (INC / 32); transpose_item(F.w_in, INC, D, 64 * kb, 32 * nb, F.Win_t, (size_t)32 * nb, scr, F.lane); continue; } r -= I_IN;
        if (r < I_OUT) { const int kb = r / (D / 32), nb = r % (D / 32); transpose_item(F.w_out, D, D, 64 * kb, 32 * nb, F.Wout_t, (size_t)32 * nb, scr, F.lane); continue; } r -= I_OUT;
        const int e = r / (3 * I_E), q = r % (3 * I_E), which = q / I_E, ii = q % I_E, kb = ii / 32, nb = ii % 32, n0 = 32 * nb;
        if (which == 0) transpose_item(F.w_gate + (size_t)e * D * FF, FF, D, 64 * kb, n0, F.Wgu_t, (size_t)e * 2048 + (n0 >> 7) * 256 + (n0 & 127), scr, F.lane);
        else if (which == 1) transpose_item(F.w_up + (size_t)e * D * FF, FF, D, 64 * kb, n0, F.Wgu_t, (size_t)e * 2048 + (n0 >> 7) * 256 + 128 + (n0 & 127), scr, F.lane);
        else transpose_item(F.w_down + (size_t)e * FF * D, D, FF, 64 * kb, n0, F.Wd_t, (size_t)e * 1024 + n0, scr, F.lane);
    }
    const size_t nchunk = (size_t)T * D / 8;
    for (size_t i = (size_t)blockIdx.x * 512 + F.tid; i < nchunk; i += (size_t)F.G * 512) {
        const f32x4 a = *(const f32x4*)(F.x + i * 8), b = *(const f32x4*)(F.x + i * 8 + 4);
        u32x4 w; w.x = cvt_pk_bf16(a[0], a[1]); w.y = cvt_pk_bf16(a[2], a[3]); w.z = cvt_pk_bf16(b[0], b[1]); w.w = cvt_pk_bf16(b[2], b[3]);
        *(u32x4*)(F.Xb + i * 8) = w; }
}

typedef float f32x16 __attribute__((ext_vector_type(16)));
typedef short s16x4 __attribute__((ext_vector_type(4)));
constexpr int SG_ROW = 272, SG_WAVE = 64 * SG_ROW, SG_SSQ_OFF = 8 * SG_WAVE;
static_assert(SG_SSQ_OFF + 8 * 128 * 4 <= LDS_BYTES, "SGU LDS");
__device__ __forceinline__ void sgu_unit(Frame& F, int u) {
    const int g = F.wave, lane = F.lane, i = lane & 31, hh = lane >> 5; const size_t row0 = (size_t)u * CHUNK;
    LAS unsigned char* vt = F.lds + g * SG_WAVE; LAS float* ssq = (LAS float*)(F.lds + SG_SSQ_OFF);
#pragma unroll 1
    for (int tt = 0; tt < 2; ++tt) { const int t = lane + 64 * tt; const bf16_t* vp = F.P1 + (row0 + t) * INC + AW + g * GD;
        float v[64];
#pragma unroll
        for (int c8 = 0; c8 < 8; ++c8) { const u32x4 r = *(const u32x4*)(vp + 8 * c8); const unsigned w[4] = {r.x, r.y, r.z, r.w};
#pragma unroll
            for (int j = 0; j < 4; ++j) { v[8 * c8 + 2 * j] = bf_lo(w[j]); v[8 * c8 + 2 * j + 1] = bf_hi(w[j]); } }
        float s = 0.f;
#pragma unroll
        for (int c = 0; c < 64; ++c) s += v[c];
        const float mu = s * (1.f / 64.f); float q = 0.f;
#pragma unroll
        for (int c = 0; c < 64; ++c) { v[c] -= mu; q += v[c] * v[c]; }
        const float rstd = 1.0f / sqrtf(q * (1.f / 64.f) + LN_EPS);
#pragma unroll
        for (int c = 0; c < 64; ++c) { const float val = v[c] * rstd * F.sgu_ln_g[g * GD + c] + F.sgu_ln_b[g * GD + c];
            *(LAS bf16_t*)(vt + c * SG_ROW + t * 2) = (bf16_t)(cvt_pk_bf16(val, 0.f) & 0xffffu); } }
    asm volatile("s_waitcnt lgkmcnt(0)" ::: "memory");
    f32x16 acc[2][4];
#pragma unroll
    for (int mt = 0; mt < 2; ++mt)
#pragma unroll
        for (int nt = 0; nt < 4; ++nt)
#pragma unroll
            for (int r = 0; r < 16; ++r) acc[mt][nt][r] = 0.f;
#pragma unroll
    for (int nt = 0; nt < 4; ++nt) { const int t = 32 * nt + i;
#pragma unroll
        for (int ks = 0; ks < 2 * nt + 2; ++ks) { const int s0 = 16 * ks + 8 * hh;
            const float* wp = F.sgu_w + ((size_t)g * CHUNK + t) * CHUNK + s0; const f32x4 w0 = *(const f32x4*)wp, w1 = *(const f32x4*)(wp + 4);
            float wv[8] = {w0[0], w0[1], w0[2], w0[3], w1[0], w1[1], w1[2], w1[3]};
#pragma unroll
            for (int j = 0; j < 8; ++j) wv[j] = (s0 + j <= t) ? wv[j] : 0.f;
            u32x4 bw; bw.x = cvt_pk_bf16(wv[0], wv[1]); bw.y = cvt_pk_bf16(wv[2], wv[3]); bw.z = cvt_pk_bf16(wv[4], wv[5]); bw.w = cvt_pk_bf16(wv[6], wv[7]);
            const bf16x8 bfrag = __builtin_bit_cast(bf16x8, bw);
#pragma unroll
            for (int mt = 0; mt < 2; ++mt) { const bf16x8 afrag = *(const LAS bf16x8*)(vt + (32 * mt + i) * SG_ROW + s0 * 2);
                acc[mt][nt] = __builtin_amdgcn_mfma_f32_32x32x16_bf16(afrag, bfrag, acc[mt][nt], 0, 0, 0); } } }
#pragma unroll
    for (int nt = 0; nt < 4; ++nt) { const int t = 32 * nt + i; const float bs = F.sgu_b[g * CHUNK + t]; float ss = 0.f;
        const bf16_t* up = F.P1 + (row0 + t) * INC + g * GD + 4 * hh;
#pragma unroll
        for (int mt = 0; mt < 2; ++mt)
#pragma unroll
            for (int g4 = 0; g4 < 4; ++g4) { const u32x2 uw = *(const u32x2*)(up + 32 * mt + 8 * g4);
                const float u0 = bf_lo(uw.x), u1 = bf_hi(uw.x), u2 = bf_lo(uw.y), u3 = bf_hi(uw.y);
                float a0 = u0 * (acc[mt][nt][4 * g4] + bs), a1 = u1 * (acc[mt][nt][4 * g4 + 1] + bs), a2 = u2 * (acc[mt][nt][4 * g4 + 2] + bs), a3 = u3 * (acc[mt][nt][4 * g4 + 3] + bs);
                acc[mt][nt][4 * g4] = a0; acc[mt][nt][4 * g4 + 1] = a1; acc[mt][nt][4 * g4 + 2] = a2; acc[mt][nt][4 * g4 + 3] = a3;
                ss += (a0 * a0 + a1 * a1) + (a2 * a2 + a3 * a3); }
        ss += __shfl_xor(ss, 32);
        if (hh == 0) ssq[g * CHUNK + t] = ss; }
    __syncthreads();
#pragma unroll
    for (int nt = 0; nt < 4; ++nt) { const int t = 32 * nt + i; float tot = 0.f;
#pragma unroll
        for (int gg = 0; gg < 8; ++gg) tot += ssq[gg * CHUNK + t];
        const float rs = 1.0f / sqrtf(tot * (1.f / AW) + LN_EPS);
        bf16_t* op = F.Amix + (row0 + t) * D + g * GD + 4 * hh;
#pragma unroll
        for (int mt = 0; mt < 2; ++mt)
#pragma unroll
            for (int g4 = 0; g4 < 4; ++g4) { const f32x4 mg = *(const f32x4*)(F.mix_g + g * GD + 32 * mt + 8 * g4 + 4 * hh);
                u32x2 w; w.x = cvt_pk_bf16(acc[mt][nt][4 * g4] * rs * mg[0], acc[mt][nt][4 * g4 + 1] * rs * mg[1]); w.y = cvt_pk_bf16(acc[mt][nt][4 * g4 + 2] * rs * mg[2], acc[mt][nt][4 * g4 + 3] * rs * mg[3]);
                *(u32x2*)(op + 32 * mt + 8 * g4) = w; } }
    __syncthreads();
}

constexpr int AT_KROW = 144, AT_VROW = 776, AT_V_OFF = 384 * AT_KROW;
static_assert(AT_V_OFF + 64 * AT_VROW <= RING_BYTES, "attention LDS");
__device__ __forceinline__ void attn_unit(Frame& F, int u) {
    const int bh = u / 48, rem = u % 48, p = rem >> 4, idx = rem & 15, b = bh >> 3, h = bh & 7;
    const int d = (p == 0) ? 1 : (p == 1) ? 4 : 16, r = (p == 0) ? 0 : (p == 1) ? (idx >> 2) : idx, blk = (p == 0) ? idx : (p == 1) ? (idx & 3) : 0;
    const int q0 = blk * 256; const int lane = F.lane, i = lane & 31, hh = lane >> 5, w = F.wave;
    const bf16_t* base = F.P1 + (size_t)b * SEQ * INC + h * HD;
    LAS unsigned char* kl = F.lds; LAS unsigned char* vl = F.lds + AT_V_OFF;
#pragma unroll
    for (int it = 0; it < 6; ++it) { const int ch = F.tid + 512 * it, key = ch >> 3, c = ch & 7, s = q0 - 128 + key;
        u32x4 kv = (u32x4){0u, 0u, 0u, 0u}, vv = (u32x4){0u, 0u, 0u, 0u};
        if (s >= 0) { const bf16_t* rp = base + (size_t)(s * d + r) * INC + c * 8; kv = *(const u32x4*)(rp + 1536); vv = *(const u32x4*)(rp + 2048); }
        *(LAS u32x4*)(kl + key * AT_KROW + c * 16) = kv;
        const unsigned vw[4] = {vv.x, vv.y, vv.z, vv.w};
#pragma unroll
        for (int j = 0; j < 4; ++j) { *(LAS bf16_t*)(vl + (8 * c + 2 * j) * AT_VROW + key * 2) = (bf16_t)(vw[j] & 0xffffu); *(LAS bf16_t*)(vl + (8 * c + 2 * j + 1) * AT_VROW + key * 2) = (bf16_t)(vw[j] >> 16); } }
    const int qs = q0 + 32 * w + i; const size_t qrow = (size_t)qs * d + r;
    bf16x8 qf[4];
#pragma unroll
    for (int ks = 0; ks < 4; ++ks) qf[ks] = *(const bf16x8*)(base + qrow * INC + 1024 + 16 * ks + 8 * hh);
    __syncthreads();
    f32x16 s[5];
#pragma unroll
    for (int kt = 0; kt < 5; ++kt) { f32x16 a;
#pragma unroll
        for (int rr = 0; rr < 16; ++rr) a[rr] = 0.f;
#pragma unroll
        for (int ks = 0; ks < 4; ++ks) { const bf16x8 kf = *(const LAS bf16x8*)(kl + (32 * w + 32 * kt + i) * AT_KROW + (16 * ks + 8 * hh) * 2);
            a = __builtin_amdgcn_mfma_f32_32x32x16_bf16(kf, qf[ks], a, 0, 0, 0); }
        s[kt] = a; }
    const float sc = 0.125f * 1.4426950408889634f; const int ksub0 = q0 + 32 * w - 128;
    float m = -INFINITY;
#pragma unroll
    for (int kt = 0; kt < 5; ++kt)
#pragma unroll
        for (int rr = 0; rr < 16; ++rr) { const int kk = (rr & 3) + 8 * (rr >> 2) + 4 * hh; bool ok = (ksub0 + 32 * kt + kk) >= 0;
            if (kt == 0) ok = ok && (kk >= i);
            if (kt == 4) ok = ok && (kk <= i);
            const float v = ok ? s[kt][rr] * sc : -INFINITY; s[kt][rr] = v; m = fmaxf(m, v); }
    m = fmaxf(m, __shfl_xor(m, 32));
    float lsum = 0.f;
#pragma unroll
    for (int kt = 0; kt < 5; ++kt)
#pragma unroll
        for (int rr = 0; rr < 16; ++rr) { const float pv = __builtin_amdgcn_exp2f(s[kt][rr] - m); s[kt][rr] = pv; lsum += pv; }
    lsum += __shfl_xor(lsum, 32);
    f32x16 o[2];
#pragma unroll
    for (int dt = 0; dt < 2; ++dt)
#pragma unroll
        for (int rr = 0; rr < 16; ++rr) o[dt][rr] = 0.f;
#pragma unroll
    for (int kt = 0; kt < 5; ++kt)
#pragma unroll
        for (int s2 = 0; s2 < 2; ++s2) { u32x4 pw; pw.x = cvt_pk_bf16(s[kt][8 * s2], s[kt][8 * s2 + 1]); pw.y = cvt_pk_bf16(s[kt][8 * s2 + 2], s[kt][8 * s2 + 3]);
            pw.z = cvt_pk_bf16(s[kt][8 * s2 + 4], s[kt][8 * s2 + 5]); pw.w = cvt_pk_bf16(s[kt][8 * s2 + 6], s[kt][8 * s2 + 7]);
            const bf16x8 pb = __builtin_bit_cast(bf16x8, pw);
#pragma unroll
            for (int dt = 0; dt < 2; ++dt) { const LAS unsigned char* ap = vl + (32 * dt + i) * AT_VROW + (32 * w + 32 * kt + 16 * s2 + 4 * hh) * 2;
                const s16x4 lo = *(const LAS s16x4*)ap, hi = *(const LAS s16x4*)(ap + 16);
                const bf16x8 af = __builtin_shufflevector(lo, hi, 0, 1, 2, 3, 4, 5, 6, 7);
                o[dt] = __builtin_amdgcn_mfma_f32_32x32x16_bf16(af, pb, o[dt], 0, 0, 0); } }
    const float inv = 1.0f / lsum; const size_t orow = (size_t)b * SEQ + qrow;
    bf16_t* op = F.Opart + ((size_t)p * T + orow) * AW + h * HD + 4 * hh;
#pragma unroll
    for (int dt = 0; dt < 2; ++dt)
#pragma unroll
        for (int g4 = 0; g4 < 4; ++g4) { u32x2 wv; wv.x = cvt_pk_bf16(o[dt][4 * g4] * inv, o[dt][4 * g4 + 1] * inv); wv.y = cvt_pk_bf16(o[dt][4 * g4 + 2] * inv, o[dt][4 * g4 + 3] * inv);
            *(u32x2*)(op + 32 * dt + 8 * g4) = wv; }
    if (hh == 0) *(f32x2*)(F.ML + (((size_t)p * T + orow) * NH + h) * 2) = (f32x2){m, lsum};
    __syncthreads();
}
__device__ __forceinline__ void p2_mixers(Frame& F) {
    constexpr int NSGU = BATCH * (SEQ / CHUNK), NATT = BATCH * NH * 48;
    for (int u = blockIdx.x; u < NSGU + NATT; u += F.G) { if (u < NSGU) sgu_unit(F, u); else attn_unit(F, u - NSGU); }
}

__device__ __forceinline__ void p3_merge(Frame& F) {
    const int gw = blockIdx.x * 8 + F.wave, NGW = F.G * 8, h = F.lane >> 3;
    for (int row = gw; row < T; row += NGW) {
        f32x2 ml[3]; float mx = -INFINITY;
#pragma unroll
        for (int p = 0; p < 3; ++p) { ml[p] = *(const f32x2*)(F.ML + (((size_t)p * T + row) * NH + h) * 2); mx = fmaxf(mx, ml[p].x); }
        float wt[3], wsum = 0.f;
#pragma unroll
        for (int p = 0; p < 3; ++p) { wt[p] = ml[p].y * __builtin_amdgcn_exp2f(ml[p].x - mx); wsum += wt[p]; }
        const float iw = 1.0f / wsum; float bv[8];
#pragma unroll
        for (int j = 0; j < 8; ++j) bv[j] = 0.f;
#pragma unroll
        for (int p = 0; p < 3; ++p) { const u32x4 r = *(const u32x4*)(F.Opart + ((size_t)p * T + row) * AW + F.lane * 8); const unsigned w[4] = {r.x, r.y, r.z, r.w}; const float f = wt[p] * iw;
#pragma unroll
            for (int j = 0; j < 4; ++j) { bv[2 * j] += f * bf_lo(w[j]); bv[2 * j + 1] += f * bf_hi(w[j]); } }
        float ss = 0.f;
#pragma unroll
        for (int j = 0; j < 8; ++j) ss += bv[j] * bv[j];
        ss = wave_sum(ss); const float rs = 1.0f / sqrtf(ss * (1.f / AW) + LN_EPS);
        const f32x4 g0 = *(const f32x4*)(F.mix_g + AW + F.lane * 8), g1 = *(const f32x4*)(F.mix_g + AW + F.lane * 8 + 4);
        u32x4 w; w.x = cvt_pk_bf16(bv[0] * rs * g0[0], bv[1] * rs * g0[1]); w.y = cvt_pk_bf16(bv[2] * rs * g0[2], bv[3] * rs * g0[3]);
        w.z = cvt_pk_bf16(bv[4] * rs * g1[0], bv[5] * rs * g1[1]); w.w = cvt_pk_bf16(bv[6] * rs * g1[2], bv[7] * rs * g1[3]);
        *(u32x4*)(F.Amix + (size_t)row * D + AW + F.lane * 8) = w;
    }
}

__device__ __forceinline__ void p4_route(Frame& F) {
    LAS float* wr = (LAS float*)F.lds;
    LAS int* sel_e = (LAS int*)(F.lds + RING_BYTES);
    LAS float* sel_g = (LAS float*)(F.lds + RING_BYTES + 1024);
    LAS int* lcnt = (LAS int*)(F.lds + RING_BYTES + 2048);
    LAS int* lbase = (LAS int*)(F.lds + RING_BYTES + 2048 + 128);
    for (int i = F.tid; i < D * 8; i += 512) { const int k = i >> 3, c = i & 7; const f32x4 v = *(const f32x4*)(F.w_router + (size_t)k * NE + 4 * c); *(LAS f32x4*)(wr + k * 32 + 4 * (c ^ ((k >> 1) & 7))) = v; }
    if (F.tid < 32) lcnt[F.tid] = 0;
    __syncthreads();
    const int sw = (F.lane >> 1) & 7;
    for (int chunk = blockIdx.x; chunk < T / 64; chunk += F.G) {
        for (int it = 0; it < 8; ++it) {
            const int tl = F.wave * 8 + it, row = chunk * 64 + tl;
            float* zp = F.out + (size_t)row * D;
            float h[16]; float s = 0.f;
#pragma unroll
            for (int qd = 0; qd < 16; ++qd) { h[qd] = zp[F.lane + 64 * qd]; s += h[qd]; }
            const float mu = wave_sum(s) * (1.f / D); float q = 0.f;
#pragma unroll
            for (int qd = 0; qd < 16; ++qd) { h[qd] -= mu; q += h[qd] * h[qd]; }
            const float rstd = 1.0f / sqrtf(wave_sum(q) * (1.f / D) + LN_EPS);
#pragma unroll
            for (int qd = 0; qd < 16; ++qd) { const int k = F.lane + 64 * qd; h[qd] = h[qd] * rstd * F.ln1_g[k] + F.ln1_b[k]; zp[k] = h[qd]; F.Hb[(size_t)row * D + k] = (bf16_t)(cvt_pk_bf16(h[qd], 0.f) & 0xffffu); }
            float lg[32];
#pragma unroll
            for (int e = 0; e < 32; ++e) lg[e] = 0.f;
#pragma unroll
            for (int qd = 0; qd < 16; ++qd) { const LAS float* rp = wr + (F.lane + 64 * qd) * 32;
#pragma unroll
                for (int c = 0; c < 8; ++c) { const f32x4 w = *(const LAS f32x4*)(rp + 4 * (c ^ sw)); lg[4 * c] += h[qd] * w[0]; lg[4 * c + 1] += h[qd] * w[1]; lg[4 * c + 2] += h[qd] * w[2]; lg[4 * c + 3] += h[qd] * w[3]; } }
#pragma unroll
            for (int e = 0; e < 32; ++e) lg[e] = wave_sum(lg[e]) + F.b_router[e];
            int idx[4]; float val[4]; unsigned taken = 0u;
#pragma unroll
            for (int r = 0; r < 4; ++r) { float best = -INFINITY; int bi = 0;
#pragma unroll
                for (int e = 0; e < 32; ++e) { const bool ok = !((taken >> e) & 1u) && (lg[e] > best); best = ok ? lg[e] : best; bi = ok ? e : bi; }
                idx[r] = bi; val[r] = best; taken |= 1u << bi; }
            const float e1 = __expf(val[1] - val[0]), e2 = __expf(val[2] - val[0]), e3 = __expf(val[3] - val[0]); const float inv = 1.0f / (1.0f + e1 + e2 + e3);
            if (F.lane == 0) { sel_e[tl * 4 + 0] = idx[0]; sel_e[tl * 4 + 1] = idx[1]; sel_e[tl * 4 + 2] = idx[2]; sel_e[tl * 4 + 3] = idx[3];
                sel_g[tl * 4 + 0] = inv; sel_g[tl * 4 + 1] = e1 * inv; sel_g[tl * 4 + 2] = e2 * inv; sel_g[tl * 4 + 3] = e3 * inv; }
        }
        __syncthreads();
        int myrank = 0, mye = 0;
        if (F.tid < 256) { mye = sel_e[F.tid]; myrank = atomicAdd((int*)&lcnt[mye], 1); }
        __syncthreads();
        if (F.tid < 32) { const int c = lcnt[F.tid]; lbase[F.tid] = c ? (int)__hip_atomic_fetch_add(F.ctl + CW_CNT + F.tid, (unsigned)c, __ATOMIC_RELAXED, __HIP_MEMORY_SCOPE_AGENT) : 0; lcnt[F.tid] = 0; }
        __syncthreads();
        if (F.tid < 256) { const int slot = (chunk * 64 + (F.tid >> 2)) * 4 + (F.tid & 3); F.list[mye * T + lbase[mye] + myrank] = slot; F.gates[slot] = sel_g[F.tid]; }
        __syncthreads();
    }
}

template <bool G1> __device__ __forceinline__ int moe_tables(Frame& F, int NPN) {
    LAS int* cnt = (LAS int*)(F.lds + TAB_OFF); LAS int* tstart = cnt + 32; LAS int* rowtab = (LAS int*)(F.lds + ROWTAB_OFF);
    if (F.tid < 32) cnt[F.tid] = (int)__hip_atomic_load(F.ctl + CW_CNT + F.tid, __ATOMIC_RELAXED, __HIP_MEMORY_SCOPE_AGENT);
    __syncthreads();
    if (F.tid == 0) { int acc = 0; for (int e = 0; e < NE; ++e) { tstart[e] = acc; acc += (cnt[e] + 255) >> 8; } tstart[NE] = acc; }
    __syncthreads();
    const int ntiles = tstart[NE], nU = ntiles * NPN;
    for (int i = 0; i < MAXU; ++i) { const int L = i * F.G + F.vcu; if (L >= nU) break;
        const int tl = L / NPN; int e = 0;
        for (int j = 1; j < NE; ++j) e += (tstart[j] <= tl) ? 1 : 0;
        const int mt = tl - tstart[e];
        if (F.tid < 256) { const int rank = mt * 256 + F.tid; const int slot = rank < cnt[e] ? F.list[e * T + rank] : -1;
            rowtab[i * 256 + F.tid] = G1 ? ((slot < 0 ? 0 : (slot >> 2)) * (D * 2)) : slot; } }
    __syncthreads();
    return ntiles;
}

__device__ __forceinline__ void p7_final(Frame& F) {
    const int gw = blockIdx.x * 8 + F.wave, NGW = F.G * 8;
    for (int row = gw; row < T; row += NGW) {
        float* hp = F.out + (size_t)row * D; float v[16];
#pragma unroll
        for (int j = 0; j < 2; ++j) { const f32x4 a = *(const f32x4*)(hp + 512 * j + F.lane * 8), b = *(const f32x4*)(hp + 512 * j + F.lane * 8 + 4);
#pragma unroll
            for (int i = 0; i < 4; ++i) { v[8 * j + i] = a[i] * DN_ALPHA; v[8 * j + 4 + i] = b[i] * DN_ALPHA; } }
#pragma unroll
        for (int k = 0; k < TOPK; ++k)
#pragma unroll
            for (int j = 0; j < 2; ++j) { const u32x4 r = *(const u32x4*)(F.Y + ((size_t)row * TOPK + k) * D + 512 * j + F.lane * 8); const unsigned w[4] = {r.x, r.y, r.z, r.w};
#pragma unroll
                for (int i = 0; i < 4; ++i) { v[8 * j + 2 * i] += bf_lo(w[i]); v[8 * j + 2 * i + 1] += bf_hi(w[i]); } }
        float s = 0.f;
#pragma unroll
        for (int i = 0; i < 16; ++i) s += v[i];
        const float mu = wave_sum(s) * (1.f / D); float q = 0.f;
#pragma unroll
        for (int i = 0; i < 16; ++i) { v[i] -= mu; q += v[i] * v[i]; }
        const float rstd = 1.0f / sqrtf(wave_sum(q) * (1.f / D) + LN_EPS);
#pragma unroll
        for (int j = 0; j < 2; ++j) { const int c = 512 * j + F.lane * 8;
            const f32x4 g0 = *(const f32x4*)(F.ln2_g + c), g1 = *(const f32x4*)(F.ln2_g + c + 4), b0 = *(const f32x4*)(F.ln2_b + c), b1 = *(const f32x4*)(F.ln2_b + c + 4);
            f32x4 o0, o1;
#pragma unroll
            for (int i = 0; i < 4; ++i) { o0[i] = v[8 * j + i] * rstd * g0[i] + b0[i]; o1[i] = v[8 * j + 4 + i] * rstd * g1[i] + b1[i]; }
            *(f32x4*)(hp + c) = o0; *(f32x4*)(hp + c + 4) = o1; }
    }
}

constexpr int N_PHASES = 8;
__global__ void __launch_bounds__(512, 2) mk_fwd(Args args) {
    extern __shared__ __attribute__((aligned(16))) unsigned char lds_raw[];
    Frame F;
    F.lds = (LAS unsigned char*)lds_raw; F.tid = threadIdx.x; F.lane = F.tid & 63; F.wave = __builtin_amdgcn_readfirstlane(F.tid >> 6);
    F.G = gridDim.x; { const int bx = blockIdx.x; F.vcu = (F.G % 8 == 0) ? (bx % 8) * (F.G / 8) + bx / 8 : bx; }
    F.x = args.in[0]; F.w_in = args.in[1]; F.sgu_w = args.in[2]; F.sgu_b = args.in[3]; F.sgu_ln_g = args.in[4]; F.sgu_ln_b = args.in[5]; F.mix_g = args.in[6]; F.w_out = args.in[7];
    F.ln1_g = args.in[8]; F.ln1_b = args.in[9]; F.w_router = args.in[10]; F.b_router = args.in[11]; F.w_gate = args.in[12]; F.b_gate = args.in[13]; F.w_up = args.in[14]; F.b_up = args.in[15];
    F.w_down = args.in[16]; F.b_down = args.in[17]; F.ln2_g = args.in[18]; F.ln2_b = args.in[19]; F.out = args.out; F.ws = args.ws;
    unsigned char* ws = args.ws;
    F.ctl = (unsigned*)(ws + WS_CTL); F.list = (int*)(ws + WS_LIST); F.gates = (float*)(ws + WS_GATES);
    F.Win_t = (bf16_t*)(ws + WS_WIN); F.Wout_t = (bf16_t*)(ws + WS_WOUT); F.Wd_t = (bf16_t*)(ws + WS_WD); F.Wgu_t = (bf16_t*)(ws + WS_WGU); F.Y = (bf16_t*)(ws + WS_Y);
    F.Hb = (bf16_t*)(ws + WS_HB); F.Xb = (bf16_t*)(ws + WS_XB); F.P1 = (bf16_t*)(ws + WS_P1); F.Amix = (bf16_t*)(ws + WS_AMIX); F.Act = (bf16_t*)(ws + WS_ACT);
    F.Opart = (bf16_t*)(ws + WS_OPART); F.ML = (float*)(ws + WS_ML);
    const int lo = args.ph_lo, hi = args.ph_hi;
    volatile LAS unsigned* misc = (volatile LAS unsigned*)(F.lds + MISC_OFF);
    if (F.tid < 16) misc[F.tid] = 0u;
    __syncthreads();
    XcdBarrier bar; bar.bar = F.ctl + CW_BAR; bar.x = 0; bar.st = misc;
    if (hi - lo > 1) bar = xcd_barrier_post(F.ctl + CW_BAR, misc);
    const LAS int* rowtab = (const LAS int*)(F.lds + ROWTAB_OFF);
#define IN(k) (lo <= (k) && (k) < hi)
#define SEAM(k) do { if (IN(k) && IN((k) + 1)) { xcd_barrier(bar); } } while (0)
    if (IN(0)) { p0_convert(F); }
    SEAM(0);
    if (IN(1)) { pg8::Gemm g{F.Xb, F.Win_t, D}; pg8::DenseOrder S{INC / 256, (T / 256) * (INC / 256), F.G, F.vcu}; pg8::EpiP1 E{F.P1};
        pg8::gemm_phase<pg8::EpiP1, pg8::DenseOrder, false>(F.lds, rowtab, g, S, E); }
    SEAM(1);
    if (IN(2)) { p2_mixers(F); }
    SEAM(2);
    if (IN(3)) { p3_merge(F); }
    SEAM(3);
    if (IN(4)) { pg8::Gemm g{F.Amix, F.Wout_t, D}; pg8::DenseOrder S{D / 256, (T / 256) * (D / 256), F.G, F.vcu}; pg8::EpiZ E{F.x, F.out};
        pg8::gemm_phase<pg8::EpiZ, pg8::DenseOrder, false>(F.lds, rowtab, g, S, E); }
    SEAM(4);
    if (IN(5)) { p4_route(F); }
    SEAM(5);
    if (IN(6)) { const int ntiles = moe_tables<true>(F, 8); pg8::Gemm g{F.Hb, F.Wgu_t, D}; pg8::MoeOrder S{8, ntiles * 8, F.G, F.vcu, (const LAS int*)(F.lds + TAB_OFF) + 32};
        pg8::EpiSwiglu E{F.Act, F.b_gate, F.b_up};
        pg8::gemm_phase<pg8::EpiSwiglu, pg8::MoeOrder, true>(F.lds, rowtab, g, S, E); }
    SEAM(6);
    if (IN(7)) { const int ntiles = moe_tables<false>(F, 4); pg8::Gemm g{F.Act, F.Wd_t, FF}; pg8::MoeOrder S{4, ntiles * 4, F.G, F.vcu, (const LAS int*)(F.lds + TAB_OFF) + 32};
        pg8::EpiScatter E{F.Y, F.b_down, F.gates, rowtab};
        pg8::gemm_phase<pg8::EpiScatter, pg8::MoeOrder, false>(F.lds, rowtab, g, S, E); }
    SEAM(7);
    if (IN(8)) { p7_final(F); }
#undef IN
#undef SEAM
}

extern "C" void kernel_launch(void* const* d_in, const int* in_sizes, int n_in, void* d_out, int out_size, void* d_ws, size_t ws_size, hipStream_t stream) {
    static int grid = 0;
    if (grid == 0) {
        if (n_in != 20 || in_sizes[0] != T * D || out_size != T * D || ws_size < WS_END) { fprintf(stderr, "kernel_launch: unexpected shapes (n_in %d, in0 %d, out %d, ws %zu)\n", n_in, n_in > 0 ? in_sizes[0] : -1, out_size, ws_size); grid = -1; return; }
        int dev = 0, cus = 0, per_cu = 0;
        hipGetDevice(&dev); hipDeviceGetAttribute(&cus, hipDeviceAttributeMultiprocessorCount, dev);
        if (hipFuncSetAttribute((const void*)mk_fwd, hipFuncAttributeMaxDynamicSharedMemorySize, LDS_BYTES) != hipSuccess) { fprintf(stderr, "kernel_launch: hipFuncSetAttribute failed\n"); grid = -1; return; }
        hipOccupancyMaxActiveBlocksPerMultiprocessor(&per_cu, (const void*)mk_fwd, 512, LDS_BYTES);
        (void)hipGetLastError();
        if (per_cu < 1) { fprintf(stderr, "kernel_launch: occupancy query says %d blocks/CU: the grid would not be resident; nothing launched\n", per_cu); grid = -1; return; }
        grid = cus;
        if (grid != 256) fprintf(stderr, "kernel_launch: note: %d CUs (tuned for 256)\n", grid);
    }
    if (grid < 0) return;
    hipMemsetAsync((char*)d_ws + WS_CTL, 0, CTL_ZERO_BYTES, stream);
    Args a{};
    for (int i = 0; i < 20; ++i) a.in[i] = (const float*)d_in[i];
    a.out = (float*)d_out; a.ws = (unsigned char*)d_ws;
#if MK_N_LAUNCHES == 1
    a.ph_lo = 0; a.ph_hi = N_PHASES + 1;
    hipLaunchKernelGGL(mk_fwd, dim3(grid), dim3(512), LDS_BYTES, stream, a);
#else
    for (int p = 0; p <= N_PHASES; ++p) { a.ph_lo = p; a.ph_hi = p + 1; hipLaunchKernelGGL(mk_fwd, dim3(grid), dim3(512), LDS_BYTES, stream, a); }
#endif
}
```

```cpp
#include <hip/hip_runtime.h>
#include <hip/hip_cooperative_groups.h>
#include <cstdio>
#include <cstdint>
namespace cg = cooperative_groups;

#ifndef MK_N_LAUNCHES
#define MK_N_LAUNCHES 1
#endif

constexpr int BATCH = 4, SEQ = 4096, T = BATCH * SEQ, D = 1024, INC = 2560, NE = 32, FF = 1024, TOPK = 4;
constexpr int AW = 512, NGRP = 8, GD = 64, CHUNK = 128, NH = 8, HD = 64;
constexpr float LN_EPS = 1e-5f, DN_ALPHA = 1.189207115002721f;
constexpr int NSLOT = T * TOPK;
constexpr int MAXTILES = 288;
constexpr int MAXU = 12;

constexpr size_t MiB = 1u << 20;
constexpr size_t WS_CTL = 0, CTL_ZERO_BYTES = 64 * 1024;
constexpr size_t WS_LIST = 1 * MiB;
constexpr size_t WS_GATES = 3 * MiB;
constexpr size_t WS_WRT = 3 * MiB + 512 * 1024;
constexpr size_t WS_WIN = 4 * MiB;
constexpr size_t WS_WOUT = 9 * MiB;
constexpr size_t WS_WD = 11 * MiB;
constexpr size_t WS_WGU = 75 * MiB;
constexpr size_t WS_HB = 139 * MiB;
constexpr size_t WS_BIG = 155 * MiB;
constexpr size_t WS_XB = WS_BIG;
constexpr size_t WS_P1 = WS_BIG + 32 * MiB;
constexpr size_t WS_AMIX = WS_BIG + 112 * MiB;
constexpr size_t WS_ACT = WS_BIG;
constexpr size_t WS_Y = 299 * MiB;
constexpr size_t WS_OPART = 427 * MiB;
constexpr size_t WS_ML = 475 * MiB;
constexpr size_t WS_END = 478 * MiB;
constexpr float WGU_SCALE = 32.0f;
constexpr int CW_BAR = 1024;
constexpr int CW_CNT = 0;

constexpr int RING_BYTES = 131072;
constexpr int TAB_OFF = RING_BYTES + 1024;
constexpr int ROWTAB_OFF = RING_BYTES + 2048;
constexpr int MISC_OFF = 147456 - 64;
constexpr int LDS_BYTES = 147456;
static_assert(ROWTAB_OFF + MAXU * 1024 <= LDS_BYTES, "LDS map");

#define LAS __attribute__((address_space(3)))
typedef unsigned short bf16_t;
typedef short bf16x8 __attribute__((ext_vector_type(8)));
typedef float f32x4 __attribute__((ext_vector_type(4)));
typedef float f32x2 __attribute__((ext_vector_type(2)));
typedef unsigned u32x4 __attribute__((ext_vector_type(4)));
typedef unsigned u32x2 __attribute__((ext_vector_type(2)));
typedef int v8i32 __attribute__((ext_vector_type(8)));
typedef int v4i32 __attribute__((ext_vector_type(4)));
typedef unsigned char fp8_t;

__device__ __forceinline__ unsigned cvt_pk_bf16(float lo, float hi) { unsigned r; asm volatile("v_cvt_pk_bf16_f32 %0, %1, %2" : "=v"(r) : "v"(lo), "v"(hi)); return r; }
__device__ __forceinline__ unsigned cvt4_fp8(float a, float b, float c, float d) { int w = 0; w = __builtin_amdgcn_cvt_pk_fp8_f32(a, b, w, false); w = __builtin_amdgcn_cvt_pk_fp8_f32(c, d, w, true); return (unsigned)w; }
__device__ __forceinline__ float bf_lo(unsigned w) { return __uint_as_float(w << 16); }
__device__ __forceinline__ float bf_hi(unsigned w) { return __uint_as_float(w & 0xffff0000u); }
__device__ __forceinline__ float bf1(bf16_t b) { return __uint_as_float((unsigned)b << 16); }
__device__ __forceinline__ float wave_sum(float v) {
#pragma unroll
    for (int o = 1; o < 64; o <<= 1) v += __shfl_xor(v, o);
    return v;
}
__device__ __forceinline__ float gelu_tanh(float x) {
    const float y2 = x * (1.5957691216057308f + 0.07135481627260025f * x * x);
    return x * __builtin_amdgcn_rcpf(1.0f + __builtin_amdgcn_exp2f(-1.4426950408889634f * y2));
}

namespace pg8 {
constexpr int BM = 256, BK = 64, HALF = 128, HTB = HALF * BK * 2, STAGE_BYTES = 8 * HTB;
__host__ __device__ __forceinline__ int lds_byte(int r, int c) { const int st = (r >> 4) * 2 + (c >> 5), rr = r & 15, cc = c & 31, ob = rr * 64 + cc * 2; return st * 1024 + (ob ^ (((ob >> 9) & 1) << 5)); }
__host__ __device__ __forceinline__ void stage_rc(int b, int& R, int& C) { const int st = b / 1024, sb = b % 1024, swz = sb ^ (((sb >> 9) & 1) << 5); R = (st >> 1) * 16 + swz / 64; C = (st & 1) * 32 + (swz % 64) / 2; }
__host__ __device__ __forceinline__ int perm32(int rho) { const int n = rho >> 4, i = rho & 15; return 8 * (i >> 2) + 4 * n + (i & 3); }

struct Unit { int pm, pn, pb, e, mt, ui; };
struct Gemm { const void* A; const void* Bt; int KB; };

struct DenseOrder {
    int nN, nU, G, v;
    __device__ __forceinline__ bool next(int i, Unit& u) const {
        const int L = i * G + v; if (L >= nU) return false;
        u.pm = L / nN; u.pn = L % nN; u.pb = u.pn; u.e = 0; u.mt = 0; u.ui = i; return true; }
};
struct MoeOrder {
    int NPN, nU, G, v; const LAS int* tstart;
    __device__ __forceinline__ bool next(int i, Unit& u) const {
        const int L = i * G + v; if (L >= nU) return false;
        const int tl = L / NPN, pn = L % NPN; int e = 0;
#pragma unroll
        for (int j = 1; j < NE; ++j) e += (tstart[j] <= tl) ? 1 : 0;
        e = __builtin_amdgcn_readfirstlane(e); const int ts = __builtin_amdgcn_readfirstlane(tstart[e]);
        u.pm = tl; u.pn = pn; u.pb = e * NPN + pn; u.e = e; u.mt = tl - ts; u.ui = i; return true; }
};

template <class Epi, class Sched, bool GATHER, bool FP8>
__device__ __forceinline__ void gemm_phase(LAS unsigned char* lds, const LAS int* rowtab, const Gemm g, const Sched& S, const Epi& E) {
    const int tid = threadIdx.x, wid = __builtin_amdgcn_readfirstlane(tid >> 6), lane = tid & 63, wr = wid >> 2, wc = wid & 3, fr = lane & 15, fq = lane >> 4;
    const int KB = g.KB, nt = KB / (BK * 2);
    unsigned voffA0[2], voffA1[2], voffB[2]; int Rr[2], Cc[2];
#pragma unroll
    for (int i = 0; i < 2; ++i) { int R, C; stage_rc(tid * 16 + i * 8192, R, C); const int Rb = Epi::PERM ? ((R & ~31) + perm32(R & 31)) : R; Rr[i] = R; Cc[i] = C;
        voffA0[i] = (unsigned)(R * KB + C * 2); voffA1[i] = (unsigned)((R + HALF) * KB + C * 2); voffB[i] = (unsigned)(Rb * KB + C * 2); }
    const size_t kstep = (size_t)(BK * 2);
    const size_t hstep = (size_t)HALF * KB;
    const size_t tstep = 2 * hstep;
    const unsigned ldsw = (unsigned)wid * 1024u;
    const int aoff = lds_byte(wr * 64 + fr, fq * 8), boff = lds_byte(wc * 32 + fr, fq * 8);
#define PG8_SA(b, h) (((b) * 2 + (h)) * HTB)
#define PG8_SB(b, h) ((4 + (b) * 2 + (h)) * HTB)
#define PG8_STAGE(bufoff, gbase, voff) do { _Pragma("unroll") for (int _i = 0; _i < 2; ++_i) \
        __builtin_amdgcn_global_load_lds((const unsigned*)((const char*)(gbase) + (voff)[_i]), (LAS unsigned*)(lds + (bufoff) + ldsw + _i * 8192), 16, 0, 0); } while (0)
#define PG8_LDA(dst, b, h) do { if constexpr (FP8) { _Pragma("unroll") for (int m = 0; m < 4; ++m) dst##8[m] = __builtin_shufflevector(*(const LAS v4i32*)(lds + PG8_SA(b, h) + aoff + m * 2048), *(const LAS v4i32*)(lds + PG8_SA(b, h) + aoff + m * 2048 + 1024), 0, 1, 2, 3, 4, 5, 6, 7); } \
        else { _Pragma("unroll") for (int m = 0; m < 4; ++m) _Pragma("unroll") for (int k = 0; k < 2; ++k) dst[m][k] = *(const LAS bf16x8*)(lds + PG8_SA(b, h) + aoff + m * 2048 + k * 1024); } } while (0)
#define PG8_LDB(dst, b, h) do { if constexpr (FP8) { _Pragma("unroll") for (int n = 0; n < 2; ++n) dst##8[n] = __builtin_shufflevector(*(const LAS v4i32*)(lds + PG8_SB(b, h) + boff + n * 2048), *(const LAS v4i32*)(lds + PG8_SB(b, h) + boff + n * 2048 + 1024), 0, 1, 2, 3, 4, 5, 6, 7); } \
        else { _Pragma("unroll") for (int n = 0; n < 2; ++n) _Pragma("unroll") for (int k = 0; k < 2; ++k) dst[n][k] = *(const LAS bf16x8*)(lds + PG8_SB(b, h) + boff + n * 2048 + k * 1024); } } while (0)
#define PG8_MMA(ai, bj, At, Bt) do { __builtin_amdgcn_s_setprio(1); if constexpr (FP8) { _Pragma("unroll") for (int m = 0; m < 4; ++m) _Pragma("unroll") for (int n = 0; n < 2; ++n) \
        acc[ai][bj][m][n] = __builtin_amdgcn_mfma_scale_f32_16x16x128_f8f6f4(Bt##8[n], At##8[m], acc[ai][bj][m][n], 0, 0, 0, 0x7F7F7F7F, 0, 0x7F7F7F7F); } \
        else { _Pragma("unroll") for (int m = 0; m < 4; ++m) _Pragma("unroll") for (int n = 0; n < 2; ++n) _Pragma("unroll") for (int k = 0; k < 2; ++k) \
        acc[ai][bj][m][n] = __builtin_amdgcn_mfma_f32_16x16x32_bf16(Bt[n][k], At[m][k], acc[ai][bj][m][n], 0, 0, 0); } __builtin_amdgcn_s_setprio(0); } while (0)
#define PG8_WAIT_V(n) asm volatile("s_waitcnt vmcnt(" #n ")" ::: "memory")
#define PG8_WAIT_L(n) asm volatile("s_waitcnt lgkmcnt(" #n ")" ::: "memory")
#define PG8_BAR __builtin_amdgcn_s_barrier()
#define PG8_SCHED __builtin_amdgcn_sched_barrier(0)
#define PG8_LOADROWS(U) do { if constexpr (GATHER) { _Pragma("unroll") for (int _i = 0; _i < 2; ++_i) { \
        voffA0[_i] = (unsigned)rowtab[(U).ui * 256 + Rr[_i]] + (unsigned)Cc[_i] * 2u; voffA1[_i] = (unsigned)rowtab[(U).ui * 256 + HALF + Rr[_i]] + (unsigned)Cc[_i] * 2u; } } } while (0)
    Unit cur, nxt; int ui = 0;
    if (!S.next(0, cur)) return;
    f32x4 acc[2][2][4][2];
#pragma unroll
    for (int a = 0; a < 2; ++a)
#pragma unroll
        for (int b = 0; b < 2; ++b)
#pragma unroll
            for (int m = 0; m < 4; ++m)
#pragma unroll
                for (int n = 0; n < 2; ++n) acc[a][b][m][n] = (f32x4){0.f, 0.f, 0.f, 0.f};
    bf16x8 At[4][2], B0[2][2], B1[2][2]; v8i32 At8[4], B08[2], B18[2];
    const char* cA = GATHER ? (const char*)g.A : (const char*)g.A + (size_t)cur.pm * tstep; const char* cB = (const char*)g.Bt + (size_t)cur.pb * tstep;
    PG8_LOADROWS(cur); PG8_WAIT_L(0);
    PG8_STAGE(PG8_SB(0, 0), cB, voffB); PG8_STAGE(PG8_SB(0, 1), cB + hstep, voffB); PG8_STAGE(PG8_SA(0, 0), cA, voffA0); PG8_STAGE(PG8_SA(0, 1), cA, voffA1);
    if (wr == 1) PG8_BAR;
    PG8_WAIT_V(2); PG8_BAR;
    PG8_STAGE(PG8_SB(1, 0), cB + kstep, voffB); PG8_STAGE(PG8_SA(1, 0), cA + kstep, voffA0); PG8_STAGE(PG8_SB(1, 1), cB + hstep + kstep, voffB);
    PG8_WAIT_V(6); PG8_BAR;
    for (;;) {
        const bool has_next = S.next(ui + 1, nxt);
        const char* nA = has_next ? (GATHER ? (const char*)g.A : (const char*)g.A + (size_t)nxt.pm * tstep) : cA; const char* nB = has_next ? (const char*)g.Bt + (size_t)nxt.pb * tstep : cB;
#pragma unroll 1
        for (int t = 0; t < nt; t += 2) {
            const bool last = (t == nt - 2);
            const char* a1 = cA + (size_t)(t + 1) * kstep;
            const char* a2 = last ? nA : cA + (size_t)(t + 2) * kstep; const char* b2 = last ? nB : cB + (size_t)(t + 2) * kstep;
            const char* a3 = a2 + kstep; const char* b3 = b2 + kstep;
            PG8_LDB(B0, 0, 0); PG8_LDB(B1, 0, 1); PG8_SCHED; PG8_LDA(At, 0, 0); PG8_STAGE(PG8_SA(1, 1), a1, voffA1);
            if (last && has_next) PG8_LOADROWS(nxt);
            PG8_WAIT_V(8); PG8_WAIT_L(0); PG8_BAR; PG8_MMA(0, 0, At, B0); PG8_MMA(0, 1, At, B1); PG8_BAR; PG8_SCHED;
            PG8_LDA(At, 0, 1); PG8_STAGE(PG8_SB(0, 0), b2, voffB); PG8_STAGE(PG8_SB(0, 1), b2 + hstep, voffB); PG8_STAGE(PG8_SA(0, 0), a2, voffA0);
            PG8_WAIT_V(8); PG8_WAIT_L(0); PG8_BAR; PG8_MMA(1, 0, At, B0); PG8_MMA(1, 1, At, B1); PG8_BAR; PG8_SCHED;
            PG8_LDB(B0, 1, 0); PG8_LDB(B1, 1, 1); PG8_SCHED; PG8_LDA(At, 1, 0); PG8_STAGE(PG8_SA(0, 1), a2, voffA1);
            PG8_WAIT_V(8); PG8_WAIT_L(0); PG8_BAR; PG8_MMA(0, 0, At, B0); PG8_MMA(0, 1, At, B1); PG8_BAR; PG8_SCHED;
            PG8_LDA(At, 1, 1); PG8_STAGE(PG8_SB(1, 0), b3, voffB); PG8_STAGE(PG8_SB(1, 1), b3 + hstep, voffB); PG8_STAGE(PG8_SA(1, 0), a3, voffA0);
            PG8_WAIT_V(8); PG8_WAIT_L(0); PG8_BAR; PG8_MMA(1, 0, At, B0); PG8_MMA(1, 1, At, B1); PG8_BAR; PG8_SCHED;
        }
        if (wr == 0) PG8_BAR;
        { int t2 = threadIdx.x; asm volatile("" : "+v"(t2));
          const int w2 = __builtin_amdgcn_readfirstlane(t2 >> 6), l2 = t2 & 63; E(acc, cur, w2 >> 2, w2 & 3, l2 & 15, l2 >> 4); }
        if (!has_next) break;
#pragma unroll
        for (int a = 0; a < 2; ++a)
#pragma unroll
            for (int b = 0; b < 2; ++b)
#pragma unroll
                for (int m = 0; m < 4; ++m)
#pragma unroll
                    for (int n = 0; n < 2; ++n) acc[a][b][m][n] = (f32x4){0.f, 0.f, 0.f, 0.f};
        cur = nxt; cA = nA; cB = nB; ++ui;
        if (wr == 1) PG8_BAR;
    }
    PG8_WAIT_V(0);
    PG8_BAR;
#undef PG8_SA
#undef PG8_SB
#undef PG8_STAGE
#undef PG8_LDA
#undef PG8_LDB
#undef PG8_MMA
#undef PG8_WAIT_V
#undef PG8_WAIT_L
#undef PG8_BAR
#undef PG8_SCHED
#undef PG8_LOADROWS
}

struct EpiP1 {
    static constexpr bool PERM = true;
    bf16_t* O;
    __device__ __forceinline__ void operator()(const f32x4 (&acc)[2][2][4][2], const Unit& u, int wr, int wc, int fr, int fq) const {
        const int row0 = u.pm * BM + wr * 64 + fr, col0 = u.pn * BM + wc * 32 + 8 * fq; const bool act = u.pn < 4;
#pragma unroll
        for (int ai = 0; ai < 2; ++ai)
#pragma unroll
            for (int m = 0; m < 4; ++m) { bf16_t* rowp = O + (size_t)(row0 + ai * HALF + m * 16) * INC + col0;
#pragma unroll
                for (int bj = 0; bj < 2; ++bj) { f32x4 v0 = acc[ai][bj][m][0], v1 = acc[ai][bj][m][1];
                    if (act) {
#pragma unroll
                        for (int j = 0; j < 4; ++j) { v0[j] = gelu_tanh(v0[j]); v1[j] = gelu_tanh(v1[j]); } }
                    u32x4 w; w.x = cvt_pk_bf16(v0[0], v0[1]); w.y = cvt_pk_bf16(v0[2], v0[3]); w.z = cvt_pk_bf16(v1[0], v1[1]); w.w = cvt_pk_bf16(v1[2], v1[3]);
                    *(u32x4*)(rowp + bj * HALF) = w; } }
    }
};
struct EpiZ {
    static constexpr bool PERM = false;
    const float* X; float* Z;
    __device__ __forceinline__ void operator()(const f32x4 (&acc)[2][2][4][2], const Unit& u, int wr, int wc, int fr, int fq) const {
        const int col0 = u.pn * BM + wc * 32 + 4 * fq;
#pragma unroll
        for (int ai = 0; ai < 2; ++ai)
#pragma unroll
            for (int m = 0; m < 4; ++m) { const size_t off = (size_t)(u.pm * BM + ai * HALF + wr * 64 + m * 16 + fr) * D + col0;
#pragma unroll
                for (int bj = 0; bj < 2; ++bj)
#pragma unroll
                    for (int n = 0; n < 2; ++n) { const f32x4 xv = *(const f32x4*)(X + off + bj * HALF + n * 16); *(f32x4*)(Z + off + bj * HALF + n * 16) = xv * DN_ALPHA + acc[ai][bj][m][n]; } }
    }
};
struct EpiSwiglu {
    static constexpr bool PERM = true;
    bf16_t* Act; const float* bg; const float* bu;
    __device__ __forceinline__ void operator()(const f32x4 (&acc)[2][2][4][2], const Unit& u, int wr, int wc, int fr, int fq) const {
        const int f0 = u.pn * HALF + wc * 32 + 8 * fq; const int row0 = u.pm * BM + wr * 64 + fr;
        const f32x4 bg0 = *(const f32x4*)(bg + u.e * FF + f0), bg1 = *(const f32x4*)(bg + u.e * FF + f0 + 4);
        const f32x4 bu0 = *(const f32x4*)(bu + u.e * FF + f0), bu1 = *(const f32x4*)(bu + u.e * FF + f0 + 4);
#pragma unroll
        for (int ai = 0; ai < 2; ++ai)
#pragma unroll
            for (int m = 0; m < 4; ++m) {
                f32x4 g0 = acc[ai][0][m][0] * (1.0f / WGU_SCALE) + bg0, g1 = acc[ai][0][m][1] * (1.0f / WGU_SCALE) + bg1, u0 = acc[ai][1][m][0] * (1.0f / WGU_SCALE) + bu0, u1 = acc[ai][1][m][1] * (1.0f / WGU_SCALE) + bu1, r0, r1;
#pragma unroll
                for (int j = 0; j < 4; ++j) {
                    const float ga = fminf(g0[j], 7.0f), gb = fminf(g1[j], 7.0f);
                    const float ua = fminf(fmaxf(u0[j], -7.0f), 7.0f), ub = fminf(fmaxf(u1[j], -7.0f), 7.0f);
                    r0[j] = (ua + 1.0f) * ga * __builtin_amdgcn_rcpf(1.0f + __builtin_amdgcn_exp2f(-1.702f * 1.4426950408889634f * ga));
                    r1[j] = (ub + 1.0f) * gb * __builtin_amdgcn_rcpf(1.0f + __builtin_amdgcn_exp2f(-1.702f * 1.4426950408889634f * gb)); }
                u32x4 w; w.x = cvt_pk_bf16(r0[0], r0[1]); w.y = cvt_pk_bf16(r0[2], r0[3]); w.z = cvt_pk_bf16(r1[0], r1[1]); w.w = cvt_pk_bf16(r1[2], r1[3]);
                *(u32x4*)(Act + (size_t)(row0 + ai * HALF + m * 16) * FF + f0) = w; }
    }
};
struct EpiScatter {
    static constexpr bool PERM = true;
    bf16_t* Y; const float* bd; const float* gates; const LAS int* rowtab;
    __device__ __forceinline__ void operator()(const f32x4 (&acc)[2][2][4][2], const Unit& u, int wr, int wc, int fr, int fq) const {
        const int c0 = u.pn * BM + wc * 32 + 8 * fq;
#pragma unroll
        for (int bj = 0; bj < 2; ++bj) { const f32x4 b0 = *(const f32x4*)(bd + u.e * D + c0 + bj * HALF), b1 = *(const f32x4*)(bd + u.e * D + c0 + bj * HALF + 4);
#pragma unroll
            for (int ai = 0; ai < 2; ++ai)
#pragma unroll
                for (int m = 0; m < 4; ++m) { const int slot = rowtab[u.ui * 256 + ai * HALF + wr * 64 + m * 16 + fr];
                    if (slot >= 0) { const float gt = gates[slot];
                        const f32x4 v0 = (acc[ai][bj][m][0] + b0) * gt, v1 = (acc[ai][bj][m][1] + b1) * gt;
                        u32x4 w; w.x = cvt_pk_bf16(v0[0], v0[1]); w.y = cvt_pk_bf16(v0[2], v0[3]); w.z = cvt_pk_bf16(v1[0], v1[1]); w.w = cvt_pk_bf16(v1[2], v1[3]);
                        *(u32x4*)(Y + (size_t)slot * D + c0 + bj * HALF) = w; } } }
    }
};
}


#define XB_TMO      128
#define XB_XCNT(j)  (256  + 64 * (j))
#define XB_XSUB(j)  (1280 + 64 * (j))
#define XB_XGEN(j)  (2304 + 64 * (j))
#define XB_TOP      3328
#define XB_TOPGEN   3392
#define XCD_BAR_WORDS 3456
#define XB_SPIN_CAP (1u << 22)
__device__ __forceinline__ unsigned xb_ld(unsigned* p)              { return __hip_atomic_load(p, __ATOMIC_RELAXED, __HIP_MEMORY_SCOPE_AGENT); }
__device__ __forceinline__ unsigned xb_add(unsigned* p, unsigned v) { return __hip_atomic_fetch_add(p, v, __ATOMIC_RELAXED, __HIP_MEMORY_SCOPE_AGENT); }
__device__ __forceinline__ unsigned xb_xcc_id() { return (unsigned)__builtin_amdgcn_s_getreg((3 << 11) | 20) & 0xFu; }
#define XB_SPIN(cond, bar) do { unsigned _sp = 0; while (cond) { __builtin_amdgcn_s_sleep(1); \
    if ((++_sp & 255u) == 0u) { if (xb_ld(&(bar)[XB_TMO])) break; if (_sp > XB_SPIN_CAP) { atomicAdd(&(bar)[XB_TMO], 1u); break; } } } } while (0)
struct XcdBarrier { unsigned* bar; unsigned x; volatile LAS unsigned* st; };
__device__ __forceinline__ XcdBarrier xcd_barrier_post(unsigned* bar, volatile LAS unsigned* st) {
    XcdBarrier b; b.bar = bar; b.x = xb_xcc_id(); b.st = st;
    if (threadIdx.x == 0) (void)xb_add(&bar[XB_XCNT(b.x)], 1u);
    return b;
}
__device__ __forceinline__ void xcd_barrier_complete(unsigned* bar, unsigned x, unsigned& nloc, unsigned& nx) {
    const unsigned G = gridDim.x * gridDim.y * gridDim.z;
    unsigned sum, cnt, mine, sp = 0u;
    for (;;) {
        sum = 0u; cnt = 0u; mine = 0u;
#pragma unroll
        for (unsigned j = 0; j < 16; ++j) { const unsigned c = xb_ld(&bar[XB_XCNT(j)]); sum += c; cnt += (c > 0u) ? 1u : 0u; mine = (j == x) ? c : mine; }
        if (sum == G) break;
        __builtin_amdgcn_s_sleep(1);
        if ((++sp & 255u) == 0u) { if (xb_ld(&bar[XB_TMO])) break; if (sp > XB_SPIN_CAP) { atomicAdd(&bar[XB_TMO], 1u); break; } }
    }
    nloc = mine > 0u ? mine : 1u; nx = cnt > 0u ? cnt : 1u;
}
__device__ __forceinline__ void xcd_barrier(const XcdBarrier& b) {
    asm volatile("s_waitcnt vmcnt(0)" ::: "memory");
    __syncthreads();
    if (threadIdx.x == 0) {
        unsigned* bar = b.bar;
        __builtin_amdgcn_s_waitcnt(0);
        unsigned nloc = b.st[0], nx = b.st[1];
        if (nloc == 0u) { xcd_barrier_complete(bar, b.x, nloc, nx); b.st[0] = nloc; b.st[1] = nx; }
        const unsigned old = xb_add(&bar[XB_XSUB(b.x)], 1u);
        const unsigned gen = old / nloc;
        if (old + 1u == (gen + 1u) * nloc) {
            __builtin_amdgcn_fence(__ATOMIC_RELEASE, "agent");
            asm volatile("s_waitcnt vmcnt(0)" ::: "memory");
            const unsigned og = xb_add(&bar[XB_TOP], 1u);
            const unsigned tg = og / nx;
            if (og + 1u == (tg + 1u) * nx) xb_add(&bar[XB_TOPGEN], 1u);
            else XB_SPIN(xb_ld(&bar[XB_TOPGEN]) == tg, bar);
            __builtin_amdgcn_fence(__ATOMIC_ACQUIRE, "agent");
            xb_add(&bar[XB_XGEN(b.x)], 1u);
            asm volatile("s_waitcnt vmcnt(0)" ::: "memory");
        } else {
            XB_SPIN(xb_ld(&bar[XB_XGEN(b.x)]) == gen, bar);
            __builtin_amdgcn_fence(__ATOMIC_ACQUIRE, "agent");
            asm volatile("s_waitcnt vmcnt(0)" ::: "memory");
        }
    }
    __syncthreads();
}

struct Args { const float* in[20]; float* out; unsigned char* ws; int ph_lo, ph_hi; };
struct Frame {
    LAS unsigned char* lds; int tid, lane, wave, G, vcu;
    const float *x, *w_in, *sgu_w, *sgu_b, *sgu_ln_g, *sgu_ln_b, *mix_g, *w_out, *ln1_g, *ln1_b, *w_router, *b_router, *w_gate, *b_gate, *w_up, *b_up, *w_down, *b_down, *ln2_g, *ln2_b;
    float* out; unsigned char* ws;
    unsigned* ctl; int* list; float* gates; bf16_t *Win_t, *Wout_t, *Y, *Xb, *P1, *Amix, *Wd_t, *Act; fp8_t *Wgu_t, *Hb; bf16_t* Opart; float* ML; bf16_t* WrtHi;
};

__device__ __forceinline__ void transpose_item(const float* W, int N, int K, int k0, int n0, bf16_t* WT, size_t dst_row0, LAS float* scr, int lane) {
#pragma unroll 8
    for (int i = 0; i < 32; ++i) { const int kk = 2 * i + (lane >> 5); scr[kk * 33 + (lane & 31)] = W[(size_t)(k0 + kk) * N + n0 + (lane & 31)]; }
    asm volatile("s_waitcnt lgkmcnt(0)" ::: "memory");
    const int c = lane & 7;
#pragma unroll
    for (int j = 0; j < 4; ++j) { const int n = (lane >> 3) + 8 * j; const LAS float* s = scr + (8 * c) * 33 + n;
        u32x4 o; o.x = cvt_pk_bf16(s[0 * 33], s[1 * 33]); o.y = cvt_pk_bf16(s[2 * 33], s[3 * 33]); o.z = cvt_pk_bf16(s[4 * 33], s[5 * 33]); o.w = cvt_pk_bf16(s[6 * 33], s[7 * 33]);
        *(u32x4*)(WT + (dst_row0 + n) * K + k0 + 8 * c) = o; }
    asm volatile("s_waitcnt lgkmcnt(0)" ::: "memory");
}
__device__ __forceinline__ void transpose_item8(const float* W, int N, int K, int k0, int n0, fp8_t* WT, size_t dst_row0, float scale, LAS float* scr, int lane) {
#pragma unroll 8
    for (int i = 0; i < 64; ++i) { const int kk = 2 * i + (lane >> 5); scr[kk * 33 + (lane & 31)] = W[(size_t)(k0 + kk) * N + n0 + (lane & 31)]; }
    asm volatile("s_waitcnt lgkmcnt(0)" ::: "memory");
    const int c = lane & 7;
#pragma unroll
    for (int j = 0; j < 4; ++j) { const int n = (lane >> 3) + 8 * j; const LAS float* s = scr + (16 * c) * 33 + n;
        u32x4 o; o.x = cvt4_fp8(s[0 * 33] * scale, s[1 * 33] * scale, s[2 * 33] * scale, s[3 * 33] * scale); o.y = cvt4_fp8(s[4 * 33] * scale, s[5 * 33] * scale, s[6 * 33] * scale, s[7 * 33] * scale);
        o.z = cvt4_fp8(s[8 * 33] * scale, s[9 * 33] * scale, s[10 * 33] * scale, s[11 * 33] * scale); o.w = cvt4_fp8(s[12 * 33] * scale, s[13 * 33] * scale, s[14 * 33] * scale, s[15 * 33] * scale);
        *(u32x4*)(WT + (dst_row0 + n) * K + k0 + 16 * c) = o; }
    asm volatile("s_waitcnt lgkmcnt(0)" ::: "memory");
}
__device__ __forceinline__ void p0_convert(Frame& F) {
    LAS float* scr = (LAS float*)(F.lds + F.wave * 17408);
    const int gw = F.vcu * 8 + F.wave, NGW = F.G * 8;
    constexpr int I_IN = (D / 64) * (INC / 32), I_OUT = (D / 64) * (D / 32), I_E8 = (D / 128) * (FF / 32), I_EB = (FF / 64) * (D / 32);
    constexpr int I_EXP = 2 * I_E8 + I_EB, NITEMS = I_IN + I_OUT + NE * I_EXP;
    for (int it = gw; it < NITEMS; it += NGW) {
        int r = it;
        if (r < I_IN) { const int kb = r / (INC / 32), nb = r % (INC / 32); transpose_item(F.w_in, INC, D, 64 * kb, 32 * nb, F.Win_t, (size_t)32 * nb, scr, F.lane); continue; } r -= I_IN;
        if (r < I_OUT) { const int kb = r / (D / 32), nb = r % (D / 32); transpose_item(F.w_out, D, D, 64 * kb, 32 * nb, F.Wout_t, (size_t)32 * nb, scr, F.lane); continue; } r -= I_OUT;
        const int e = r / I_EXP, q = r % I_EXP;
        if (q < 2 * I_E8) { const int which = q / I_E8, ii = q % I_E8, kb = ii / 32, n0 = 32 * (ii % 32);
            transpose_item8((which ? F.w_up : F.w_gate) + (size_t)e * D * FF, FF, D, 128 * kb, n0, F.Wgu_t, (size_t)e * 2048 + (n0 >> 7) * 256 + which * 128 + (n0 & 127), WGU_SCALE, scr, F.lane); }
        else { const int ii = q - 2 * I_E8, kb = ii / 32, n0 = 32 * (ii % 32); transpose_item(F.w_down + (size_t)e * FF * D, D, FF, 64 * kb, n0, F.Wd_t, (size_t)e * 1024 + n0, scr, F.lane); }
    }
    for (int i2 = blockIdx.x * 512 + F.tid; i2 < D * NE; i2 += F.G * 512) { const int k = i2 >> 5, e = i2 & 31; const float wv = F.w_router[i2];
        const unsigned hi = cvt_pk_bf16(wv, 0.f) & 0xffffu; const unsigned lo = cvt_pk_bf16(wv - bf_lo(hi), 0.f) & 0xffffu;
        F.WrtHi[(size_t)e * D + k] = (bf16_t)hi; F.WrtHi[(size_t)(NE + e) * D + k] = (bf16_t)lo; }
    const size_t nchunk = (size_t)T * D / 8;
    for (size_t i = (size_t)blockIdx.x * 512 + F.tid; i < nchunk; i += (size_t)F.G * 512) {
        const f32x4 a = *(const f32x4*)(F.x + i * 8), b = *(const f32x4*)(F.x + i * 8 + 4);
        u32x4 w; w.x = cvt_pk_bf16(a[0], a[1]); w.y = cvt_pk_bf16(a[2], a[3]); w.z = cvt_pk_bf16(b[0], b[1]); w.w = cvt_pk_bf16(b[2], b[3]);
        *(u32x4*)(F.Xb + i * 8) = w; }
}

typedef float f32x16 __attribute__((ext_vector_type(16)));
typedef short s16x4 __attribute__((ext_vector_type(4)));
constexpr int SG_ROW = 272, SG_WAVE = 64 * SG_ROW, SG_SSQ_OFF = 8 * SG_WAVE;
static_assert(SG_SSQ_OFF + 8 * 128 * 4 <= LDS_BYTES, "SGU LDS");
__device__ __forceinline__ void sgu_unit(Frame& F, int u) {
    const int g = F.wave, lane = F.lane, i = lane & 31, hh = lane >> 5; const size_t row0 = (size_t)u * CHUNK;
    LAS unsigned char* vt = F.lds + g * SG_WAVE; LAS float* ssq = (LAS float*)(F.lds + SG_SSQ_OFF);
#pragma unroll 1
    for (int tt = 0; tt < 2; ++tt) { const int t = lane + 64 * tt; const bf16_t* vp = F.P1 + (row0 + t) * INC + AW + g * GD;
        float v[64];
#pragma unroll
        for (int c8 = 0; c8 < 8; ++c8) { const u32x4 r = *(const u32x4*)(vp + 8 * c8); const unsigned w[4] = {r.x, r.y, r.z, r.w};
#pragma unroll
            for (int j = 0; j < 4; ++j) { v[8 * c8 + 2 * j] = bf_lo(w[j]); v[8 * c8 + 2 * j + 1] = bf_hi(w[j]); } }
        float s = 0.f;
#pragma unroll
        for (int c = 0; c < 64; ++c) s += v[c];
        const float mu = s * (1.f / 64.f); float q = 0.f;
#pragma unroll
        for (int c = 0; c < 64; ++c) { v[c] -= mu; q += v[c] * v[c]; }
        const float rstd = 1.0f / sqrtf(q * (1.f / 64.f) + LN_EPS);
#pragma unroll
        for (int c = 0; c < 64; ++c) { const float val = v[c] * rstd * F.sgu_ln_g[g * GD + c] + F.sgu_ln_b[g * GD + c];
            *(LAS bf16_t*)(vt + c * SG_ROW + t * 2) = (bf16_t)(cvt_pk_bf16(val, 0.f) & 0xffffu); } }
    asm volatile("s_waitcnt lgkmcnt(0)" ::: "memory");
    f32x16 acc[2][4];
#pragma unroll
    for (int mt = 0; mt < 2; ++mt)
#pragma unroll
        for (int nt = 0; nt < 4; ++nt)
#pragma unroll
            for (int r = 0; r < 16; ++r) acc[mt][nt][r] = 0.f;
#pragma unroll
    for (int nt = 0; nt < 4; ++nt) { const int t = 32 * nt + i;
#pragma unroll
        for (int ks = 0; ks < 2 * nt + 2; ++ks) { const int s0 = 16 * ks + 8 * hh;
            const float* wp = F.sgu_w + ((size_t)g * CHUNK + t) * CHUNK + s0; const f32x4 w0 = *(const f32x4*)wp, w1 = *(const f32x4*)(wp + 4);
            float wv[8] = {w0[0], w0[1], w0[2], w0[3], w1[0], w1[1], w1[2], w1[3]};
#pragma unroll
            for (int j = 0; j < 8; ++j) wv[j] = (s0 + j <= t) ? wv[j] : 0.f;
            u32x4 bw; bw.x = cvt_pk_bf16(wv[0], wv[1]); bw.y = cvt_pk_bf16(wv[2], wv[3]); bw.z = cvt_pk_bf16(wv[4], wv[5]); bw.w = cvt_pk_bf16(wv[6], wv[7]);
            const bf16x8 bfrag = __builtin_bit_cast(bf16x8, bw);
#pragma unroll
            for (int mt = 0; mt < 2; ++mt) { const bf16x8 afrag = *(const LAS bf16x8*)(vt + (32 * mt + i) * SG_ROW + s0 * 2);
                acc[mt][nt] = __builtin_amdgcn_mfma_f32_32x32x16_bf16(afrag, bfrag, acc[mt][nt], 0, 0, 0); } } }
#pragma unroll
    for (int nt = 0; nt < 4; ++nt) { const int t = 32 * nt + i; const float bs = F.sgu_b[g * CHUNK + t]; float ss = 0.f;
        const bf16_t* up = F.P1 + (row0 + t) * INC + g * GD + 4 * hh;
#pragma unroll
        for (int mt = 0; mt < 2; ++mt)
#pragma unroll
            for (int g4 = 0; g4 < 4; ++g4) { const u32x2 uw = *(const u32x2*)(up + 32 * mt + 8 * g4);
                const float u0 = bf_lo(uw.x), u1 = bf_hi(uw.x), u2 = bf_lo(uw.y), u3 = bf_hi(uw.y);
                float a0 = u0 * (acc[mt][nt][4 * g4] + bs), a1 = u1 * (acc[mt][nt][4 * g4 + 1] + bs), a2 = u2 * (acc[mt][nt][4 * g4 + 2] + bs), a3 = u3 * (acc[mt][nt][4 * g4 + 3] + bs);
                acc[mt][nt][4 * g4] = a0; acc[mt][nt][4 * g4 + 1] = a1; acc[mt][nt][4 * g4 + 2] = a2; acc[mt][nt][4 * g4 + 3] = a3;
                ss += (a0 * a0 + a1 * a1) + (a2 * a2 + a3 * a3); }
        ss += __shfl_xor(ss, 32);
        if (hh == 0) ssq[g * CHUNK + t] = ss; }
    __syncthreads();
#pragma unroll
    for (int nt = 0; nt < 4; ++nt) { const int t = 32 * nt + i; float tot = 0.f;
#pragma unroll
        for (int gg = 0; gg < 8; ++gg) tot += ssq[gg * CHUNK + t];
        const float rs = 1.0f / sqrtf(tot * (1.f / AW) + LN_EPS);
        bf16_t* op = F.Amix + (row0 + t) * D + g * GD + 4 * hh;
#pragma unroll
        for (int mt = 0; mt < 2; ++mt)
#pragma unroll
            for (int g4 = 0; g4 < 4; ++g4) { const f32x4 mg = *(const f32x4*)(F.mix_g + g * GD + 32 * mt + 8 * g4 + 4 * hh);
                u32x2 w; w.x = cvt_pk_bf16(acc[mt][nt][4 * g4] * rs * mg[0], acc[mt][nt][4 * g4 + 1] * rs * mg[1]); w.y = cvt_pk_bf16(acc[mt][nt][4 * g4 + 2] * rs * mg[2], acc[mt][nt][4 * g4 + 3] * rs * mg[3]);
                *(u32x2*)(op + 32 * mt + 8 * g4) = w; } }
    __syncthreads();
}

constexpr int AT_KROW = 144, AT_VROW = 776, AT_V_OFF = 384 * AT_KROW;
static_assert(AT_V_OFF + 64 * AT_VROW <= RING_BYTES, "attention LDS");
__device__ __forceinline__ void attn_unit(Frame& F, int u) {
    const int bh = u / 48, rem = u % 48, p = rem >> 4, idx = rem & 15, b = bh >> 3, h = bh & 7;
    const int d = (p == 0) ? 1 : (p == 1) ? 4 : 16, r = (p == 0) ? 0 : (p == 1) ? (idx >> 2) : idx, blk = (p == 0) ? idx : (p == 1) ? (idx & 3) : 0;
    const int q0 = blk * 256; const int lane = F.lane, i = lane & 31, hh = lane >> 5, w = F.wave;
    const bf16_t* base = F.P1 + (size_t)b * SEQ * INC + h * HD;
    LAS unsigned char* kl = F.lds; LAS unsigned char* vl = F.lds + AT_V_OFF;
#pragma unroll
    for (int it = 0; it < 6; ++it) { const int ch = F.tid + 512 * it, key = ch >> 3, c = ch & 7, s = q0 - 128 + key;
        u32x4 kv = (u32x4){0u, 0u, 0u, 0u}, vv = (u32x4){0u, 0u, 0u, 0u};
        if (s >= 0) { const bf16_t* rp = base + (size_t)(s * d + r) * INC + c * 8; kv = *(const u32x4*)(rp + 1536); vv = *(const u32x4*)(rp + 2048); }
        *(LAS u32x4*)(kl + key * AT_KROW + c * 16) = kv;
        const unsigned vw[4] = {vv.x, vv.y, vv.z, vv.w};
#pragma unroll
        for (int j = 0; j < 4; ++j) { *(LAS bf16_t*)(vl + (8 * c + 2 * j) * AT_VROW + key * 2) = (bf16_t)(vw[j] & 0xffffu); *(LAS bf16_t*)(vl + (8 * c + 2 * j + 1) * AT_VROW + key * 2) = (bf16_t)(vw[j] >> 16); } }
    const int qs = q0 + 32 * w + i; const size_t qrow = (size_t)qs * d + r;
    bf16x8 qf[4];
#pragma unroll
    for (int ks = 0; ks < 4; ++ks) qf[ks] = *(const bf16x8*)(base + qrow * INC + 1024 + 16 * ks + 8 * hh);
    __syncthreads();
    f32x16 s[5];
#pragma unroll
    for (int kt = 0; kt < 5; ++kt) { f32x16 a;
#pragma unroll
        for (int rr = 0; rr < 16; ++rr) a[rr] = 0.f;
#pragma unroll
        for (int ks = 0; ks < 4; ++ks) { const bf16x8 kf = *(const LAS bf16x8*)(kl + (32 * w + 32 * kt + i) * AT_KROW + (16 * ks + 8 * hh) * 2);
            a = __builtin_amdgcn_mfma_f32_32x32x16_bf16(kf, qf[ks], a, 0, 0, 0); }
        s[kt] = a; }
    const float sc = 0.125f * 1.4426950408889634f; const int ksub0 = q0 + 32 * w - 128;
    float m = -INFINITY;
#pragma unroll
    for (int kt = 0; kt < 5; ++kt)
#pragma unroll
        for (int rr = 0; rr < 16; ++rr) { const int kk = (rr & 3) + 8 * (rr >> 2) + 4 * hh; bool ok = (ksub0 + 32 * kt + kk) >= 0;
            if (kt == 0) ok = ok && (kk >= i);
            if (kt == 4) ok = ok && (kk <= i);
            const float v = ok ? s[kt][rr] * sc : -INFINITY; s[kt][rr] = v; m = fmaxf(m, v); }
    m = fmaxf(m, __shfl_xor(m, 32));
    float lsum = 0.f;
#pragma unroll
    for (int kt = 0; kt < 5; ++kt)
#pragma unroll
        for (int rr = 0; rr < 16; ++rr) { const float pv = __builtin_amdgcn_exp2f(s[kt][rr] - m); s[kt][rr] = pv; lsum += pv; }
    lsum += __shfl_xor(lsum, 32);
    f32x16 o[2];
#pragma unroll
    for (int dt = 0; dt < 2; ++dt)
#pragma unroll
        for (int rr = 0; rr < 16; ++rr) o[dt][rr] = 0.f;
#pragma unroll
    for (int kt = 0; kt < 5; ++kt)
#pragma unroll
        for (int s2 = 0; s2 < 2; ++s2) { u32x4 pw; pw.x = cvt_pk_bf16(s[kt][8 * s2], s[kt][8 * s2 + 1]); pw.y = cvt_pk_bf16(s[kt][8 * s2 + 2], s[kt][8 * s2 + 3]);
            pw.z = cvt_pk_bf16(s[kt][8 * s2 + 4], s[kt][8 * s2 + 5]); pw.w = cvt_pk_bf16(s[kt][8 * s2 + 6], s[kt][8 * s2 + 7]);
            const bf16x8 pb = __builtin_bit_cast(bf16x8, pw);
#pragma unroll
            for (int dt = 0; dt < 2; ++dt) { const LAS unsigned char* ap = vl + (32 * dt + i) * AT_VROW + (32 * w + 32 * kt + 16 * s2 + 4 * hh) * 2;
                const s16x4 lo = *(const LAS s16x4*)ap, hi = *(const LAS s16x4*)(ap + 16);
                const bf16x8 af = __builtin_shufflevector(lo, hi, 0, 1, 2, 3, 4, 5, 6, 7);
                o[dt] = __builtin_amdgcn_mfma_f32_32x32x16_bf16(af, pb, o[dt], 0, 0, 0); } }
    const float inv = 1.0f / lsum; const size_t orow = (size_t)b * SEQ + qrow;
    bf16_t* op = F.Opart + ((size_t)p * T + orow) * AW + h * HD + 4 * hh;
#pragma unroll
    for (int dt = 0; dt < 2; ++dt)
#pragma unroll
        for (int g4 = 0; g4 < 4; ++g4) { u32x2 wv; wv.x = cvt_pk_bf16(o[dt][4 * g4] * inv, o[dt][4 * g4 + 1] * inv); wv.y = cvt_pk_bf16(o[dt][4 * g4 + 2] * inv, o[dt][4 * g4 + 3] * inv);
            *(u32x2*)(op + 32 * dt + 8 * g4) = wv; }
    if (hh == 0) *(f32x2*)(F.ML + (((size_t)p * T + orow) * NH + h) * 2) = (f32x2){m, lsum};
    __syncthreads();
}
__device__ __forceinline__ void p2_mixers(Frame& F) {
    constexpr int NSGU = BATCH * (SEQ / CHUNK), NATT = BATCH * NH * 48;
    for (int u = blockIdx.x; u < NSGU + NATT; u += F.G) { if (u < NSGU) sgu_unit(F, u); else attn_unit(F, u - NSGU); }
}

__device__ __forceinline__ void p3_merge(Frame& F) {
    const int gw = blockIdx.x * 8 + F.wave, NGW = F.G * 8, h = F.lane >> 3;
    for (int row = gw; row < T; row += NGW) {
        f32x2 ml[3]; float mx = -INFINITY;
#pragma unroll
        for (int p = 0; p < 3; ++p) { ml[p] = *(const f32x2*)(F.ML + (((size_t)p * T + row) * NH + h) * 2); mx = fmaxf(mx, ml[p].x); }
        float wt[3], wsum = 0.f;
#pragma unroll
        for (int p = 0; p < 3; ++p) { wt[p] = ml[p].y * __builtin_amdgcn_exp2f(ml[p].x - mx); wsum += wt[p]; }
        const float iw = 1.0f / wsum; float bv[8];
#pragma unroll
        for (int j = 0; j < 8; ++j) bv[j] = 0.f;
#pragma unroll
        for (int p = 0; p < 3; ++p) { const u32x4 r = *(const u32x4*)(F.Opart + ((size_t)p * T + row) * AW + F.lane * 8); const unsigned w[4] = {r.x, r.y, r.z, r.w}; const float f = wt[p] * iw;
#pragma unroll
            for (int j = 0; j < 4; ++j) { bv[2 * j] += f * bf_lo(w[j]); bv[2 * j + 1] += f * bf_hi(w[j]); } }
        float ss = 0.f;
#pragma unroll
        for (int j = 0; j < 8; ++j) ss += bv[j] * bv[j];
        ss = wave_sum(ss); const float rs = 1.0f / sqrtf(ss * (1.f / AW) + LN_EPS);
        const f32x4 g0 = *(const f32x4*)(F.mix_g + AW + F.lane * 8), g1 = *(const f32x4*)(F.mix_g + AW + F.lane * 8 + 4);
        u32x4 w; w.x = cvt_pk_bf16(bv[0] * rs * g0[0], bv[1] * rs * g0[1]); w.y = cvt_pk_bf16(bv[2] * rs * g0[2], bv[3] * rs * g0[3]);
        w.z = cvt_pk_bf16(bv[4] * rs * g1[0], bv[5] * rs * g1[1]); w.w = cvt_pk_bf16(bv[6] * rs * g1[2], bv[7] * rs * g1[3]);
        *(u32x4*)(F.Amix + (size_t)row * D + AW + F.lane * 8) = w;
    }
}

constexpr int RT_ROW = 2112, RT_WAVE = 8 * RT_ROW, RT_LG_OFF = 8 * RT_WAVE, RT_SEL_OFF = RT_LG_OFF + 8192;
static_assert(RT_SEL_OFF + 2048 + 256 <= MISC_OFF, "route LDS");
__device__ __forceinline__ void p4_route(Frame& F) {
    const int lane = F.lane, w = F.wave;
    LAS unsigned char* hl = F.lds + w * RT_WAVE;
    LAS float* lgb = (LAS float*)(F.lds + RT_LG_OFF + w * 1024);
    LAS int* sel_e = (LAS int*)(F.lds + RT_SEL_OFF); LAS float* sel_g = (LAS float*)(F.lds + RT_SEL_OFF + 1024);
    LAS int* lcnt = (LAS int*)(F.lds + RT_SEL_OFF + 2048); LAS int* lbase = lcnt + 32;
    if (F.tid < 32) lcnt[F.tid] = 0;
    __syncthreads();
    f32x4 gg[4], bb[4];
#pragma unroll
    for (int j = 0; j < 4; ++j) { gg[j] = *(const f32x4*)(F.ln1_g + 4 * lane + 256 * j); bb[j] = *(const f32x4*)(F.ln1_b + 4 * lane + 256 * j); }
    for (int chunk = blockIdx.x; chunk < T / 64; chunk += F.G) {
#pragma unroll 1
        for (int batch = 0; batch < 2; ++batch) {
            const int row0 = chunk * 64 + w * 8 + batch * 4;
            f32x4 v[4][4]; float s[4], q[4];
#pragma unroll
            for (int tk = 0; tk < 4; ++tk) { s[tk] = 0.f;
#pragma unroll
                for (int j = 0; j < 4; ++j) { v[tk][j] = *(const f32x4*)(F.out + (size_t)(row0 + tk) * D + 4 * lane + 256 * j); s[tk] += (v[tk][j][0] + v[tk][j][1]) + (v[tk][j][2] + v[tk][j][3]); } }
#pragma unroll
            for (int o = 1; o < 64; o <<= 1) {
#pragma unroll
                for (int tk = 0; tk < 4; ++tk) s[tk] += __shfl_xor(s[tk], o); }
#pragma unroll
            for (int tk = 0; tk < 4; ++tk) { const float mu = s[tk] * (1.f / D); q[tk] = 0.f;
#pragma unroll
                for (int j = 0; j < 4; ++j) { v[tk][j] = v[tk][j] - mu; q[tk] += (v[tk][j][0] * v[tk][j][0] + v[tk][j][1] * v[tk][j][1]) + (v[tk][j][2] * v[tk][j][2] + v[tk][j][3] * v[tk][j][3]); } }
#pragma unroll
            for (int o = 1; o < 64; o <<= 1) {
#pragma unroll
                for (int tk = 0; tk < 4; ++tk) q[tk] += __shfl_xor(q[tk], o); }
#pragma unroll
            for (int tk = 0; tk < 4; ++tk) { const float rstd = 1.0f / sqrtf(q[tk] * (1.f / D) + LN_EPS);
#pragma unroll
                for (int j = 0; j < 4; ++j) { const f32x4 h = v[tk][j] * rstd * gg[j] + bb[j]; const size_t off = (size_t)(row0 + tk) * D + 4 * lane + 256 * j;
                    *(f32x4*)(F.out + off) = h;
                    u32x2 hi; hi.x = cvt_pk_bf16(h[0], h[1]); hi.y = cvt_pk_bf16(h[2], h[3]);
                    *(unsigned*)(F.Hb + off) = cvt4_fp8(h[0], h[1], h[2], h[3]);
                    u32x2 lo; lo.x = cvt_pk_bf16(h[0] - bf_lo(hi.x), h[1] - bf_hi(hi.x)); lo.y = cvt_pk_bf16(h[2] - bf_lo(hi.y), h[3] - bf_hi(hi.y));
                    *(LAS u32x2*)(hl + tk * RT_ROW + (4 * lane + 256 * j) * 2) = hi; *(LAS u32x2*)(hl + (4 + tk) * RT_ROW + (4 * lane + 256 * j) * 2) = lo; } }
            asm volatile("s_waitcnt lgkmcnt(0)" ::: "memory");
            f32x4 acc[2] = {(f32x4){0.f, 0.f, 0.f, 0.f}, (f32x4){0.f, 0.f, 0.f, 0.f}};
            const LAS unsigned char* ap = hl + (lane & 3) * RT_ROW + (8 * (lane >> 4)) * 2;
            const bf16_t* bp = F.WrtHi + (size_t)(lane & 15) * D + 8 * (lane >> 4);
#pragma unroll 16
            for (int ks = 0; ks < 32; ++ks) {
                const bf16x8 ah = *(const LAS bf16x8*)(ap + ks * 64), al = *(const LAS bf16x8*)(ap + 4 * RT_ROW + ks * 64);
#pragma unroll
                for (int nt = 0; nt < 2; ++nt) { const bf16x8 bh = *(const bf16x8*)(bp + (size_t)nt * 16 * D + ks * 32), bl = *(const bf16x8*)(bp + (size_t)(NE * D) + (size_t)nt * 16 * D + ks * 32);
                    acc[nt] = __builtin_amdgcn_mfma_f32_16x16x32_bf16(ah, bh, acc[nt], 0, 0, 0);
                    acc[nt] = __builtin_amdgcn_mfma_f32_16x16x32_bf16(ah, bl, acc[nt], 0, 0, 0);
                    acc[nt] = __builtin_amdgcn_mfma_f32_16x16x32_bf16(al, bh, acc[nt], 0, 0, 0); } }
            if (lane < 16) {
#pragma unroll
                for (int nt = 0; nt < 2; ++nt)
#pragma unroll
                    for (int r = 0; r < 4; ++r) lgb[(batch * 4 + r) * 32 + 16 * nt + lane] = acc[nt][r]; }
            asm volatile("s_waitcnt lgkmcnt(0)" ::: "memory");
        }
        if (lane < 8) {
            float lg[32];
#pragma unroll
            for (int c = 0; c < 8; ++c) { const f32x4 x = *(const LAS f32x4*)(lgb + lane * 32 + 4 * c), br = *(const f32x4*)(F.b_router + 4 * c); lg[4 * c] = x[0] + br[0]; lg[4 * c + 1] = x[1] + br[1]; lg[4 * c + 2] = x[2] + br[2]; lg[4 * c + 3] = x[3] + br[3]; }
            int idx[4]; float val[4]; unsigned taken = 0u;
#pragma unroll
            for (int r = 0; r < 4; ++r) { float best = -INFINITY; int bi = 0;
#pragma unroll
                for (int e = 0; e < 32; ++e) { const bool ok = !((taken >> e) & 1u) && (lg[e] > best); best = ok ? lg[e] : best; bi = ok ? e : bi; }
                idx[r] = bi; val[r] = best; taken |= 1u << bi; }
            const float e1 = __expf(val[1] - val[0]), e2 = __expf(val[2] - val[0]), e3 = __expf(val[3] - val[0]); const float inv = 1.0f / (1.0f + e1 + e2 + e3);
            const int tl = w * 8 + lane;
            sel_e[tl * 4 + 0] = idx[0]; sel_e[tl * 4 + 1] = idx[1]; sel_e[tl * 4 + 2] = idx[2]; sel_e[tl * 4 + 3] = idx[3];
            sel_g[tl * 4 + 0] = inv; sel_g[tl * 4 + 1] = e1 * inv; sel_g[tl * 4 + 2] = e2 * inv; sel_g[tl * 4 + 3] = e3 * inv; }
        __syncthreads();
        int myrank = 0, mye = 0;
        if (F.tid < 256) { mye = sel_e[F.tid]; myrank = atomicAdd((int*)&lcnt[mye], 1); }
        __syncthreads();
        if (F.tid < 32) { const int c = lcnt[F.tid]; lbase[F.tid] = c ? (int)__hip_atomic_fetch_add(F.ctl + CW_CNT + F.tid, (unsigned)c, __ATOMIC_RELAXED, __HIP_MEMORY_SCOPE_AGENT) : 0; lcnt[F.tid] = 0; }
        __syncthreads();
        if (F.tid < 256) { const int slot = (chunk * 64 + (F.tid >> 2)) * 4 + (F.tid & 3); F.list[mye * T + lbase[mye] + myrank] = slot; F.gates[slot] = sel_g[F.tid]; }
        __syncthreads();
    }
}

template <bool G1> __device__ __forceinline__ int moe_tables(Frame& F, int NPN) {
    LAS int* cnt = (LAS int*)(F.lds + TAB_OFF); LAS int* tstart = cnt + 32; LAS int* rowtab = (LAS int*)(F.lds + ROWTAB_OFF);
    if (F.tid < 32) cnt[F.tid] = (int)__hip_atomic_load(F.ctl + CW_CNT + F.tid, __ATOMIC_RELAXED, __HIP_MEMORY_SCOPE_AGENT);
    __syncthreads();
    if (F.tid == 0) { int acc = 0; for (int e = 0; e < NE; ++e) { tstart[e] = acc; acc += (cnt[e] + 255) >> 8; } tstart[NE] = acc; }
    __syncthreads();
    const int ntiles = tstart[NE], nU = ntiles * NPN;
    for (int i = 0; i < MAXU; ++i) { const int L = i * F.G + F.vcu; if (L >= nU) break;
        const int tl = L / NPN; int e = 0;
        for (int j = 1; j < NE; ++j) e += (tstart[j] <= tl) ? 1 : 0;
        const int mt = tl - tstart[e];
        if (F.tid < 256) { const int rank = mt * 256 + F.tid; const int slot = rank < cnt[e] ? F.list[e * T + rank] : -1;
            rowtab[i * 256 + F.tid] = G1 ? ((slot < 0 ? 0 : (slot >> 2)) * D) : slot; } }
    __syncthreads();
    return ntiles;
}

__device__ __forceinline__ void p7_final(Frame& F) {
    const int gw = blockIdx.x * 8 + F.wave, NGW = F.G * 8;
    for (int row = gw; row < T; row += NGW) {
        float* hp = F.out + (size_t)row * D; float v[16];
#pragma unroll
        for (int j = 0; j < 2; ++j) { const f32x4 a = *(const f32x4*)(hp + 512 * j + F.lane * 8), b = *(const f32x4*)(hp + 512 * j + F.lane * 8 + 4);
#pragma unroll
            for (int i = 0; i < 4; ++i) { v[8 * j + i] = a[i] * DN_ALPHA; v[8 * j + 4 + i] = b[i] * DN_ALPHA; } }
#pragma unroll
        for (int k = 0; k < TOPK; ++k)
#pragma unroll
            for (int j = 0; j < 2; ++j) { const u32x4 r = *(const u32x4*)(F.Y + ((size_t)row * TOPK + k) * D + 512 * j + F.lane * 8); const unsigned w[4] = {r.x, r.y, r.z, r.w};
#pragma unroll
                for (int i = 0; i < 4; ++i) { v[8 * j + 2 * i] += bf_lo(w[i]); v[8 * j + 2 * i + 1] += bf_hi(w[i]); } }
        float s = 0.f;
#pragma unroll
        for (int i = 0; i < 16; ++i) s += v[i];
        const float mu = wave_sum(s) * (1.f / D); float q = 0.f;
#pragma unroll
        for (int i = 0; i < 16; ++i) { v[i] -= mu; q += v[i] * v[i]; }
        const float rstd = 1.0f / sqrtf(wave_sum(q) * (1.f / D) + LN_EPS);
#pragma unroll
        for (int j = 0; j < 2; ++j) { const int c = 512 * j + F.lane * 8;
            const f32x4 g0 = *(const f32x4*)(F.ln2_g + c), g1 = *(const f32x4*)(F.ln2_g + c + 4), b0 = *(const f32x4*)(F.ln2_b + c), b1 = *(const f32x4*)(F.ln2_b + c + 4);
            f32x4 o0, o1;
#pragma unroll
            for (int i = 0; i < 4; ++i) { o0[i] = v[8 * j + i] * rstd * g0[i] + b0[i]; o1[i] = v[8 * j + 4 + i] * rstd * g1[i] + b1[i]; }
            *(f32x4*)(hp + c) = o0; *(f32x4*)(hp + c + 4) = o1; }
    }
}

constexpr int N_PHASES = 8;
__global__ void __launch_bounds__(512, 2) mk_fwd(Args args) {
    extern __shared__ __attribute__((aligned(16))) unsigned char lds_raw[];
    Frame F;
    F.lds = (LAS unsigned char*)lds_raw; F.tid = threadIdx.x; F.lane = F.tid & 63; F.wave = __builtin_amdgcn_readfirstlane(F.tid >> 6);
    F.G = gridDim.x; { const int bx = blockIdx.x; F.vcu = (F.G % 8 == 0) ? (bx % 8) * (F.G / 8) + bx / 8 : bx; }
    F.x = args.in[0]; F.w_in = args.in[1]; F.sgu_w = args.in[2]; F.sgu_b = args.in[3]; F.sgu_ln_g = args.in[4]; F.sgu_ln_b = args.in[5]; F.mix_g = args.in[6]; F.w_out = args.in[7];
    F.ln1_g = args.in[8]; F.ln1_b = args.in[9]; F.w_router = args.in[10]; F.b_router = args.in[11]; F.w_gate = args.in[12]; F.b_gate = args.in[13]; F.w_up = args.in[14]; F.b_up = args.in[15];
    F.w_down = args.in[16]; F.b_down = args.in[17]; F.ln2_g = args.in[18]; F.ln2_b = args.in[19]; F.out = args.out; F.ws = args.ws;
    unsigned char* ws = args.ws;
    F.ctl = (unsigned*)(ws + WS_CTL); F.list = (int*)(ws + WS_LIST); F.gates = (float*)(ws + WS_GATES);
    F.Win_t = (bf16_t*)(ws + WS_WIN); F.Wout_t = (bf16_t*)(ws + WS_WOUT); F.Wd_t = (bf16_t*)(ws + WS_WD); F.Wgu_t = (fp8_t*)(ws + WS_WGU); F.Y = (bf16_t*)(ws + WS_Y);
    F.Hb = (fp8_t*)(ws + WS_HB); F.Xb = (bf16_t*)(ws + WS_XB); F.P1 = (bf16_t*)(ws + WS_P1); F.Amix = (bf16_t*)(ws + WS_AMIX); F.Act = (bf16_t*)(ws + WS_ACT);
    F.WrtHi = (bf16_t*)(ws + WS_WRT); F.Opart = (bf16_t*)(ws + WS_OPART); F.ML = (float*)(ws + WS_ML);
    const int lo = args.ph_lo, hi = args.ph_hi;
    volatile LAS unsigned* misc = (volatile LAS unsigned*)(F.lds + MISC_OFF);
    if (F.tid < 16) misc[F.tid] = 0u;
    __syncthreads();
    XcdBarrier bar; bar.bar = F.ctl + CW_BAR; bar.x = 0; bar.st = misc;
    if (hi - lo > 1) bar = xcd_barrier_post(F.ctl + CW_BAR, misc);
    const LAS int* rowtab = (const LAS int*)(F.lds + ROWTAB_OFF);
#ifndef PROBE_DUP
#define PROBE_DUP -1
#endif
#define IN(k) (lo <= (k) && (k) < hi)
#define SEAM(k) do { if (IN(k) && IN((k) + 1)) { xcd_barrier(bar); } } while (0)
#define REP(k) for (int _rep = 0; _rep < ((PROBE_DUP == (k)) ? 2 : 1); ++_rep)
    if (IN(0)) REP(0) { p0_convert(F); }
    SEAM(0);
    if (IN(1)) REP(1) { pg8::Gemm g{F.Xb, F.Win_t, D * 2}; pg8::DenseOrder S{INC / 256, (T / 256) * (INC / 256), F.G, F.vcu}; pg8::EpiP1 E{F.P1};
        pg8::gemm_phase<pg8::EpiP1, pg8::DenseOrder, false, false>(F.lds, rowtab, g, S, E); }
    SEAM(1);
    if (IN(2)) REP(2) { p2_mixers(F); }
    SEAM(2);
    if (IN(3)) REP(3) { p3_merge(F); }
    SEAM(3);
    if (IN(4)) REP(4) { pg8::Gemm g{F.Amix, F.Wout_t, D * 2}; pg8::DenseOrder S{D / 256, (T / 256) * (D / 256), F.G, F.vcu}; pg8::EpiZ E{F.x, F.out};
        pg8::gemm_phase<pg8::EpiZ, pg8::DenseOrder, false, false>(F.lds, rowtab, g, S, E); }
    SEAM(4);
    if (IN(5)) { p4_route(F); }
    SEAM(5);
    if (IN(6)) REP(6) { const int ntiles = moe_tables<true>(F, 8); pg8::Gemm g{F.Hb, F.Wgu_t, D}; pg8::MoeOrder S{8, ntiles * 8, F.G, F.vcu, (const LAS int*)(F.lds + TAB_OFF) + 32};
        pg8::EpiSwiglu E{F.Act, F.b_gate, F.b_up};
        pg8::gemm_phase<pg8::EpiSwiglu, pg8::MoeOrder, true, true>(F.lds, rowtab, g, S, E); }
    SEAM(6);
    if (IN(7)) REP(7) { const int ntiles = moe_tables<false>(F, 4); pg8::Gemm g{F.Act, F.Wd_t, FF * 2}; pg8::MoeOrder S{4, ntiles * 4, F.G, F.vcu, (const LAS int*)(F.lds + TAB_OFF) + 32};
        pg8::EpiScatter E{F.Y, F.b_down, F.gates, rowtab};
        pg8::gemm_phase<pg8::EpiScatter, pg8::MoeOrder, false, false>(F.lds, rowtab, g, S, E); }
    SEAM(7);
    if (IN(8)) { p7_final(F); }
#undef IN
#undef SEAM
}

extern "C" void kernel_launch(void* const* d_in, const int* in_sizes, int n_in, void* d_out, int out_size, void* d_ws, size_t ws_size, hipStream_t stream) {
    static int grid = 0;
    if (grid == 0) {
        if (n_in != 20 || in_sizes[0] != T * D || out_size != T * D || ws_size < WS_END) { fprintf(stderr, "kernel_launch: unexpected shapes (n_in %d, in0 %d, out %d, ws %zu)\n", n_in, n_in > 0 ? in_sizes[0] : -1, out_size, ws_size); grid = -1; return; }
        int dev = 0, cus = 0, per_cu = 0;
        hipGetDevice(&dev); hipDeviceGetAttribute(&cus, hipDeviceAttributeMultiprocessorCount, dev);
        if (hipFuncSetAttribute((const void*)mk_fwd, hipFuncAttributeMaxDynamicSharedMemorySize, LDS_BYTES) != hipSuccess) { fprintf(stderr, "kernel_launch: hipFuncSetAttribute failed\n"); grid = -1; return; }
        hipOccupancyMaxActiveBlocksPerMultiprocessor(&per_cu, (const void*)mk_fwd, 512, LDS_BYTES);
        (void)hipGetLastError();
        if (per_cu < 1) { fprintf(stderr, "kernel_launch: occupancy query says %d blocks/CU: the grid would not be resident; nothing launched\n", per_cu); grid = -1; return; }
        grid = cus;
        if (grid != 256) fprintf(stderr, "kernel_launch: note: %d CUs (tuned for 256)\n", grid);
    }
    if (grid < 0) return;
    hipMemsetAsync((char*)d_ws + WS_CTL, 0, CTL_ZERO_BYTES, stream);
    Args a{};
    for (int i = 0; i < 20; ++i) a.in[i] = (const float*)d_in[i];
    a.out = (float*)d_out; a.ws = (unsigned char*)d_ws;
#if MK_N_LAUNCHES == 1
    a.ph_lo = 0; a.ph_hi = N_PHASES + 1;
    hipLaunchKernelGGL(mk_fwd, dim3(grid), dim3(512), LDS_BYTES, stream, a);
#else
    for (int p = 0; p <= N_PHASES; ++p) { a.ph_lo = p; a.ph_hi = p + 1; hipLaunchKernelGGL(mk_fwd, dim3(grid), dim3(512), LDS_BYTES, stream, a); }
#endif
}
```

```cpp
#include <hip/hip_runtime.h>
#include <hip/hip_cooperative_groups.h>
#include <cstdio>
#include <cstdint>
namespace cg = cooperative_groups;

#ifndef MK_N_LAUNCHES
#define MK_N_LAUNCHES 1
#endif

constexpr int BATCH = 4, SEQ = 4096, T = BATCH * SEQ, D = 1024, INC = 2560, NE = 32, FF = 1024, TOPK = 4;
constexpr int AW = 512, NGRP = 8, GD = 64, CHUNK = 128, NH = 8, HD = 64;
constexpr float LN_EPS = 1e-5f, DN_ALPHA = 1.189207115002721f;
constexpr int NSLOT = T * TOPK;
constexpr int MAXTILES = 288;
constexpr int MAXU = 12;

constexpr size_t MiB = 1u << 20;
constexpr size_t WS_CTL = 0, CTL_ZERO_BYTES = 64 * 1024;
constexpr size_t WS_LIST = 1 * MiB;
constexpr size_t WS_GATES = 3 * MiB;
constexpr size_t WS_WRT = 3 * MiB + 512 * 1024;
constexpr size_t WS_WIN = 4 * MiB;
constexpr size_t WS_WOUT = 9 * MiB;
constexpr size_t WS_WD = 11 * MiB;
constexpr size_t WS_WGU = 75 * MiB;
constexpr size_t WS_HB = 139 * MiB;
constexpr size_t WS_BIG = 155 * MiB;
constexpr size_t WS_XB = WS_BIG;
constexpr size_t WS_P1 = WS_BIG + 32 * MiB;
constexpr size_t WS_AMIX = WS_BIG + 112 * MiB;
constexpr size_t WS_ACT = WS_BIG;
constexpr size_t WS_Y = 299 * MiB;
constexpr size_t WS_OPART = 427 * MiB;
constexpr size_t WS_ML = 475 * MiB;
constexpr size_t WS_END = 478 * MiB;
#ifndef G2_FP8
#define G2_FP8 1
#endif
constexpr float WGU_SCALE = 32.0f, WD_SCALE = G2_FP8 ? 64.0f : 1.0f;
#if G2_FP8
typedef unsigned char act_t;
#else
typedef unsigned short act_t;
#endif
constexpr int CW_BAR = 1024;
constexpr int CW_CNT = 0;

constexpr int RING_BYTES = 131072;
constexpr int TAB_OFF = RING_BYTES + 1024;
constexpr int ROWTAB_OFF = RING_BYTES + 2048;
constexpr int MISC_OFF = 147456 - 64;
constexpr int LDS_BYTES = 147456;
static_assert(ROWTAB_OFF + MAXU * 1024 <= LDS_BYTES, "LDS map");

#define LAS __attribute__((address_space(3)))
typedef unsigned short bf16_t;
typedef unsigned char fp8_t;
typedef short bf16x8 __attribute__((ext_vector_type(8)));
typedef float f32x4 __attribute__((ext_vector_type(4)));
typedef float f32x2 __attribute__((ext_vector_type(2)));
typedef unsigned u32x4 __attribute__((ext_vector_type(4)));
typedef unsigned u32x2 __attribute__((ext_vector_type(2)));
typedef int v8i32 __attribute__((ext_vector_type(8)));
typedef int v4i32 __attribute__((ext_vector_type(4)));


__device__ __forceinline__ unsigned cvt_pk_bf16(float lo, float hi) { unsigned r; asm volatile("v_cvt_pk_bf16_f32 %0, %1, %2" : "=v"(r) : "v"(lo), "v"(hi)); return r; }
__device__ __forceinline__ unsigned cvt4_fp8(float a, float b, float c, float d) { int w = 0; w = __builtin_amdgcn_cvt_pk_fp8_f32(a, b, w, false); w = __builtin_amdgcn_cvt_pk_fp8_f32(c, d, w, true); return (unsigned)w; }
__device__ __forceinline__ float bf_lo(unsigned w) { return __uint_as_float(w << 16); }
__device__ __forceinline__ float bf_hi(unsigned w) { return __uint_as_float(w & 0xffff0000u); }
__device__ __forceinline__ float bf1(bf16_t b) { return __uint_as_float((unsigned)b << 16); }
__device__ __forceinline__ float wave_sum(float v) {
#pragma unroll
    for (int o = 1; o < 64; o <<= 1) v += __shfl_xor(v, o);
    return v;
}
__device__ __forceinline__ float gelu_tanh(float x) {
    const float y2 = x * (1.5957691216057308f + 0.07135481627260025f * x * x);
    return x * __builtin_amdgcn_rcpf(1.0f + __builtin_amdgcn_exp2f(-1.4426950408889634f * y2));
}

namespace pg8 {
constexpr int BM = 256, BK = 64, HALF = 128, HTB = HALF * BK * 2, STAGE_BYTES = 8 * HTB;
__host__ __device__ __forceinline__ int lds_byte(int r, int c) { const int st = (r >> 4) * 2 + (c >> 5), rr = r & 15, cc = c & 31, ob = rr * 64 + cc * 2; return st * 1024 + (ob ^ (((ob >> 9) & 1) << 5)); }
__host__ __device__ __forceinline__ void stage_rc(int b, int& R, int& C) { const int st = b / 1024, sb = b % 1024, swz = sb ^ (((sb >> 9) & 1) << 5); R = (st >> 1) * 16 + swz / 64; C = (st & 1) * 32 + (swz % 64) / 2; }
__host__ __device__ __forceinline__ int perm32(int rho) { const int n = rho >> 4, i = rho & 15; return 8 * (i >> 2) + 4 * n + (i & 3); }

struct Unit { int pm, pn, pb, e, mt, ui; };
struct Gemm { const void* A; const void* Bt; int KB; };

struct DenseOrder {
    int nN, nU, G, v;
    __device__ __forceinline__ bool next(int i, Unit& u) const {
        const int L = i * G + v; if (L >= nU) return false;
        u.pm = L / nN; u.pn = L % nN; u.pb = u.pn; u.e = 0; u.mt = 0; u.ui = i; return true; }
};
struct MoeOrder {
    int NPN, nU, G, v; const LAS int* tstart;
    __device__ __forceinline__ bool next(int i, Unit& u) const {
        const int L = i * G + v; if (L >= nU) return false;
        const int tl = L / NPN, pn = L % NPN; int e = 0;
#pragma unroll
        for (int j = 1; j < NE; ++j) e += (tstart[j] <= tl) ? 1 : 0;
        e = __builtin_amdgcn_readfirstlane(e); const int ts = __builtin_amdgcn_readfirstlane(tstart[e]);
        u.pm = tl; u.pn = pn; u.pb = e * NPN + pn; u.e = e; u.mt = tl - ts; u.ui = i; return true; }
};

template <class Epi, class Sched, bool GATHER, bool FP8>
__device__ __forceinline__ void gemm_phase(LAS unsigned char* lds, const LAS int* rowtab, const Gemm g, const Sched& S, const Epi& E) {
    const int tid = threadIdx.x, wid = __builtin_amdgcn_readfirstlane(tid >> 6), lane = tid & 63, wr = wid >> 2, wc = wid & 3, fr = lane & 15, fq = lane >> 4;
    const int KB = g.KB, nt = KB / (BK * 2);
    unsigned voffA0[2], voffA1[2], voffB[2]; int Rr[2], Cc[2];
#pragma unroll
    for (int i = 0; i < 2; ++i) { int R, C; stage_rc(tid * 16 + i * 8192, R, C); const int Rb = Epi::PERM ? ((R & ~31) + perm32(R & 31)) : R; Rr[i] = R; Cc[i] = C;
        voffA0[i] = (unsigned)(R * KB + C * 2); voffA1[i] = (unsigned)((R + HALF) * KB + C * 2); voffB[i] = (unsigned)(Rb * KB + C * 2); }
    const unsigned kstep = (unsigned)(BK * 2);
    const unsigned hstep = (unsigned)HALF * (unsigned)KB;
    const unsigned tstep = 2u * hstep;
    const __amdgpu_buffer_rsrc_t rsA = __builtin_amdgcn_make_buffer_rsrc(const_cast<void*>(g.A), 0, -1, 0x00020000);
    const __amdgpu_buffer_rsrc_t rsB = __builtin_amdgcn_make_buffer_rsrc(const_cast<void*>(g.Bt), 0, -1, 0x00020000);
    const unsigned ldsw = (unsigned)wid * 1024u;
    const int aoff = lds_byte(wr * 64 + fr, fq * 8), boff = lds_byte(wc * 32 + fr, fq * 8);
#define PG8_SA(b, h) (((b) * 2 + (h)) * HTB)
#define PG8_SB(b, h) ((4 + (b) * 2 + (h)) * HTB)
#define PG8_STAGE(bufoff, rs, soff, voff) do { _Pragma("unroll") for (int _i = 0; _i < 2; ++_i) \
        __builtin_amdgcn_raw_ptr_buffer_load_lds(rs, (LAS void*)(lds + (bufoff) + ldsw + _i * 8192), 16, (int)(voff)[_i], (int)(soff), 0, 0); } while (0)
#define PG8_LDA(dst, b, h) do { if constexpr (FP8) { _Pragma("unroll") for (int m = 0; m < 4; ++m) dst##8[m] = __builtin_shufflevector(*(const LAS v4i32*)(lds + PG8_SA(b, h) + aoff + m * 2048), *(const LAS v4i32*)(lds + PG8_SA(b, h) + aoff + m * 2048 + 1024), 0, 1, 2, 3, 4, 5, 6, 7); } \
        else { _Pragma("unroll") for (int m = 0; m < 4; ++m) _Pragma("unroll") for (int k = 0; k < 2; ++k) dst[m][k] = *(const LAS bf16x8*)(lds + PG8_SA(b, h) + aoff + m * 2048 + k * 1024); } } while (0)
#define PG8_LDB(dst, b, h) do { if constexpr (FP8) { _Pragma("unroll") for (int n = 0; n < 2; ++n) dst##8[n] = __builtin_shufflevector(*(const LAS v4i32*)(lds + PG8_SB(b, h) + boff + n * 2048), *(const LAS v4i32*)(lds + PG8_SB(b, h) + boff + n * 2048 + 1024), 0, 1, 2, 3, 4, 5, 6, 7); } \
        else { _Pragma("unroll") for (int n = 0; n < 2; ++n) _Pragma("unroll") for (int k = 0; k < 2; ++k) dst[n][k] = *(const LAS bf16x8*)(lds + PG8_SB(b, h) + boff + n * 2048 + k * 1024); } } while (0)
#define PG8_MMA(ai, bj, At, Bt) do { __builtin_amdgcn_s_setprio(1); if constexpr (FP8) { _Pragma("unroll") for (int m = 0; m < 4; ++m) _Pragma("unroll") for (int n = 0; n < 2; ++n) \
        acc[ai][bj][m][n] = __builtin_amdgcn_mfma_scale_f32_16x16x128_f8f6f4(Bt##8[n], At##8[m], acc[ai][bj][m][n], 0, 0, 0, 0x7F7F7F7F, 0, 0x7F7F7F7F); } \
        else { _Pragma("unroll") for (int m = 0; m < 4; ++m) _Pragma("unroll") for (int n = 0; n < 2; ++n) _Pragma("unroll") for (int k = 0; k < 2; ++k) \
        acc[ai][bj][m][n] = __builtin_amdgcn_mfma_f32_16x16x32_bf16(Bt[n][k], At[m][k], acc[ai][bj][m][n], 0, 0, 0); } __builtin_amdgcn_s_setprio(0); } while (0)
#define PG8_WAIT_V(n) asm volatile("s_waitcnt vmcnt(" #n ")" ::: "memory")
#define PG8_WAIT_L(n) asm volatile("s_waitcnt lgkmcnt(" #n ")" ::: "memory")
#define PG8_BAR __builtin_amdgcn_s_barrier()
#define PG8_SCHED __builtin_amdgcn_sched_barrier(0)
#define PG8_LOADROWS(U) do { if constexpr (GATHER) { _Pragma("unroll") for (int _i = 0; _i < 2; ++_i) { \
        voffA0[_i] = (unsigned)rowtab[(U).ui * 256 + Rr[_i]] + (unsigned)Cc[_i] * 2u; voffA1[_i] = (unsigned)rowtab[(U).ui * 256 + HALF + Rr[_i]] + (unsigned)Cc[_i] * 2u; } } } while (0)
    Unit cur, nxt; int ui = 0;
    if (!S.next(0, cur)) return;
    f32x4 acc[2][2][4][2];
#pragma unroll
    for (int a = 0; a < 2; ++a)
#pragma unroll
        for (int b = 0; b < 2; ++b)
#pragma unroll
            for (int m = 0; m < 4; ++m)
#pragma unroll
                for (int n = 0; n < 2; ++n) acc[a][b][m][n] = (f32x4){0.f, 0.f, 0.f, 0.f};
    bf16x8 At[4][2], B0[2][2], B1[2][2]; v8i32 At8[4], B08[2], B18[2];
    unsigned cA = GATHER ? 0u : (unsigned)cur.pm * tstep, cB = (unsigned)cur.pb * tstep;
    PG8_LOADROWS(cur); PG8_WAIT_L(0);
    PG8_STAGE(PG8_SB(0, 0), rsB, cB, voffB); PG8_STAGE(PG8_SB(0, 1), rsB, cB + hstep, voffB); PG8_STAGE(PG8_SA(0, 0), rsA, cA, voffA0); PG8_STAGE(PG8_SA(0, 1), rsA, cA, voffA1);
    if (wr == 1) PG8_BAR;
    PG8_WAIT_V(2); PG8_BAR;
    PG8_STAGE(PG8_SB(1, 0), rsB, cB + kstep, voffB); PG8_STAGE(PG8_SA(1, 0), rsA, cA + kstep, voffA0); PG8_STAGE(PG8_SB(1, 1), rsB, cB + hstep + kstep, voffB);
    PG8_WAIT_V(6); PG8_BAR;
    for (;;) {
        const bool has_next = S.next(ui + 1, nxt);
        const unsigned nA = has_next ? (GATHER ? 0u : (unsigned)nxt.pm * tstep) : cA, nB = has_next ? (unsigned)nxt.pb * tstep : cB;
#pragma unroll 1
        for (int t = 0; t < nt; t += 2) {
            const bool last = (t == nt - 2);
            const unsigned a1 = cA + (unsigned)(t + 1) * kstep;
            const unsigned a2 = last ? nA : cA + (unsigned)(t + 2) * kstep, b2 = last ? nB : cB + (unsigned)(t + 2) * kstep;
            const unsigned a3 = a2 + kstep, b3 = b2 + kstep;
            PG8_LDB(B0, 0, 0); PG8_LDB(B1, 0, 1); PG8_SCHED; PG8_LDA(At, 0, 0); PG8_STAGE(PG8_SA(1, 1), rsA, a1, voffA1);
            if (last && has_next) PG8_LOADROWS(nxt);
            PG8_WAIT_V(8); PG8_WAIT_L(0); PG8_BAR; PG8_MMA(0, 0, At, B0); PG8_MMA(0, 1, At, B1); PG8_BAR; PG8_SCHED;
            PG8_LDA(At, 0, 1); PG8_STAGE(PG8_SB(0, 0), rsB, b2, voffB); PG8_STAGE(PG8_SB(0, 1), rsB, b2 + hstep, voffB); PG8_STAGE(PG8_SA(0, 0), rsA, a2, voffA0);
            PG8_WAIT_V(8); PG8_WAIT_L(0); PG8_BAR; PG8_MMA(1, 0, At, B0); PG8_MMA(1, 1, At, B1); PG8_BAR; PG8_SCHED;
            PG8_LDB(B0, 1, 0); PG8_LDB(B1, 1, 1); PG8_SCHED; PG8_LDA(At, 1, 0); PG8_STAGE(PG8_SA(0, 1), rsA, a2, voffA1);
            PG8_WAIT_V(8); PG8_WAIT_L(0); PG8_BAR; PG8_MMA(0, 0, At, B0); PG8_MMA(0, 1, At, B1); PG8_BAR; PG8_SCHED;
            PG8_LDA(At, 1, 1); PG8_STAGE(PG8_SB(1, 0), rsB, b3, voffB); PG8_STAGE(PG8_SB(1, 1), rsB, b3 + hstep, voffB); PG8_STAGE(PG8_SA(1, 0), rsA, a3, voffA0);
            PG8_WAIT_V(8); PG8_WAIT_L(0); PG8_BAR; PG8_MMA(1, 0, At, B0); PG8_MMA(1, 1, At, B1); PG8_BAR; PG8_SCHED;
        }
        if (wr == 0) PG8_BAR;
        { int t2 = threadIdx.x; asm volatile("" : "+v"(t2));
          const int w2 = __builtin_amdgcn_readfirstlane(t2 >> 6), l2 = t2 & 63; E(acc, cur, w2 >> 2, w2 & 3, l2 & 15, l2 >> 4); }
        if (!has_next) break;
#pragma unroll
        for (int a = 0; a < 2; ++a)
#pragma unroll
            for (int b = 0; b < 2; ++b)
#pragma unroll
                for (int m = 0; m < 4; ++m)
#pragma unroll
                    for (int n = 0; n < 2; ++n) acc[a][b][m][n] = (f32x4){0.f, 0.f, 0.f, 0.f};
        cur = nxt; cA = nA; cB = nB; ++ui;
        if (wr == 1) PG8_BAR;
    }
    PG8_WAIT_V(0);
    PG8_BAR;
#undef PG8_SA
#undef PG8_SB
#undef PG8_STAGE
#undef PG8_LDA
#undef PG8_LDB
#undef PG8_MMA
#undef PG8_WAIT_V
#undef PG8_WAIT_L
#undef PG8_BAR
#undef PG8_SCHED
#undef PG8_LOADROWS
}

struct EpiP1 {
    static constexpr bool PERM = true;
    bf16_t* O;
    __device__ __forceinline__ void operator()(const f32x4 (&acc)[2][2][4][2], const Unit& u, int wr, int wc, int fr, int fq) const {
        const int row0 = u.pm * BM + wr * 64 + fr, col0 = u.pn * BM + wc * 32 + 8 * fq; const bool act = u.pn < 4;
#pragma unroll
        for (int ai = 0; ai < 2; ++ai)
#pragma unroll
            for (int m = 0; m < 4; ++m) { bf16_t* rowp = O + (size_t)(row0 + ai * HALF + m * 16) * INC + col0;
#pragma unroll
                for (int bj = 0; bj < 2; ++bj) { f32x4 v0 = acc[ai][bj][m][0], v1 = acc[ai][bj][m][1];
                    if (act) {
#pragma unroll
                        for (int j = 0; j < 4; ++j) { v0[j] = gelu_tanh(v0[j]); v1[j] = gelu_tanh(v1[j]); } }
                    u32x4 w; w.x = cvt_pk_bf16(v0[0], v0[1]); w.y = cvt_pk_bf16(v0[2], v0[3]); w.z = cvt_pk_bf16(v1[0], v1[1]); w.w = cvt_pk_bf16(v1[2], v1[3]);
                    *(u32x4*)(rowp + bj * HALF) = w; } }
    }
};
struct EpiZ {
    static constexpr bool PERM = false;
    const float* X; float* Z;
    __device__ __forceinline__ void operator()(const f32x4 (&acc)[2][2][4][2], const Unit& u, int wr, int wc, int fr, int fq) const {
        const int col0 = u.pn * BM + wc * 32 + 4 * fq;
#pragma unroll
        for (int ai = 0; ai < 2; ++ai)
#pragma unroll
            for (int m = 0; m < 4; ++m) { const size_t off = (size_t)(u.pm * BM + ai * HALF + wr * 64 + m * 16 + fr) * D + col0;
#pragma unroll
                for (int bj = 0; bj < 2; ++bj)
#pragma unroll
                    for (int n = 0; n < 2; ++n) { const f32x4 xv = *(const f32x4*)(X + off + bj * HALF + n * 16); *(f32x4*)(Z + off + bj * HALF + n * 16) = xv * DN_ALPHA + acc[ai][bj][m][n]; } }
    }
};
struct EpiSwiglu {
    static constexpr bool PERM = true;
    act_t* Act; const float* bg; const float* bu;
    __device__ __forceinline__ void operator()(const f32x4 (&acc)[2][2][4][2], const Unit& u, int wr, int wc, int fr, int fq) const {
        const int f0 = u.pn * HALF + wc * 32 + 8 * fq; const int row0 = u.pm * BM + wr * 64 + fr;
        const f32x4 bg0 = *(const f32x4*)(bg + u.e * FF + f0), bg1 = *(const f32x4*)(bg + u.e * FF + f0 + 4);
        const f32x4 bu0 = *(const f32x4*)(bu + u.e * FF + f0), bu1 = *(const f32x4*)(bu + u.e * FF + f0 + 4);
#pragma unroll
        for (int ai = 0; ai < 2; ++ai)
#pragma unroll
            for (int m = 0; m < 4; ++m) {
                f32x4 g0 = acc[ai][0][m][0] * (1.0f / WGU_SCALE) + bg0, g1 = acc[ai][0][m][1] * (1.0f / WGU_SCALE) + bg1, u0 = acc[ai][1][m][0] * (1.0f / WGU_SCALE) + bu0, u1 = acc[ai][1][m][1] * (1.0f / WGU_SCALE) + bu1, r0, r1;
#pragma unroll
                for (int j = 0; j < 4; ++j) {
                    const float ga = fminf(g0[j], 7.0f), gb = fminf(g1[j], 7.0f);
                    const float ua = fminf(fmaxf(u0[j], -7.0f), 7.0f), ub = fminf(fmaxf(u1[j], -7.0f), 7.0f);
                    r0[j] = (ua + 1.0f) * ga * __builtin_amdgcn_rcpf(1.0f + __builtin_amdgcn_exp2f(-1.702f * 1.4426950408889634f * ga));
                    r1[j] = (ub + 1.0f) * gb * __builtin_amdgcn_rcpf(1.0f + __builtin_amdgcn_exp2f(-1.702f * 1.4426950408889634f * gb)); }
                if constexpr (G2_FP8) { u32x2 w; w.x = cvt4_fp8(r0[0], r0[1], r0[2], r0[3]); w.y = cvt4_fp8(r1[0], r1[1], r1[2], r1[3]); *(u32x2*)(Act + (size_t)(row0 + ai * HALF + m * 16) * FF + f0) = w; }
                else { u32x4 w; w.x = cvt_pk_bf16(r0[0], r0[1]); w.y = cvt_pk_bf16(r0[2], r0[3]); w.z = cvt_pk_bf16(r1[0], r1[1]); w.w = cvt_pk_bf16(r1[2], r1[3]); *(u32x4*)(Act + (size_t)(row0 + ai * HALF + m * 16) * FF + f0) = w; } }
    }
};
struct EpiScatter {
    static constexpr bool PERM = true;
    bf16_t* Y; const float* bd; const float* gates; const LAS int* rowtab;
    __device__ __forceinline__ void operator()(const f32x4 (&acc)[2][2][4][2], const Unit& u, int wr, int wc, int fr, int fq) const {
        const int c0 = u.pn * BM + wc * 32 + 8 * fq;
#pragma unroll
        for (int bj = 0; bj < 2; ++bj) { const f32x4 b0 = *(const f32x4*)(bd + u.e * D + c0 + bj * HALF), b1 = *(const f32x4*)(bd + u.e * D + c0 + bj * HALF + 4);
#pragma unroll
            for (int ai = 0; ai < 2; ++ai)
#pragma unroll
                for (int m = 0; m < 4; ++m) { const int slot = rowtab[u.ui * 256 + ai * HALF + wr * 64 + m * 16 + fr];
                    if (slot >= 0) { const float gt = gates[slot];
                        const f32x4 v0 = (acc[ai][bj][m][0] * (1.0f / WD_SCALE) + b0) * gt, v1 = (acc[ai][bj][m][1] * (1.0f / WD_SCALE) + b1) * gt;
                        u32x4 w; w.x = cvt_pk_bf16(v0[0], v0[1]); w.y = cvt_pk_bf16(v0[2], v0[3]); w.z = cvt_pk_bf16(v1[0], v1[1]); w.w = cvt_pk_bf16(v1[2], v1[3]);
                        *(u32x4*)(Y + (size_t)slot * D + c0 + bj * HALF) = w; } } }
    }
};
}


#define XB_TMO      128
#define XB_XCNT(j)  (256  + 64 * (j))
#define XB_XSUB(j)  (1280 + 64 * (j))
#define XB_XGEN(j)  (2304 + 64 * (j))
#define XB_TOP      3328
#define XB_TOPGEN   3392
#define XCD_BAR_WORDS 3456
#define XB_SPIN_CAP (1u << 22)
__device__ __forceinline__ unsigned xb_ld(unsigned* p)              { return __hip_atomic_load(p, __ATOMIC_RELAXED, __HIP_MEMORY_SCOPE_AGENT); }
__device__ __forceinline__ unsigned xb_add(unsigned* p, unsigned v) { return __hip_atomic_fetch_add(p, v, __ATOMIC_RELAXED, __HIP_MEMORY_SCOPE_AGENT); }
__device__ __forceinline__ unsigned xb_xcc_id() { return (unsigned)__builtin_amdgcn_s_getreg((3 << 11) | 20) & 0xFu; }
#define XB_SPIN(cond, bar) do { unsigned _sp = 0; while (cond) { __builtin_amdgcn_s_sleep(1); \
    if ((++_sp & 255u) == 0u) { if (xb_ld(&(bar)[XB_TMO])) break; if (_sp > XB_SPIN_CAP) { atomicAdd(&(bar)[XB_TMO], 1u); break; } } } } while (0)
struct XcdBarrier { unsigned* bar; unsigned x; volatile LAS unsigned* st; };
__device__ __forceinline__ XcdBarrier xcd_barrier_post(unsigned* bar, volatile LAS unsigned* st) {
    XcdBarrier b; b.bar = bar; b.x = xb_xcc_id(); b.st = st;
    if (threadIdx.x == 0) (void)xb_add(&bar[XB_XCNT(b.x)], 1u);
    return b;
}
__device__ __forceinline__ void xcd_barrier_complete(unsigned* bar, unsigned x, unsigned& nloc, unsigned& nx) {
    const unsigned G = gridDim.x * gridDim.y * gridDim.z;
    unsigned sum, cnt, mine, sp = 0u;
    for (;;) {
        sum = 0u; cnt = 0u; mine = 0u;
#pragma unroll
        for (unsigned j = 0; j < 16; ++j) { const unsigned c = xb_ld(&bar[XB_XCNT(j)]); sum += c; cnt += (c > 0u) ? 1u : 0u; mine = (j == x) ? c : mine; }
        if (sum == G) break;
        __builtin_amdgcn_s_sleep(1);
        if ((++sp & 255u) == 0u) { if (xb_ld(&bar[XB_TMO])) break; if (sp > XB_SPIN_CAP) { atomicAdd(&bar[XB_TMO], 1u); break; } }
    }
    nloc = mine > 0u ? mine : 1u; nx = cnt > 0u ? cnt : 1u;
}
__device__ __forceinline__ void xcd_barrier(const XcdBarrier& b) {
    asm volatile("s_waitcnt vmcnt(0)" ::: "memory");
    __syncthreads();
    if (threadIdx.x == 0) {
        unsigned* bar = b.bar;
        __builtin_amdgcn_s_waitcnt(0);
        unsigned nloc = b.st[0], nx = b.st[1];
        if (nloc == 0u) { xcd_barrier_complete(bar, b.x, nloc, nx); b.st[0] = nloc; b.st[1] = nx; }
        const unsigned old = xb_add(&bar[XB_XSUB(b.x)], 1u);
        const unsigned gen = old / nloc;
        if (old + 1u == (gen + 1u) * nloc) {
            __builtin_amdgcn_fence(__ATOMIC_RELEASE, "agent");
            asm volatile("s_waitcnt vmcnt(0)" ::: "memory");
            const unsigned og = xb_add(&bar[XB_TOP], 1u);
            const unsigned tg = og / nx;
            if (og + 1u == (tg + 1u) * nx) xb_add(&bar[XB_TOPGEN], 1u);
            else XB_SPIN(xb_ld(&bar[XB_TOPGEN]) == tg, bar);
            __builtin_amdgcn_fence(__ATOMIC_ACQUIRE, "agent");
            xb_add(&bar[XB_XGEN(b.x)], 1u);
            asm volatile("s_waitcnt vmcnt(0)" ::: "memory");
        } else {
            XB_SPIN(xb_ld(&bar[XB_XGEN(b.x)]) == gen, bar);
            __builtin_amdgcn_fence(__ATOMIC_ACQUIRE, "agent");
            asm volatile("s_waitcnt vmcnt(0)" ::: "memory");
        }
    }
    __syncthreads();
}

struct Args { const float* in[20]; float* out; unsigned char* ws; int ph_lo, ph_hi; };
struct Frame {
    LAS unsigned char* lds; int tid, lane, wave, G, vcu;
    const float *x, *w_in, *sgu_w, *sgu_b, *sgu_ln_g, *sgu_ln_b, *mix_g, *w_out, *ln1_g, *ln1_b, *w_router, *b_router, *w_gate, *b_gate, *w_up, *b_up, *w_down, *b_down, *ln2_g, *ln2_b;
    float* out; unsigned char* ws;
    unsigned* ctl; int* list; float* gates; bf16_t *Win_t, *Wout_t, *Y, *Xb, *P1, *Amix; act_t *Wd_t, *Act; fp8_t *Wgu_t, *Hb; bf16_t* Opart; float* ML; bf16_t* WrtHi;
};

__device__ __forceinline__ void transpose_item(const float* W, int N, int K, int k0, int n0, bf16_t* WT, size_t dst_row0, LAS float* scr, int lane) {
#pragma unroll 8
    for (int i = 0; i < 32; ++i) { const int kk = 2 * i + (lane >> 5); scr[kk * 33 + (lane & 31)] = W[(size_t)(k0 + kk) * N + n0 + (lane & 31)]; }
    asm volatile("s_waitcnt lgkmcnt(0)" ::: "memory");
    const int c = lane & 7;
#pragma unroll
    for (int j = 0; j < 4; ++j) { const int n = (lane >> 3) + 8 * j; const LAS float* s = scr + (8 * c) * 33 + n;
        u32x4 o; o.x = cvt_pk_bf16(s[0 * 33], s[1 * 33]); o.y = cvt_pk_bf16(s[2 * 33], s[3 * 33]); o.z = cvt_pk_bf16(s[4 * 33], s[5 * 33]); o.w = cvt_pk_bf16(s[6 * 33], s[7 * 33]);
        *(u32x4*)(WT + (dst_row0 + n) * K + k0 + 8 * c) = o; }
    asm volatile("s_waitcnt lgkmcnt(0)" ::: "memory");
}
__device__ __forceinline__ void transpose_item8(const float* W, int N, int K, int k0, int n0, fp8_t* WT, size_t dst_row0, float scale, LAS float* scr, int lane) {
#pragma unroll 8
    for (int i = 0; i < 64; ++i) { const int kk = 2 * i + (lane >> 5); scr[kk * 33 + (lane & 31)] = W[(size_t)(k0 + kk) * N + n0 + (lane & 31)]; }
    asm volatile("s_waitcnt lgkmcnt(0)" ::: "memory");
    const int c = lane & 7;
#pragma unroll
    for (int j = 0; j < 4; ++j) { const int n = (lane >> 3) + 8 * j; const LAS float* s = scr + (16 * c) * 33 + n;
        u32x4 o; o.x = cvt4_fp8(s[0 * 33] * scale, s[1 * 33] * scale, s[2 * 33] * scale, s[3 * 33] * scale); o.y = cvt4_fp8(s[4 * 33] * scale, s[5 * 33] * scale, s[6 * 33] * scale, s[7 * 33] * scale);
        o.z = cvt4_fp8(s[8 * 33] * scale, s[9 * 33] * scale, s[10 * 33] * scale, s[11 * 33] * scale); o.w = cvt4_fp8(s[12 * 33] * scale, s[13 * 33] * scale, s[14 * 33] * scale, s[15 * 33] * scale);
        *(u32x4*)(WT + (dst_row0 + n) * K + k0 + 16 * c) = o; }
    asm volatile("s_waitcnt lgkmcnt(0)" ::: "memory");
}
__device__ __forceinline__ void p0_convert(Frame& F) {
    LAS float* scr = (LAS float*)(F.lds + F.wave * 17408);
    const int gw = F.vcu * 8 + F.wave, NGW = F.G * 8;
    constexpr int I_IN = (D / 64) * (INC / 32), I_OUT = (D / 64) * (D / 32), I_E8 = (D / 128) * (FF / 32), I_EB = (FF / 64) * (D / 32);
    constexpr int I_ED = G2_FP8 ? I_E8 : I_EB, I_EXP = 2 * I_E8 + I_ED, NITEMS = I_IN + I_OUT + NE * I_EXP;
    for (int it = gw; it < NITEMS; it += NGW) {
        int r = it;
        if (r < I_IN) { const int kb = r / (INC / 32), nb = r % (INC / 32); transpose_item(F.w_in, INC, D, 64 * kb, 32 * nb, F.Win_t, (size_t)32 * nb, scr, F.lane); continue; } r -= I_IN;
        if (r < I_OUT) { const int kb = r / (D / 32), nb = r % (D / 32); transpose_item(F.w_out, D, D, 64 * kb, 32 * nb, F.Wout_t, (size_t)32 * nb, scr, F.lane); continue; } r -= I_OUT;
        const int e = r / I_EXP, q = r % I_EXP;
        if (q < 2 * I_E8) { const int which = q / I_E8, ii = q % I_E8, kb = ii / 32, n0 = 32 * (ii % 32);
            transpose_item8((which ? F.w_up : F.w_gate) + (size_t)e * D * FF, FF, D, 128 * kb, n0, F.Wgu_t, (size_t)e * 2048 + (n0 >> 7) * 256 + which * 128 + (n0 & 127), WGU_SCALE, scr, F.lane); }
        else { const int ii = q - 2 * I_E8, kb = ii / 32, n0 = 32 * (ii % 32);
            if constexpr (G2_FP8) transpose_item8(F.w_down + (size_t)e * FF * D, D, FF, 128 * kb, n0, (fp8_t*)F.Wd_t, (size_t)e * 1024 + n0, WD_SCALE, scr, F.lane);
            else transpose_item(F.w_down + (size_t)e * FF * D, D, FF, 64 * kb, n0, (bf16_t*)F.Wd_t, (size_t)e * 1024 + n0, scr, F.lane); }
    }
    for (int i2 = blockIdx.x * 512 + F.tid; i2 < D * NE; i2 += F.G * 512) { const int k = i2 >> 5, e = i2 & 31; const float wv = F.w_router[i2];
        const unsigned hi = cvt_pk_bf16(wv, 0.f) & 0xffffu; const unsigned lo = cvt_pk_bf16(wv - bf_lo(hi), 0.f) & 0xffffu;
        F.WrtHi[(size_t)e * D + k] = (bf16_t)hi; F.WrtHi[(size_t)(NE + e) * D + k] = (bf16_t)lo; }
    const size_t nchunk = (size_t)T * D / 8;
    for (size_t i = (size_t)blockIdx.x * 512 + F.tid; i < nchunk; i += (size_t)F.G * 512) {
        const f32x4 a = *(const f32x4*)(F.x + i * 8), b = *(const f32x4*)(F.x + i * 8 + 4);
        u32x4 w; w.x = cvt_pk_bf16(a[0], a[1]); w.y = cvt_pk_bf16(a[2], a[3]); w.z = cvt_pk_bf16(b[0], b[1]); w.w = cvt_pk_bf16(b[2], b[3]);
        *(u32x4*)(F.Xb + i * 8) = w; }
}

typedef float f32x16 __attribute__((ext_vector_type(16)));
typedef short s16x4 __attribute__((ext_vector_type(4)));
constexpr int SG_ROW = 272, SG_WAVE = 64 * SG_ROW, SG_SSQ_OFF = 8 * SG_WAVE;
static_assert(SG_SSQ_OFF + 8 * 128 * 4 <= LDS_BYTES, "SGU LDS");
__device__ __forceinline__ void sgu_unit(Frame& F, int u) {
    const int g = F.wave, lane = F.lane, i = lane & 31, hh = lane >> 5; const size_t row0 = (size_t)u * CHUNK;
    LAS unsigned char* vt = F.lds + g * SG_WAVE; LAS float* ssq = (LAS float*)(F.lds + SG_SSQ_OFF);
#pragma unroll 1
    for (int tt = 0; tt < 2; ++tt) { const int t = lane + 64 * tt; const bf16_t* vp = F.P1 + (row0 + t) * INC + AW + g * GD;
        float v[64];
#pragma unroll
        for (int c8 = 0; c8 < 8; ++c8) { const u32x4 r = *(const u32x4*)(vp + 8 * c8); const unsigned w[4] = {r.x, r.y, r.z, r.w};
#pragma unroll
            for (int j = 0; j < 4; ++j) { v[8 * c8 + 2 * j] = bf_lo(w[j]); v[8 * c8 + 2 * j + 1] = bf_hi(w[j]); } }
        float s = 0.f;
#pragma unroll
        for (int c = 0; c < 64; ++c) s += v[c];
        const float mu = s * (1.f / 64.f); float q = 0.f;
#pragma unroll
        for (int c = 0; c < 64; ++c) { v[c] -= mu; q += v[c] * v[c]; }
        const float rstd = 1.0f / sqrtf(q * (1.f / 64.f) + LN_EPS);
#pragma unroll
        for (int c = 0; c < 64; ++c) { const float val = v[c] * rstd * F.sgu_ln_g[g * GD + c] + F.sgu_ln_b[g * GD + c];
            *(LAS bf16_t*)(vt + c * SG_ROW + t * 2) = (bf16_t)(cvt_pk_bf16(val, 0.f) & 0xffffu); } }
    asm volatile("s_waitcnt lgkmcnt(0)" ::: "memory");
    f32x16 acc[2][4];
#pragma unroll
    for (int mt = 0; mt < 2; ++mt)
#pragma unroll
        for (int nt = 0; nt < 4; ++nt)
#pragma unroll
            for (int r = 0; r < 16; ++r) acc[mt][nt][r] = 0.f;
#pragma unroll
    for (int nt = 0; nt < 4; ++nt) { const int t = 32 * nt + i;
#pragma unroll
        for (int ks = 0; ks < 2 * nt + 2; ++ks) { const int s0 = 16 * ks + 8 * hh;
            const float* wp = F.sgu_w + ((size_t)g * CHUNK + t) * CHUNK + s0; const f32x4 w0 = *(const f32x4*)wp, w1 = *(const f32x4*)(wp + 4);
            float wv[8] = {w0[0], w0[1], w0[2], w0[3], w1[0], w1[1], w1[2], w1[3]};
#pragma unroll
            for (int j = 0; j < 8; ++j) wv[j] = (s0 + j <= t) ? wv[j] : 0.f;
            u32x4 bw; bw.x = cvt_pk_bf16(wv[0], wv[1]); bw.y = cvt_pk_bf16(wv[2], wv[3]); bw.z = cvt_pk_bf16(wv[4], wv[5]); bw.w = cvt_pk_bf16(wv[6], wv[7]);
            const bf16x8 bfrag = __builtin_bit_cast(bf16x8, bw);
#pragma unroll
            for (int mt = 0; mt < 2; ++mt) { const bf16x8 afrag = *(const LAS bf16x8*)(vt + (32 * mt + i) * SG_ROW + s0 * 2);
                acc[mt][nt] = __builtin_amdgcn_mfma_f32_32x32x16_bf16(afrag, bfrag, acc[mt][nt], 0, 0, 0); } } }
#pragma unroll
    for (int nt = 0; nt < 4; ++nt) { const int t = 32 * nt + i; const float bs = F.sgu_b[g * CHUNK + t]; float ss = 0.f;
        const bf16_t* up = F.P1 + (row0 + t) * INC + g * GD + 4 * hh;
#pragma unroll
        for (int mt = 0; mt < 2; ++mt)
#pragma unroll
            for (int g4 = 0; g4 < 4; ++g4) { const u32x2 uw = *(const u32x2*)(up + 32 * mt + 8 * g4);
                const float u0 = bf_lo(uw.x), u1 = bf_hi(uw.x), u2 = bf_lo(uw.y), u3 = bf_hi(uw.y);
                float a0 = u0 * (acc[mt][nt][4 * g4] + bs), a1 = u1 * (acc[mt][nt][4 * g4 + 1] + bs), a2 = u2 * (acc[mt][nt][4 * g4 + 2] + bs), a3 = u3 * (acc[mt][nt][4 * g4 + 3] + bs);
                acc[mt][nt][4 * g4] = a0; acc[mt][nt][4 * g4 + 1] = a1; acc[mt][nt][4 * g4 + 2] = a2; acc[mt][nt][4 * g4 + 3] = a3;
                ss += (a0 * a0 + a1 * a1) + (a2 * a2 + a3 * a3); }
        ss += __shfl_xor(ss, 32);
        if (hh == 0) ssq[g * CHUNK + t] = ss; }
    __syncthreads();
#pragma unroll
    for (int nt = 0; nt < 4; ++nt) { const int t = 32 * nt + i; float tot = 0.f;
#pragma unroll
        for (int gg = 0; gg < 8; ++gg) tot += ssq[gg * CHUNK + t];
        const float rs = 1.0f / sqrtf(tot * (1.f / AW) + LN_EPS);
        bf16_t* op = F.Amix + (row0 + t) * D + g * GD + 4 * hh;
#pragma unroll
        for (int mt = 0; mt < 2; ++mt)
#pragma unroll
            for (int g4 = 0; g4 < 4; ++g4) { const f32x4 mg = *(const f32x4*)(F.mix_g + g * GD + 32 * mt + 8 * g4 + 4 * hh);
                u32x2 w; w.x = cvt_pk_bf16(acc[mt][nt][4 * g4] * rs * mg[0], acc[mt][nt][4 * g4 + 1] * rs * mg[1]); w.y = cvt_pk_bf16(acc[mt][nt][4 * g4 + 2] * rs * mg[2], acc[mt][nt][4 * g4 + 3] * rs * mg[3]);
                *(u32x2*)(op + 32 * mt + 8 * g4) = w; } }
    __syncthreads();
}

constexpr int AT_KROW = 144, AT_VROW = 776, AT_V_OFF = 384 * AT_KROW;
static_assert(AT_V_OFF + 64 * AT_VROW <= RING_BYTES, "attention LDS");
__device__ __forceinline__ void attn_unit(Frame& F, int u) {
    const int bh = u / 48, rem = u % 48, p = rem >> 4, idx = rem & 15, b = bh >> 3, h = bh & 7;
    const int d = (p == 0) ? 1 : (p == 1) ? 4 : 16, r = (p == 0) ? 0 : (p == 1) ? (idx >> 2) : idx, blk = (p == 0) ? idx : (p == 1) ? (idx & 3) : 0;
    const int q0 = blk * 256; const int lane = F.lane, i = lane & 31, hh = lane >> 5, w = F.wave;
    const bf16_t* base = F.P1 + (size_t)b * SEQ * INC + h * HD;
    LAS unsigned char* kl = F.lds; LAS unsigned char* vl = F.lds + AT_V_OFF;
#pragma unroll
    for (int it = 0; it < 6; ++it) { const int ch = F.tid + 512 * it, key = ch >> 3, c = ch & 7, s = q0 - 128 + key;
        u32x4 kv = (u32x4){0u, 0u, 0u, 0u}, vv = (u32x4){0u, 0u, 0u, 0u};
        if (s >= 0) { const bf16_t* rp = base + (size_t)(s * d + r) * INC + c * 8; kv = *(const u32x4*)(rp + 1536); vv = *(const u32x4*)(rp + 2048); }
        *(LAS u32x4*)(kl + key * AT_KROW + c * 16) = kv;
        const unsigned vw[4] = {vv.x, vv.y, vv.z, vv.w};
#pragma unroll
        for (int j = 0; j < 4; ++j) { *(LAS bf16_t*)(vl + (8 * c + 2 * j) * AT_VROW + key * 2) = (bf16_t)(vw[j] & 0xffffu); *(LAS bf16_t*)(vl + (8 * c + 2 * j + 1) * AT_VROW + key * 2) = (bf16_t)(vw[j] >> 16); } }
    const int qs = q0 + 32 * w + i; const size_t qrow = (size_t)qs * d + r;
    bf16x8 qf[4];
#pragma unroll
    for (int ks = 0; ks < 4; ++ks) qf[ks] = *(const bf16x8*)(base + qrow * INC + 1024 + 16 * ks + 8 * hh);
    __syncthreads();
    f32x16 s[5];
#pragma unroll
    for (int kt = 0; kt < 5; ++kt) { f32x16 a;
#pragma unroll
        for (int rr = 0; rr < 16; ++rr) a[rr] = 0.f;
#pragma unroll
        for (int ks = 0; ks < 4; ++ks) { const bf16x8 kf = *(const LAS bf16x8*)(kl + (32 * w + 32 * kt + i) * AT_KROW + (16 * ks + 8 * hh) * 2);
            a = __builtin_amdgcn_mfma_f32_32x32x16_bf16(kf, qf[ks], a, 0, 0, 0); }
        s[kt] = a; }
    const float sc = 0.125f * 1.4426950408889634f; const int ksub0 = q0 + 32 * w - 128;
    float m = -INFINITY;
#pragma unroll
    for (int kt = 0; kt < 5; ++kt)
#pragma unroll
        for (int rr = 0; rr < 16; ++rr) { const int kk = (rr & 3) + 8 * (rr >> 2) + 4 * hh; bool ok = (ksub0 + 32 * kt + kk) >= 0;
            if (kt == 0) ok = ok && (kk >= i);
            if (kt == 4) ok = ok && (kk <= i);
            const float v = ok ? s[kt][rr] * sc : -INFINITY; s[kt][rr] = v; m = fmaxf(m, v); }
    m = fmaxf(m, __shfl_xor(m, 32));
    float lsum = 0.f;
#pragma unroll
    for (int kt = 0; kt < 5; ++kt)
#pragma unroll
        for (int rr = 0; rr < 16; ++rr) { const float pv = __builtin_amdgcn_exp2f(s[kt][rr] - m); s[kt][rr] = pv; lsum += pv; }
    lsum += __shfl_xor(lsum, 32);
    f32x16 o[2];
#pragma unroll
    for (int dt = 0; dt < 2; ++dt)
#pragma unroll
        for (int rr = 0; rr < 16; ++rr) o[dt][rr] = 0.f;
#pragma unroll
    for (int kt = 0; kt < 5; ++kt)
#pragma unroll
        for (int s2 = 0; s2 < 2; ++s2) { u32x4 pw; pw.x = cvt_pk_bf16(s[kt][8 * s2], s[kt][8 * s2 + 1]); pw.y = cvt_pk_bf16(s[kt][8 * s2 + 2], s[kt][8 * s2 + 3]);
            pw.z = cvt_pk_bf16(s[kt][8 * s2 + 4], s[kt][8 * s2 + 5]); pw.w = cvt_pk_bf16(s[kt][8 * s2 + 6], s[kt][8 * s2 + 7]);
            const bf16x8 pb = __builtin_bit_cast(bf16x8, pw);
#pragma unroll
            for (int dt = 0; dt < 2; ++dt) { const LAS unsigned char* ap = vl + (32 * dt + i) * AT_VROW + (32 * w + 32 * kt + 16 * s2 + 4 * hh) * 2;
                const s16x4 lo = *(const LAS s16x4*)ap, hi = *(const LAS s16x4*)(ap + 16);
                const bf16x8 af = __builtin_shufflevector(lo, hi, 0, 1, 2, 3, 4, 5, 6, 7);
                o[dt] = __builtin_amdgcn_mfma_f32_32x32x16_bf16(af, pb, o[dt], 0, 0, 0); } }
    const float inv = 1.0f / lsum; const size_t orow = (size_t)b * SEQ + qrow;
    bf16_t* op = F.Opart + ((size_t)p * T + orow) * AW + h * HD + 4 * hh;
#pragma unroll
    for (int dt = 0; dt < 2; ++dt)
#pragma unroll
        for (int g4 = 0; g4 < 4; ++g4) { u32x2 wv; wv.x = cvt_pk_bf16(o[dt][4 * g4] * inv, o[dt][4 * g4 + 1] * inv); wv.y = cvt_pk_bf16(o[dt][4 * g4 + 2] * inv, o[dt][4 * g4 + 3] * inv);
            *(u32x2*)(op + 32 * dt + 8 * g4) = wv; }
    if (hh == 0) *(f32x2*)(F.ML + (((size_t)p * T + orow) * NH + h) * 2) = (f32x2){m, lsum};
    __syncthreads();
}
__device__ __forceinline__ void p2_mixers(Frame& F) {
    constexpr int NSGU = BATCH * (SEQ / CHUNK), NATT = BATCH * NH * 48;
    for (int u = blockIdx.x; u < NSGU + NATT; u += F.G) { if (u < NSGU) sgu_unit(F, u); else attn_unit(F, u - NSGU); }
}

__device__ __forceinline__ void p3_merge(Frame& F) {
    const int gw = blockIdx.x * 8 + F.wave, NGW = F.G * 8, h = F.lane >> 3;
    for (int row = gw; row < T; row += NGW) {
        f32x2 ml[3]; float mx = -INFINITY;
#pragma unroll
        for (int p = 0; p < 3; ++p) { ml[p] = *(const f32x2*)(F.ML + (((size_t)p * T + row) * NH + h) * 2); mx = fmaxf(mx, ml[p].x); }
        float wt[3], wsum = 0.f;
#pragma unroll
        for (int p = 0; p < 3; ++p) { wt[p] = ml[p].y * __builtin_amdgcn_exp2f(ml[p].x - mx); wsum += wt[p]; }
        const float iw = 1.0f / wsum; float bv[8];
#pragma unroll
        for (int j = 0; j < 8; ++j) bv[j] = 0.f;
#pragma unroll
        for (int p = 0; p < 3; ++p) { const u32x4 r = *(const u32x4*)(F.Opart + ((size_t)p * T + row) * AW + F.lane * 8); const unsigned w[4] = {r.x, r.y, r.z, r.w}; const float f = wt[p] * iw;
#pragma unroll
            for (int j = 0; j < 4; ++j) { bv[2 * j] += f * bf_lo(w[j]); bv[2 * j + 1] += f * bf_hi(w[j]); } }
        float ss = 0.f;
#pragma unroll
        for (int j = 0; j < 8; ++j) ss += bv[j] * bv[j];
        ss = wave_sum(ss); const float rs = 1.0f / sqrtf(ss * (1.f / AW) + LN_EPS);
        const f32x4 g0 = *(const f32x4*)(F.mix_g + AW + F.lane * 8), g1 = *(const f32x4*)(F.mix_g + AW + F.lane * 8 + 4);
        u32x4 w; w.x = cvt_pk_bf16(bv[0] * rs * g0[0], bv[1] * rs * g0[1]); w.y = cvt_pk_bf16(bv[2] * rs * g0[2], bv[3] * rs * g0[3]);
        w.z = cvt_pk_bf16(bv[4] * rs * g1[0], bv[5] * rs * g1[1]); w.w = cvt_pk_bf16(bv[6] * rs * g1[2], bv[7] * rs * g1[3]);
        *(u32x4*)(F.Amix + (size_t)row * D + AW + F.lane * 8) = w;
    }
}

constexpr int RT_ROW = 2112, RT_WAVE = 8 * RT_ROW, RT_LG_OFF = 8 * RT_WAVE, RT_SEL_OFF = RT_LG_OFF + 8192;
static_assert(RT_SEL_OFF + 2048 + 256 <= MISC_OFF, "route LDS");
__device__ __forceinline__ void p4_route(Frame& F) {
    const int lane = F.lane, w = F.wave;
    LAS unsigned char* hl = F.lds + w * RT_WAVE;
    LAS float* lgb = (LAS float*)(F.lds + RT_LG_OFF + w * 1024);
    LAS int* sel_e = (LAS int*)(F.lds + RT_SEL_OFF); LAS float* sel_g = (LAS float*)(F.lds + RT_SEL_OFF + 1024);
    LAS int* lcnt = (LAS int*)(F.lds + RT_SEL_OFF + 2048); LAS int* lbase = lcnt + 32;
    if (F.tid < 32) lcnt[F.tid] = 0;
    __syncthreads();
    f32x4 gg[4], bb[4];
#pragma unroll
    for (int j = 0; j < 4; ++j) { gg[j] = *(const f32x4*)(F.ln1_g + 4 * lane + 256 * j); bb[j] = *(const f32x4*)(F.ln1_b + 4 * lane + 256 * j); }
    for (int chunk = blockIdx.x; chunk < T / 64; chunk += F.G) {
#pragma unroll 1
        for (int batch = 0; batch < 2; ++batch) {
            const int row0 = chunk * 64 + w * 8 + batch * 4;
            f32x4 v[4][4]; float s[4], q[4];
#pragma unroll
            for (int tk = 0; tk < 4; ++tk) { s[tk] = 0.f;
#pragma unroll
                for (int j = 0; j < 4; ++j) { v[tk][j] = *(const f32x4*)(F.out + (size_t)(row0 + tk) * D + 4 * lane + 256 * j); s[tk] += (v[tk][j][0] + v[tk][j][1]) + (v[tk][j][2] + v[tk][j][3]); } }
#pragma unroll
            for (int o = 1; o < 64; o <<= 1) {
#pragma unroll
                for (int tk = 0; tk < 4; ++tk) s[tk] += __shfl_xor(s[tk], o); }
#pragma unroll
            for (int tk = 0; tk < 4; ++tk) { const float mu = s[tk] * (1.f / D); q[tk] = 0.f;
#pragma unroll
                for (int j = 0; j < 4; ++j) { v[tk][j] = v[tk][j] - mu; q[tk] += (v[tk][j][0] * v[tk][j][0] + v[tk][j][1] * v[tk][j][1]) + (v[tk][j][2] * v[tk][j][2] + v[tk][j][3] * v[tk][j][3]); } }
#pragma unroll
            for (int o = 1; o < 64; o <<= 1) {
#pragma unroll
                for (int tk = 0; tk < 4; ++tk) q[tk] += __shfl_xor(q[tk], o); }
#pragma unroll
            for (int tk = 0; tk < 4; ++tk) { const float rstd = 1.0f / sqrtf(q[tk] * (1.f / D) + LN_EPS);
#pragma unroll
                for (int j = 0; j < 4; ++j) { const f32x4 h = v[tk][j] * rstd * gg[j] + bb[j]; const size_t off = (size_t)(row0 + tk) * D + 4 * lane + 256 * j;
                    *(f32x4*)(F.out + off) = h;
                    u32x2 hi; hi.x = cvt_pk_bf16(h[0], h[1]); hi.y = cvt_pk_bf16(h[2], h[3]);
                    *(unsigned*)(F.Hb + off) = cvt4_fp8(h[0], h[1], h[2], h[3]);
                    u32x2 lo; lo.x = cvt_pk_bf16(h[0] - bf_lo(hi.x), h[1] - bf_hi(hi.x)); lo.y = cvt_pk_bf16(h[2] - bf_lo(hi.y), h[3] - bf_hi(hi.y));
                    *(LAS u32x2*)(hl + tk * RT_ROW + (4 * lane + 256 * j) * 2) = hi; *(LAS u32x2*)(hl + (4 + tk) * RT_ROW + (4 * lane + 256 * j) * 2) = lo; } }
            asm volatile("s_waitcnt lgkmcnt(0)" ::: "memory");
            f32x4 acc[2] = {(f32x4){0.f, 0.f, 0.f, 0.f}, (f32x4){0.f, 0.f, 0.f, 0.f}};
            const LAS unsigned char* ap = hl + (lane & 3) * RT_ROW + (8 * (lane >> 4)) * 2;
            const bf16_t* bp = F.WrtHi + (size_t)(lane & 15) * D + 8 * (lane >> 4);
#pragma unroll 16
            for (int ks = 0; ks < 32; ++ks) {
                const bf16x8 ah = *(const LAS bf16x8*)(ap + ks * 64), al = *(const LAS bf16x8*)(ap + 4 * RT_ROW + ks * 64);
#pragma unroll
                for (int nt = 0; nt < 2; ++nt) { const bf16x8 bh = *(const bf16x8*)(bp + (size_t)nt * 16 * D + ks * 32), bl = *(const bf16x8*)(bp + (size_t)(NE * D) + (size_t)nt * 16 * D + ks * 32);
                    acc[nt] = __builtin_amdgcn_mfma_f32_16x16x32_bf16(ah, bh, acc[nt], 0, 0, 0);
                    acc[nt] = __builtin_amdgcn_mfma_f32_16x16x32_bf16(ah, bl, acc[nt], 0, 0, 0);
                    acc[nt] = __builtin_amdgcn_mfma_f32_16x16x32_bf16(al, bh, acc[nt], 0, 0, 0); } }
            if (lane < 16) {
#pragma unroll
                for (int nt = 0; nt < 2; ++nt)
#pragma unroll
                    for (int r = 0; r < 4; ++r) lgb[(batch * 4 + r) * 32 + 16 * nt + lane] = acc[nt][r]; }
            asm volatile("s_waitcnt lgkmcnt(0)" ::: "memory");
        }
        if (lane < 8) {
            float lg[32];
#pragma unroll
            for (int c = 0; c < 8; ++c) { const f32x4 x = *(const LAS f32x4*)(lgb + lane * 32 + 4 * c), br = *(const f32x4*)(F.b_router + 4 * c); lg[4 * c] = x[0] + br[0]; lg[4 * c + 1] = x[1] + br[1]; lg[4 * c + 2] = x[2] + br[2]; lg[4 * c + 3] = x[3] + br[3]; }
            int idx[4]; float val[4]; unsigned taken = 0u;
#pragma unroll
            for (int r = 0; r < 4; ++r) { float best = -INFINITY; int bi = 0;
#pragma unroll
                for (int e = 0; e < 32; ++e) { const bool ok = !((taken >> e) & 1u) && (lg[e] > best); best = ok ? lg[e] : best; bi = ok ? e : bi; }
                idx[r] = bi; val[r] = best; taken |= 1u << bi; }
            const float e1 = __expf(val[1] - val[0]), e2 = __expf(val[2] - val[0]), e3 = __expf(val[3] - val[0]); const float inv = 1.0f / (1.0f + e1 + e2 + e3);
            const int tl = w * 8 + lane;
            sel_e[tl * 4 + 0] = idx[0]; sel_e[tl * 4 + 1] = idx[1]; sel_e[tl * 4 + 2] = idx[2]; sel_e[tl * 4 + 3] = idx[3];
            sel_g[tl * 4 + 0] = inv; sel_g[tl * 4 + 1] = e1 * inv; sel_g[tl * 4 + 2] = e2 * inv; sel_g[tl * 4 + 3] = e3 * inv; }
        __syncthreads();
        int myrank = 0, mye = 0;
        if (F.tid < 256) { mye = sel_e[F.tid]; myrank = atomicAdd((int*)&lcnt[mye], 1); }
        __syncthreads();
        if (F.tid < 32) { const int c = lcnt[F.tid]; lbase[F.tid] = c ? (int)__hip_atomic_fetch_add(F.ctl + CW_CNT + F.tid, (unsigned)c, __ATOMIC_RELAXED, __HIP_MEMORY_SCOPE_AGENT) : 0; lcnt[F.tid] = 0; }
        __syncthreads();
        if (F.tid < 256) { const int slot = (chunk * 64 + (F.tid >> 2)) * 4 + (F.tid & 3); F.list[mye * T + lbase[mye] + myrank] = slot; F.gates[slot] = sel_g[F.tid]; }
        __syncthreads();
    }
}

template <bool G1> __device__ __forceinline__ int moe_tables(Frame& F, int NPN) {
    LAS int* cnt = (LAS int*)(F.lds + TAB_OFF); LAS int* tstart = cnt + 32; LAS int* rowtab = (LAS int*)(F.lds + ROWTAB_OFF);
    if (F.tid < 32) cnt[F.tid] = (int)__hip_atomic_load(F.ctl + CW_CNT + F.tid, __ATOMIC_RELAXED, __HIP_MEMORY_SCOPE_AGENT);
    __syncthreads();
    if (F.tid == 0) { int acc = 0; for (int e = 0; e < NE; ++e) { tstart[e] = acc; acc += (cnt[e] + 255) >> 8; } tstart[NE] = acc; }
    __syncthreads();
    const int ntiles = tstart[NE], nU = ntiles * NPN;
    for (int i = 0; i < MAXU; ++i) { const int L = i * F.G + F.vcu; if (L >= nU) break;
        const int tl = L / NPN; int e = 0;
        for (int j = 1; j < NE; ++j) e += (tstart[j] <= tl) ? 1 : 0;
        const int mt = tl - tstart[e];
        if (F.tid < 256) { const int rank = mt * 256 + F.tid; const int slot = rank < cnt[e] ? F.list[e * T + rank] : -1;
            rowtab[i * 256 + F.tid] = G1 ? ((slot < 0 ? 0 : (slot >> 2)) * D) : slot; } }
    __syncthreads();
    return ntiles;
}

__device__ __forceinline__ void p7_final(Frame& F) {
    const int gw = blockIdx.x * 8 + F.wave, NGW = F.G * 8;
    for (int row = gw; row < T; row += NGW) {
        float* hp = F.out + (size_t)row * D; float v[16];
#pragma unroll
        for (int j = 0; j < 2; ++j) { const f32x4 a = *(const f32x4*)(hp + 512 * j + F.lane * 8), b = *(const f32x4*)(hp + 512 * j + F.lane * 8 + 4);
#pragma unroll
            for (int i = 0; i < 4; ++i) { v[8 * j + i] = a[i] * DN_ALPHA; v[8 * j + 4 + i] = b[i] * DN_ALPHA; } }
#pragma unroll
        for (int k = 0; k < TOPK; ++k)
#pragma unroll
            for (int j = 0; j < 2; ++j) { const u32x4 r = *(const u32x4*)(F.Y + ((size_t)row * TOPK + k) * D + 512 * j + F.lane * 8); const unsigned w[4] = {r.x, r.y, r.z, r.w};
#pragma unroll
                for (int i = 0; i < 4; ++i) { v[8 * j + 2 * i] += bf_lo(w[i]); v[8 * j + 2 * i + 1] += bf_hi(w[i]); } }
        float s = 0.f;
#pragma unroll
        for (int i = 0; i < 16; ++i) s += v[i];
        const float mu = wave_sum(s) * (1.f / D); float q = 0.f;
#pragma unroll
        for (int i = 0; i < 16; ++i) { v[i] -= mu; q += v[i] * v[i]; }
        const float rstd = 1.0f / sqrtf(wave_sum(q) * (1.f / D) + LN_EPS);
#pragma unroll
        for (int j = 0; j < 2; ++j) { const int c = 512 * j + F.lane * 8;
            const f32x4 g0 = *(const f32x4*)(F.ln2_g + c), g1 = *(const f32x4*)(F.ln2_g + c + 4), b0 = *(const f32x4*)(F.ln2_b + c), b1 = *(const f32x4*)(F.ln2_b + c + 4);
            f32x4 o0, o1;
#pragma unroll
            for (int i = 0; i < 4; ++i) { o0[i] = v[8 * j + i] * rstd * g0[i] + b0[i]; o1[i] = v[8 * j + 4 + i] * rstd * g1[i] + b1[i]; }
            *(f32x4*)(hp + c) = o0; *(f32x4*)(hp + c + 4) = o1; }
    }
}

constexpr int N_PHASES = 8;
__global__ void __launch_bounds__(512, 2) mk_fwd(Args args) {
    extern __shared__ __attribute__((aligned(16))) unsigned char lds_raw[];
    Frame F;
    F.lds = (LAS unsigned char*)lds_raw; F.tid = threadIdx.x; F.lane = F.tid & 63; F.wave = __builtin_amdgcn_readfirstlane(F.tid >> 6);
    F.G = gridDim.x; { const int bx = blockIdx.x; F.vcu = (F.G % 8 == 0) ? (bx % 8) * (F.G / 8) + bx / 8 : bx; }
    F.x = args.in[0]; F.w_in = args.in[1]; F.sgu_w = args.in[2]; F.sgu_b = args.in[3]; F.sgu_ln_g = args.in[4]; F.sgu_ln_b = args.in[5]; F.mix_g = args.in[6]; F.w_out = args.in[7];
    F.ln1_g = args.in[8]; F.ln1_b = args.in[9]; F.w_router = args.in[10]; F.b_router = args.in[11]; F.w_gate = args.in[12]; F.b_gate = args.in[13]; F.w_up = args.in[14]; F.b_up = args.in[15];
    F.w_down = args.in[16]; F.b_down = args.in[17]; F.ln2_g = args.in[18]; F.ln2_b = args.in[19]; F.out = args.out; F.ws = args.ws;
    unsigned char* ws = args.ws;
    F.ctl = (unsigned*)(ws + WS_CTL); F.list = (int*)(ws + WS_LIST); F.gates = (float*)(ws + WS_GATES);
    F.Win_t = (bf16_t*)(ws + WS_WIN); F.Wout_t = (bf16_t*)(ws + WS_WOUT); F.Wd_t = (act_t*)(ws + WS_WD); F.Wgu_t = (fp8_t*)(ws + WS_WGU); F.Y = (bf16_t*)(ws + WS_Y);
    F.Hb = (fp8_t*)(ws + WS_HB); F.Xb = (bf16_t*)(ws + WS_XB); F.P1 = (bf16_t*)(ws + WS_P1); F.Amix = (bf16_t*)(ws + WS_AMIX); F.Act = (act_t*)(ws + WS_ACT);
    F.WrtHi = (bf16_t*)(ws + WS_WRT); F.Opart = (bf16_t*)(ws + WS_OPART); F.ML = (float*)(ws + WS_ML);
    const int lo = args.ph_lo, hi = args.ph_hi;
    volatile LAS unsigned* misc = (volatile LAS unsigned*)(F.lds + MISC_OFF);
    if (F.tid < 16) misc[F.tid] = 0u;
    __syncthreads();
    XcdBarrier bar; bar.bar = F.ctl + CW_BAR; bar.x = 0; bar.st = misc;
    if (hi - lo > 1) bar = xcd_barrier_post(F.ctl + CW_BAR, misc);
    const LAS int* rowtab = (const LAS int*)(F.lds + ROWTAB_OFF);
#ifndef PROBE_DUP
#define PROBE_DUP -1
#endif
#define IN(k) (lo <= (k) && (k) < hi)
#define SEAM(k) do { if (IN(k) && IN((k) + 1)) { xcd_barrier(bar); } } while (0)
#define REP(k) for (int _rep = 0; _rep < ((PROBE_DUP == (k)) ? 2 : 1); ++_rep)
    if (IN(0)) REP(0) { p0_convert(F); }
    SEAM(0);
    if (IN(1)) REP(1) { pg8::Gemm g{F.Xb, F.Win_t, D * 2}; pg8::DenseOrder S{INC / 256, (T / 256) * (INC / 256), F.G, F.vcu}; pg8::EpiP1 E{F.P1};
        pg8::gemm_phase<pg8::EpiP1, pg8::DenseOrder, false, false>(F.lds, rowtab, g, S, E); }
    SEAM(1);
    if (IN(2)) REP(2) { p2_mixers(F); }
    SEAM(2);
    if (IN(3)) REP(3) { p3_merge(F); }
    SEAM(3);
    if (IN(4)) REP(4) { pg8::Gemm g{F.Amix, F.Wout_t, D * 2}; pg8::DenseOrder S{D / 256, (T / 256) * (D / 256), F.G, F.vcu}; pg8::EpiZ E{F.x, F.out};
        pg8::gemm_phase<pg8::EpiZ, pg8::DenseOrder, false, false>(F.lds, rowtab, g, S, E); }
    SEAM(4);
    if (IN(5)) { p4_route(F); }
    SEAM(5);
    if (IN(6)) REP(6) { const int ntiles = moe_tables<true>(F, 8); pg8::Gemm g{F.Hb, F.Wgu_t, D}; pg8::MoeOrder S{8, ntiles * 8, F.G, F.vcu, (const LAS int*)(F.lds + TAB_OFF) + 32};
        pg8::EpiSwiglu E{F.Act, F.b_gate, F.b_up};
        pg8::gemm_phase<pg8::EpiSwiglu, pg8::MoeOrder, true, true>(F.lds, rowtab, g, S, E); }
    SEAM(6);
    if (IN(7)) REP(7) { const int ntiles = moe_tables<false>(F, 4); pg8::Gemm g{F.Act, F.Wd_t, FF * (int)sizeof(act_t)}; pg8::MoeOrder S{4, ntiles * 4, F.G, F.vcu, (const LAS int*)(F.lds + TAB_OFF) + 32};
        pg8::EpiScatter E{F.Y, F.b_down, F.gates, rowtab};
        pg8::gemm_phase<pg8::EpiScatter, pg8::MoeOrder, false, (G2_FP8 != 0)>(F.lds, rowtab, g, S, E); }
    SEAM(7);
    if (IN(8)) { p7_final(F); }
#undef IN
#undef SEAM
}

extern "C" void kernel_launch(void* const* d_in, const int* in_sizes, int n_in, void* d_out, int out_size, void* d_ws, size_t ws_size, hipStream_t stream) {
    static int grid = 0;
    if (grid == 0) {
        if (n_in != 20 || in_sizes[0] != T * D || out_size != T * D || ws_size < WS_END) { fprintf(stderr, "kernel_launch: unexpected shapes (n_in %d, in0 %d, out %d, ws %zu)\n", n_in, n_in > 0 ? in_sizes[0] : -1, out_size, ws_size); grid = -1; return; }
        int dev = 0, cus = 0, per_cu = 0;
        hipGetDevice(&dev); hipDeviceGetAttribute(&cus, hipDeviceAttributeMultiprocessorCount, dev);
        if (hipFuncSetAttribute((const void*)mk_fwd, hipFuncAttributeMaxDynamicSharedMemorySize, LDS_BYTES) != hipSuccess) { fprintf(stderr, "kernel_launch: hipFuncSetAttribute failed\n"); grid = -1; return; }
        hipOccupancyMaxActiveBlocksPerMultiprocessor(&per_cu, (const void*)mk_fwd, 512, LDS_BYTES);
        (void)hipGetLastError();
        if (per_cu < 1) { fprintf(stderr, "kernel_launch: occupancy query says %d blocks/CU: the grid would not be resident; nothing launched\n", per_cu); grid = -1; return; }
        grid = cus;
        if (grid != 256) fprintf(stderr, "kernel_launch: note: %d CUs (tuned for 256)\n", grid);
    }
    if (grid < 0) return;
    hipMemsetAsync((char*)d_ws + WS_CTL, 0, CTL_ZERO_BYTES, stream);
    Args a{};
    for (int i = 0; i < 20; ++i) a.in[i] = (const float*)d_in[i];
    a.out = (float*)d_out; a.ws = (unsigned char*)d_ws;
#if MK_N_LAUNCHES == 1
    a.ph_lo = 0; a.ph_hi = N_PHASES + 1;
    hipLaunchKernelGGL(mk_fwd, dim3(grid), dim3(512), LDS_BYTES, stream, a);
#else
    for (int p = 0; p <= N_PHASES; ++p) { a.ph_lo = p; a.ph_hi = p + 1; hipLaunchKernelGGL(mk_fwd, dim3(grid), dim3(512), LDS_BYTES, stream, a); }
#endif
}
```

```cpp
#include <hip/hip_runtime.h>
#include <hip/hip_cooperative_groups.h>
#include <cstdio>
#include <cstdint>
namespace cg = cooperative_groups;

#ifndef MK_N_LAUNCHES
#define MK_N_LAUNCHES 1
#endif

constexpr int BATCH = 4, SEQ = 4096, T = BATCH * SEQ, D = 1024, INC = 2560, NE = 32, FF = 1024, TOPK = 4;
constexpr int AW = 512, NGRP = 8, GD = 64, CHUNK = 128, NH = 8, HD = 64;
constexpr float LN_EPS = 1e-5f, DN_ALPHA = 1.189207115002721f;
constexpr int NSLOT = T * TOPK;
constexpr int MAXTILES = 288;
constexpr int MAXU = 12;

constexpr size_t MiB = 1u << 20;
constexpr size_t WS_CTL = 0, CTL_ZERO_BYTES = 64 * 1024;
constexpr size_t WS_LIST = 1 * MiB;
constexpr size_t WS_GATES = 3 * MiB;
constexpr size_t WS_WRT = 3 * MiB + 512 * 1024;
constexpr size_t WS_WIN = 4 * MiB;
constexpr size_t WS_WOUT = 9 * MiB;
constexpr size_t WS_WD = 11 * MiB;
constexpr size_t WS_WGU = 75 * MiB;
constexpr size_t WS_HB = 139 * MiB;
constexpr size_t WS_BIG = 155 * MiB;
constexpr size_t WS_XB = WS_BIG;
constexpr size_t WS_P1 = WS_BIG + 32 * MiB;
constexpr size_t WS_AMIX = WS_BIG + 112 * MiB;
constexpr size_t WS_ACT = WS_BIG;
constexpr size_t WS_Y = 299 * MiB;
constexpr size_t WS_OPART = 427 * MiB;
constexpr size_t WS_ML = 475 * MiB;
constexpr size_t WS_END = 478 * MiB;
#ifndef G2_FP8
#define G2_FP8 1
#endif
constexpr float WGU_SCALE = 32.0f, WD_SCALE = G2_FP8 ? 64.0f : 1.0f;
#if G2_FP8
typedef unsigned char act_t;
#else
typedef unsigned short act_t;
#endif
constexpr int CW_BAR = 1024;
constexpr int CW_CNT = 0;

constexpr int RING_BYTES = 131072;
constexpr int TAB_OFF = RING_BYTES + 1024;
constexpr int ROWTAB_OFF = RING_BYTES + 2048;
constexpr int MISC_OFF = 147456 - 64;
constexpr int LDS_BYTES = 147456;
static_assert(ROWTAB_OFF + MAXU * 1024 <= LDS_BYTES, "LDS map");

#define LAS __attribute__((address_space(3)))
typedef unsigned short bf16_t;
typedef unsigned char fp8_t;
typedef short bf16x8 __attribute__((ext_vector_type(8)));
typedef float f32x4 __attribute__((ext_vector_type(4)));
typedef float f32x2 __attribute__((ext_vector_type(2)));
typedef unsigned u32x4 __attribute__((ext_vector_type(4)));
typedef unsigned u32x2 __attribute__((ext_vector_type(2)));
typedef int v8i32 __attribute__((ext_vector_type(8)));
typedef int v4i32 __attribute__((ext_vector_type(4)));


__device__ __forceinline__ unsigned cvt_pk_bf16(float lo, float hi) { unsigned r; asm volatile("v_cvt_pk_bf16_f32 %0, %1, %2" : "=v"(r) : "v"(lo), "v"(hi)); return r; }
__device__ __forceinline__ unsigned cvt4_fp8(float a, float b, float c, float d) { int w = 0; w = __builtin_amdgcn_cvt_pk_fp8_f32(a, b, w, false); w = __builtin_amdgcn_cvt_pk_fp8_f32(c, d, w, true); return (unsigned)w; }
__device__ __forceinline__ float bf_lo(unsigned w) { return __uint_as_float(w << 16); }
__device__ __forceinline__ float bf_hi(unsigned w) { return __uint_as_float(w & 0xffff0000u); }
__device__ __forceinline__ float bf1(bf16_t b) { return __uint_as_float((unsigned)b << 16); }
__device__ __forceinline__ float wave_sum(float v) {
#pragma unroll
    for (int o = 1; o < 64; o <<= 1) v += __shfl_xor(v, o);
    return v;
}
__device__ __forceinline__ float gelu_tanh(float x) {
    const float y2 = x * (1.5957691216057308f + 0.07135481627260025f * x * x);
    return x * __builtin_amdgcn_rcpf(1.0f + __builtin_amdgcn_exp2f(-1.4426950408889634f * y2));
}

namespace pg8 {
constexpr int BM = 256, BK = 64, HALF = 128, HTB = HALF * BK * 2, STAGE_BYTES = 8 * HTB;
__host__ __device__ __forceinline__ int lds_byte(int r, int c) { const int st = (r >> 4) * 2 + (c >> 5), rr = r & 15, cc = c & 31, ob = rr * 64 + cc * 2; return st * 1024 + (ob ^ (((ob >> 9) & 1) << 5)); }
__host__ __device__ __forceinline__ void stage_rc(int b, int& R, int& C) { const int st = b / 1024, sb = b % 1024, swz = sb ^ (((sb >> 9) & 1) << 5); R = (st >> 1) * 16 + swz / 64; C = (st & 1) * 32 + (swz % 64) / 2; }
__host__ __device__ __forceinline__ int perm32(int rho) { const int n = rho >> 4, i = rho & 15; return 8 * (i >> 2) + 4 * n + (i & 3); }

struct Unit { int pm, pn, pb, e, mt, ui; };
struct Gemm { const void* A; const void* Bt; int KB; };

struct DenseOrder {
    int nN, nU, G, v;
    __device__ __forceinline__ bool next(int i, Unit& u) const {
        const int L = i * G + v; if (L >= nU) return false;
        u.pm = L / nN; u.pn = L % nN; u.pb = u.pn; u.e = 0; u.mt = 0; u.ui = i; return true; }
};
struct MoeOrder {
    int NPN, nU, G, v; const LAS int* tstart;
    __device__ __forceinline__ bool next(int i, Unit& u) const {
        const int L = i * G + v; if (L >= nU) return false;
        const int tl = L / NPN, pn = L % NPN; int e = 0;
#pragma unroll
        for (int j = 1; j < NE; ++j) e += (tstart[j] <= tl) ? 1 : 0;
        e = __builtin_amdgcn_readfirstlane(e); const int ts = __builtin_amdgcn_readfirstlane(tstart[e]);
        u.pm = tl; u.pn = pn; u.pb = e * NPN + pn; u.e = e; u.mt = tl - ts; u.ui = i; return true; }
};

template <class Epi, class Sched, bool GATHER, bool FP8>
__device__ __forceinline__ void gemm_phase(LAS unsigned char* lds, const LAS int* rowtab, const Gemm g, const Sched& S, const Epi& E) {
    const int tid = threadIdx.x, wid = __builtin_amdgcn_readfirstlane(tid >> 6), lane = tid & 63, wr = wid >> 2, wc = wid & 3, fr = lane & 15, fq = lane >> 4;
    const int KB = g.KB, nt = KB / (BK * 2);
    unsigned voffA0[2], voffA1[2], voffB[2]; int Rr[2], Cc[2];
#pragma unroll
    for (int i = 0; i < 2; ++i) { int R, C; stage_rc(tid * 16 + i * 8192, R, C); const int Rb = Epi::PERM ? ((R & ~31) + perm32(R & 31)) : R; Rr[i] = R; Cc[i] = C;
        voffA0[i] = (unsigned)(R * KB + C * 2); voffA1[i] = (unsigned)((R + HALF) * KB + C * 2); voffB[i] = (unsigned)(Rb * KB + C * 2); }
    const unsigned kstep = (unsigned)(BK * 2);
    const unsigned hstep = (unsigned)HALF * (unsigned)KB;
    const unsigned tstep = 2u * hstep;
    const __amdgpu_buffer_rsrc_t rsA = __builtin_amdgcn_make_buffer_rsrc(const_cast<void*>(g.A), 0, -1, 0x00020000);
    const __amdgpu_buffer_rsrc_t rsB = __builtin_amdgcn_make_buffer_rsrc(const_cast<void*>(g.Bt), 0, -1, 0x00020000);
    const unsigned ldsw = (unsigned)wid * 1024u;
    const int aoff = lds_byte(wr * 64 + fr, fq * 8), boff = lds_byte(wc * 32 + fr, fq * 8);
#define PG8_SA(b, h) (((b) * 2 + (h)) * HTB)
#define PG8_SB(b, h) ((4 + (b) * 2 + (h)) * HTB)
#define PG8_STAGE(bufoff, rs, soff, voff) do { _Pragma("unroll") for (int _i = 0; _i < 2; ++_i) \
        __builtin_amdgcn_raw_ptr_buffer_load_lds(rs, (LAS void*)(lds + (bufoff) + ldsw + _i * 8192), 16, (int)(voff)[_i], (int)(soff), 0, 0); } while (0)
#define PG8_LDA(dst, b, h) do { if constexpr (FP8) { _Pragma("unroll") for (int m = 0; m < 4; ++m) dst##8[m] = __builtin_shufflevector(*(const LAS v4i32*)(lds + PG8_SA(b, h) + aoff + m * 2048), *(const LAS v4i32*)(lds + PG8_SA(b, h) + aoff + m * 2048 + 1024), 0, 1, 2, 3, 4, 5, 6, 7); } \
        else { _Pragma("unroll") for (int m = 0; m < 4; ++m) _Pragma("unroll") for (int k = 0; k < 2; ++k) dst[m][k] = *(const LAS bf16x8*)(lds + PG8_SA(b, h) + aoff + m * 2048 + k * 1024); } } while (0)
#define PG8_LDB(dst, b, h) do { if constexpr (FP8) { _Pragma("unroll") for (int n = 0; n < 2; ++n) dst##8[n] = __builtin_shufflevector(*(const LAS v4i32*)(lds + PG8_SB(b, h) + boff + n * 2048), *(const LAS v4i32*)(lds + PG8_SB(b, h) + boff + n * 2048 + 1024), 0, 1, 2, 3, 4, 5, 6, 7); } \
        else { _Pragma("unroll") for (int n = 0; n < 2; ++n) _Pragma("unroll") for (int k = 0; k < 2; ++k) dst[n][k] = *(const LAS bf16x8*)(lds + PG8_SB(b, h) + boff + n * 2048 + k * 1024); } } while (0)
#define PG8_MMA(ai, bj, At, Bt) do { __builtin_amdgcn_s_setprio(1); if constexpr (FP8) { _Pragma("unroll") for (int m = 0; m < 4; ++m) _Pragma("unroll") for (int n = 0; n < 2; ++n) \
        acc[ai][bj][m][n] = __builtin_amdgcn_mfma_scale_f32_16x16x128_f8f6f4(Bt##8[n], At##8[m], acc[ai][bj][m][n], 0, 0, 0, 0x7F7F7F7F, 0, 0x7F7F7F7F); } \
        else { _Pragma("unroll") for (int m = 0; m < 4; ++m) _Pragma("unroll") for (int n = 0; n < 2; ++n) _Pragma("unroll") for (int k = 0; k < 2; ++k) \
        acc[ai][bj][m][n] = __builtin_amdgcn_mfma_f32_16x16x32_bf16(Bt[n][k], At[m][k], acc[ai][bj][m][n], 0, 0, 0); } __builtin_amdgcn_s_setprio(0); } while (0)
#define PG8_WAIT_V(n) asm volatile("s_waitcnt vmcnt(" #n ")" ::: "memory")
#define PG8_WAIT_L(n) asm volatile("s_waitcnt lgkmcnt(" #n ")" ::: "memory")
#define PG8_BAR __builtin_amdgcn_s_barrier()
#define PG8_SCHED __builtin_amdgcn_sched_barrier(0)
#define PG8_LOADROWS(U) do { if constexpr (GATHER) { _Pragma("unroll") for (int _i = 0; _i < 2; ++_i) { \
        voffA0[_i] = (unsigned)rowtab[(U).ui * 256 + Rr[_i]] + (unsigned)Cc[_i] * 2u; voffA1[_i] = (unsigned)rowtab[(U).ui * 256 + HALF + Rr[_i]] + (unsigned)Cc[_i] * 2u; } } } while (0)
    Unit cur, nxt; int ui = 0;
    if (!S.next(0, cur)) return;
    f32x4 acc[2][2][4][2];
#pragma unroll
    for (int a = 0; a < 2; ++a)
#pragma unroll
        for (int b = 0; b < 2; ++b)
#pragma unroll
            for (int m = 0; m < 4; ++m)
#pragma unroll
                for (int n = 0; n < 2; ++n) acc[a][b][m][n] = (f32x4){0.f, 0.f, 0.f, 0.f};
    bf16x8 At[4][2], B0[2][2], B1[2][2]; v8i32 At8[4], B08[2], B18[2];
    unsigned cA = GATHER ? 0u : (unsigned)cur.pm * tstep, cB = (unsigned)cur.pb * tstep;
    PG8_LOADROWS(cur); PG8_WAIT_L(0);
    PG8_STAGE(PG8_SB(0, 0), rsB, cB, voffB); PG8_STAGE(PG8_SB(0, 1), rsB, cB + hstep, voffB); PG8_STAGE(PG8_SA(0, 0), rsA, cA, voffA0); PG8_STAGE(PG8_SA(0, 1), rsA, cA, voffA1);
    if (wr == 1) PG8_BAR;
    PG8_WAIT_V(2); PG8_BAR;
    PG8_STAGE(PG8_SB(1, 0), rsB, cB + kstep, voffB); PG8_STAGE(PG8_SA(1, 0), rsA, cA + kstep, voffA0); PG8_STAGE(PG8_SB(1, 1), rsB, cB + hstep + kstep, voffB);
    PG8_WAIT_V(6); PG8_BAR;
    for (;;) {
        const bool has_next = S.next(ui + 1, nxt);
        const unsigned nA = has_next ? (GATHER ? 0u : (unsigned)nxt.pm * tstep) : cA, nB = has_next ? (unsigned)nxt.pb * tstep : cB;
#pragma unroll 1
        for (int t = 0; t < nt; t += 2) {
            const bool last = (t == nt - 2);
            const unsigned a1 = cA + (unsigned)(t + 1) * kstep;
            const unsigned a2 = last ? nA : cA + (unsigned)(t + 2) * kstep, b2 = last ? nB : cB + (unsigned)(t + 2) * kstep;
            const unsigned a3 = a2 + kstep, b3 = b2 + kstep;
            PG8_LDB(B0, 0, 0); PG8_LDB(B1, 0, 1); PG8_SCHED; PG8_LDA(At, 0, 0); PG8_STAGE(PG8_SA(1, 1), rsA, a1, voffA1);
            if (last && has_next) PG8_LOADROWS(nxt);
            PG8_WAIT_V(8); PG8_WAIT_L(0); PG8_BAR; PG8_MMA(0, 0, At, B0); PG8_MMA(0, 1, At, B1); PG8_BAR; PG8_SCHED;
            PG8_LDA(At, 0, 1); PG8_STAGE(PG8_SB(0, 0), rsB, b2, voffB); PG8_STAGE(PG8_SB(0, 1), rsB, b2 + hstep, voffB); PG8_STAGE(PG8_SA(0, 0), rsA, a2, voffA0);
            PG8_WAIT_V(8); PG8_WAIT_L(0); PG8_BAR; PG8_MMA(1, 0, At, B0); PG8_MMA(1, 1, At, B1); PG8_BAR; PG8_SCHED;
            PG8_LDB(B0, 1, 0); PG8_LDB(B1, 1, 1); PG8_SCHED; PG8_LDA(At, 1, 0); PG8_STAGE(PG8_SA(0, 1), rsA, a2, voffA1);
            PG8_WAIT_V(8); PG8_WAIT_L(0); PG8_BAR; PG8_MMA(0, 0, At, B0); PG8_MMA(0, 1, At, B1); PG8_BAR; PG8_SCHED;
            PG8_LDA(At, 1, 1); PG8_STAGE(PG8_SB(1, 0), rsB, b3, voffB); PG8_STAGE(PG8_SB(1, 1), rsB, b3 + hstep, voffB); PG8_STAGE(PG8_SA(1, 0), rsA, a3, voffA0);
            PG8_WAIT_V(8); PG8_WAIT_L(0); PG8_BAR; PG8_MMA(1, 0, At, B0); PG8_MMA(1, 1, At, B1); PG8_BAR; PG8_SCHED;
        }
        if (wr == 0) PG8_BAR;
        { int t2 = threadIdx.x; asm volatile("" : "+v"(t2));
          const int w2 = __builtin_amdgcn_readfirstlane(t2 >> 6), l2 = t2 & 63; E(acc, cur, w2 >> 2, w2 & 3, l2 & 15, l2 >> 4); }
        if (!has_next) break;
#pragma unroll
        for (int a = 0; a < 2; ++a)
#pragma unroll
            for (int b = 0; b < 2; ++b)
#pragma unroll
                for (int m = 0; m < 4; ++m)
#pragma unroll
                    for (int n = 0; n < 2; ++n) acc[a][b][m][n] = (f32x4){0.f, 0.f, 0.f, 0.f};
        cur = nxt; cA = nA; cB = nB; ++ui;
        if (wr == 1) PG8_BAR;
    }
    PG8_WAIT_V(0);
    PG8_BAR;
#undef PG8_SA
#undef PG8_SB
#undef PG8_STAGE
#undef PG8_LDA
#undef PG8_LDB
#undef PG8_MMA
#undef PG8_WAIT_V
#undef PG8_WAIT_L
#undef PG8_BAR
#undef PG8_SCHED
#undef PG8_LOADROWS
}

struct EpiP1 {
    static constexpr bool PERM = true;
    bf16_t* O;
    __device__ __forceinline__ void operator()(const f32x4 (&acc)[2][2][4][2], const Unit& u, int wr, int wc, int fr, int fq) const {
        const int row0 = u.pm * BM + wr * 64 + fr, col0 = u.pn * BM + wc * 32 + 8 * fq; const bool act = u.pn < 4;
#pragma unroll
        for (int ai = 0; ai < 2; ++ai)
#pragma unroll
            for (int m = 0; m < 4; ++m) { bf16_t* rowp = O + (size_t)(row0 + ai * HALF + m * 16) * INC + col0;
#pragma unroll
                for (int bj = 0; bj < 2; ++bj) { f32x4 v0 = acc[ai][bj][m][0], v1 = acc[ai][bj][m][1];
                    if (act) {
#pragma unroll
                        for (int j = 0; j < 4; ++j) { v0[j] = gelu_tanh(v0[j]); v1[j] = gelu_tanh(v1[j]); } }
                    u32x4 w; w.x = cvt_pk_bf16(v0[0], v0[1]); w.y = cvt_pk_bf16(v0[2], v0[3]); w.z = cvt_pk_bf16(v1[0], v1[1]); w.w = cvt_pk_bf16(v1[2], v1[3]);
                    *(u32x4*)(rowp + bj * HALF) = w; } }
    }
};
struct EpiZ {
    static constexpr bool PERM = false;
    const float* X; float* Z;
    __device__ __forceinline__ void operator()(const f32x4 (&acc)[2][2][4][2], const Unit& u, int wr, int wc, int fr, int fq) const {
        const int col0 = u.pn * BM + wc * 32 + 4 * fq;
#pragma unroll
        for (int ai = 0; ai < 2; ++ai)
#pragma unroll
            for (int m = 0; m < 4; ++m) { const size_t off = (size_t)(u.pm * BM + ai * HALF + wr * 64 + m * 16 + fr) * D + col0;
#pragma unroll
                for (int bj = 0; bj < 2; ++bj)
#pragma unroll
                    for (int n = 0; n < 2; ++n) { const f32x4 xv = *(const f32x4*)(X + off + bj * HALF + n * 16); *(f32x4*)(Z + off + bj * HALF + n * 16) = xv * DN_ALPHA + acc[ai][bj][m][n]; } }
    }
};
struct EpiSwiglu {
    static constexpr bool PERM = true;
    act_t* Act; const float* bg; const float* bu;
    __device__ __forceinline__ void operator()(const f32x4 (&acc)[2][2][4][2], const Unit& u, int wr, int wc, int fr, int fq) const {
        const int f0 = u.pn * HALF + wc * 32 + 8 * fq; const int row0 = u.pm * BM + wr * 64 + fr;
        const f32x4 bg0 = *(const f32x4*)(bg + u.e * FF + f0), bg1 = *(const f32x4*)(bg + u.e * FF + f0 + 4);
        const f32x4 bu0 = *(const f32x4*)(bu + u.e * FF + f0), bu1 = *(const f32x4*)(bu + u.e * FF + f0 + 4);
#pragma unroll
        for (int ai = 0; ai < 2; ++ai)
#pragma unroll
            for (int m = 0; m < 4; ++m) {
                f32x4 g0 = acc[ai][0][m][0] * (1.0f / WGU_SCALE) + bg0, g1 = acc[ai][0][m][1] * (1.0f / WGU_SCALE) + bg1, u0 = acc[ai][1][m][0] * (1.0f / WGU_SCALE) + bu0, u1 = acc[ai][1][m][1] * (1.0f / WGU_SCALE) + bu1, r0, r1;
#pragma unroll
                for (int j = 0; j < 4; ++j) {
                    const float ga = fminf(g0[j], 7.0f), gb = fminf(g1[j], 7.0f);
                    const float ua = fminf(fmaxf(u0[j], -7.0f), 7.0f), ub = fminf(fmaxf(u1[j], -7.0f), 7.0f);
                    r0[j] = (ua + 1.0f) * ga * __builtin_amdgcn_rcpf(1.0f + __builtin_amdgcn_exp2f(-1.702f * 1.4426950408889634f * ga));
                    r1[j] = (ub + 1.0f) * gb * __builtin_amdgcn_rcpf(1.0f + __builtin_amdgcn_exp2f(-1.702f * 1.4426950408889634f * gb)); }
                if constexpr (G2_FP8) { u32x2 w; w.x = cvt4_fp8(r0[0], r0[1], r0[2], r0[3]); w.y = cvt4_fp8(r1[0], r1[1], r1[2], r1[3]); *(u32x2*)(Act + (size_t)(row0 + ai * HALF + m * 16) * FF + f0) = w; }
                else { u32x4 w; w.x = cvt_pk_bf16(r0[0], r0[1]); w.y = cvt_pk_bf16(r0[2], r0[3]); w.z = cvt_pk_bf16(r1[0], r1[1]); w.w = cvt_pk_bf16(r1[2], r1[3]); *(u32x4*)(Act + (size_t)(row0 + ai * HALF + m * 16) * FF + f0) = w; } }
    }
};
struct EpiScatter {
    static constexpr bool PERM = true;
    bf16_t* Y; const float* bd; const float* gates; const LAS int* rowtab;
    __device__ __forceinline__ void operator()(const f32x4 (&acc)[2][2][4][2], const Unit& u, int wr, int wc, int fr, int fq) const {
        const int c0 = u.pn * BM + wc * 32 + 8 * fq;
#pragma unroll
        for (int bj = 0; bj < 2; ++bj) { const f32x4 b0 = *(const f32x4*)(bd + u.e * D + c0 + bj * HALF), b1 = *(const f32x4*)(bd + u.e * D + c0 + bj * HALF + 4);
#pragma unroll
            for (int ai = 0; ai < 2; ++ai)
#pragma unroll
                for (int m = 0; m < 4; ++m) { const int slot = rowtab[u.ui * 256 + ai * HALF + wr * 64 + m * 16 + fr];
                    if (slot >= 0) { const float gt = gates[slot];
                        const f32x4 v0 = (acc[ai][bj][m][0] * (1.0f / WD_SCALE) + b0) * gt, v1 = (acc[ai][bj][m][1] * (1.0f / WD_SCALE) + b1) * gt;
                        u32x4 w; w.x = cvt_pk_bf16(v0[0], v0[1]); w.y = cvt_pk_bf16(v0[2], v0[3]); w.z = cvt_pk_bf16(v1[0], v1[1]); w.w = cvt_pk_bf16(v1[2], v1[3]);
                        *(u32x4*)(Y + (size_t)slot * D + c0 + bj * HALF) = w; } } }
    }
};
}


#define XB_TMO      128
#define XB_XCNT(j)  (256  + 64 * (j))
#define XB_XSUB(j)  (1280 + 64 * (j))
#define XB_XGEN(j)  (2304 + 64 * (j))
#define XB_TOP      3328
#define XB_TOPGEN   3392
#define XCD_BAR_WORDS 3456
#define XB_SPIN_CAP (1u << 22)
__device__ __forceinline__ unsigned xb_ld(unsigned* p)              { return __hip_atomic_load(p, __ATOMIC_RELAXED, __HIP_MEMORY_SCOPE_AGENT); }
__device__ __forceinline__ unsigned xb_add(unsigned* p, unsigned v) { return __hip_atomic_fetch_add(p, v, __ATOMIC_RELAXED, __HIP_MEMORY_SCOPE_AGENT); }
__device__ __forceinline__ unsigned xb_xcc_id() { return (unsigned)__builtin_amdgcn_s_getreg((3 << 11) | 20) & 0xFu; }
#define XB_SPIN(cond, bar) do { unsigned _sp = 0; while (cond) { __builtin_amdgcn_s_sleep(1); \
    if ((++_sp & 255u) == 0u) { if (xb_ld(&(bar)[XB_TMO])) break; if (_sp > XB_SPIN_CAP) { atomicAdd(&(bar)[XB_TMO], 1u); break; } } } } while (0)
struct XcdBarrier { unsigned* bar; unsigned x; volatile LAS unsigned* st; };
__device__ __forceinline__ XcdBarrier xcd_barrier_post(unsigned* bar, volatile LAS unsigned* st) {
    XcdBarrier b; b.bar = bar; b.x = xb_xcc_id(); b.st = st;
    if (threadIdx.x == 0) (void)xb_add(&bar[XB_XCNT(b.x)], 1u);
    return b;
}
__device__ __forceinline__ void xcd_barrier_complete(unsigned* bar, unsigned x, unsigned& nloc, unsigned& nx) {
    const unsigned G = gridDim.x * gridDim.y * gridDim.z;
    unsigned sum, cnt, mine, sp = 0u;
    for (;;) {
        sum = 0u; cnt = 0u; mine = 0u;
#pragma unroll
        for (unsigned j = 0; j < 16; ++j) { const unsigned c = xb_ld(&bar[XB_XCNT(j)]); sum += c; cnt += (c > 0u) ? 1u : 0u; mine = (j == x) ? c : mine; }
        if (sum == G) break;
        __builtin_amdgcn_s_sleep(1);
        if ((++sp & 255u) == 0u) { if (xb_ld(&bar[XB_TMO])) break; if (sp > XB_SPIN_CAP) { atomicAdd(&bar[XB_TMO], 1u); break; } }
    }
    nloc = mine > 0u ? mine : 1u; nx = cnt > 0u ? cnt : 1u;
}
__device__ __forceinline__ void xcd_barrier(const XcdBarrier& b) {
    asm volatile("s_waitcnt vmcnt(0)" ::: "memory");
    __syncthreads();
    if (threadIdx.x == 0) {
        unsigned* bar = b.bar;
        __builtin_amdgcn_s_waitcnt(0);
        unsigned nloc = b.st[0], nx = b.st[1];
        if (nloc == 0u) { xcd_barrier_complete(bar, b.x, nloc, nx); b.st[0] = nloc; b.st[1] = nx; }
        const unsigned old = xb_add(&bar[XB_XSUB(b.x)], 1u);
        const unsigned gen = old / nloc;
        if (old + 1u == (gen + 1u) * nloc) {
            __builtin_amdgcn_fence(__ATOMIC_RELEASE, "agent");
            asm volatile("s_waitcnt vmcnt(0)" ::: "memory");
            const unsigned og = xb_add(&bar[XB_TOP], 1u);
            const unsigned tg = og / nx;
            if (og + 1u == (tg + 1u) * nx) xb_add(&bar[XB_TOPGEN], 1u);
            else XB_SPIN(xb_ld(&bar[XB_TOPGEN]) == tg, bar);
            __builtin_amdgcn_fence(__ATOMIC_ACQUIRE, "agent");
            xb_add(&bar[XB_XGEN(b.x)], 1u);
            asm volatile("s_waitcnt vmcnt(0)" ::: "memory");
        } else {
            XB_SPIN(xb_ld(&bar[XB_XGEN(b.x)]) == gen, bar);
            __builtin_amdgcn_fence(__ATOMIC_ACQUIRE, "agent");
            asm volatile("s_waitcnt vmcnt(0)" ::: "memory");
        }
    }
    __syncthreads();
}

struct Args { const float* in[20]; float* out; unsigned char* ws; int ph_lo, ph_hi; };
struct Frame {
    LAS unsigned char* lds; int tid, lane, wave, G, vcu;
    const float *x, *w_in, *sgu_w, *sgu_b, *sgu_ln_g, *sgu_ln_b, *mix_g, *w_out, *ln1_g, *ln1_b, *w_router, *b_router, *w_gate, *b_gate, *w_up, *b_up, *w_down, *b_down, *ln2_g, *ln2_b;
    float* out; unsigned char* ws;
    unsigned* ctl; int* list; float* gates; bf16_t *Win_t, *Wout_t, *Y, *Xb, *P1, *Amix; act_t *Wd_t, *Act; fp8_t *Wgu_t, *Hb; bf16_t* Opart; float* ML; bf16_t* WrtHi;
};

__device__ __forceinline__ void transpose_item(const float* W, int N, int K, int k0, int n0, bf16_t* WT, size_t dst_row0, LAS float* scr, int lane) {
    { const int kr = lane >> 3, c4 = lane & 7; f32x4 v[8];
#pragma unroll
      for (int i = 0; i < 8; ++i) v[i] = *(const f32x4*)(W + (size_t)(k0 + 8 * i + kr) * N + n0 + 4 * c4);
#pragma unroll
      for (int i = 0; i < 8; ++i) { LAS float* d = scr + (8 * i + kr) * 33 + 4 * c4; d[0] = v[i][0]; d[1] = v[i][1]; d[2] = v[i][2]; d[3] = v[i][3]; } }
    asm volatile("s_waitcnt lgkmcnt(0)" ::: "memory");
    const int c = lane & 7;
#pragma unroll
    for (int j = 0; j < 4; ++j) { const int n = (lane >> 3) + 8 * j; const LAS float* s = scr + (8 * c) * 33 + n;
        u32x4 o; o.x = cvt_pk_bf16(s[0 * 33], s[1 * 33]); o.y = cvt_pk_bf16(s[2 * 33], s[3 * 33]); o.z = cvt_pk_bf16(s[4 * 33], s[5 * 33]); o.w = cvt_pk_bf16(s[6 * 33], s[7 * 33]);
        *(u32x4*)(WT + (dst_row0 + n) * K + k0 + 8 * c) = o; }
    asm volatile("s_waitcnt lgkmcnt(0)" ::: "memory");
}
__device__ __forceinline__ void transpose_item8(const float* W, int N, int K, int k0, int n0, fp8_t* WT, size_t dst_row0, float scale, LAS float* scr, int lane) {
    { const int kr = lane >> 3, c4 = lane & 7; f32x4 v[16];
#pragma unroll
      for (int i = 0; i < 16; ++i) v[i] = *(const f32x4*)(W + (size_t)(k0 + 8 * i + kr) * N + n0 + 4 * c4);
#pragma unroll
      for (int i = 0; i < 16; ++i) { LAS float* d = scr + (8 * i + kr) * 33 + 4 * c4; d[0] = v[i][0]; d[1] = v[i][1]; d[2] = v[i][2]; d[3] = v[i][3]; } }
    asm volatile("s_waitcnt lgkmcnt(0)" ::: "memory");
    const int c = lane & 7;
#pragma unroll
    for (int j = 0; j < 4; ++j) { const int n = (lane >> 3) + 8 * j; const LAS float* s = scr + (16 * c) * 33 + n;
        u32x4 o; o.x = cvt4_fp8(s[0 * 33] * scale, s[1 * 33] * scale, s[2 * 33] * scale, s[3 * 33] * scale); o.y = cvt4_fp8(s[4 * 33] * scale, s[5 * 33] * scale, s[6 * 33] * scale, s[7 * 33] * scale);
        o.z = cvt4_fp8(s[8 * 33] * scale, s[9 * 33] * scale, s[10 * 33] * scale, s[11 * 33] * scale); o.w = cvt4_fp8(s[12 * 33] * scale, s[13 * 33] * scale, s[14 * 33] * scale, s[15 * 33] * scale);
        *(u32x4*)(WT + (dst_row0 + n) * K + k0 + 16 * c) = o; }
    asm volatile("s_waitcnt lgkmcnt(0)" ::: "memory");
}
__device__ __forceinline__ void p0_convert(Frame& F) {
    LAS float* scr = (LAS float*)(F.lds + F.wave * 17408);
    const int gw = F.vcu * 8 + F.wave, NGW = F.G * 8;
    constexpr int I_IN = (D / 64) * (INC / 32), I_OUT = (D / 64) * (D / 32), I_E8 = (D / 128) * (FF / 32), I_EB = (FF / 64) * (D / 32);
    constexpr int I_ED = G2_FP8 ? I_E8 : I_EB, I_EXP = 2 * I_E8 + I_ED, NITEMS = I_IN + I_OUT + NE * I_EXP;
    for (int it = gw; it < NITEMS; it += NGW) {
        int r = it;
        if (r < I_IN) { const int kb = r / (INC / 32), nb = r % (INC / 32); transpose_item(F.w_in, INC, D, 64 * kb, 32 * nb, F.Win_t, (size_t)32 * nb, scr, F.lane); continue; } r -= I_IN;
        if (r < I_OUT) { const int kb = r / (D / 32), nb = r % (D / 32); transpose_item(F.w_out, D, D, 64 * kb, 32 * nb, F.Wout_t, (size_t)32 * nb, scr, F.lane); continue; } r -= I_OUT;
        const int e = r / I_EXP, q = r % I_EXP;
        if (q < 2 * I_E8) { const int which = q / I_E8, ii = q % I_E8, kb = ii / 32, n0 = 32 * (ii % 32);
            transpose_item8((which ? F.w_up : F.w_gate) + (size_t)e * D * FF, FF, D, 128 * kb, n0, F.Wgu_t, (size_t)e * 2048 + (n0 >> 7) * 256 + which * 128 + (n0 & 127), WGU_SCALE, scr, F.lane); }
        else { const int ii = q - 2 * I_E8, kb = ii / 32, n0 = 32 * (ii % 32);
            if constexpr (G2_FP8) transpose_item8(F.w_down + (size_t)e * FF * D, D, FF, 128 * kb, n0, (fp8_t*)F.Wd_t, (size_t)e * 1024 + n0, WD_SCALE, scr, F.lane);
            else transpose_item(F.w_down + (size_t)e * FF * D, D, FF, 64 * kb, n0, (bf16_t*)F.Wd_t, (size_t)e * 1024 + n0, scr, F.lane); }
    }
    for (int i2 = blockIdx.x * 512 + F.tid; i2 < D * NE; i2 += F.G * 512) { const int k = i2 >> 5, e = i2 & 31; const float wv = F.w_router[i2];
        const unsigned hi = cvt_pk_bf16(wv, 0.f) & 0xffffu; const unsigned lo = cvt_pk_bf16(wv - bf_lo(hi), 0.f) & 0xffffu;
        F.WrtHi[(size_t)e * D + k] = (bf16_t)hi; F.WrtHi[(size_t)(NE + e) * D + k] = (bf16_t)lo; }
    const size_t nchunk = (size_t)T * D / 8, cstride = (size_t)F.G * 512;
    for (size_t i = (size_t)blockIdx.x * 512 + F.tid; i < nchunk; i += 4 * cstride) {
        f32x4 a[4], b[4];
#pragma unroll
        for (int j = 0; j < 4; ++j) { const size_t ii = i + j * cstride; if (ii < nchunk) { a[j] = *(const f32x4*)(F.x + ii * 8); b[j] = *(const f32x4*)(F.x + ii * 8 + 4); } }
#pragma unroll
        for (int j = 0; j < 4; ++j) { const size_t ii = i + j * cstride; if (ii < nchunk) {
            u32x4 w; w.x = cvt_pk_bf16(a[j][0], a[j][1]); w.y = cvt_pk_bf16(a[j][2], a[j][3]); w.z = cvt_pk_bf16(b[j][0], b[j][1]); w.w = cvt_pk_bf16(b[j][2], b[j][3]);
            *(u32x4*)(F.Xb + ii * 8) = w; } } }
}

typedef float f32x16 __attribute__((ext_vector_type(16)));
typedef short s16x4 __attribute__((ext_vector_type(4)));
constexpr int SG_ROW = 272, SG_WAVE = 64 * SG_ROW, SG_SSQ_OFF = 8 * SG_WAVE;
static_assert(SG_SSQ_OFF + 8 * 128 * 4 <= LDS_BYTES, "SGU LDS");
__device__ __forceinline__ void sgu_unit(Frame& F, int u) {
    const int g = F.wave, lane = F.lane, i = lane & 31, hh = lane >> 5; const size_t row0 = (size_t)u * CHUNK;
    LAS unsigned char* vt = F.lds + g * SG_WAVE; LAS float* ssq = (LAS float*)(F.lds + SG_SSQ_OFF);
#pragma unroll 1
    for (int tt = 0; tt < 2; ++tt) { const int t = lane + 64 * tt; const bf16_t* vp = F.P1 + (row0 + t) * INC + AW + g * GD;
        float v[64];
#pragma unroll
        for (int c8 = 0; c8 < 8; ++c8) { const u32x4 r = *(const u32x4*)(vp + 8 * c8); const unsigned w[4] = {r.x, r.y, r.z, r.w};
#pragma unroll
            for (int j = 0; j < 4; ++j) { v[8 * c8 + 2 * j] = bf_lo(w[j]); v[8 * c8 + 2 * j + 1] = bf_hi(w[j]); } }
        float s = 0.f;
#pragma unroll
        for (int c = 0; c < 64; ++c) s += v[c];
        const float mu = s * (1.f / 64.f); float q = 0.f;
#pragma unroll
        for (int c = 0; c < 64; ++c) { v[c] -= mu; q += v[c] * v[c]; }
        const float rstd = 1.0f / sqrtf(q * (1.f / 64.f) + LN_EPS);
#pragma unroll
        for (int c = 0; c < 64; ++c) { const float val = v[c] * rstd * F.sgu_ln_g[g * GD + c] + F.sgu_ln_b[g * GD + c];
            *(LAS bf16_t*)(vt + c * SG_ROW + t * 2) = (bf16_t)(cvt_pk_bf16(val, 0.f) & 0xffffu); } }
    asm volatile("s_waitcnt lgkmcnt(0)" ::: "memory");
    f32x16 acc[2][4];
#pragma unroll
    for (int mt = 0; mt < 2; ++mt)
#pragma unroll
        for (int nt = 0; nt < 4; ++nt)
#pragma unroll
            for (int r = 0; r < 16; ++r) acc[mt][nt][r] = 0.f;
#pragma unroll
    for (int nt = 0; nt < 4; ++nt) { const int t = 32 * nt + i;
#pragma unroll
        for (int ks = 0; ks < 2 * nt + 2; ++ks) { const int s0 = 16 * ks + 8 * hh;
            const float* wp = F.sgu_w + ((size_t)g * CHUNK + t) * CHUNK + s0; const f32x4 w0 = *(const f32x4*)wp, w1 = *(const f32x4*)(wp + 4);
            float wv[8] = {w0[0], w0[1], w0[2], w0[3], w1[0], w1[1], w1[2], w1[3]};
#pragma unroll
            for (int j = 0; j < 8; ++j) wv[j] = (s0 + j <= t) ? wv[j] : 0.f;
            u32x4 bw; bw.x = cvt_pk_bf16(wv[0], wv[1]); bw.y = cvt_pk_bf16(wv[2], wv[3]); bw.z = cvt_pk_bf16(wv[4], wv[5]); bw.w = cvt_pk_bf16(wv[6], wv[7]);
            const bf16x8 bfrag = __builtin_bit_cast(bf16x8, bw);
#pragma unroll
            for (int mt = 0; mt < 2; ++mt) { const bf16x8 afrag = *(const LAS bf16x8*)(vt + (32 * mt + i) * SG_ROW + s0 * 2);
                acc[mt][nt] = __builtin_amdgcn_mfma_f32_32x32x16_bf16(afrag, bfrag, acc[mt][nt], 0, 0, 0); } } }
#pragma unroll
    for (int nt = 0; nt < 4; ++nt) { const int t = 32 * nt + i; const float bs = F.sgu_b[g * CHUNK + t]; float ss = 0.f;
        const bf16_t* up = F.P1 + (row0 + t) * INC + g * GD + 4 * hh;
#pragma unroll
        for (int mt = 0; mt < 2; ++mt)
#pragma unroll
            for (int g4 = 0; g4 < 4; ++g4) { const u32x2 uw = *(const u32x2*)(up + 32 * mt + 8 * g4);
                const float u0 = bf_lo(uw.x), u1 = bf_hi(uw.x), u2 = bf_lo(uw.y), u3 = bf_hi(uw.y);
                float a0 = u0 * (acc[mt][nt][4 * g4] + bs), a1 = u1 * (acc[mt][nt][4 * g4 + 1] + bs), a2 = u2 * (acc[mt][nt][4 * g4 + 2] + bs), a3 = u3 * (acc[mt][nt][4 * g4 + 3] + bs);
                acc[mt][nt][4 * g4] = a0; acc[mt][nt][4 * g4 + 1] = a1; acc[mt][nt][4 * g4 + 2] = a2; acc[mt][nt][4 * g4 + 3] = a3;
                ss += (a0 * a0 + a1 * a1) + (a2 * a2 + a3 * a3); }
        ss += __shfl_xor(ss, 32);
        if (hh == 0) ssq[g * CHUNK + t] = ss; }
    __syncthreads();
#pragma unroll
    for (int nt = 0; nt < 4; ++nt) { const int t = 32 * nt + i; float tot = 0.f;
#pragma unroll
        for (int gg = 0; gg < 8; ++gg) tot += ssq[gg * CHUNK + t];
        const float rs = 1.0f / sqrtf(tot * (1.f / AW) + LN_EPS);
        bf16_t* op = F.Amix + (row0 + t) * D + g * GD + 4 * hh;
#pragma unroll
        for (int mt = 0; mt < 2; ++mt)
#pragma unroll
            for (int g4 = 0; g4 < 4; ++g4) { const f32x4 mg = *(const f32x4*)(F.mix_g + g * GD + 32 * mt + 8 * g4 + 4 * hh);
                u32x2 w; w.x = cvt_pk_bf16(acc[mt][nt][4 * g4] * rs * mg[0], acc[mt][nt][4 * g4 + 1] * rs * mg[1]); w.y = cvt_pk_bf16(acc[mt][nt][4 * g4 + 2] * rs * mg[2], acc[mt][nt][4 * g4 + 3] * rs * mg[3]);
                *(u32x2*)(op + 32 * mt + 8 * g4) = w; } }
    __syncthreads();
}

constexpr int AT_KROW = 144, AT_VROW = 776, AT_V_OFF = 384 * AT_KROW;
static_assert(AT_V_OFF + 64 * AT_VROW <= RING_BYTES, "attention LDS");
__device__ __forceinline__ void attn_unit(Frame& F, int u) {
    const int bh = u / 48, rem = u % 48, p = rem >> 4, idx = rem & 15, b = bh >> 3, h = bh & 7;
    const int d = (p == 0) ? 1 : (p == 1) ? 4 : 16, r = (p == 0) ? 0 : (p == 1) ? (idx >> 2) : idx, blk = (p == 0) ? idx : (p == 1) ? (idx & 3) : 0;
    const int q0 = blk * 256; const int lane = F.lane, i = lane & 31, hh = lane >> 5, w = F.wave;
    const bf16_t* base = F.P1 + (size_t)b * SEQ * INC + h * HD;
    LAS unsigned char* kl = F.lds; LAS unsigned char* vl = F.lds + AT_V_OFF;
#pragma unroll
    for (int it = 0; it < 6; ++it) { const int ch = F.tid + 512 * it, key = ch >> 3, c = ch & 7, s = q0 - 128 + key;
        u32x4 kv = (u32x4){0u, 0u, 0u, 0u}, vv = (u32x4){0u, 0u, 0u, 0u};
        if (s >= 0) { const bf16_t* rp = base + (size_t)(s * d + r) * INC + c * 8; kv = *(const u32x4*)(rp + 1536); vv = *(const u32x4*)(rp + 2048); }
        *(LAS u32x4*)(kl + key * AT_KROW + c * 16) = kv;
        const unsigned vw[4] = {vv.x, vv.y, vv.z, vv.w};
#pragma unroll
        for (int j = 0; j < 4; ++j) { *(LAS bf16_t*)(vl + (8 * c + 2 * j) * AT_VROW + key * 2) = (bf16_t)(vw[j] & 0xffffu); *(LAS bf16_t*)(vl + (8 * c + 2 * j + 1) * AT_VROW + key * 2) = (bf16_t)(vw[j] >> 16); } }
    const int qs = q0 + 32 * w + i; const size_t qrow = (size_t)qs * d + r;
    bf16x8 qf[4];
#pragma unroll
    for (int ks = 0; ks < 4; ++ks) qf[ks] = *(const bf16x8*)(base + qrow * INC + 1024 + 16 * ks + 8 * hh);
    __syncthreads();
    f32x16 s[5];
#pragma unroll
    for (int kt = 0; kt < 5; ++kt) { f32x16 a;
#pragma unroll
        for (int rr = 0; rr < 16; ++rr) a[rr] = 0.f;
#pragma unroll
        for (int ks = 0; ks < 4; ++ks) { const bf16x8 kf = *(const LAS bf16x8*)(kl + (32 * w + 32 * kt + i) * AT_KROW + (16 * ks + 8 * hh) * 2);
            a = __builtin_amdgcn_mfma_f32_32x32x16_bf16(kf, qf[ks], a, 0, 0, 0); }
        s[kt] = a; }
    const float sc = 0.125f * 1.4426950408889634f; const int ksub0 = q0 + 32 * w - 128;
    float m = -INFINITY;
#pragma unroll
    for (int kt = 0; kt < 5; ++kt)
#pragma unroll
        for (int rr = 0; rr < 16; ++rr) { const int kk = (rr & 3) + 8 * (rr >> 2) + 4 * hh; bool ok = (ksub0 + 32 * kt + kk) >= 0;
            if (kt == 0) ok = ok && (kk >= i);
            if (kt == 4) ok = ok && (kk <= i);
            const float v = ok ? s[kt][rr] * sc : -INFINITY; s[kt][rr] = v; m = fmaxf(m, v); }
    m = fmaxf(m, __shfl_xor(m, 32));
    float lsum = 0.f;
#pragma unroll
    for (int kt = 0; kt < 5; ++kt)
#pragma unroll
        for (int rr = 0; rr < 16; ++rr) { const float pv = __builtin_amdgcn_exp2f(s[kt][rr] - m); s[kt][rr] = pv; lsum += pv; }
    lsum += __shfl_xor(lsum, 32);
    f32x16 o[2];
#pragma unroll
    for (int dt = 0; dt < 2; ++dt)
#pragma unroll
        for (int rr = 0; rr < 16; ++rr) o[dt][rr] = 0.f;
#pragma unroll
    for (int kt = 0; kt < 5; ++kt)
#pragma unroll
        for (int s2 = 0; s2 < 2; ++s2) { u32x4 pw; pw.x = cvt_pk_bf16(s[kt][8 * s2], s[kt][8 * s2 + 1]); pw.y = cvt_pk_bf16(s[kt][8 * s2 + 2], s[kt][8 * s2 + 3]);
            pw.z = cvt_pk_bf16(s[kt][8 * s2 + 4], s[kt][8 * s2 + 5]); pw.w = cvt_pk_bf16(s[kt][8 * s2 + 6], s[kt][8 * s2 + 7]);
            const bf16x8 pb = __builtin_bit_cast(bf16x8, pw);
#pragma unroll
            for (int dt = 0; dt < 2; ++dt) { const LAS unsigned char* ap = vl + (32 * dt + i) * AT_VROW + (32 * w + 32 * kt + 16 * s2 + 4 * hh) * 2;
                const s16x4 lo = *(const LAS s16x4*)ap, hi = *(const LAS s16x4*)(ap + 16);
                const bf16x8 af = __builtin_shufflevector(lo, hi, 0, 1, 2, 3, 4, 5, 6, 7);
                o[dt] = __builtin_amdgcn_mfma_f32_32x32x16_bf16(af, pb, o[dt], 0, 0, 0); } }
    const float inv = 1.0f / lsum; const size_t orow = (size_t)b * SEQ + qrow;
    bf16_t* op = F.Opart + ((size_t)p * T + orow) * AW + h * HD + 4 * hh;
#pragma unroll
    for (int dt = 0; dt < 2; ++dt)
#pragma unroll
        for (int g4 = 0; g4 < 4; ++g4) { u32x2 wv; wv.x = cvt_pk_bf16(o[dt][4 * g4] * inv, o[dt][4 * g4 + 1] * inv); wv.y = cvt_pk_bf16(o[dt][4 * g4 + 2] * inv, o[dt][4 * g4 + 3] * inv);
            *(u32x2*)(op + 32 * dt + 8 * g4) = wv; }
    if (hh == 0) *(f32x2*)(F.ML + (((size_t)p * T + orow) * NH + h) * 2) = (f32x2){m, lsum};
    __syncthreads();
}
__device__ __forceinline__ void p2_mixers(Frame& F) {
    constexpr int NSGU = BATCH * (SEQ / CHUNK), NATT = BATCH * NH * 48;
    for (int u = blockIdx.x; u < NSGU + NATT; u += F.G) { if (u < NSGU) sgu_unit(F, u); else attn_unit(F, u - NSGU); }
}

__device__ __forceinline__ void p3_merge(Frame& F) {
    const int gw = blockIdx.x * 8 + F.wave, NGW = F.G * 8, h = F.lane >> 3;
    for (int row = gw; row < T; row += NGW) {
        f32x2 ml[3]; float mx = -INFINITY;
#pragma unroll
        for (int p = 0; p < 3; ++p) { ml[p] = *(const f32x2*)(F.ML + (((size_t)p * T + row) * NH + h) * 2); mx = fmaxf(mx, ml[p].x); }
        float wt[3], wsum = 0.f;
#pragma unroll
        for (int p = 0; p < 3; ++p) { wt[p] = ml[p].y * __builtin_amdgcn_exp2f(ml[p].x - mx); wsum += wt[p]; }
        const float iw = 1.0f / wsum; float bv[8];
#pragma unroll
        for (int j = 0; j < 8; ++j) bv[j] = 0.f;
#pragma unroll
        for (int p = 0; p < 3; ++p) { const u32x4 r = *(const u32x4*)(F.Opart + ((size_t)p * T + row) * AW + F.lane * 8); const unsigned w[4] = {r.x, r.y, r.z, r.w}; const float f = wt[p] * iw;
#pragma unroll
            for (int j = 0; j < 4; ++j) { bv[2 * j] += f * bf_lo(w[j]); bv[2 * j + 1] += f * bf_hi(w[j]); } }
        float ss = 0.f;
#pragma unroll
        for (int j = 0; j < 8; ++j) ss += bv[j] * bv[j];
        ss = wave_sum(ss); const float rs = 1.0f / sqrtf(ss * (1.f / AW) + LN_EPS);
        const f32x4 g0 = *(const f32x4*)(F.mix_g + AW + F.lane * 8), g1 = *(const f32x4*)(F.mix_g + AW + F.lane * 8 + 4);
        u32x4 w; w.x = cvt_pk_bf16(bv[0] * rs * g0[0], bv[1] * rs * g0[1]); w.y = cvt_pk_bf16(bv[2] * rs * g0[2], bv[3] * rs * g0[3]);
        w.z = cvt_pk_bf16(bv[4] * rs * g1[0], bv[5] * rs * g1[1]); w.w = cvt_pk_bf16(bv[6] * rs * g1[2], bv[7] * rs * g1[3]);
        *(u32x4*)(F.Amix + (size_t)row * D + AW + F.lane * 8) = w;
    }
}

constexpr int RT_ROW = 2064, RT_IMG = 32 * RT_ROW, RT_LGT_OFF = 2 * RT_IMG, RT_SEL_OFF = RT_LGT_OFF + 32 * 33 * 4;
static_assert(RT_SEL_OFF + 2048 + 256 <= MISC_OFF && 8 * 32 * 32 * 4 <= RT_IMG, "route LDS");
__device__ __forceinline__ void p4_route(Frame& F) {
    const int lane = F.lane, w = F.wave;
    LAS unsigned char* img = F.lds; LAS float* part = (LAS float*)F.lds; LAS float* lgt = (LAS float*)(F.lds + RT_LGT_OFF);
    LAS int* sel_e = (LAS int*)(F.lds + RT_SEL_OFF); LAS float* sel_g = (LAS float*)(F.lds + RT_SEL_OFF + 1024);
    LAS int* lcnt = (LAS int*)(F.lds + RT_SEL_OFF + 2048); LAS int* lbase = lcnt + 32;
    if (F.tid < 32) lcnt[F.tid] = 0;
    f32x4 gg[4], bb[4];
#pragma unroll
    for (int j = 0; j < 4; ++j) { gg[j] = *(const f32x4*)(F.ln1_g + 4 * lane + 256 * j); bb[j] = *(const f32x4*)(F.ln1_b + 4 * lane + 256 * j); }
    bf16x8 bh[4][2], bl[4][2];
#pragma unroll
    for (int ks = 0; ks < 4; ++ks)
#pragma unroll
        for (int nt = 0; nt < 2; ++nt) { const bf16_t* bp = F.WrtHi + (size_t)(16 * nt + (lane & 15)) * D + 128 * w + 32 * ks + 8 * (lane >> 4);
            bh[ks][nt] = *(const bf16x8*)bp; bl[ks][nt] = *(const bf16x8*)(bp + (size_t)NE * D); }
    __syncthreads();
    for (int chunk = blockIdx.x; chunk < T / 64; chunk += F.G) {
#pragma unroll 1
        for (int half = 0; half < 2; ++half) {
            const int row0 = chunk * 64 + half * 32 + w * 4;
            f32x4 v[4][4]; float s[4], q[4];
#pragma unroll
            for (int tk = 0; tk < 4; ++tk) { s[tk] = 0.f;
#pragma unroll
                for (int j = 0; j < 4; ++j) { v[tk][j] = *(const f32x4*)(F.out + (size_t)(row0 + tk) * D + 4 * lane + 256 * j); s[tk] += (v[tk][j][0] + v[tk][j][1]) + (v[tk][j][2] + v[tk][j][3]); } }
#pragma unroll
            for (int o = 1; o < 64; o <<= 1) {
#pragma unroll
                for (int tk = 0; tk < 4; ++tk) s[tk] += __shfl_xor(s[tk], o); }
#pragma unroll
            for (int tk = 0; tk < 4; ++tk) { const float mu = s[tk] * (1.f / D); q[tk] = 0.f;
#pragma unroll
                for (int j = 0; j < 4; ++j) { v[tk][j] = v[tk][j] - mu; q[tk] += (v[tk][j][0] * v[tk][j][0] + v[tk][j][1] * v[tk][j][1]) + (v[tk][j][2] * v[tk][j][2] + v[tk][j][3] * v[tk][j][3]); } }
#pragma unroll
            for (int o = 1; o < 64; o <<= 1) {
#pragma unroll
                for (int tk = 0; tk < 4; ++tk) q[tk] += __shfl_xor(q[tk], o); }
#pragma unroll
            for (int tk = 0; tk < 4; ++tk) { const float rstd = 1.0f / sqrtf(q[tk] * (1.f / D) + LN_EPS);
#pragma unroll
                for (int j = 0; j < 4; ++j) { const f32x4 h = v[tk][j] * rstd * gg[j] + bb[j]; const size_t off = (size_t)(row0 + tk) * D + 4 * lane + 256 * j;
                    *(f32x4*)(F.out + off) = h;
                    *(unsigned*)(F.Hb + off) = cvt4_fp8(h[0], h[1], h[2], h[3]);
                    u32x2 hi; hi.x = cvt_pk_bf16(h[0], h[1]); hi.y = cvt_pk_bf16(h[2], h[3]);
                    u32x2 lo; lo.x = cvt_pk_bf16(h[0] - bf_lo(hi.x), h[1] - bf_hi(hi.x)); lo.y = cvt_pk_bf16(h[2] - bf_lo(hi.y), h[3] - bf_hi(hi.y));
                    LAS unsigned char* dp = img + (w * 4 + tk) * RT_ROW + (4 * lane + 256 * j) * 2;
                    *(LAS u32x2*)dp = hi; *(LAS u32x2*)(dp + RT_IMG) = lo; } }
            __syncthreads();
            f32x4 acc[2][2];
#pragma unroll
            for (int mt = 0; mt < 2; ++mt)
#pragma unroll
                for (int nt = 0; nt < 2; ++nt) acc[mt][nt] = (f32x4){0.f, 0.f, 0.f, 0.f};
#pragma unroll
            for (int mt = 0; mt < 2; ++mt) { const LAS unsigned char* ap = img + (16 * mt + (lane & 15)) * RT_ROW + (128 * w + 8 * (lane >> 4)) * 2;
#pragma unroll
                for (int ks = 0; ks < 4; ++ks) { const bf16x8 ah = *(const LAS bf16x8*)(ap + ks * 64), al = *(const LAS bf16x8*)(ap + RT_IMG + ks * 64);
#pragma unroll
                    for (int nt = 0; nt < 2; ++nt) {
                        acc[mt][nt] = __builtin_amdgcn_mfma_f32_16x16x32_bf16(ah, bh[ks][nt], acc[mt][nt], 0, 0, 0);
                        acc[mt][nt] = __builtin_amdgcn_mfma_f32_16x16x32_bf16(ah, bl[ks][nt], acc[mt][nt], 0, 0, 0);
                        acc[mt][nt] = __builtin_amdgcn_mfma_f32_16x16x32_bf16(al, bh[ks][nt], acc[mt][nt], 0, 0, 0); } } }
            __syncthreads();
#pragma unroll
            for (int mt = 0; mt < 2; ++mt)
#pragma unroll
                for (int nt = 0; nt < 2; ++nt)
#pragma unroll
                    for (int r = 0; r < 4; ++r) part[(w * 32 + 16 * mt + 4 * (lane >> 4) + r) * 32 + 16 * nt + (lane & 15)] = acc[mt][nt][r];
            __syncthreads();
#pragma unroll
            for (int qq = 0; qq < 2; ++qq) { const int p = F.tid + 512 * qq, tok = p >> 5, e = p & 31; float sum = F.b_router[e];
#pragma unroll
                for (int ww = 0; ww < 8; ++ww) sum += part[(ww * 32 + tok) * 32 + e];
                lgt[tok * 33 + e] = sum; }
            __syncthreads();
            if (F.tid < 32) {
                float lg[32];
#pragma unroll
                for (int e = 0; e < 32; ++e) lg[e] = lgt[F.tid * 33 + e];
                int idx[4]; float val[4]; unsigned taken = 0u;
#pragma unroll
                for (int r = 0; r < 4; ++r) { float best = -INFINITY; int bi = 0;
#pragma unroll
                    for (int e = 0; e < 32; ++e) { const bool ok = !((taken >> e) & 1u) && (lg[e] > best); best = ok ? lg[e] : best; bi = ok ? e : bi; }
                    idx[r] = bi; val[r] = best; taken |= 1u << bi; }
                const float e1 = __expf(val[1] - val[0]), e2 = __expf(val[2] - val[0]), e3 = __expf(val[3] - val[0]); const float inv = 1.0f / (1.0f + e1 + e2 + e3);
                const int tl = half * 32 + F.tid;
                sel_e[tl * 4 + 0] = idx[0]; sel_e[tl * 4 + 1] = idx[1]; sel_e[tl * 4 + 2] = idx[2]; sel_e[tl * 4 + 3] = idx[3];
                sel_g[tl * 4 + 0] = inv; sel_g[tl * 4 + 1] = e1 * inv; sel_g[tl * 4 + 2] = e2 * inv; sel_g[tl * 4 + 3] = e3 * inv; }
            __syncthreads();
        }
        int myrank = 0, mye = 0;
        if (F.tid < 256) { mye = sel_e[F.tid]; myrank = atomicAdd((int*)&lcnt[mye], 1); }
        __syncthreads();
        if (F.tid < 32) { const int c = lcnt[F.tid]; lbase[F.tid] = c ? (int)__hip_atomic_fetch_add(F.ctl + CW_CNT + F.tid, (unsigned)c, __ATOMIC_RELAXED, __HIP_MEMORY_SCOPE_AGENT) : 0; lcnt[F.tid] = 0; }
        __syncthreads();
        if (F.tid < 256) { const int slot = (chunk * 64 + (F.tid >> 2)) * 4 + (F.tid & 3); F.list[mye * T + lbase[mye] + myrank] = slot; F.gates[slot] = sel_g[F.tid]; }
        __syncthreads();
    }
}

template <bool G1> __device__ __forceinline__ int moe_tables(Frame& F, int NPN) {
    LAS int* cnt = (LAS int*)(F.lds + TAB_OFF); LAS int* tstart = cnt + 32; LAS int* rowtab = (LAS int*)(F.lds + ROWTAB_OFF);
    if (F.tid < 32) cnt[F.tid] = (int)__hip_atomic_load(F.ctl + CW_CNT + F.tid, __ATOMIC_RELAXED, __HIP_MEMORY_SCOPE_AGENT);
    __syncthreads();
    if (F.tid == 0) { int acc = 0; for (int e = 0; e < NE; ++e) { tstart[e] = acc; acc += (cnt[e] + 255) >> 8; } tstart[NE] = acc; }
    __syncthreads();
    const int ntiles = tstart[NE], nU = ntiles * NPN;
    for (int i = 0; i < MAXU; ++i) { const int L = i * F.G + F.vcu; if (L >= nU) break;
        const int tl = L / NPN; int e = 0;
        for (int j = 1; j < NE; ++j) e += (tstart[j] <= tl) ? 1 : 0;
        const int mt = tl - tstart[e];
        if (F.tid < 256) { const int rank = mt * 256 + F.tid; const int slot = rank < cnt[e] ? F.list[e * T + rank] : -1;
            rowtab[i * 256 + F.tid] = G1 ? ((slot < 0 ? 0 : (slot >> 2)) * D) : slot; } }
    __syncthreads();
    return ntiles;
}

__device__ __forceinline__ void p7_final(Frame& F) {
    const int gw = blockIdx.x * 8 + F.wave, NGW = F.G * 8;
    for (int row = gw; row < T; row += NGW) {
        float* hp = F.out + (size_t)row * D; float v[16];
#pragma unroll
        for (int j = 0; j < 2; ++j) { const f32x4 a = *(const f32x4*)(hp + 512 * j + F.lane * 8), b = *(const f32x4*)(hp + 512 * j + F.lane * 8 + 4);
#pragma unroll
            for (int i = 0; i < 4; ++i) { v[8 * j + i] = a[i] * DN_ALPHA; v[8 * j + 4 + i] = b[i] * DN_ALPHA; } }
#pragma unroll
        for (int k = 0; k < TOPK; ++k)
#pragma unroll
            for (int j = 0; j < 2; ++j) { const u32x4 r = *(const u32x4*)(F.Y + ((size_t)row * TOPK + k) * D + 512 * j + F.lane * 8); const unsigned w[4] = {r.x, r.y, r.z, r.w};
#pragma unroll
                for (int i = 0; i < 4; ++i) { v[8 * j + 2 * i] += bf_lo(w[i]); v[8 * j + 2 * i + 1] += bf_hi(w[i]); } }
        float s = 0.f;
#pragma unroll
        for (int i = 0; i < 16; ++i) s += v[i];
        const float mu = wave_sum(s) * (1.f / D); float q = 0.f;
#pragma unroll
        for (int i = 0; i < 16; ++i) { v[i] -= mu; q += v[i] * v[i]; }
        const float rstd = 1.0f / sqrtf(wave_sum(q) * (1.f / D) + LN_EPS);
#pragma unroll
        for (int j = 0; j < 2; ++j) { const int c = 512 * j + F.lane * 8;
            const f32x4 g0 = *(const f32x4*)(F.ln2_g + c), g1 = *(const f32x4*)(F.ln2_g + c + 4), b0 = *(const f32x4*)(F.ln2_b + c), b1 = *(const f32x4*)(F.ln2_b + c + 4);
            f32x4 o0, o1;
#pragma unroll
            for (int i = 0; i < 4; ++i) { o0[i] = v[8 * j + i] * rstd * g0[i] + b0[i]; o1[i] = v[8 * j + 4 + i] * rstd * g1[i] + b1[i]; }
            *(f32x4*)(hp + c) = o0; *(f32x4*)(hp + c + 4) = o1; }
    }
}

constexpr int N_PHASES = 8;
__global__ void __launch_bounds__(512, 2) mk_fwd(Args args) {
    extern __shared__ __attribute__((aligned(16))) unsigned char lds_raw[];
    Frame F;
    F.lds = (LAS unsigned char*)lds_raw; F.tid = threadIdx.x; F.lane = F.tid & 63; F.wave = __builtin_amdgcn_readfirstlane(F.tid >> 6);
    F.G = gridDim.x; { const int bx = blockIdx.x; F.vcu = (F.G % 8 == 0) ? (bx % 8) * (F.G / 8) + bx / 8 : bx; }
    F.x = args.in[0]; F.w_in = args.in[1]; F.sgu_w = args.in[2]; F.sgu_b = args.in[3]; F.sgu_ln_g = args.in[4]; F.sgu_ln_b = args.in[5]; F.mix_g = args.in[6]; F.w_out = args.in[7];
    F.ln1_g = args.in[8]; F.ln1_b = args.in[9]; F.w_router = args.in[10]; F.b_router = args.in[11]; F.w_gate = args.in[12]; F.b_gate = args.in[13]; F.w_up = args.in[14]; F.b_up = args.in[15];
    F.w_down = args.in[16]; F.b_down = args.in[17]; F.ln2_g = args.in[18]; F.ln2_b = args.in[19]; F.out = args.out; F.ws = args.ws;
    unsigned char* ws = args.ws;
    F.ctl = (unsigned*)(ws + WS_CTL); F.list = (int*)(ws + WS_LIST); F.gates = (float*)(ws + WS_GATES);
    F.Win_t = (bf16_t*)(ws + WS_WIN); F.Wout_t = (bf16_t*)(ws + WS_WOUT); F.Wd_t = (act_t*)(ws + WS_WD); F.Wgu_t = (fp8_t*)(ws + WS_WGU); F.Y = (bf16_t*)(ws + WS_Y);
    F.Hb = (fp8_t*)(ws + WS_HB); F.Xb = (bf16_t*)(ws + WS_XB); F.P1 = (bf16_t*)(ws + WS_P1); F.Amix = (bf16_t*)(ws + WS_AMIX); F.Act = (act_t*)(ws + WS_ACT);
    F.WrtHi = (bf16_t*)(ws + WS_WRT); F.Opart = (bf16_t*)(ws + WS_OPART); F.ML = (float*)(ws + WS_ML);
    const int lo = args.ph_lo, hi = args.ph_hi;
    volatile LAS unsigned* misc = (volatile LAS unsigned*)(F.lds + MISC_OFF);
    if (F.tid < 16) misc[F.tid] = 0u;
    __syncthreads();
    XcdBarrier bar; bar.bar = F.ctl + CW_BAR; bar.x = 0; bar.st = misc;
    if (hi - lo > 1) bar = xcd_barrier_post(F.ctl + CW_BAR, misc);
    const LAS int* rowtab = (const LAS int*)(F.lds + ROWTAB_OFF);
#ifndef PROBE_DUP
#define PROBE_DUP -1
#endif
#define IN(k) (lo <= (k) && (k) < hi)
#define SEAM(k) do { if (IN(k) && IN((k) + 1)) { xcd_barrier(bar); } } while (0)
#define REP(k) for (int _rep = 0; _rep < ((PROBE_DUP == (k)) ? 2 : 1); ++_rep)
    if (IN(0)) REP(0) { p0_convert(F); }
    SEAM(0);
    if (IN(1)) REP(1) { pg8::Gemm g{F.Xb, F.Win_t, D * 2}; pg8::DenseOrder S{INC / 256, (T / 256) * (INC / 256), F.G, F.vcu}; pg8::EpiP1 E{F.P1};
        pg8::gemm_phase<pg8::EpiP1, pg8::DenseOrder, false, false>(F.lds, rowtab, g, S, E); }
    SEAM(1);
    if (IN(2)) REP(2) { p2_mixers(F); }
    SEAM(2);
    if (IN(3)) REP(3) { p3_merge(F); }
    SEAM(3);
    if (IN(4)) REP(4) { pg8::Gemm g{F.Amix, F.Wout_t, D * 2}; pg8::DenseOrder S{D / 256, (T / 256) * (D / 256), F.G, F.vcu}; pg8::EpiZ E{F.x, F.out};
        pg8::gemm_phase<pg8::EpiZ, pg8::DenseOrder, false, false>(F.lds, rowtab, g, S, E); }
    SEAM(4);
    if (IN(5)) { p4_route(F); }
    SEAM(5);
    if (IN(6)) REP(6) { const int ntiles = moe_tables<true>(F, 8); pg8::Gemm g{F.Hb, F.Wgu_t, D}; pg8::MoeOrder S{8, ntiles * 8, F.G, F.vcu, (const LAS int*)(F.lds + TAB_OFF) + 32};
        pg8::EpiSwiglu E{F.Act, F.b_gate, F.b_up};
        pg8::gemm_phase<pg8::EpiSwiglu, pg8::MoeOrder, true, true>(F.lds, rowtab, g, S, E); }
    SEAM(6);
    if (IN(7)) REP(7) { const int ntiles = moe_tables<false>(F, 4); pg8::Gemm g{F.Act, F.Wd_t, FF * (int)sizeof(act_t)}; pg8::MoeOrder S{4, ntiles * 4, F.G, F.vcu, (const LAS int*)(F.lds + TAB_OFF) + 32};
        pg8::EpiScatter E{F.Y, F.b_down, F.gates, rowtab};
        pg8::gemm_phase<pg8::EpiScatter, pg8::MoeOrder, false, (G2_FP8 != 0)>(F.lds, rowtab, g, S, E); }
    SEAM(7);
    if (IN(8)) { p7_final(F); }
#undef IN
#undef SEAM
}

extern "C" void kernel_launch(void* const* d_in, const int* in_sizes, int n_in, void* d_out, int out_size, void* d_ws, size_t ws_size, hipStream_t stream) {
    static int grid = 0;
    if (grid == 0) {
        if (n_in != 20 || in_sizes[0] != T * D || out_size != T * D || ws_size < WS_END) { fprintf(stderr, "kernel_launch: unexpected shapes (n_in %d, in0 %d, out %d, ws %zu)\n", n_in, n_in > 0 ? in_sizes[0] : -1, out_size, ws_size); grid = -1; return; }
        int dev = 0, cus = 0, per_cu = 0;
        hipGetDevice(&dev); hipDeviceGetAttribute(&cus, hipDeviceAttributeMultiprocessorCount, dev);
        if (hipFuncSetAttribute((const void*)mk_fwd, hipFuncAttributeMaxDynamicSharedMemorySize, LDS_BYTES) != hipSuccess) { fprintf(stderr, "kernel_launch: hipFuncSetAttribute failed\n"); grid = -1; return; }
        hipOccupancyMaxActiveBlocksPerMultiprocessor(&per_cu, (const void*)mk_fwd, 512, LDS_BYTES);
        (void)hipGetLastError();
        if (per_cu < 1) { fprintf(stderr, "kernel_launch: occupancy query says %d blocks/CU: the grid would not be resident; nothing launched\n", per_cu); grid = -1; return; }
        grid = cus;
        if (grid != 256) fprintf(stderr, "kernel_launch: note: %d CUs (tuned for 256)\n", grid);
    }
    if (grid < 0) return;
    hipMemsetAsync((char*)d_ws + WS_CTL, 0, CTL_ZERO_BYTES, stream);
    Args a{};
    for (int i = 0; i < 20; ++i) a.in[i] = (const float*)d_in[i];
    a.out = (float*)d_out; a.ws = (unsigned char*)d_ws;
#if MK_N_LAUNCHES == 1
    a.ph_lo = 0; a.ph_hi = N_PHASES + 1;
    hipLaunchKernelGGL(mk_fwd, dim3(grid), dim3(512), LDS_BYTES, stream, a);
#else
    for (int p = 0; p <= N_PHASES; ++p) { a.ph_lo = p; a.ph_hi = p + 1; hipLaunchKernelGGL(mk_fwd, dim3(grid), dim3(512), LDS_BYTES, stream, a); }
#endif
}
```

```cpp
#include <hip/hip_runtime.h>
#include <hip/hip_cooperative_groups.h>
#include <cstdio>
#include <cstdint>
namespace cg = cooperative_groups;

#ifndef MK_N_LAUNCHES
#define MK_N_LAUNCHES 1
#endif

constexpr int BATCH = 4, SEQ = 4096, T = BATCH * SEQ, D = 1024, INC = 2560, NE = 32, FF = 1024, TOPK = 4;
constexpr int AW = 512, NGRP = 8, GD = 64, CHUNK = 128, NH = 8, HD = 64;
constexpr float LN_EPS = 1e-5f, DN_ALPHA = 1.189207115002721f;
constexpr int NSLOT = T * TOPK;
constexpr int MAXTILES = 288;
constexpr int MAXU = 12;

constexpr size_t MiB = 1u << 20;
constexpr size_t WS_CTL = 0, CTL_ZERO_BYTES = 64 * 1024;
constexpr size_t WS_LIST = 1 * MiB;
constexpr size_t WS_GATES = 3 * MiB;
constexpr size_t WS_EINFO = 3 * MiB + 256 * 1024;
constexpr size_t WS_WRT = 3 * MiB + 512 * 1024;
constexpr size_t WS_WIN = 4 * MiB;
constexpr size_t WS_WOUT = 9 * MiB;
constexpr size_t WS_WD = 11 * MiB;
constexpr size_t WS_WGU = 75 * MiB;
constexpr size_t WS_HB = 139 * MiB;
constexpr size_t WS_BIG = 155 * MiB;
constexpr size_t WS_XB = WS_BIG;
constexpr size_t WS_P1 = WS_BIG + 32 * MiB;
constexpr size_t WS_AMIX = WS_BIG + 112 * MiB;
constexpr size_t WS_ACT = WS_BIG;
constexpr size_t WS_Y = 299 * MiB;
constexpr size_t WS_OPART = 427 * MiB;
constexpr size_t WS_ML = 475 * MiB;
constexpr size_t WS_END = 478 * MiB;
#ifndef G2_FP8
#define G2_FP8 1
#endif
constexpr float WGU_SCALE = 32.0f, WD_SCALE = G2_FP8 ? 64.0f : 1.0f;
#if G2_FP8
typedef unsigned char act_t;
#else
typedef unsigned short act_t;
#endif
constexpr int CW_BAR = 1024;
constexpr int CW_CNT = 0;

constexpr int RING_BYTES = 131072;
constexpr int TAB_OFF = RING_BYTES + 1024;
constexpr int ROWTAB_OFF = RING_BYTES + 2048;
constexpr int MISC_OFF = 147456 - 64;
constexpr int LDS_BYTES = 147456;
static_assert(ROWTAB_OFF + MAXU * 1024 <= LDS_BYTES, "LDS map");

#define LAS __attribute__((address_space(3)))
typedef unsigned short bf16_t;
typedef unsigned char fp8_t;
typedef short bf16x8 __attribute__((ext_vector_type(8)));
typedef float f32x4 __attribute__((ext_vector_type(4)));
typedef float f32x2 __attribute__((ext_vector_type(2)));
typedef unsigned u32x4 __attribute__((ext_vector_type(4)));
typedef unsigned u32x2 __attribute__((ext_vector_type(2)));
typedef int v8i32 __attribute__((ext_vector_type(8)));
typedef int v4i32 __attribute__((ext_vector_type(4)));


__device__ __forceinline__ unsigned cvt_pk_bf16(float lo, float hi) { unsigned r; asm volatile("v_cvt_pk_bf16_f32 %0, %1, %2" : "=v"(r) : "v"(lo), "v"(hi)); return r; }
__device__ __forceinline__ unsigned cvt4_fp8(float a, float b, float c, float d) { int w = 0; w = __builtin_amdgcn_cvt_pk_fp8_f32(a, b, w, false); w = __builtin_amdgcn_cvt_pk_fp8_f32(c, d, w, true); return (unsigned)w; }
__device__ __forceinline__ float bf_lo(unsigned w) { return __uint_as_float(w << 16); }
__device__ __forceinline__ float bf_hi(unsigned w) { return __uint_as_float(w & 0xffff0000u); }
__device__ __forceinline__ float bf1(bf16_t b) { return __uint_as_float((unsigned)b << 16); }
__device__ __forceinline__ float wave_sum(float v) {
#pragma unroll
    for (int o = 1; o < 64; o <<= 1) v += __shfl_xor(v, o);
    return v;
}
__device__ __forceinline__ float gelu_tanh(float x) {
    const float y2 = x * (1.5957691216057308f + 0.07135481627260025f * x * x);
    return x * __builtin_amdgcn_rcpf(1.0f + __builtin_amdgcn_exp2f(-1.4426950408889634f * y2));
}

namespace pg8 {
constexpr int BM = 256, BK = 64, HALF = 128, HTB = HALF * BK * 2, STAGE_BYTES = 8 * HTB;
__host__ __device__ __forceinline__ int lds_byte(int r, int c) { const int st = (r >> 4) * 2 + (c >> 5), rr = r & 15, cc = c & 31, ob = rr * 64 + cc * 2; return st * 1024 + (ob ^ (((ob >> 9) & 1) << 5)); }
__host__ __device__ __forceinline__ void stage_rc(int b, int& R, int& C) { const int st = b / 1024, sb = b % 1024, swz = sb ^ (((sb >> 9) & 1) << 5); R = (st >> 1) * 16 + swz / 64; C = (st & 1) * 32 + (swz % 64) / 2; }
__host__ __device__ __forceinline__ int perm32(int rho) { const int n = rho >> 4, i = rho & 15; return 8 * (i >> 2) + 4 * n + (i & 3); }

struct Unit { int pm, pn, pb, e, mt, ui; };
struct Gemm { const void* A; const void* Bt; int KB; };

struct DenseOrder {
    int nN, nU, G, v, i0, i1;
    __device__ __forceinline__ bool next(int i, Unit& u) const {
        i += i0; if (i >= i1) return false;
        const int L = i * G + v; if (L >= nU) return false;
        u.pm = L / nN; u.pn = L % nN; u.pb = u.pn; u.e = 0; u.mt = 0; u.ui = i; return true; }
};
struct MoeOrder {
    int NPN, nU, G, v; const LAS int* tstart;
    __device__ __forceinline__ bool next(int i, Unit& u) const {
        const int L = i * G + v; if (L >= nU) return false;
        const int tl = L / NPN, pn = L % NPN; int e = 0;
#pragma unroll
        for (int j = 1; j < NE; ++j) e += (tstart[j] <= tl) ? 1 : 0;
        e = __builtin_amdgcn_readfirstlane(e); const int ts = __builtin_amdgcn_readfirstlane(tstart[e]);
        u.pm = tl; u.pn = pn; u.pb = e * NPN + pn; u.e = e; u.mt = tl - ts; u.ui = i; return true; }
};

template <class Epi, class Sched, bool GATHER, bool FP8>
__device__ __forceinline__ void gemm_phase(LAS unsigned char* lds, const LAS int* rowtab, const Gemm g, const Sched& S, const Epi& E) {
    const int tid = threadIdx.x, wid = __builtin_amdgcn_readfirstlane(tid >> 6), lane = tid & 63, wr = wid >> 2, wc = wid & 3, fr = lane & 15, fq = lane >> 4;
    const int KB = g.KB, nt = KB / (BK * 2);
    unsigned voffA0[2], voffA1[2], voffB[2]; int Rr[2], Cc[2];
#pragma unroll
    for (int i = 0; i < 2; ++i) { int R, C; stage_rc(tid * 16 + i * 8192, R, C); const int Rb = Epi::PERM ? ((R & ~31) + perm32(R & 31)) : R; Rr[i] = R; Cc[i] = C;
        voffA0[i] = (unsigned)(R * KB + C * 2); voffA1[i] = (unsigned)((R + HALF) * KB + C * 2); voffB[i] = (unsigned)(Rb * KB + C * 2); }
    const unsigned kstep = (unsigned)(BK * 2);
    const unsigned hstep = (unsigned)HALF * (unsigned)KB;
    const unsigned tstep = 2u * hstep;
    const __amdgpu_buffer_rsrc_t rsA = __builtin_amdgcn_make_buffer_rsrc(const_cast<void*>(g.A), 0, -1, 0x00020000);
    const __amdgpu_buffer_rsrc_t rsB = __builtin_amdgcn_make_buffer_rsrc(const_cast<void*>(g.Bt), 0, -1, 0x00020000);
    const unsigned ldsw = (unsigned)wid * 1024u;
    const int aoff = lds_byte(wr * 64 + fr, fq * 8), boff = lds_byte(wc * 32 + fr, fq * 8);
#define PG8_SA(b, h) (((b) * 2 + (h)) * HTB)
#define PG8_SB(b, h) ((4 + (b) * 2 + (h)) * HTB)
#define PG8_STAGE(bufoff, rs, soff, voff) do { _Pragma("unroll") for (int _i = 0; _i < 2; ++_i) \
        __builtin_amdgcn_raw_ptr_buffer_load_lds(rs, (LAS void*)(lds + (bufoff) + ldsw + _i * 8192), 16, (int)(voff)[_i], (int)(soff), 0, 0); } while (0)
#define PG8_LDA(dst, b, h) do { if constexpr (FP8) { _Pragma("unroll") for (int m = 0; m < 4; ++m) dst##8[m] = __builtin_shufflevector(*(const LAS v4i32*)(lds + PG8_SA(b, h) + aoff + m * 2048), *(const LAS v4i32*)(lds + PG8_SA(b, h) + aoff + m * 2048 + 1024), 0, 1, 2, 3, 4, 5, 6, 7); } \
        else { _Pragma("unroll") for (int m = 0; m < 4; ++m) _Pragma("unroll") for (int k = 0; k < 2; ++k) dst[m][k] = *(const LAS bf16x8*)(lds + PG8_SA(b, h) + aoff + m * 2048 + k * 1024); } } while (0)
#define PG8_LDB(dst, b, h) do { if constexpr (FP8) { _Pragma("unroll") for (int n = 0; n < 2; ++n) dst##8[n] = __builtin_shufflevector(*(const LAS v4i32*)(lds + PG8_SB(b, h) + boff + n * 2048), *(const LAS v4i32*)(lds + PG8_SB(b, h) + boff + n * 2048 + 1024), 0, 1, 2, 3, 4, 5, 6, 7); } \
        else { _Pragma("unroll") for (int n = 0; n < 2; ++n) _Pragma("unroll") for (int k = 0; k < 2; ++k) dst[n][k] = *(const LAS bf16x8*)(lds + PG8_SB(b, h) + boff + n * 2048 + k * 1024); } } while (0)
#define PG8_MMA(ai, bj, At, Bt) do { __builtin_amdgcn_s_setprio(1); if constexpr (FP8) { _Pragma("unroll") for (int m = 0; m < 4; ++m) _Pragma("unroll") for (int n = 0; n < 2; ++n) \
        acc[ai][bj][m][n] = __builtin_amdgcn_mfma_scale_f32_16x16x128_f8f6f4(Bt##8[n], At##8[m], acc[ai][bj][m][n], 0, 0, 0, 0x7F7F7F7F, 0, 0x7F7F7F7F); } \
        else { _Pragma("unroll") for (int m = 0; m < 4; ++m) _Pragma("unroll") for (int n = 0; n < 2; ++n) _Pragma("unroll") for (int k = 0; k < 2; ++k) \
        acc[ai][bj][m][n] = __builtin_amdgcn_mfma_f32_16x16x32_bf16(Bt[n][k], At[m][k], acc[ai][bj][m][n], 0, 0, 0); } __builtin_amdgcn_s_setprio(0); } while (0)
#define PG8_WAIT_V(n) asm volatile("s_waitcnt vmcnt(" #n ")" ::: "memory")
#define PG8_WAIT_L(n) asm volatile("s_waitcnt lgkmcnt(" #n ")" ::: "memory")
#define PG8_BAR __builtin_amdgcn_s_barrier()
#define PG8_SCHED __builtin_amdgcn_sched_barrier(0)
#define PG8_LOADROWS(U) do { if constexpr (GATHER) { _Pragma("unroll") for (int _i = 0; _i < 2; ++_i) { \
        voffA0[_i] = (unsigned)rowtab[(U).ui * 256 + Rr[_i]] + (unsigned)Cc[_i] * 2u; voffA1[_i] = (unsigned)rowtab[(U).ui * 256 + HALF + Rr[_i]] + (unsigned)Cc[_i] * 2u; } } } while (0)
    Unit cur, nxt; int ui = 0;
    if (!S.next(0, cur)) return;
    f32x4 acc[2][2][4][2];
#pragma unroll
    for (int a = 0; a < 2; ++a)
#pragma unroll
        for (int b = 0; b < 2; ++b)
#pragma unroll
            for (int m = 0; m < 4; ++m)
#pragma unroll
                for (int n = 0; n < 2; ++n) acc[a][b][m][n] = (f32x4){0.f, 0.f, 0.f, 0.f};
    bf16x8 At[4][2], B0[2][2], B1[2][2]; v8i32 At8[4], B08[2], B18[2];
    unsigned cA = GATHER ? 0u : (unsigned)cur.pm * tstep, cB = (unsigned)cur.pb * tstep;
    PG8_LOADROWS(cur); PG8_WAIT_L(0);
    PG8_STAGE(PG8_SB(0, 0), rsB, cB, voffB); PG8_STAGE(PG8_SB(0, 1), rsB, cB + hstep, voffB); PG8_STAGE(PG8_SA(0, 0), rsA, cA, voffA0); PG8_STAGE(PG8_SA(0, 1), rsA, cA, voffA1);
    if (wr == 1) PG8_BAR;
    PG8_WAIT_V(2); PG8_BAR;
    PG8_STAGE(PG8_SB(1, 0), rsB, cB + kstep, voffB); PG8_STAGE(PG8_SA(1, 0), rsA, cA + kstep, voffA0); PG8_STAGE(PG8_SB(1, 1), rsB, cB + hstep + kstep, voffB);
    PG8_WAIT_V(6); PG8_BAR;
    for (;;) {
        const bool has_next = S.next(ui + 1, nxt);
        const unsigned nA = has_next ? (GATHER ? 0u : (unsigned)nxt.pm * tstep) : cA, nB = has_next ? (unsigned)nxt.pb * tstep : cB;
#pragma unroll 1
        for (int t = 0; t < nt; t += 2) {
            const bool last = (t == nt - 2);
            const unsigned a1 = cA + (unsigned)(t + 1) * kstep;
            const unsigned a2 = last ? nA : cA + (unsigned)(t + 2) * kstep, b2 = last ? nB : cB + (unsigned)(t + 2) * kstep;
            const unsigned a3 = a2 + kstep, b3 = b2 + kstep;
            PG8_LDB(B0, 0, 0); PG8_LDB(B1, 0, 1); PG8_SCHED; PG8_LDA(At, 0, 0); PG8_STAGE(PG8_SA(1, 1), rsA, a1, voffA1);
            if (last && has_next) PG8_LOADROWS(nxt);
            PG8_WAIT_V(8); PG8_WAIT_L(0); PG8_BAR; PG8_MMA(0, 0, At, B0); PG8_MMA(0, 1, At, B1); PG8_BAR; PG8_SCHED;
            PG8_LDA(At, 0, 1); PG8_STAGE(PG8_SB(0, 0), rsB, b2, voffB); PG8_STAGE(PG8_SB(0, 1), rsB, b2 + hstep, voffB); PG8_STAGE(PG8_SA(0, 0), rsA, a2, voffA0);
            PG8_WAIT_V(8); PG8_WAIT_L(0); PG8_BAR; PG8_MMA(1, 0, At, B0); PG8_MMA(1, 1, At, B1); PG8_BAR; PG8_SCHED;
            PG8_LDB(B0, 1, 0); PG8_LDB(B1, 1, 1); PG8_SCHED; PG8_LDA(At, 1, 0); PG8_STAGE(PG8_SA(0, 1), rsA, a2, voffA1);
            PG8_WAIT_V(8); PG8_WAIT_L(0); PG8_BAR; PG8_MMA(0, 0, At, B0); PG8_MMA(0, 1, At, B1); PG8_BAR; PG8_SCHED;
            PG8_LDA(At, 1, 1); PG8_STAGE(PG8_SB(1, 0), rsB, b3, voffB); PG8_STAGE(PG8_SB(1, 1), rsB, b3 + hstep, voffB); PG8_STAGE(PG8_SA(1, 0), rsA, a3, voffA0);
            PG8_WAIT_V(8); PG8_WAIT_L(0); PG8_BAR; PG8_MMA(1, 0, At, B0); PG8_MMA(1, 1, At, B1); PG8_BAR; PG8_SCHED;
        }
        if (wr == 0) PG8_BAR;
        { int t2 = threadIdx.x; asm volatile("" : "+v"(t2));
          const int w2 = __builtin_amdgcn_readfirstlane(t2 >> 6), l2 = t2 & 63; E(acc, cur, w2 >> 2, w2 & 3, l2 & 15, l2 >> 4); }
        if (!has_next) break;
#pragma unroll
        for (int a = 0; a < 2; ++a)
#pragma unroll
            for (int b = 0; b < 2; ++b)
#pragma unroll
                for (int m = 0; m < 4; ++m)
#pragma unroll
                    for (int n = 0; n < 2; ++n) acc[a][b][m][n] = (f32x4){0.f, 0.f, 0.f, 0.f};
        cur = nxt; cA = nA; cB = nB; ++ui;
        if (wr == 1) PG8_BAR;
    }
    PG8_WAIT_V(0);
    PG8_BAR;
#undef PG8_SA
#undef PG8_SB
#undef PG8_STAGE
#undef PG8_LDA
#undef PG8_LDB
#undef PG8_MMA
#undef PG8_WAIT_V
#undef PG8_WAIT_L
#undef PG8_BAR
#undef PG8_SCHED
#undef PG8_LOADROWS
}

struct EpiP1 {
    static constexpr bool PERM = true;
    bf16_t* O;
    __device__ __forceinline__ void operator()(const f32x4 (&acc)[2][2][4][2], const Unit& u, int wr, int wc, int fr, int fq) const {
        const int row0 = u.pm * BM + wr * 64 + fr, col0 = u.pn * BM + wc * 32 + 8 * fq; const bool act = u.pn < 4;
#pragma unroll
        for (int ai = 0; ai < 2; ++ai)
#pragma unroll
            for (int m = 0; m < 4; ++m) { bf16_t* rowp = O + (size_t)(row0 + ai * HALF + m * 16) * INC + col0;
#pragma unroll
                for (int bj = 0; bj < 2; ++bj) { f32x4 v0 = acc[ai][bj][m][0], v1 = acc[ai][bj][m][1];
                    if (act) {
#pragma unroll
                        for (int j = 0; j < 4; ++j) { v0[j] = gelu_tanh(v0[j]); v1[j] = gelu_tanh(v1[j]); } }
                    u32x4 w; w.x = cvt_pk_bf16(v0[0], v0[1]); w.y = cvt_pk_bf16(v0[2], v0[3]); w.z = cvt_pk_bf16(v1[0], v1[1]); w.w = cvt_pk_bf16(v1[2], v1[3]);
                    *(u32x4*)(rowp + bj * HALF) = w; } }
    }
};
struct EpiZ {
    static constexpr bool PERM = false;
    const float* X; float* Z;
    __device__ __forceinline__ void operator()(const f32x4 (&acc)[2][2][4][2], const Unit& u, int wr, int wc, int fr, int fq) const {
        const int col0 = u.pn * BM + wc * 32 + 4 * fq;
#pragma unroll
        for (int ai = 0; ai < 2; ++ai)
#pragma unroll
            for (int m = 0; m < 4; ++m) { const size_t off = (size_t)(u.pm * BM + ai * HALF + wr * 64 + m * 16 + fr) * D + col0;
#pragma unroll
                for (int bj = 0; bj < 2; ++bj)
#pragma unroll
                    for (int n = 0; n < 2; ++n) { const f32x4 xv = *(const f32x4*)(X + off + bj * HALF + n * 16); *(f32x4*)(Z + off + bj * HALF + n * 16) = xv * DN_ALPHA + acc[ai][bj][m][n]; } }
    }
};
struct EpiSwiglu {
    static constexpr bool PERM = true;
    act_t* Act; const float* bg; const float* bu;
    __device__ __forceinline__ void operator()(const f32x4 (&acc)[2][2][4][2], const Unit& u, int wr, int wc, int fr, int fq) const {
        const int f0 = u.pn * HALF + wc * 32 + 8 * fq; const int row0 = u.pm * BM + wr * 64 + fr;
        const f32x4 bg0 = *(const f32x4*)(bg + u.e * FF + f0), bg1 = *(const f32x4*)(bg + u.e * FF + f0 + 4);
        const f32x4 bu0 = *(const f32x4*)(bu + u.e * FF + f0), bu1 = *(const f32x4*)(bu + u.e * FF + f0 + 4);
#pragma unroll
        for (int ai = 0; ai < 2; ++ai)
#pragma unroll
            for (int m = 0; m < 4; ++m) {
                f32x4 g0 = acc[ai][0][m][0] * (1.0f / WGU_SCALE) + bg0, g1 = acc[ai][0][m][1] * (1.0f / WGU_SCALE) + bg1, u0 = acc[ai][1][m][0] * (1.0f / WGU_SCALE) + bu0, u1 = acc[ai][1][m][1] * (1.0f / WGU_SCALE) + bu1, r0, r1;
#pragma unroll
                for (int j = 0; j < 4; ++j) {
                    const float ga = fminf(g0[j], 7.0f), gb = fminf(g1[j], 7.0f);
                    const float ua = fminf(fmaxf(u0[j], -7.0f), 7.0f), ub = fminf(fmaxf(u1[j], -7.0f), 7.0f);
                    r0[j] = (ua + 1.0f) * ga * __builtin_amdgcn_rcpf(1.0f + __builtin_amdgcn_exp2f(-1.702f * 1.4426950408889634f * ga));
                    r1[j] = (ub + 1.0f) * gb * __builtin_amdgcn_rcpf(1.0f + __builtin_amdgcn_exp2f(-1.702f * 1.4426950408889634f * gb)); }
                if constexpr (G2_FP8) { u32x2 w; w.x = cvt4_fp8(r0[0], r0[1], r0[2], r0[3]); w.y = cvt4_fp8(r1[0], r1[1], r1[2], r1[3]); *(u32x2*)(Act + (size_t)(row0 + ai * HALF + m * 16) * FF + f0) = w; }
                else { u32x4 w; w.x = cvt_pk_bf16(r0[0], r0[1]); w.y = cvt_pk_bf16(r0[2], r0[3]); w.z = cvt_pk_bf16(r1[0], r1[1]); w.w = cvt_pk_bf16(r1[2], r1[3]); *(u32x4*)(Act + (size_t)(row0 + ai * HALF + m * 16) * FF + f0) = w; } }
    }
};
struct EpiY {
    static constexpr bool PERM = true;
    bf16_t* Y; const float* bd;
    __device__ __forceinline__ void operator()(const f32x4 (&acc)[2][2][4][2], const Unit& u, int wr, int wc, int fr, int fq) const {
        const int c0 = u.pn * BM + wc * 32 + 8 * fq; const int row0 = u.pm * BM + wr * 64 + fr;
        f32x4 b[2][2];
#pragma unroll
        for (int bj = 0; bj < 2; ++bj) { b[bj][0] = *(const f32x4*)(bd + u.e * D + c0 + bj * HALF); b[bj][1] = *(const f32x4*)(bd + u.e * D + c0 + bj * HALF + 4); }
#pragma unroll
        for (int ai = 0; ai < 2; ++ai)
#pragma unroll
            for (int m = 0; m < 4; ++m) { bf16_t* rowp = Y + (size_t)(row0 + ai * HALF + m * 16) * D + c0;
#pragma unroll
                for (int bj = 0; bj < 2; ++bj) { const f32x4 v0 = acc[ai][bj][m][0] * (1.0f / WD_SCALE) + b[bj][0], v1 = acc[ai][bj][m][1] * (1.0f / WD_SCALE) + b[bj][1];
                    u32x4 w; w.x = cvt_pk_bf16(v0[0], v0[1]); w.y = cvt_pk_bf16(v0[2], v0[3]); w.z = cvt_pk_bf16(v1[0], v1[1]); w.w = cvt_pk_bf16(v1[2], v1[3]);
                    *(u32x4*)(rowp + bj * HALF) = w; } }
    }
};
}


#define XB_TMO      128
#define XB_XCNT(j)  (256  + 64 * (j))
#define XB_XSUB(j)  (1280 + 64 * (j))
#define XB_XGEN(j)  (2304 + 64 * (j))
#define XB_TOP      3328
#define XB_TOPGEN   3392
#define XCD_BAR_WORDS 3456
#define XB_SPIN_CAP (1u << 22)
__device__ __forceinline__ unsigned xb_ld(unsigned* p)              { return __hip_atomic_load(p, __ATOMIC_RELAXED, __HIP_MEMORY_SCOPE_AGENT); }
__device__ __forceinline__ unsigned xb_add(unsigned* p, unsigned v) { return __hip_atomic_fetch_add(p, v, __ATOMIC_RELAXED, __HIP_MEMORY_SCOPE_AGENT); }
__device__ __forceinline__ unsigned xb_xcc_id() { return (unsigned)__builtin_amdgcn_s_getreg((3 << 11) | 20) & 0xFu; }
#define XB_SPIN(cond, bar) do { unsigned _sp = 0; while (cond) { __builtin_amdgcn_s_sleep(1); \
    if ((++_sp & 255u) == 0u) { if (xb_ld(&(bar)[XB_TMO])) break; if (_sp > XB_SPIN_CAP) { atomicAdd(&(bar)[XB_TMO], 1u); break; } } } } while (0)
struct XcdBarrier { unsigned* bar; unsigned x; volatile LAS unsigned* st; };
__device__ __forceinline__ XcdBarrier xcd_barrier_post(unsigned* bar, volatile LAS unsigned* st) {
    XcdBarrier b; b.bar = bar; b.x = xb_xcc_id(); b.st = st;
    if (threadIdx.x == 0) (void)xb_add(&bar[XB_XCNT(b.x)], 1u);
    return b;
}
__device__ __forceinline__ void xcd_barrier_complete(unsigned* bar, unsigned x, unsigned& nloc, unsigned& nx) {
    const unsigned G = gridDim.x * gridDim.y * gridDim.z;
    unsigned sum, cnt, mine, sp = 0u;
    for (;;) {
        sum = 0u; cnt = 0u; mine = 0u;
#pragma unroll
        for (unsigned j = 0; j < 16; ++j) { const unsigned c = xb_ld(&bar[XB_XCNT(j)]); sum += c; cnt += (c > 0u) ? 1u : 0u; mine = (j == x) ? c : mine; }
        if (sum == G) break;
        __builtin_amdgcn_s_sleep(1);
        if ((++sp & 255u) == 0u) { if (xb_ld(&bar[XB_TMO])) break; if (sp > XB_SPIN_CAP) { atomicAdd(&bar[XB_TMO], 1u); break; } }
    }
    nloc = mine > 0u ? mine : 1u; nx = cnt > 0u ? cnt : 1u;
}
__device__ __forceinline__ void xcd_barrier(const XcdBarrier& b) {
    asm volatile("s_waitcnt vmcnt(0)" ::: "memory");
    __syncthreads();
    if (threadIdx.x == 0) {
        unsigned* bar = b.bar;
        __builtin_amdgcn_s_waitcnt(0);
        unsigned nloc = b.st[0], nx = b.st[1];
        if (nloc == 0u) { xcd_barrier_complete(bar, b.x, nloc, nx); b.st[0] = nloc; b.st[1] = nx; }
        const unsigned old = xb_add(&bar[XB_XSUB(b.x)], 1u);
        const unsigned gen = old / nloc;
        if (old + 1u == (gen + 1u) * nloc) {
            __builtin_amdgcn_fence(__ATOMIC_RELEASE, "agent");
            asm volatile("s_waitcnt vmcnt(0)" ::: "memory");
            const unsigned og = xb_add(&bar[XB_TOP], 1u);
            const unsigned tg = og / nx;
            if (og + 1u == (tg + 1u) * nx) xb_add(&bar[XB_TOPGEN], 1u);
            else XB_SPIN(xb_ld(&bar[XB_TOPGEN]) == tg, bar);
            __builtin_amdgcn_fence(__ATOMIC_ACQUIRE, "agent");
            xb_add(&bar[XB_XGEN(b.x)], 1u);
            asm volatile("s_waitcnt vmcnt(0)" ::: "memory");
        } else {
            XB_SPIN(xb_ld(&bar[XB_XGEN(b.x)]) == gen, bar);
            __builtin_amdgcn_fence(__ATOMIC_ACQUIRE, "agent");
            asm volatile("s_waitcnt vmcnt(0)" ::: "memory");
        }
    }
    __syncthreads();
}

struct Args { const float* in[20]; float* out; unsigned char* ws; int ph_lo, ph_hi; };
struct Frame {
    LAS unsigned char* lds; int tid, lane, wave, G, vcu;
    const float *x, *w_in, *sgu_w, *sgu_b, *sgu_ln_g, *sgu_ln_b, *mix_g, *w_out, *ln1_g, *ln1_b, *w_router, *b_router, *w_gate, *b_gate, *w_up, *b_up, *w_down, *b_down, *ln2_g, *ln2_b;
    float* out; unsigned char* ws;
    unsigned* ctl; int* list; int* einfo; float* gates; bf16_t *Win_t, *Wout_t, *Y, *Xb, *P1, *Amix; act_t *Wd_t, *Act; fp8_t *Wgu_t, *Hb; bf16_t* Opart; float* ML; bf16_t* WrtHi;
};

__device__ __forceinline__ void transpose_item(const float* W, int N, int K, int k0, int n0, bf16_t* WT, size_t dst_row0, LAS float* scr, int lane) {
    { const int kr = lane >> 3, c4 = lane & 7; f32x4 v[8];
#pragma unroll
      for (int i = 0; i < 8; ++i) v[i] = *(const f32x4*)(W + (size_t)(k0 + 8 * i + kr) * N + n0 + 4 * c4);
#pragma unroll
      for (int i = 0; i < 8; ++i) { LAS float* d = scr + (8 * i + kr) * 33 + 4 * c4; d[0] = v[i][0]; d[1] = v[i][1]; d[2] = v[i][2]; d[3] = v[i][3]; } }
    asm volatile("s_waitcnt lgkmcnt(0)" ::: "memory");
    const int c = lane & 7;
#pragma unroll
    for (int j = 0; j < 4; ++j) { const int n = (lane >> 3) + 8 * j; const LAS float* s = scr + (8 * c) * 33 + n;
        u32x4 o; o.x = cvt_pk_bf16(s[0 * 33], s[1 * 33]); o.y = cvt_pk_bf16(s[2 * 33], s[3 * 33]); o.z = cvt_pk_bf16(s[4 * 33], s[5 * 33]); o.w = cvt_pk_bf16(s[6 * 33], s[7 * 33]);
        *(u32x4*)(WT + (dst_row0 + n) * K + k0 + 8 * c) = o; }
    asm volatile("s_waitcnt lgkmcnt(0)" ::: "memory");
}
__device__ __forceinline__ void transpose_item8(const float* W, int N, int K, int k0, int n0, fp8_t* WT, size_t dst_row0, float scale, LAS float* scr, int lane) {
    { const int kr = lane >> 3, c4 = lane & 7; f32x4 v[16];
#pragma unroll
      for (int i = 0; i < 16; ++i) v[i] = *(const f32x4*)(W + (size_t)(k0 + 8 * i + kr) * N + n0 + 4 * c4);
#pragma unroll
      for (int i = 0; i < 16; ++i) { LAS float* d = scr + (8 * i + kr) * 33 + 4 * c4; d[0] = v[i][0]; d[1] = v[i][1]; d[2] = v[i][2]; d[3] = v[i][3]; } }
    asm volatile("s_waitcnt lgkmcnt(0)" ::: "memory");
    const int c = lane & 7;
#pragma unroll
    for (int j = 0; j < 4; ++j) { const int n = (lane >> 3) + 8 * j; const LAS float* s = scr + (16 * c) * 33 + n;
        u32x4 o; o.x = cvt4_fp8(s[0 * 33] * scale, s[1 * 33] * scale, s[2 * 33] * scale, s[3 * 33] * scale); o.y = cvt4_fp8(s[4 * 33] * scale, s[5 * 33] * scale, s[6 * 33] * scale, s[7 * 33] * scale);
        o.z = cvt4_fp8(s[8 * 33] * scale, s[9 * 33] * scale, s[10 * 33] * scale, s[11 * 33] * scale); o.w = cvt4_fp8(s[12 * 33] * scale, s[13 * 33] * scale, s[14 * 33] * scale, s[15 * 33] * scale);
        *(u32x4*)(WT + (dst_row0 + n) * K + k0 + 16 * c) = o; }
    asm volatile("s_waitcnt lgkmcnt(0)" ::: "memory");
}
constexpr int MOE_ITEMS = NE * 3 * 8 * 32;
static_assert(G2_FP8, "the MoE item list below assumes fp8 copies of all three expert matrices");
__device__ __forceinline__ void moe_convert_items(Frame& F, int first, int count) {
    LAS float* scr = (LAS float*)(F.lds + F.wave * 17408);
    for (int it = first; it < first + count && it < MOE_ITEMS; ++it) {
        const int nb = it & 31, kb = (it >> 5) & 7, ew = it >> 8, e = ew / 3, which = ew - 3 * e, n0 = 32 * nb;
        if (which < 2) transpose_item8((which ? F.w_up : F.w_gate) + (size_t)e * D * FF, FF, D, 128 * kb, n0, F.Wgu_t, (size_t)e * 2048 + (n0 >> 7) * 256 + which * 128 + (n0 & 127), WGU_SCALE, scr, F.lane);
        else transpose_item8(F.w_down + (size_t)e * FF * D, D, FF, 128 * kb, n0, (fp8_t*)F.Wd_t, (size_t)e * 1024 + n0, WD_SCALE, scr, F.lane);
    }
}
__device__ __forceinline__ void p0_convert(Frame& F) {
    LAS float* scr = (LAS float*)(F.lds + F.wave * 17408);
    const int gw = F.vcu * 8 + F.wave, NGW = F.G * 8;
    constexpr int I_IN = (D / 64) * (INC / 32), I_OUT = (D / 64) * (D / 32);
    for (int it = gw; it < I_IN + I_OUT; it += NGW) {
        int r = it;
        if (r < I_IN) { const int kb = r / (INC / 32), nb = r % (INC / 32); transpose_item(F.w_in, INC, D, 64 * kb, 32 * nb, F.Win_t, (size_t)32 * nb, scr, F.lane); continue; } r -= I_IN;
        { const int kb = r / (D / 32), nb = r % (D / 32); transpose_item(F.w_out, D, D, 64 * kb, 32 * nb, F.Wout_t, (size_t)32 * nb, scr, F.lane); }
    }
    for (int i2 = blockIdx.x * 512 + F.tid; i2 < D * NE; i2 += F.G * 512) { const int k = i2 >> 5, e = i2 & 31; const float wv = F.w_router[i2];
        const unsigned hi = cvt_pk_bf16(wv, 0.f) & 0xffffu; const unsigned lo = cvt_pk_bf16(wv - bf_lo(hi), 0.f) & 0xffffu;
        F.WrtHi[(size_t)e * D + k] = (bf16_t)hi; F.WrtHi[(size_t)(NE + e) * D + k] = (bf16_t)lo; }
    const size_t nchunk = (size_t)T * D / 8, cstride = (size_t)F.G * 512;
    for (size_t i = (size_t)blockIdx.x * 512 + F.tid; i < nchunk; i += 4 * cstride) {
        f32x4 a[4], b[4];
#pragma unroll
        for (int j = 0; j < 4; ++j) { const size_t ii = i + j * cstride; if (ii < nchunk) { a[j] = *(const f32x4*)(F.x + ii * 8); b[j] = *(const f32x4*)(F.x + ii * 8 + 4); } }
#pragma unroll
        for (int j = 0; j < 4; ++j) { const size_t ii = i + j * cstride; if (ii < nchunk) {
            u32x4 w; w.x = cvt_pk_bf16(a[j][0], a[j][1]); w.y = cvt_pk_bf16(a[j][2], a[j][3]); w.z = cvt_pk_bf16(b[j][0], b[j][1]); w.w = cvt_pk_bf16(b[j][2], b[j][3]);
            *(u32x4*)(F.Xb + ii * 8) = w; } } }
}

typedef float f32x16 __attribute__((ext_vector_type(16)));
typedef short s16x4 __attribute__((ext_vector_type(4)));
constexpr int SG_ROW = 272, SG_WAVE = 64 * SG_ROW, SG_SSQ_OFF = 8 * SG_WAVE;
static_assert(SG_SSQ_OFF + 8 * 128 * 4 <= LDS_BYTES, "SGU LDS");
__device__ __forceinline__ void sgu_unit(Frame& F, int u) {
    const int g = F.wave, lane = F.lane, i = lane & 31, hh = lane >> 5; const size_t row0 = (size_t)u * CHUNK;
    LAS unsigned char* vt = F.lds + g * SG_WAVE; LAS float* ssq = (LAS float*)(F.lds + SG_SSQ_OFF);
#pragma unroll 1
    for (int tt = 0; tt < 2; ++tt) { const int t = lane + 64 * tt; const bf16_t* vp = F.P1 + (row0 + t) * INC + AW + g * GD;
        float v[64];
#pragma unroll
        for (int c8 = 0; c8 < 8; ++c8) { const u32x4 r = *(const u32x4*)(vp + 8 * c8); const unsigned w[4] = {r.x, r.y, r.z, r.w};
#pragma unroll
            for (int j = 0; j < 4; ++j) { v[8 * c8 + 2 * j] = bf_lo(w[j]); v[8 * c8 + 2 * j + 1] = bf_hi(w[j]); } }
        float s = 0.f;
#pragma unroll
        for (int c = 0; c < 64; ++c) s += v[c];
        const float mu = s * (1.f / 64.f); float q = 0.f;
#pragma unroll
        for (int c = 0; c < 64; ++c) { v[c] -= mu; q += v[c] * v[c]; }
        const float rstd = 1.0f / sqrtf(q * (1.f / 64.f) + LN_EPS);
#pragma unroll
        for (int c = 0; c < 64; ++c) { const float val = v[c] * rstd * F.sgu_ln_g[g * GD + c] + F.sgu_ln_b[g * GD + c];
            *(LAS bf16_t*)(vt + c * SG_ROW + t * 2) = (bf16_t)(cvt_pk_bf16(val, 0.f) & 0xffffu); } }
    asm volatile("s_waitcnt lgkmcnt(0)" ::: "memory");
    f32x16 acc[2][4];
#pragma unroll
    for (int mt = 0; mt < 2; ++mt)
#pragma unroll
        for (int nt = 0; nt < 4; ++nt)
#pragma unroll
            for (int r = 0; r < 16; ++r) acc[mt][nt][r] = 0.f;
#pragma unroll
    for (int nt = 0; nt < 4; ++nt) { const int t = 32 * nt + i;
#pragma unroll
        for (int ks = 0; ks < 2 * nt + 2; ++ks) { const int s0 = 16 * ks + 8 * hh;
            const float* wp = F.sgu_w + ((size_t)g * CHUNK + t) * CHUNK + s0; const f32x4 w0 = *(const f32x4*)wp, w1 = *(const f32x4*)(wp + 4);
            float wv[8] = {w0[0], w0[1], w0[2], w0[3], w1[0], w1[1], w1[2], w1[3]};
#pragma unroll
            for (int j = 0; j < 8; ++j) wv[j] = (s0 + j <= t) ? wv[j] : 0.f;
            u32x4 bw; bw.x = cvt_pk_bf16(wv[0], wv[1]); bw.y = cvt_pk_bf16(wv[2], wv[3]); bw.z = cvt_pk_bf16(wv[4], wv[5]); bw.w = cvt_pk_bf16(wv[6], wv[7]);
            const bf16x8 bfrag = __builtin_bit_cast(bf16x8, bw);
#pragma unroll
            for (int mt = 0; mt < 2; ++mt) { const bf16x8 afrag = *(const LAS bf16x8*)(vt + (32 * mt + i) * SG_ROW + s0 * 2);
                acc[mt][nt] = __builtin_amdgcn_mfma_f32_32x32x16_bf16(afrag, bfrag, acc[mt][nt], 0, 0, 0); } } }
#pragma unroll
    for (int nt = 0; nt < 4; ++nt) { const int t = 32 * nt + i; const float bs = F.sgu_b[g * CHUNK + t]; float ss = 0.f;
        const bf16_t* up = F.P1 + (row0 + t) * INC + g * GD + 4 * hh;
#pragma unroll
        for (int mt = 0; mt < 2; ++mt)
#pragma unroll
            for (int g4 = 0; g4 < 4; ++g4) { const u32x2 uw = *(const u32x2*)(up + 32 * mt + 8 * g4);
                const float u0 = bf_lo(uw.x), u1 = bf_hi(uw.x), u2 = bf_lo(uw.y), u3 = bf_hi(uw.y);
                float a0 = u0 * (acc[mt][nt][4 * g4] + bs), a1 = u1 * (acc[mt][nt][4 * g4 + 1] + bs), a2 = u2 * (acc[mt][nt][4 * g4 + 2] + bs), a3 = u3 * (acc[mt][nt][4 * g4 + 3] + bs);
                acc[mt][nt][4 * g4] = a0; acc[mt][nt][4 * g4 + 1] = a1; acc[mt][nt][4 * g4 + 2] = a2; acc[mt][nt][4 * g4 + 3] = a3;
                ss += (a0 * a0 + a1 * a1) + (a2 * a2 + a3 * a3); }
        ss += __shfl_xor(ss, 32);
        if (hh == 0) ssq[g * CHUNK + t] = ss; }
    __syncthreads();
#pragma unroll
    for (int nt = 0; nt < 4; ++nt) { const int t = 32 * nt + i; float tot = 0.f;
#pragma unroll
        for (int gg = 0; gg < 8; ++gg) tot += ssq[gg * CHUNK + t];
        const float rs = 1.0f / sqrtf(tot * (1.f / AW) + LN_EPS);
        bf16_t* op = F.Amix + (row0 + t) * D + g * GD + 4 * hh;
#pragma unroll
        for (int mt = 0; mt < 2; ++mt)
#pragma unroll
            for (int g4 = 0; g4 < 4; ++g4) { const f32x4 mg = *(const f32x4*)(F.mix_g + g * GD + 32 * mt + 8 * g4 + 4 * hh);
                u32x2 w; w.x = cvt_pk_bf16(acc[mt][nt][4 * g4] * rs * mg[0], acc[mt][nt][4 * g4 + 1] * rs * mg[1]); w.y = cvt_pk_bf16(acc[mt][nt][4 * g4 + 2] * rs * mg[2], acc[mt][nt][4 * g4 + 3] * rs * mg[3]);
                *(u32x2*)(op + 32 * mt + 8 * g4) = w; } }
    __syncthreads();
}

constexpr int AT_KROW = 144, AT_VROW = 776, AT_V_OFF = 384 * AT_KROW;
static_assert(AT_V_OFF + 64 * AT_VROW <= RING_BYTES, "attention LDS");
__device__ __forceinline__ void attn_unit(Frame& F, int u) {
    const int bh = u / 48, rem = u % 48, p = rem >> 4, idx = rem & 15, b = bh >> 3, h = bh & 7;
    const int d = (p == 0) ? 1 : (p == 1) ? 4 : 16, r = (p == 0) ? 0 : (p == 1) ? (idx >> 2) : idx, blk = (p == 0) ? idx : (p == 1) ? (idx & 3) : 0;
    const int q0 = blk * 256; const int lane = F.lane, i = lane & 31, hh = lane >> 5, w = F.wave;
    const bf16_t* base = F.P1 + (size_t)b * SEQ * INC + h * HD;
    LAS unsigned char* kl = F.lds; LAS unsigned char* vl = F.lds + AT_V_OFF;
#pragma unroll
    for (int it = 0; it < 6; ++it) { const int ch = F.tid + 512 * it, key = ch >> 3, c = ch & 7, s = q0 - 128 + key;
        u32x4 kv = (u32x4){0u, 0u, 0u, 0u}, vv = (u32x4){0u, 0u, 0u, 0u};
        if (s >= 0) { const bf16_t* rp = base + (size_t)(s * d + r) * INC + c * 8; kv = *(const u32x4*)(rp + 1536); vv = *(const u32x4*)(rp + 2048); }
        *(LAS u32x4*)(kl + key * AT_KROW + c * 16) = kv;
        const unsigned vw[4] = {vv.x, vv.y, vv.z, vv.w};
#pragma unroll
        for (int j = 0; j < 4; ++j) { *(LAS bf16_t*)(vl + (8 * c + 2 * j) * AT_VROW + key * 2) = (bf16_t)(vw[j] & 0xffffu); *(LAS bf16_t*)(vl + (8 * c + 2 * j + 1) * AT_VROW + key * 2) = (bf16_t)(vw[j] >> 16); } }
    const int qs = q0 + 32 * w + i; const size_t qrow = (size_t)qs * d + r;
    bf16x8 qf[4];
#pragma unroll
    for (int ks = 0; ks < 4; ++ks) qf[ks] = *(const bf16x8*)(base + qrow * INC + 1024 + 16 * ks + 8 * hh);
    __syncthreads();
    f32x16 s[5];
#pragma unroll
    for (int kt = 0; kt < 5; ++kt) { f32x16 a;
#pragma unroll
        for (int rr = 0; rr < 16; ++rr) a[rr] = 0.f;
#pragma unroll
        for (int ks = 0; ks < 4; ++ks) { const bf16x8 kf = *(const LAS bf16x8*)(kl + (32 * w + 32 * kt + i) * AT_KROW + (16 * ks + 8 * hh) * 2);
            a = __builtin_amdgcn_mfma_f32_32x32x16_bf16(kf, qf[ks], a, 0, 0, 0); }
        s[kt] = a; }
    const float sc = 0.125f * 1.4426950408889634f; const int ksub0 = q0 + 32 * w - 128;
    float m = -INFINITY;
#pragma unroll
    for (int kt = 0; kt < 5; ++kt)
#pragma unroll
        for (int rr = 0; rr < 16; ++rr) { const int kk = (rr & 3) + 8 * (rr >> 2) + 4 * hh; bool ok = (ksub0 + 32 * kt + kk) >= 0;
            if (kt == 0) ok = ok && (kk >= i);
            if (kt == 4) ok = ok && (kk <= i);
            const float v = ok ? s[kt][rr] * sc : -INFINITY; s[kt][rr] = v; m = fmaxf(m, v); }
    m = fmaxf(m, __shfl_xor(m, 32));
    float lsum = 0.f;
#pragma unroll
    for (int kt = 0; kt < 5; ++kt)
#pragma unroll
        for (int rr = 0; rr < 16; ++rr) { const float pv = __builtin_amdgcn_exp2f(s[kt][rr] - m); s[kt][rr] = pv; lsum += pv; }
    lsum += __shfl_xor(lsum, 32);
    f32x16 o[2];
#pragma unroll
    for (int dt = 0; dt < 2; ++dt)
#pragma unroll
        for (int rr = 0; rr < 16; ++rr) o[dt][rr] = 0.f;
#pragma unroll
    for (int kt = 0; kt < 5; ++kt)
#pragma unroll
        for (int s2 = 0; s2 < 2; ++s2) { u32x4 pw; pw.x = cvt_pk_bf16(s[kt][8 * s2], s[kt][8 * s2 + 1]); pw.y = cvt_pk_bf16(s[kt][8 * s2 + 2], s[kt][8 * s2 + 3]);
            pw.z = cvt_pk_bf16(s[kt][8 * s2 + 4], s[kt][8 * s2 + 5]); pw.w = cvt_pk_bf16(s[kt][8 * s2 + 6], s[kt][8 * s2 + 7]);
            const bf16x8 pb = __builtin_bit_cast(bf16x8, pw);
#pragma unroll
            for (int dt = 0; dt < 2; ++dt) { const LAS unsigned char* ap = vl + (32 * dt + i) * AT_VROW + (32 * w + 32 * kt + 16 * s2 + 4 * hh) * 2;
                const s16x4 lo = *(const LAS s16x4*)ap, hi = *(const LAS s16x4*)(ap + 16);
                const bf16x8 af = __builtin_shufflevector(lo, hi, 0, 1, 2, 3, 4, 5, 6, 7);
                o[dt] = __builtin_amdgcn_mfma_f32_32x32x16_bf16(af, pb, o[dt], 0, 0, 0); } }
    const float inv = 1.0f / lsum; const size_t orow = (size_t)b * SEQ + qrow;
    bf16_t* op = F.Opart + ((size_t)p * T + orow) * AW + h * HD + 4 * hh;
#pragma unroll
    for (int dt = 0; dt < 2; ++dt)
#pragma unroll
        for (int g4 = 0; g4 < 4; ++g4) { u32x2 wv; wv.x = cvt_pk_bf16(o[dt][4 * g4] * inv, o[dt][4 * g4 + 1] * inv); wv.y = cvt_pk_bf16(o[dt][4 * g4 + 2] * inv, o[dt][4 * g4 + 3] * inv);
            *(u32x2*)(op + 32 * dt + 8 * g4) = wv; }
    if (hh == 0) *(f32x2*)(F.ML + (((size_t)p * T + orow) * NH + h) * 2) = (f32x2){m, lsum};
    __syncthreads();
}
__device__ __forceinline__ void p2_mixers(Frame& F) {
    constexpr int NSGU = BATCH * (SEQ / CHUNK), NATT = BATCH * NH * 48;
    for (int u = blockIdx.x; u < NSGU + NATT; u += F.G) { if (u < NSGU) sgu_unit(F, u); else attn_unit(F, u - NSGU); }
}

__device__ __forceinline__ void p3_merge(Frame& F) {
    const int gw = blockIdx.x * 8 + F.wave, NGW = F.G * 8, h = F.lane >> 3;
    for (int row = gw; row < T; row += NGW) {
        f32x2 ml[3]; float mx = -INFINITY;
#pragma unroll
        for (int p = 0; p < 3; ++p) { ml[p] = *(const f32x2*)(F.ML + (((size_t)p * T + row) * NH + h) * 2); mx = fmaxf(mx, ml[p].x); }
        float wt[3], wsum = 0.f;
#pragma unroll
        for (int p = 0; p < 3; ++p) { wt[p] = ml[p].y * __builtin_amdgcn_exp2f(ml[p].x - mx); wsum += wt[p]; }
        const float iw = 1.0f / wsum; float bv[8];
#pragma unroll
        for (int j = 0; j < 8; ++j) bv[j] = 0.f;
#pragma unroll
        for (int p = 0; p < 3; ++p) { const u32x4 r = *(const u32x4*)(F.Opart + ((size_t)p * T + row) * AW + F.lane * 8); const unsigned w[4] = {r.x, r.y, r.z, r.w}; const float f = wt[p] * iw;
#pragma unroll
            for (int j = 0; j < 4; ++j) { bv[2 * j] += f * bf_lo(w[j]); bv[2 * j + 1] += f * bf_hi(w[j]); } }
        float ss = 0.f;
#pragma unroll
        for (int j = 0; j < 8; ++j) ss += bv[j] * bv[j];
        ss = wave_sum(ss); const float rs = 1.0f / sqrtf(ss * (1.f / AW) + LN_EPS);
        const f32x4 g0 = *(const f32x4*)(F.mix_g + AW + F.lane * 8), g1 = *(const f32x4*)(F.mix_g + AW + F.lane * 8 + 4);
        u32x4 w; w.x = cvt_pk_bf16(bv[0] * rs * g0[0], bv[1] * rs * g0[1]); w.y = cvt_pk_bf16(bv[2] * rs * g0[2], bv[3] * rs * g0[3]);
        w.z = cvt_pk_bf16(bv[4] * rs * g1[0], bv[5] * rs * g1[1]); w.w = cvt_pk_bf16(bv[6] * rs * g1[2], bv[7] * rs * g1[3]);
        *(u32x4*)(F.Amix + (size_t)row * D + AW + F.lane * 8) = w;
    }
}

constexpr int RT_ROW = 2064, RT_IMG = 32 * RT_ROW, RT_LGT_OFF = 2 * RT_IMG, RT_SEL_OFF = RT_LGT_OFF + 32 * 33 * 4;
static_assert(RT_SEL_OFF + 2048 + 256 <= MISC_OFF && 8 * 32 * 32 * 4 <= RT_IMG, "route LDS");
__device__ __forceinline__ void p4_route(Frame& F) {
    const int lane = F.lane, w = F.wave;
    LAS unsigned char* img = F.lds; LAS float* part = (LAS float*)F.lds; LAS float* lgt = (LAS float*)(F.lds + RT_LGT_OFF);
    LAS int* sel_e = (LAS int*)(F.lds + RT_SEL_OFF); LAS float* sel_g = (LAS float*)(F.lds + RT_SEL_OFF + 1024);
    LAS int* lcnt = (LAS int*)(F.lds + RT_SEL_OFF + 2048); LAS int* lbase = lcnt + 32;
    if (F.tid < 32) lcnt[F.tid] = 0;
    f32x4 gg[4], bb[4];
#pragma unroll
    for (int j = 0; j < 4; ++j) { gg[j] = *(const f32x4*)(F.ln1_g + 4 * lane + 256 * j); bb[j] = *(const f32x4*)(F.ln1_b + 4 * lane + 256 * j); }
    bf16x8 bh[4][2], bl[4][2];
#pragma unroll
    for (int ks = 0; ks < 4; ++ks)
#pragma unroll
        for (int nt = 0; nt < 2; ++nt) { const bf16_t* bp = F.WrtHi + (size_t)(16 * nt + (lane & 15)) * D + 128 * w + 32 * ks + 8 * (lane >> 4);
            bh[ks][nt] = *(const bf16x8*)bp; bl[ks][nt] = *(const bf16x8*)(bp + (size_t)NE * D); }
    __syncthreads();
    for (int chunk = blockIdx.x; chunk < T / 64; chunk += F.G) {
#pragma unroll 1
        for (int half = 0; half < 2; ++half) {
            const int row0 = chunk * 64 + half * 32 + w * 4;
            f32x4 v[4][4]; float s[4], q[4];
#pragma unroll
            for (int tk = 0; tk < 4; ++tk) { s[tk] = 0.f;
#pragma unroll
                for (int j = 0; j < 4; ++j) { v[tk][j] = *(const f32x4*)(F.out + (size_t)(row0 + tk) * D + 4 * lane + 256 * j); s[tk] += (v[tk][j][0] + v[tk][j][1]) + (v[tk][j][2] + v[tk][j][3]); } }
#pragma unroll
            for (int o = 1; o < 64; o <<= 1) {
#pragma unroll
                for (int tk = 0; tk < 4; ++tk) s[tk] += __shfl_xor(s[tk], o); }
#pragma unroll
            for (int tk = 0; tk < 4; ++tk) { const float mu = s[tk] * (1.f / D); q[tk] = 0.f;
#pragma unroll
                for (int j = 0; j < 4; ++j) { v[tk][j] = v[tk][j] - mu; q[tk] += (v[tk][j][0] * v[tk][j][0] + v[tk][j][1] * v[tk][j][1]) + (v[tk][j][2] * v[tk][j][2] + v[tk][j][3] * v[tk][j][3]); } }
#pragma unroll
            for (int o = 1; o < 64; o <<= 1) {
#pragma unroll
                for (int tk = 0; tk < 4; ++tk) q[tk] += __shfl_xor(q[tk], o); }
#pragma unroll
            for (int tk = 0; tk < 4; ++tk) { const float rstd = 1.0f / sqrtf(q[tk] * (1.f / D) + LN_EPS);
#pragma unroll
                for (int j = 0; j < 4; ++j) { const f32x4 h = v[tk][j] * rstd * gg[j] + bb[j]; const size_t off = (size_t)(row0 + tk) * D + 4 * lane + 256 * j;
                    *(f32x4*)(F.out + off) = h;
                    *(unsigned*)(F.Hb + off) = cvt4_fp8(h[0], h[1], h[2], h[3]);
                    u32x2 hi; hi.x = cvt_pk_bf16(h[0], h[1]); hi.y = cvt_pk_bf16(h[2], h[3]);
                    u32x2 lo; lo.x = cvt_pk_bf16(h[0] - bf_lo(hi.x), h[1] - bf_hi(hi.x)); lo.y = cvt_pk_bf16(h[2] - bf_lo(hi.y), h[3] - bf_hi(hi.y));
                    LAS unsigned char* dp = img + (w * 4 + tk) * RT_ROW + (4 * lane + 256 * j) * 2;
                    *(LAS u32x2*)dp = hi; *(LAS u32x2*)(dp + RT_IMG) = lo; } }
            __syncthreads();
            f32x4 acc[2][2];
#pragma unroll
            for (int mt = 0; mt < 2; ++mt)
#pragma unroll
                for (int nt = 0; nt < 2; ++nt) acc[mt][nt] = (f32x4){0.f, 0.f, 0.f, 0.f};
#pragma unroll
            for (int mt = 0; mt < 2; ++mt) { const LAS unsigned char* ap = img + (16 * mt + (lane & 15)) * RT_ROW + (128 * w + 8 * (lane >> 4)) * 2;
#pragma unroll
                for (int ks = 0; ks < 4; ++ks) { const bf16x8 ah = *(const LAS bf16x8*)(ap + ks * 64), al = *(const LAS bf16x8*)(ap + RT_IMG + ks * 64);
#pragma unroll
                    for (int nt = 0; nt < 2; ++nt) {
                        acc[mt][nt] = __builtin_amdgcn_mfma_f32_16x16x32_bf16(ah, bh[ks][nt], acc[mt][nt], 0, 0, 0);
                        acc[mt][nt] = __builtin_amdgcn_mfma_f32_16x16x32_bf16(ah, bl[ks][nt], acc[mt][nt], 0, 0, 0);
                        acc[mt][nt] = __builtin_amdgcn_mfma_f32_16x16x32_bf16(al, bh[ks][nt], acc[mt][nt], 0, 0, 0); } } }
            __syncthreads();
#pragma unroll
            for (int mt = 0; mt < 2; ++mt)
#pragma unroll
                for (int nt = 0; nt < 2; ++nt)
#pragma unroll
                    for (int r = 0; r < 4; ++r) part[(w * 32 + 16 * mt + 4 * (lane >> 4) + r) * 32 + 16 * nt + (lane & 15)] = acc[mt][nt][r];
            __syncthreads();
#pragma unroll
            for (int qq = 0; qq < 2; ++qq) { const int p = F.tid + 512 * qq, tok = p >> 5, e = p & 31; float sum = F.b_router[e];
#pragma unroll
                for (int ww = 0; ww < 8; ++ww) sum += part[(ww * 32 + tok) * 32 + e];
                lgt[tok * 33 + e] = sum; }
            __syncthreads();
            if (F.tid < 32) {
                float lg[32];
#pragma unroll
                for (int e = 0; e < 32; ++e) lg[e] = lgt[F.tid * 33 + e];
                int idx[4]; float val[4]; unsigned taken = 0u;
#pragma unroll
                for (int r = 0; r < 4; ++r) { float best = -INFINITY; int bi = 0;
#pragma unroll
                    for (int e = 0; e < 32; ++e) { const bool ok = !((taken >> e) & 1u) && (lg[e] > best); best = ok ? lg[e] : best; bi = ok ? e : bi; }
                    idx[r] = bi; val[r] = best; taken |= 1u << bi; }
                const float e1 = __expf(val[1] - val[0]), e2 = __expf(val[2] - val[0]), e3 = __expf(val[3] - val[0]); const float inv = 1.0f / (1.0f + e1 + e2 + e3);
                const int tl = half * 32 + F.tid;
                sel_e[tl * 4 + 0] = idx[0]; sel_e[tl * 4 + 1] = idx[1]; sel_e[tl * 4 + 2] = idx[2]; sel_e[tl * 4 + 3] = idx[3];
                sel_g[tl * 4 + 0] = inv; sel_g[tl * 4 + 1] = e1 * inv; sel_g[tl * 4 + 2] = e2 * inv; sel_g[tl * 4 + 3] = e3 * inv; }
            __syncthreads();
        }
        int myrank = 0, mye = 0;
        if (F.tid < 256) { mye = sel_e[F.tid]; myrank = atomicAdd((int*)&lcnt[mye], 1); }
        __syncthreads();
        if (F.tid < 32) { const int c = lcnt[F.tid]; lbase[F.tid] = c ? (int)__hip_atomic_fetch_add(F.ctl + CW_CNT + F.tid, (unsigned)c, __ATOMIC_RELAXED, __HIP_MEMORY_SCOPE_AGENT) : 0; lcnt[F.tid] = 0; }
        __syncthreads();
        if (F.tid < 256) { const int slot = (chunk * 64 + (F.tid >> 2)) * 4 + (F.tid & 3); F.list[mye * T + lbase[mye] + myrank] = slot; F.gates[slot] = sel_g[F.tid]; F.einfo[slot] = mye | ((lbase[mye] + myrank) << 8); }
        __syncthreads();
    }
}

template <bool G1> __device__ __forceinline__ int moe_tables(Frame& F, int NPN) {
    LAS int* cnt = (LAS int*)(F.lds + TAB_OFF); LAS int* tstart = cnt + 32; LAS int* rowtab = (LAS int*)(F.lds + ROWTAB_OFF);
    if (F.tid < 32) cnt[F.tid] = (int)__hip_atomic_load(F.ctl + CW_CNT + F.tid, __ATOMIC_RELAXED, __HIP_MEMORY_SCOPE_AGENT);
    __syncthreads();
    if (F.tid == 0) { int acc = 0; for (int e = 0; e < NE; ++e) { tstart[e] = acc; acc += (cnt[e] + 255) >> 8; } tstart[NE] = acc; }
    __syncthreads();
    const int ntiles = tstart[NE], nU = ntiles * NPN;
    for (int i = 0; i < MAXU; ++i) { const int L = i * F.G + F.vcu; if (L >= nU) break;
        const int tl = L / NPN; int e = 0;
        for (int j = 1; j < NE; ++j) e += (tstart[j] <= tl) ? 1 : 0;
        const int mt = tl - tstart[e];
        if (F.tid < 256) { const int rank = mt * 256 + F.tid; const int slot = rank < cnt[e] ? F.list[e * T + rank] : -1;
            rowtab[i * 256 + F.tid] = G1 ? ((slot < 0 ? 0 : (slot >> 2)) * D) : slot; } }
    __syncthreads();
    return ntiles;
}

__device__ __forceinline__ void p7_final(Frame& F) {
    LAS int* cnt = (LAS int*)(F.lds + TAB_OFF); LAS int* tstart = cnt + 32;
    if (F.tid < 32) cnt[F.tid] = (int)__hip_atomic_load(F.ctl + CW_CNT + F.tid, __ATOMIC_RELAXED, __HIP_MEMORY_SCOPE_AGENT);
    __syncthreads();
    if (F.tid == 0) { int acc = 0; for (int e = 0; e < NE; ++e) { tstart[e] = acc; acc += (cnt[e] + 255) >> 8; } tstart[NE] = acc; }
    __syncthreads();
    const int gw = blockIdx.x * 8 + F.wave, NGW = F.G * 8;
    for (int row = gw; row < T; row += NGW) {
        float* hp = F.out + (size_t)row * D; float v[16];
#pragma unroll
        for (int j = 0; j < 2; ++j) { const f32x4 a = *(const f32x4*)(hp + 512 * j + F.lane * 8), b = *(const f32x4*)(hp + 512 * j + F.lane * 8 + 4);
#pragma unroll
            for (int i = 0; i < 4; ++i) { v[8 * j + i] = a[i] * DN_ALPHA; v[8 * j + 4 + i] = b[i] * DN_ALPHA; } }
#pragma unroll
        for (int k = 0; k < TOPK; ++k) { const int info = F.einfo[row * TOPK + k]; const float gt = F.gates[row * TOPK + k];
            const size_t pos = ((size_t)tstart[info & 255] << 8) + (size_t)(info >> 8);
#pragma unroll
            for (int j = 0; j < 2; ++j) { const u32x4 r = *(const u32x4*)(F.Y + pos * D + 512 * j + F.lane * 8); const unsigned w[4] = {r.x, r.y, r.z, r.w};
#pragma unroll
                for (int i = 0; i < 4; ++i) { v[8 * j + 2 * i] += gt * bf_lo(w[i]); v[8 * j + 2 * i + 1] += gt * bf_hi(w[i]); } } }
        float s = 0.f;
#pragma unroll
        for (int i = 0; i < 16; ++i) s += v[i];
        const float mu = wave_sum(s) * (1.f / D); float q = 0.f;
#pragma unroll
        for (int i = 0; i < 16; ++i) { v[i] -= mu; q += v[i] * v[i]; }
        const float rstd = 1.0f / sqrtf(wave_sum(q) * (1.f / D) + LN_EPS);
#pragma unroll
        for (int j = 0; j < 2; ++j) { const int c = 512 * j + F.lane * 8;
            const f32x4 g0 = *(const f32x4*)(F.ln2_g + c), g1 = *(const f32x4*)(F.ln2_g + c + 4), b0 = *(const f32x4*)(F.ln2_b + c), b1 = *(const f32x4*)(F.ln2_b + c + 4);
            f32x4 o0, o1;
#pragma unroll
            for (int i = 0; i < 4; ++i) { o0[i] = v[8 * j + i] * rstd * g0[i] + b0[i]; o1[i] = v[8 * j + 4 + i] * rstd * g1[i] + b1[i]; }
            *(f32x4*)(hp + c) = o0; *(f32x4*)(hp + c + 4) = o1; }
    }
}

constexpr int N_PHASES = 8;
__global__ void __launch_bounds__(512, 2) mk_fwd(Args args) {
    extern __shared__ __attribute__((aligned(16))) unsigned char lds_raw[];
    Frame F;
    F.lds = (LAS unsigned char*)lds_raw; F.tid = threadIdx.x; F.lane = F.tid & 63; F.wave = __builtin_amdgcn_readfirstlane(F.tid >> 6);
    F.G = gridDim.x; { const int bx = blockIdx.x; F.vcu = (F.G % 8 == 0) ? (bx % 8) * (F.G / 8) + bx / 8 : bx; }
    F.x = args.in[0]; F.w_in = args.in[1]; F.sgu_w = args.in[2]; F.sgu_b = args.in[3]; F.sgu_ln_g = args.in[4]; F.sgu_ln_b = args.in[5]; F.mix_g = args.in[6]; F.w_out = args.in[7];
    F.ln1_g = args.in[8]; F.ln1_b = args.in[9]; F.w_router = args.in[10]; F.b_router = args.in[11]; F.w_gate = args.in[12]; F.b_gate = args.in[13]; F.w_up = args.in[14]; F.b_up = args.in[15];
    F.w_down = args.in[16]; F.b_down = args.in[17]; F.ln2_g = args.in[18]; F.ln2_b = args.in[19]; F.out = args.out; F.ws = args.ws;
    unsigned char* ws = args.ws;
    F.ctl = (unsigned*)(ws + WS_CTL); F.list = (int*)(ws + WS_LIST); F.einfo = (int*)(ws + WS_EINFO); F.gates = (float*)(ws + WS_GATES);
    F.Win_t = (bf16_t*)(ws + WS_WIN); F.Wout_t = (bf16_t*)(ws + WS_WOUT); F.Wd_t = (act_t*)(ws + WS_WD); F.Wgu_t = (fp8_t*)(ws + WS_WGU); F.Y = (bf16_t*)(ws + WS_Y);
    F.Hb = (fp8_t*)(ws + WS_HB); F.Xb = (bf16_t*)(ws + WS_XB); F.P1 = (bf16_t*)(ws + WS_P1); F.Amix = (bf16_t*)(ws + WS_AMIX); F.Act = (act_t*)(ws + WS_ACT);
    F.WrtHi = (bf16_t*)(ws + WS_WRT); F.Opart = (bf16_t*)(ws + WS_OPART); F.ML = (float*)(ws + WS_ML);
    const int lo = args.ph_lo, hi = args.ph_hi;
    volatile LAS unsigned* misc = (volatile LAS unsigned*)(F.lds + MISC_OFF);
    if (F.tid < 16) misc[F.tid] = 0u;
    __syncthreads();
    XcdBarrier bar; bar.bar = F.ctl + CW_BAR; bar.x = 0; bar.st = misc;
    if (hi - lo > 1) bar = xcd_barrier_post(F.ctl + CW_BAR, misc);
    const LAS int* rowtab = (const LAS int*)(F.lds + ROWTAB_OFF);
#ifndef PROBE_DUP
#define PROBE_DUP -1
#endif
#define IN(k) (lo <= (k) && (k) < hi)
#define SEAM(k) do { if (IN(k) && IN((k) + 1)) { xcd_barrier(bar); } } while (0)
#define REP(k) for (int _rep = 0; _rep < ((PROBE_DUP == (k)) ? 2 : 1); ++_rep)
    if (IN(0)) REP(0) { p0_convert(F); }
    SEAM(0);
    if (IN(1)) REP(1) {
        pg8::Gemm g{F.Xb, F.Win_t, D * 2}; pg8::EpiP1 E{F.P1}; constexpr int NU1 = (T / 256) * (INC / 256);
        int nun = 0; for (int i = 0; i * F.G + F.vcu < NU1; ++i) ++nun;
        int pos = 0, first = (F.vcu * 8 + F.wave) * (MOE_ITEMS / (F.G * 8) + 1), count = MOE_ITEMS / (F.G * 8) + 1;
        if (F.G == 256) { if (nun == 3) { pos = F.vcu & 3; count = 9; first = (F.vcu * 8 + F.wave) * 9; } else { pos = F.vcu % 3; count = 15; first = 9216 + ((F.vcu - 128) * 8 + F.wave) * 15; } }
        { pg8::DenseOrder S{INC / 256, NU1, F.G, F.vcu, 0, pos}; pg8::gemm_phase<pg8::EpiP1, pg8::DenseOrder, false, false>(F.lds, rowtab, g, S, E); }
        moe_convert_items(F, first, count);
        __syncthreads();
        { pg8::DenseOrder S{INC / 256, NU1, F.G, F.vcu, pos, 1 << 20}; pg8::gemm_phase<pg8::EpiP1, pg8::DenseOrder, false, false>(F.lds, rowtab, g, S, E); } }
    SEAM(1);
    if (IN(2)) REP(2) { p2_mixers(F); }
    SEAM(2);
    if (IN(3)) REP(3) { p3_merge(F); }
    SEAM(3);
    if (IN(4)) REP(4) { pg8::Gemm g{F.Amix, F.Wout_t, D * 2}; pg8::DenseOrder S{D / 256, (T / 256) * (D / 256), F.G, F.vcu, 0, 1 << 20}; pg8::EpiZ E{F.x, F.out};
        pg8::gemm_phase<pg8::EpiZ, pg8::DenseOrder, false, false>(F.lds, rowtab, g, S, E); }
    SEAM(4);
    if (IN(5)) { p4_route(F); }
    SEAM(5);
    if (IN(6)) REP(6) { const int ntiles = moe_tables<true>(F, 8); pg8::Gemm g{F.Hb, F.Wgu_t, D}; pg8::MoeOrder S{8, ntiles * 8, F.G, F.vcu, (const LAS int*)(F.lds + TAB_OFF) + 32};
        pg8::EpiSwiglu E{F.Act, F.b_gate, F.b_up};
        pg8::gemm_phase<pg8::EpiSwiglu, pg8::MoeOrder, true, true>(F.lds, rowtab, g, S, E); }
    SEAM(6);
    if (IN(7)) REP(7) { const int ntiles = moe_tables<false>(F, 4); pg8::Gemm g{F.Act, F.Wd_t, FF * (int)sizeof(act_t)}; pg8::MoeOrder S{4, ntiles * 4, F.G, F.vcu, (const LAS int*)(F.lds + TAB_OFF) + 32};
        pg8::EpiY E{F.Y, F.b_down};
        pg8::gemm_phase<pg8::EpiY, pg8::MoeOrder, false, (G2_FP8 != 0)>(F.lds, rowtab, g, S, E); }
    SEAM(7);
    if (IN(8)) { p7_final(F); }
#undef IN
#undef SEAM
}

extern "C" void kernel_launch(void* const* d_in, const int* in_sizes, int n_in, void* d_out, int out_size, void* d_ws, size_t ws_size, hipStream_t stream) {
    static int grid = 0;
    if (grid == 0) {
        if (n_in != 20 || in_sizes[0] != T * D || out_size != T * D || ws_size < WS_END) { fprintf(stderr, "kernel_launch: unexpected shapes (n_in %d, in0 %d, out %d, ws %zu)\n", n_in, n_in > 0 ? in_sizes[0] : -1, out_size, ws_size); grid = -1; return; }
        int dev = 0, cus = 0, per_cu = 0;
        hipGetDevice(&dev); hipDeviceGetAttribute(&cus, hipDeviceAttributeMultiprocessorCount, dev);
        if (hipFuncSetAttribute((const void*)mk_fwd, hipFuncAttributeMaxDynamicSharedMemorySize, LDS_BYTES) != hipSuccess) { fprintf(stderr, "kernel_launch: hipFuncSetAttribute failed\n"); grid = -1; return; }
        hipOccupancyMaxActiveBlocksPerMultiprocessor(&per_cu, (const void*)mk_fwd, 512, LDS_BYTES);
        (void)hipGetLastError();
        if (per_cu < 1) { fprintf(stderr, "kernel_launch: occupancy query says %d blocks/CU: the grid would not be resident; nothing launched\n", per_cu); grid = -1; return; }
        grid = cus;
        if (grid != 256) fprintf(stderr, "kernel_launch: note: %d CUs (tuned for 256)\n", grid);
    }
    if (grid < 0) return;
    hipMemsetAsync((char*)d_ws + WS_CTL, 0, CTL_ZERO_BYTES, stream);
    Args a{};
    for (int i = 0; i < 20; ++i) a.in[i] = (const float*)d_in[i];
    a.out = (float*)d_out; a.ws = (unsigned char*)d_ws;
#if MK_N_LAUNCHES == 1
    a.ph_lo = 0; a.ph_hi = N_PHASES + 1;
    hipLaunchKernelGGL(mk_fwd, dim3(grid), dim3(512), LDS_BYTES, stream, a);
#else
    for (int p = 0; p <= N_PHASES; ++p) { a.ph_lo = p; a.ph_hi = p + 1; hipLaunchKernelGGL(mk_fwd, dim3(grid), dim3(512), LDS_BYTES, stream, a); }
#endif
}
```

```cpp
#include <hip/hip_runtime.h>
#include <hip/hip_cooperative_groups.h>
#include <cstdio>
#include <cstdint>
namespace cg = cooperative_groups;

#ifndef MK_N_LAUNCHES
#define MK_N_LAUNCHES 1
#endif

constexpr int BATCH = 4, SEQ = 4096, T = BATCH * SEQ, D = 1024, INC = 2560, NE = 32, FF = 1024, TOPK = 4;
constexpr int AW = 512, NGRP = 8, GD = 64, CHUNK = 128, NH = 8, HD = 64;
constexpr float LN_EPS = 1e-5f, DN_ALPHA = 1.189207115002721f;
constexpr int NSLOT = T * TOPK;
constexpr int MAXTILES = 288;
constexpr int MAXU = 12;

constexpr size_t MiB = 1u << 20;
constexpr size_t WS_CTL = 0, CTL_ZERO_BYTES = 64 * 1024;
constexpr size_t WS_LIST = 1 * MiB;
constexpr size_t WS_GATES = 3 * MiB;
constexpr size_t WS_EINFO = 3 * MiB + 256 * 1024;
constexpr size_t WS_WRT = 3 * MiB + 512 * 1024;
constexpr size_t WS_WIN = 4 * MiB;
constexpr size_t WS_WOUT = 9 * MiB;
constexpr size_t WS_WD = 11 * MiB;
constexpr size_t WS_WGU = 75 * MiB;
constexpr size_t WS_HB = 139 * MiB;
constexpr size_t WS_BIG = 155 * MiB;
constexpr size_t WS_XB = WS_BIG;
constexpr size_t WS_P1 = WS_BIG + 32 * MiB;
constexpr size_t WS_AMIX = WS_BIG + 112 * MiB;
constexpr size_t WS_ACT = WS_BIG;
constexpr size_t WS_Y = 299 * MiB;
constexpr size_t WS_OPART = 427 * MiB;
constexpr size_t WS_ML = 475 * MiB;
constexpr size_t WS_END = 478 * MiB;
#ifndef G2_FP8
#define G2_FP8 1
#endif
constexpr float WGU_SCALE = 32.0f, WD_SCALE = G2_FP8 ? 64.0f : 1.0f;
#if G2_FP8
typedef unsigned char act_t;
#else
typedef unsigned short act_t;
#endif
constexpr int CW_BAR = 1024;
constexpr int CW_CNT = 0;

constexpr int RING_BYTES = 131072;
constexpr int TAB_OFF = RING_BYTES + 1024;
constexpr int ROWTAB_OFF = RING_BYTES + 2048;
constexpr int MISC_OFF = 147456 - 64;
constexpr int LDS_BYTES = 147456;
static_assert(ROWTAB_OFF + MAXU * 1024 <= LDS_BYTES, "LDS map");

#define LAS __attribute__((address_space(3)))
typedef unsigned short bf16_t;
typedef unsigned char fp8_t;
typedef short bf16x8 __attribute__((ext_vector_type(8)));
typedef float f32x4 __attribute__((ext_vector_type(4)));
typedef float f32x2 __attribute__((ext_vector_type(2)));
typedef unsigned u32x4 __attribute__((ext_vector_type(4)));
typedef unsigned u32x2 __attribute__((ext_vector_type(2)));
typedef int v8i32 __attribute__((ext_vector_type(8)));
typedef int v4i32 __attribute__((ext_vector_type(4)));


__device__ __forceinline__ unsigned cvt_pk_bf16(float lo, float hi) { unsigned r; asm volatile("v_cvt_pk_bf16_f32 %0, %1, %2" : "=v"(r) : "v"(lo), "v"(hi)); return r; }
__device__ __forceinline__ unsigned cvt4_fp8(float a, float b, float c, float d) { int w = 0; w = __builtin_amdgcn_cvt_pk_fp8_f32(a, b, w, false); w = __builtin_amdgcn_cvt_pk_fp8_f32(c, d, w, true); return (unsigned)w; }
__device__ __forceinline__ float bf_lo(unsigned w) { return __uint_as_float(w << 16); }
__device__ __forceinline__ float bf_hi(unsigned w) { return __uint_as_float(w & 0xffff0000u); }
__device__ __forceinline__ float bf1(bf16_t b) { return __uint_as_float((unsigned)b << 16); }
__device__ __forceinline__ float wave_sum(float v) {
#pragma unroll
    for (int o = 1; o < 64; o <<= 1) v += __shfl_xor(v, o);
    return v;
}
__device__ __forceinline__ float gelu_tanh(float x) {
    const float y2 = x * (1.5957691216057308f + 0.07135481627260025f * x * x);
    return x * __builtin_amdgcn_rcpf(1.0f + __builtin_amdgcn_exp2f(-1.4426950408889634f * y2));
}

namespace pg8 {
constexpr int BM = 256, BK = 64, HALF = 128, HTB = HALF * BK * 2, STAGE_BYTES = 8 * HTB;
__host__ __device__ __forceinline__ int lds_byte(int r, int c) { const int st = (r >> 4) * 2 + (c >> 5), rr = r & 15, cc = c & 31, ob = rr * 64 + cc * 2; return st * 1024 + (ob ^ (((ob >> 9) & 1) << 5)); }
__host__ __device__ __forceinline__ void stage_rc(int b, int& R, int& C) { const int st = b / 1024, sb = b % 1024, swz = sb ^ (((sb >> 9) & 1) << 5); R = (st >> 1) * 16 + swz / 64; C = (st & 1) * 32 + (swz % 64) / 2; }
__host__ __device__ __forceinline__ int perm32(int rho) { const int n = rho >> 4, i = rho & 15; return 8 * (i >> 2) + 4 * n + (i & 3); }

struct Unit { int pm, pn, pb, e, mt, ui; };
struct Gemm { const void* A; const void* Bt; int KB; };

struct DenseOrder {
    int nN, nU, G, v, i0, i1;
    __device__ __forceinline__ bool next(int i, Unit& u) const {
        i += i0; if (i >= i1) return false;
        const int L = i * G + v; if (L >= nU) return false;
        u.pm = L / nN; u.pn = L % nN; u.pb = u.pn; u.e = 0; u.mt = 0; u.ui = i; return true; }
};
struct MoeOrder {
    int NPN, nU, G, v; const LAS int* tstart;
    __device__ __forceinline__ bool next(int i, Unit& u) const {
        const int L = i * G + v; if (L >= nU) return false;
        const int tl = L / NPN, pn = L % NPN; int e = 0;
#pragma unroll
        for (int j = 1; j < NE; ++j) e += (tstart[j] <= tl) ? 1 : 0;
        e = __builtin_amdgcn_readfirstlane(e); const int ts = __builtin_amdgcn_readfirstlane(tstart[e]);
        u.pm = tl; u.pn = pn; u.pb = e * NPN + pn; u.e = e; u.mt = tl - ts; u.ui = i; return true; }
};

template <class Epi, class Sched, bool GATHER, bool FP8>
__device__ __forceinline__ void gemm_phase(LAS unsigned char* lds, const LAS int* rowtab, const Gemm g, const Sched& S, const Epi& E) {
    const int tid = threadIdx.x, wid = __builtin_amdgcn_readfirstlane(tid >> 6), lane = tid & 63, wr = wid >> 2, wc = wid & 3, fr = lane & 15, fq = lane >> 4;
    const int KB = g.KB, nt = KB / (BK * 2);
    unsigned voffA0[2], voffA1[2], voffB[2]; int Rr[2], Cc[2];
#pragma unroll
    for (int i = 0; i < 2; ++i) { int R, C; stage_rc(tid * 16 + i * 8192, R, C); const int Rb = Epi::PERM ? ((R & ~31) + perm32(R & 31)) : R; Rr[i] = R; Cc[i] = C;
        voffA0[i] = (unsigned)(R * KB + C * 2); voffA1[i] = (unsigned)((R + HALF) * KB + C * 2); voffB[i] = (unsigned)(Rb * KB + C * 2); }
    const unsigned kstep = (unsigned)(BK * 2);
    const unsigned hstep = (unsigned)HALF * (unsigned)KB;
    const unsigned tstep = 2u * hstep;
    const __amdgpu_buffer_rsrc_t rsA = __builtin_amdgcn_make_buffer_rsrc(const_cast<void*>(g.A), 0, -1, 0x00020000);
    const __amdgpu_buffer_rsrc_t rsB = __builtin_amdgcn_make_buffer_rsrc(const_cast<void*>(g.Bt), 0, -1, 0x00020000);
    const unsigned ldsw = (unsigned)wid * 1024u;
    const int aoff = lds_byte(wr * 64 + fr, fq * 8), boff = lds_byte(wc * 32 + fr, fq * 8);
#define PG8_SA(b, h) (((b) * 2 + (h)) * HTB)
#define PG8_SB(b, h) ((4 + (b) * 2 + (h)) * HTB)
#define PG8_STAGE(bufoff, rs, soff, voff) do { _Pragma("unroll") for (int _i = 0; _i < 2; ++_i) \
        __builtin_amdgcn_raw_ptr_buffer_load_lds(rs, (LAS void*)(lds + (bufoff) + ldsw + _i * 8192), 16, (int)(voff)[_i], (int)(soff), 0, 0); } while (0)
#define PG8_LDA(dst, b, h) do { if constexpr (FP8) { _Pragma("unroll") for (int m = 0; m < 4; ++m) dst##8[m] = __builtin_shufflevector(*(const LAS v4i32*)(lds + PG8_SA(b, h) + aoff + m * 2048), *(const LAS v4i32*)(lds + PG8_SA(b, h) + aoff + m * 2048 + 1024), 0, 1, 2, 3, 4, 5, 6, 7); } \
        else { _Pragma("unroll") for (int m = 0; m < 4; ++m) _Pragma("unroll") for (int k = 0; k < 2; ++k) dst[m][k] = *(const LAS bf16x8*)(lds + PG8_SA(b, h) + aoff + m * 2048 + k * 1024); } } while (0)
#define PG8_LDB(dst, b, h) do { if constexpr (FP8) { _Pragma("unroll") for (int n = 0; n < 2; ++n) dst##8[n] = __builtin_shufflevector(*(const LAS v4i32*)(lds + PG8_SB(b, h) + boff + n * 2048), *(const LAS v4i32*)(lds + PG8_SB(b, h) + boff + n * 2048 + 1024), 0, 1, 2, 3, 4, 5, 6, 7); } \
        else { _Pragma("unroll") for (int n = 0; n < 2; ++n) _Pragma("unroll") for (int k = 0; k < 2; ++k) dst[n][k] = *(const LAS bf16x8*)(lds + PG8_SB(b, h) + boff + n * 2048 + k * 1024); } } while (0)
#define PG8_MMA(ai, bj, At, Bt) do { __builtin_amdgcn_s_setprio(1); if constexpr (FP8) { _Pragma("unroll") for (int m = 0; m < 4; ++m) _Pragma("unroll") for (int n = 0; n < 2; ++n) \
        acc[ai][bj][m][n] = __builtin_amdgcn_mfma_scale_f32_16x16x128_f8f6f4(Bt##8[n], At##8[m], acc[ai][bj][m][n], 0, 0, 0, 0x7F7F7F7F, 0, 0x7F7F7F7F); } \
        else { _Pragma("unroll") for (int m = 0; m < 4; ++m) _Pragma("unroll") for (int n = 0; n < 2; ++n) _Pragma("unroll") for (int k = 0; k < 2; ++k) \
        acc[ai][bj][m][n] = __builtin_amdgcn_mfma_f32_16x16x32_bf16(Bt[n][k], At[m][k], acc[ai][bj][m][n], 0, 0, 0); } __builtin_amdgcn_s_setprio(0); } while (0)
#define PG8_WAIT_V(n) asm volatile("s_waitcnt vmcnt(" #n ")" ::: "memory")
#define PG8_WAIT_L(n) asm volatile("s_waitcnt lgkmcnt(" #n ")" ::: "memory")
#define PG8_BAR __builtin_amdgcn_s_barrier()
#define PG8_SCHED __builtin_amdgcn_sched_barrier(0)
#define PG8_LOADROWS(U) do { if constexpr (GATHER) { _Pragma("unroll") for (int _i = 0; _i < 2; ++_i) { \
        voffA0[_i] = (unsigned)rowtab[(U).ui * 256 + Rr[_i]] + (unsigned)Cc[_i] * 2u; voffA1[_i] = (unsigned)rowtab[(U).ui * 256 + HALF + Rr[_i]] + (unsigned)Cc[_i] * 2u; } } } while (0)
    Unit cur, nxt; int ui = 0;
    if (!S.next(0, cur)) return;
    f32x4 acc[2][2][4][2];
#pragma unroll
    for (int a = 0; a < 2; ++a)
#pragma unroll
        for (int b = 0; b < 2; ++b)
#pragma unroll
            for (int m = 0; m < 4; ++m)
#pragma unroll
                for (int n = 0; n < 2; ++n) acc[a][b][m][n] = (f32x4){0.f, 0.f, 0.f, 0.f};
    bf16x8 At[4][2], B0[2][2], B1[2][2]; v8i32 At8[4], B08[2], B18[2];
    unsigned cA = GATHER ? 0u : (unsigned)cur.pm * tstep, cB = (unsigned)cur.pb * tstep;
    PG8_LOADROWS(cur); PG8_WAIT_L(0);
    PG8_STAGE(PG8_SB(0, 0), rsB, cB, voffB); PG8_STAGE(PG8_SB(0, 1), rsB, cB + hstep, voffB); PG8_STAGE(PG8_SA(0, 0), rsA, cA, voffA0); PG8_STAGE(PG8_SA(0, 1), rsA, cA, voffA1);
    if (wr == 1) PG8_BAR;
    PG8_WAIT_V(2); PG8_BAR;
    PG8_STAGE(PG8_SB(1, 0), rsB, cB + kstep, voffB); PG8_STAGE(PG8_SA(1, 0), rsA, cA + kstep, voffA0); PG8_STAGE(PG8_SB(1, 1), rsB, cB + hstep + kstep, voffB);
    PG8_WAIT_V(6); PG8_BAR;
    for (;;) {
        const bool has_next = S.next(ui + 1, nxt);
        const unsigned nA = has_next ? (GATHER ? 0u : (unsigned)nxt.pm * tstep) : cA, nB = has_next ? (unsigned)nxt.pb * tstep : cB;
#pragma unroll 1
        for (int t = 0; t < nt; t += 2) {
            const bool last = (t == nt - 2);
            const unsigned a1 = cA + (unsigned)(t + 1) * kstep;
            const unsigned a2 = last ? nA : cA + (unsigned)(t + 2) * kstep, b2 = last ? nB : cB + (unsigned)(t + 2) * kstep;
            const unsigned a3 = a2 + kstep, b3 = b2 + kstep;
            PG8_LDB(B0, 0, 0); PG8_LDB(B1, 0, 1); PG8_SCHED; PG8_LDA(At, 0, 0); PG8_STAGE(PG8_SA(1, 1), rsA, a1, voffA1);
            if (last && has_next) PG8_LOADROWS(nxt);
            PG8_WAIT_V(8); PG8_WAIT_L(0); PG8_BAR; PG8_MMA(0, 0, At, B0); PG8_MMA(0, 1, At, B1); PG8_BAR; PG8_SCHED;
            PG8_LDA(At, 0, 1); PG8_STAGE(PG8_SB(0, 0), rsB, b2, voffB); PG8_STAGE(PG8_SB(0, 1), rsB, b2 + hstep, voffB); PG8_STAGE(PG8_SA(0, 0), rsA, a2, voffA0);
            PG8_WAIT_V(8); PG8_WAIT_L(0); PG8_BAR; PG8_MMA(1, 0, At, B0); PG8_MMA(1, 1, At, B1); PG8_BAR; PG8_SCHED;
            PG8_LDB(B0, 1, 0); PG8_LDB(B1, 1, 1); PG8_SCHED; PG8_LDA(At, 1, 0); PG8_STAGE(PG8_SA(0, 1), rsA, a2, voffA1);
            PG8_WAIT_V(8); PG8_WAIT_L(0); PG8_BAR; PG8_MMA(0, 0, At, B0); PG8_MMA(0, 1, At, B1); PG8_BAR; PG8_SCHED;
            PG8_LDA(At, 1, 1); PG8_STAGE(PG8_SB(1, 0), rsB, b3, voffB); PG8_STAGE(PG8_SB(1, 1), rsB, b3 + hstep, voffB); PG8_STAGE(PG8_SA(1, 0), rsA, a3, voffA0);
            PG8_WAIT_V(8); PG8_WAIT_L(0); PG8_BAR; PG8_MMA(1, 0, At, B0); PG8_MMA(1, 1, At, B1); PG8_BAR; PG8_SCHED;
        }
        if (wr == 0) PG8_BAR;
        { int t2 = threadIdx.x; asm volatile("" : "+v"(t2));
          const int w2 = __builtin_amdgcn_readfirstlane(t2 >> 6), l2 = t2 & 63; E(acc, cur, w2 >> 2, w2 & 3, l2 & 15, l2 >> 4); }
        if (!has_next) break;
#pragma unroll
        for (int a = 0; a < 2; ++a)
#pragma unroll
            for (int b = 0; b < 2; ++b)
#pragma unroll
                for (int m = 0; m < 4; ++m)
#pragma unroll
                    for (int n = 0; n < 2; ++n) acc[a][b][m][n] = (f32x4){0.f, 0.f, 0.f, 0.f};
        cur = nxt; cA = nA; cB = nB; ++ui;
        if (wr == 1) PG8_BAR;
    }
    PG8_WAIT_V(0);
    PG8_BAR;
#undef PG8_SA
#undef PG8_SB
#undef PG8_STAGE
#undef PG8_LDA
#undef PG8_LDB
#undef PG8_MMA
#undef PG8_WAIT_V
#undef PG8_WAIT_L
#undef PG8_BAR
#undef PG8_SCHED
#undef PG8_LOADROWS
}

struct EpiP1 {
    static constexpr bool PERM = true;
    bf16_t* O;
    __device__ __forceinline__ void operator()(const f32x4 (&acc)[2][2][4][2], const Unit& u, int wr, int wc, int fr, int fq) const {
        const int row0 = u.pm * BM + wr * 64 + fr, col0 = u.pn * BM + wc * 32 + 8 * fq; const bool act = u.pn < 4;
#pragma unroll
        for (int ai = 0; ai < 2; ++ai)
#pragma unroll
            for (int m = 0; m < 4; ++m) { bf16_t* rowp = O + (size_t)(row0 + ai * HALF + m * 16) * INC + col0;
#pragma unroll
                for (int bj = 0; bj < 2; ++bj) { f32x4 v0 = acc[ai][bj][m][0], v1 = acc[ai][bj][m][1];
                    if (act) {
#pragma unroll
                        for (int j = 0; j < 4; ++j) { v0[j] = gelu_tanh(v0[j]); v1[j] = gelu_tanh(v1[j]); } }
                    u32x4 w; w.x = cvt_pk_bf16(v0[0], v0[1]); w.y = cvt_pk_bf16(v0[2], v0[3]); w.z = cvt_pk_bf16(v1[0], v1[1]); w.w = cvt_pk_bf16(v1[2], v1[3]);
                    *(u32x4*)(rowp + bj * HALF) = w; } }
    }
};
struct EpiZ {
    static constexpr bool PERM = false;
    const float* X; float* Z;
    __device__ __forceinline__ void operator()(const f32x4 (&acc)[2][2][4][2], const Unit& u, int wr, int wc, int fr, int fq) const {
        const int col0 = u.pn * BM + wc * 32 + 4 * fq;
#pragma unroll
        for (int ai = 0; ai < 2; ++ai)
#pragma unroll
            for (int m = 0; m < 4; ++m) { const size_t off = (size_t)(u.pm * BM + ai * HALF + wr * 64 + m * 16 + fr) * D + col0;
#pragma unroll
                for (int bj = 0; bj < 2; ++bj)
#pragma unroll
                    for (int n = 0; n < 2; ++n) { const f32x4 xv = *(const f32x4*)(X + off + bj * HALF + n * 16); *(f32x4*)(Z + off + bj * HALF + n * 16) = xv * DN_ALPHA + acc[ai][bj][m][n]; } }
    }
};
struct EpiSwiglu {
    static constexpr bool PERM = true;
    act_t* Act; const float* bg; const float* bu;
    __device__ __forceinline__ void operator()(const f32x4 (&acc)[2][2][4][2], const Unit& u, int wr, int wc, int fr, int fq) const {
        const int f0 = u.pn * HALF + wc * 32 + 8 * fq; const int row0 = u.pm * BM + wr * 64 + fr;
        const f32x4 bg0 = *(const f32x4*)(bg + u.e * FF + f0), bg1 = *(const f32x4*)(bg + u.e * FF + f0 + 4);
        const f32x4 bu0 = *(const f32x4*)(bu + u.e * FF + f0), bu1 = *(const f32x4*)(bu + u.e * FF + f0 + 4);
#pragma unroll
        for (int ai = 0; ai < 2; ++ai)
#pragma unroll
            for (int m = 0; m < 4; ++m) {
                f32x4 g0 = acc[ai][0][m][0] * (1.0f / WGU_SCALE) + bg0, g1 = acc[ai][0][m][1] * (1.0f / WGU_SCALE) + bg1, u0 = acc[ai][1][m][0] * (1.0f / WGU_SCALE) + bu0, u1 = acc[ai][1][m][1] * (1.0f / WGU_SCALE) + bu1, r0, r1;
#pragma unroll
                for (int j = 0; j < 4; ++j) {
                    const float ga = fminf(g0[j], 7.0f), gb = fminf(g1[j], 7.0f);
                    const float ua = fminf(fmaxf(u0[j], -7.0f), 7.0f), ub = fminf(fmaxf(u1[j], -7.0f), 7.0f);
                    r0[j] = (ua + 1.0f) * ga * __builtin_amdgcn_rcpf(1.0f + __builtin_amdgcn_exp2f(-1.702f * 1.4426950408889634f * ga));
                    r1[j] = (ub + 1.0f) * gb * __builtin_amdgcn_rcpf(1.0f + __builtin_amdgcn_exp2f(-1.702f * 1.4426950408889634f * gb)); }
                if constexpr (G2_FP8) { u32x2 w; w.x = cvt4_fp8(r0[0], r0[1], r0[2], r0[3]); w.y = cvt4_fp8(r1[0], r1[1], r1[2], r1[3]); *(u32x2*)(Act + (size_t)(row0 + ai * HALF + m * 16) * FF + f0) = w; }
                else { u32x4 w; w.x = cvt_pk_bf16(r0[0], r0[1]); w.y = cvt_pk_bf16(r0[2], r0[3]); w.z = cvt_pk_bf16(r1[0], r1[1]); w.w = cvt_pk_bf16(r1[2], r1[3]); *(u32x4*)(Act + (size_t)(row0 + ai * HALF + m * 16) * FF + f0) = w; } }
    }
};
struct EpiY {
    static constexpr bool PERM = true;
    bf16_t* Y; const float* bd;
    __device__ __forceinline__ void operator()(const f32x4 (&acc)[2][2][4][2], const Unit& u, int wr, int wc, int fr, int fq) const {
        const int c0 = u.pn * BM + wc * 32 + 8 * fq; const int row0 = u.pm * BM + wr * 64 + fr;
        f32x4 b[2][2];
#pragma unroll
        for (int bj = 0; bj < 2; ++bj) { b[bj][0] = *(const f32x4*)(bd + u.e * D + c0 + bj * HALF); b[bj][1] = *(const f32x4*)(bd + u.e * D + c0 + bj * HALF + 4); }
#pragma unroll
        for (int ai = 0; ai < 2; ++ai)
#pragma unroll
            for (int m = 0; m < 4; ++m) { bf16_t* rowp = Y + (size_t)(row0 + ai * HALF + m * 16) * D + c0;
#pragma unroll
                for (int bj = 0; bj < 2; ++bj) { const f32x4 v0 = acc[ai][bj][m][0] * (1.0f / WD_SCALE) + b[bj][0], v1 = acc[ai][bj][m][1] * (1.0f / WD_SCALE) + b[bj][1];
                    u32x4 w; w.x = cvt_pk_bf16(v0[0], v0[1]); w.y = cvt_pk_bf16(v0[2], v0[3]); w.z = cvt_pk_bf16(v1[0], v1[1]); w.w = cvt_pk_bf16(v1[2], v1[3]);
                    *(u32x4*)(rowp + bj * HALF) = w; } }
    }
};
}


#define XB_TMO      128
#define XB_XCNT(j)  (256  + 64 * (j))
#define XB_XSUB(j)  (1280 + 64 * (j))
#define XB_XGEN(j)  (2304 + 64 * (j))
#define XB_TOP      3328
#define XB_TOPGEN   3392
#define XCD_BAR_WORDS 3456
#define XB_SPIN_CAP (1u << 22)
__device__ __forceinline__ unsigned xb_ld(unsigned* p)              { return __hip_atomic_load(p, __ATOMIC_RELAXED, __HIP_MEMORY_SCOPE_AGENT); }
__device__ __forceinline__ unsigned xb_add(unsigned* p, unsigned v) { return __hip_atomic_fetch_add(p, v, __ATOMIC_RELAXED, __HIP_MEMORY_SCOPE_AGENT); }
__device__ __forceinline__ unsigned xb_xcc_id() { return (unsigned)__builtin_amdgcn_s_getreg((3 << 11) | 20) & 0xFu; }
#define XB_SPIN(cond, bar) do { unsigned _sp = 0; while (cond) { __builtin_amdgcn_s_sleep(1); \
    if ((++_sp & 255u) == 0u) { if (xb_ld(&(bar)[XB_TMO])) break; if (_sp > XB_SPIN_CAP) { atomicAdd(&(bar)[XB_TMO], 1u); break; } } } } while (0)
struct XcdBarrier { unsigned* bar; unsigned x; volatile LAS unsigned* st; };
__device__ __forceinline__ XcdBarrier xcd_barrier_post(unsigned* bar, volatile LAS unsigned* st) {
    XcdBarrier b; b.bar = bar; b.x = xb_xcc_id(); b.st = st;
    if (threadIdx.x == 0) (void)xb_add(&bar[XB_XCNT(b.x)], 1u);
    return b;
}
__device__ __forceinline__ void xcd_barrier_complete(unsigned* bar, unsigned x, unsigned& nloc, unsigned& nx) {
    const unsigned G = gridDim.x * gridDim.y * gridDim.z;
    unsigned sum, cnt, mine, sp = 0u;
    for (;;) {
        sum = 0u; cnt = 0u; mine = 0u;
#pragma unroll
        for (unsigned j = 0; j < 16; ++j) { const unsigned c = xb_ld(&bar[XB_XCNT(j)]); sum += c; cnt += (c > 0u) ? 1u : 0u; mine = (j == x) ? c : mine; }
        if (sum == G) break;
        __builtin_amdgcn_s_sleep(1);
        if ((++sp & 255u) == 0u) { if (xb_ld(&bar[XB_TMO])) break; if (sp > XB_SPIN_CAP) { atomicAdd(&bar[XB_TMO], 1u); break; } }
    }
    nloc = mine > 0u ? mine : 1u; nx = cnt > 0u ? cnt : 1u;
}
__device__ __forceinline__ void xcd_barrier(const XcdBarrier& b) {
    asm volatile("s_waitcnt vmcnt(0)" ::: "memory");
    __syncthreads();
    if (threadIdx.x == 0) {
        unsigned* bar = b.bar;
        __builtin_amdgcn_s_waitcnt(0);
        unsigned nloc = b.st[0], nx = b.st[1];
        if (nloc == 0u) { xcd_barrier_complete(bar, b.x, nloc, nx); b.st[0] = nloc; b.st[1] = nx; }
        const unsigned old = xb_add(&bar[XB_XSUB(b.x)], 1u);
        const unsigned gen = old / nloc;
        if (old + 1u == (gen + 1u) * nloc) {
            __builtin_amdgcn_fence(__ATOMIC_RELEASE, "agent");
            asm volatile("s_waitcnt vmcnt(0)" ::: "memory");
            const unsigned og = xb_add(&bar[XB_TOP], 1u);
            const unsigned tg = og / nx;
            if (og + 1u == (tg + 1u) * nx) xb_add(&bar[XB_TOPGEN], 1u);
            else XB_SPIN(xb_ld(&bar[XB_TOPGEN]) == tg, bar);
            __builtin_amdgcn_fence(__ATOMIC_ACQUIRE, "agent");
            xb_add(&bar[XB_XGEN(b.x)], 1u);
            asm volatile("s_waitcnt vmcnt(0)" ::: "memory");
        } else {
            XB_SPIN(xb_ld(&bar[XB_XGEN(b.x)]) == gen, bar);
            __builtin_amdgcn_fence(__ATOMIC_ACQUIRE, "agent");
            asm volatile("s_waitcnt vmcnt(0)" ::: "memory");
        }
    }
    __syncthreads();
}

struct Args { const float* in[20]; float* out; unsigned char* ws; int ph_lo, ph_hi; };
struct Frame {
    LAS unsigned char* lds; int tid, lane, wave, G, vcu;
    const float *x, *w_in, *sgu_w, *sgu_b, *sgu_ln_g, *sgu_ln_b, *mix_g, *w_out, *ln1_g, *ln1_b, *w_router, *b_router, *w_gate, *b_gate, *w_up, *b_up, *w_down, *b_down, *ln2_g, *ln2_b;
    float* out; unsigned char* ws;
    unsigned* ctl; int* list; int* einfo; float* gates; bf16_t *Win_t, *Wout_t, *Y, *Xb, *P1, *Amix; act_t *Wd_t, *Act; fp8_t *Wgu_t, *Hb; bf16_t* Opart; float* ML; bf16_t* WrtHi;
};

__device__ __forceinline__ void transpose_item(const float* W, int N, int K, int k0, int n0, bf16_t* WT, size_t dst_row0, LAS float* scr, int lane) {
    { const int kr = lane >> 3, c4 = lane & 7; f32x4 v[8];
#pragma unroll
      for (int i = 0; i < 8; ++i) v[i] = *(const f32x4*)(W + (size_t)(k0 + 8 * i + kr) * N + n0 + 4 * c4);
#pragma unroll
      for (int i = 0; i < 8; ++i) { LAS float* d = scr + (8 * i + kr) * 33 + 4 * c4; d[0] = v[i][0]; d[1] = v[i][1]; d[2] = v[i][2]; d[3] = v[i][3]; } }
    asm volatile("s_waitcnt lgkmcnt(0)" ::: "memory");
    const int c = lane & 7;
#pragma unroll
    for (int j = 0; j < 4; ++j) { const int n = (lane >> 3) + 8 * j; const LAS float* s = scr + (8 * c) * 33 + n;
        u32x4 o; o.x = cvt_pk_bf16(s[0 * 33], s[1 * 33]); o.y = cvt_pk_bf16(s[2 * 33], s[3 * 33]); o.z = cvt_pk_bf16(s[4 * 33], s[5 * 33]); o.w = cvt_pk_bf16(s[6 * 33], s[7 * 33]);
        *(u32x4*)(WT + (dst_row0 + n) * K + k0 + 8 * c) = o; }
    asm volatile("s_waitcnt lgkmcnt(0)" ::: "memory");
}
__device__ __forceinline__ void transpose_item8(const float* W, int N, int K, int k0, int n0, fp8_t* WT, size_t dst_row0, float scale, LAS float* scr, int lane) {
    { const int kr = lane >> 3, c4 = lane & 7; f32x4 v[16];
#pragma unroll
      for (int i = 0; i < 16; ++i) v[i] = *(const f32x4*)(W + (size_t)(k0 + 8 * i + kr) * N + n0 + 4 * c4);
#pragma unroll
      for (int i = 0; i < 16; ++i) { LAS float* d = scr + (8 * i + kr) * 33 + 4 * c4; d[0] = v[i][0]; d[1] = v[i][1]; d[2] = v[i][2]; d[3] = v[i][3]; } }
    asm volatile("s_waitcnt lgkmcnt(0)" ::: "memory");
    const int c = lane & 7;
#pragma unroll
    for (int j = 0; j < 4; ++j) { const int n = (lane >> 3) + 8 * j; const LAS float* s = scr + (16 * c) * 33 + n;
        u32x4 o; o.x = cvt4_fp8(s[0 * 33] * scale, s[1 * 33] * scale, s[2 * 33] * scale, s[3 * 33] * scale); o.y = cvt4_fp8(s[4 * 33] * scale, s[5 * 33] * scale, s[6 * 33] * scale, s[7 * 33] * scale);
        o.z = cvt4_fp8(s[8 * 33] * scale, s[9 * 33] * scale, s[10 * 33] * scale, s[11 * 33] * scale); o.w = cvt4_fp8(s[12 * 33] * scale, s[13 * 33] * scale, s[14 * 33] * scale, s[15 * 33] * scale);
        *(u32x4*)(WT + (dst_row0 + n) * K + k0 + 16 * c) = o; }
    asm volatile("s_waitcnt lgkmcnt(0)" ::: "memory");
}
constexpr int MOE_ITEMS = NE * 3 * 8 * 32;
static_assert(G2_FP8, "the MoE item list below assumes fp8 copies of all three expert matrices");
__device__ __forceinline__ void moe_convert_items(Frame& F, int first, int count) {
    LAS float* scr = (LAS float*)(F.lds + F.wave * 17408);
    for (int it = first; it < first + count && it < MOE_ITEMS; ++it) {
        const int nb = it & 31, kb = (it >> 5) & 7, ew = it >> 8, e = ew / 3, which = ew - 3 * e, n0 = 32 * nb;
        if (which < 2) transpose_item8((which ? F.w_up : F.w_gate) + (size_t)e * D * FF, FF, D, 128 * kb, n0, F.Wgu_t, (size_t)e * 2048 + (n0 >> 7) * 256 + which * 128 + (n0 & 127), WGU_SCALE, scr, F.lane);
        else transpose_item8(F.w_down + (size_t)e * FF * D, D, FF, 128 * kb, n0, (fp8_t*)F.Wd_t, (size_t)e * 1024 + n0, WD_SCALE, scr, F.lane);
    }
}
__device__ __forceinline__ void p0_convert(Frame& F) {
    LAS float* scr = (LAS float*)(F.lds + F.wave * 17408);
    const int gw = F.vcu * 8 + F.wave, NGW = F.G * 8;
    constexpr int I_IN = (D / 64) * (INC / 32), I_OUT = (D / 64) * (D / 32);
    for (int it = gw; it < I_IN + I_OUT; it += NGW) {
        int r = it;
        if (r < I_IN) { const int kb = r / (INC / 32), nb = r % (INC / 32); transpose_item(F.w_in, INC, D, 64 * kb, 32 * nb, F.Win_t, (size_t)32 * nb, scr, F.lane); continue; } r -= I_IN;
        { const int kb = r / (D / 32), nb = r % (D / 32); transpose_item(F.w_out, D, D, 64 * kb, 32 * nb, F.Wout_t, (size_t)32 * nb, scr, F.lane); }
    }
    for (int i2 = blockIdx.x * 512 + F.tid; i2 < D * NE; i2 += F.G * 512) { const int k = i2 >> 5, e = i2 & 31; const float wv = F.w_router[i2];
        const unsigned hi = cvt_pk_bf16(wv, 0.f) & 0xffffu; const unsigned lo = cvt_pk_bf16(wv - bf_lo(hi), 0.f) & 0xffffu;
        F.WrtHi[(size_t)e * D + k] = (bf16_t)hi; F.WrtHi[(size_t)(NE + e) * D + k] = (bf16_t)lo; }
    const size_t nchunk = (size_t)T * D / 8, cstride = (size_t)F.G * 512;
    for (size_t i = (size_t)blockIdx.x * 512 + F.tid; i < nchunk; i += 4 * cstride) {
        f32x4 a[4], b[4];
#pragma unroll
        for (int j = 0; j < 4; ++j) { const size_t ii = i + j * cstride; if (ii < nchunk) { a[j] = *(const f32x4*)(F.x + ii * 8); b[j] = *(const f32x4*)(F.x + ii * 8 + 4); } }
#pragma unroll
        for (int j = 0; j < 4; ++j) { const size_t ii = i + j * cstride; if (ii < nchunk) {
            u32x4 w; w.x = cvt_pk_bf16(a[j][0], a[j][1]); w.y = cvt_pk_bf16(a[j][2], a[j][3]); w.z = cvt_pk_bf16(b[j][0], b[j][1]); w.w = cvt_pk_bf16(b[j][2], b[j][3]);
            *(u32x4*)(F.Xb + ii * 8) = w; } } }
}

typedef float f32x16 __attribute__((ext_vector_type(16)));
typedef short s16x4 __attribute__((ext_vector_type(4)));
constexpr int SG_ROW = 272, SG_WAVE = 64 * SG_ROW, SG_SSQ_OFF = 8 * SG_WAVE;
static_assert(SG_SSQ_OFF + 8 * 128 * 4 <= LDS_BYTES, "SGU LDS");
__device__ __forceinline__ void sgu_unit(Frame& F, int u, int half) {
    const int g = F.wave, lane = F.lane, i = lane & 31, hh = lane >> 5; const size_t row0 = (size_t)u * CHUNK;
    LAS unsigned char* vt = F.lds + g * SG_WAVE; LAS float* ssq = (LAS float*)(F.lds + SG_SSQ_OFF);
    { u32x4 raw[2][8];
#pragma unroll
      for (int tt = 0; tt < 2; ++tt) { if (tt <= half) { const bf16_t* vp = F.P1 + (row0 + lane + 64 * tt) * INC + AW + g * GD;
#pragma unroll
          for (int c8 = 0; c8 < 8; ++c8) raw[tt][c8] = *(const u32x4*)(vp + 8 * c8); } }
#pragma unroll
      for (int tt = 0; tt < 2; ++tt) { if (tt <= half) { const int t = lane + 64 * tt;
        float v[64];
#pragma unroll
        for (int c8 = 0; c8 < 8; ++c8) { const unsigned w[4] = {raw[tt][c8].x, raw[tt][c8].y, raw[tt][c8].z, raw[tt][c8].w};
#pragma unroll
            for (int j = 0; j < 4; ++j) { v[8 * c8 + 2 * j] = bf_lo(w[j]); v[8 * c8 + 2 * j + 1] = bf_hi(w[j]); } }
        float s = 0.f;
#pragma unroll
        for (int c = 0; c < 64; ++c) s += v[c];
        const float mu = s * (1.f / 64.f); float q = 0.f;
#pragma unroll
        for (int c = 0; c < 64; ++c) { v[c] -= mu; q += v[c] * v[c]; }
        const float rstd = 1.0f / sqrtf(q * (1.f / 64.f) + LN_EPS);
#pragma unroll
        for (int c = 0; c < 64; ++c) { const float val = v[c] * rstd * F.sgu_ln_g[g * GD + c] + F.sgu_ln_b[g * GD + c];
            *(LAS bf16_t*)(vt + c * SG_ROW + t * 2) = (bf16_t)(cvt_pk_bf16(val, 0.f) & 0xffffu); } } } }
    asm volatile("s_waitcnt lgkmcnt(0)" ::: "memory");
    unsigned ssq_base = (unsigned)(uintptr_t)(ssq + i); asm volatile("" : "+v"(ssq_base));
    LAS float* ssq_r = (LAS float*)(uintptr_t)ssq_base; LAS float* ssq_w = ssq_r + g * 64;
    f32x16 acc[2][2];
#pragma unroll
    for (int n2 = 0; n2 < 2; ++n2) { const int nt = 2 * half + n2, t = 32 * nt + i, nks = 2 * nt + 2;
#pragma unroll
        for (int mt = 0; mt < 2; ++mt)
#pragma unroll
            for (int r = 0; r < 16; ++r) acc[mt][n2][r] = 0.f;
        const bf16_t* up = F.P1 + (row0 + t) * INC + g * GD + 4 * hh; u32x2 uq[2][4];
#pragma unroll
        for (int mt = 0; mt < 2; ++mt)
#pragma unroll
            for (int g4 = 0; g4 < 4; ++g4) uq[mt][g4] = *(const u32x2*)(up + 32 * mt + 8 * g4);
        const float bs = F.sgu_b[g * CHUNK + t];
        for (int kb = 0; kb < nks; kb += 4) {
            f32x4 wq[4][2];
#pragma unroll
            for (int k4 = 0; k4 < 4; ++k4) { if (kb + k4 < nks) { const float* wp = F.sgu_w + ((size_t)g * CHUNK + t) * CHUNK + 16 * (kb + k4) + 8 * hh; wq[k4][0] = *(const f32x4*)wp; wq[k4][1] = *(const f32x4*)(wp + 4); } }
#pragma unroll
            for (int k4 = 0; k4 < 4; ++k4) { if (kb + k4 < nks) { const int s0 = 16 * (kb + k4) + 8 * hh;
                float wv[8] = {wq[k4][0][0], wq[k4][0][1], wq[k4][0][2], wq[k4][0][3], wq[k4][1][0], wq[k4][1][1], wq[k4][1][2], wq[k4][1][3]};
#pragma unroll
                for (int j = 0; j < 8; ++j) wv[j] = (s0 + j <= t) ? wv[j] : 0.f;
                u32x4 bw; bw.x = cvt_pk_bf16(wv[0], wv[1]); bw.y = cvt_pk_bf16(wv[2], wv[3]); bw.z = cvt_pk_bf16(wv[4], wv[5]); bw.w = cvt_pk_bf16(wv[6], wv[7]);
                const bf16x8 bfrag = __builtin_bit_cast(bf16x8, bw);
#pragma unroll
                for (int mt = 0; mt < 2; ++mt) { const bf16x8 afrag = *(const LAS bf16x8*)(vt + (32 * mt + i) * SG_ROW + s0 * 2);
                    acc[mt][n2] = __builtin_amdgcn_mfma_f32_32x32x16_bf16(afrag, bfrag, acc[mt][n2], 0, 0, 0); } } } }
        float ss = 0.f;
#pragma unroll
        for (int mt = 0; mt < 2; ++mt)
#pragma unroll
            for (int g4 = 0; g4 < 4; ++g4) { const u32x2 uw = uq[mt][g4];
                const float u0 = bf_lo(uw.x), u1 = bf_hi(uw.x), u2 = bf_lo(uw.y), u3 = bf_hi(uw.y);
                float a0 = u0 * (acc[mt][n2][4 * g4] + bs), a1 = u1 * (acc[mt][n2][4 * g4 + 1] + bs), a2 = u2 * (acc[mt][n2][4 * g4 + 2] + bs), a3 = u3 * (acc[mt][n2][4 * g4 + 3] + bs);
                acc[mt][n2][4 * g4] = a0; acc[mt][n2][4 * g4 + 1] = a1; acc[mt][n2][4 * g4 + 2] = a2; acc[mt][n2][4 * g4 + 3] = a3;
                ss += (a0 * a0 + a1 * a1) + (a2 * a2 + a3 * a3); }
        ss += __shfl_xor(ss, 32);
        if (hh == 0) ssq_w[32 * n2] = ss; }
    __syncthreads();
#pragma unroll
    for (int n2 = 0; n2 < 2; ++n2) { const int t = 64 * half + 32 * n2 + i; float tot = 0.f;
#pragma unroll
        for (int gg = 0; gg < 8; ++gg) tot += ssq_r[gg * 64 + 32 * n2];
        const float rs = 1.0f / sqrtf(tot * (1.f / AW) + LN_EPS);
        bf16_t* op = F.Amix + (row0 + t) * D + g * GD + 4 * hh;
#pragma unroll
        for (int mt = 0; mt < 2; ++mt)
#pragma unroll
            for (int g4 = 0; g4 < 4; ++g4) { const f32x4 mg = *(const f32x4*)(F.mix_g + g * GD + 32 * mt + 8 * g4 + 4 * hh);
                u32x2 w; w.x = cvt_pk_bf16(acc[mt][n2][4 * g4] * rs * mg[0], acc[mt][n2][4 * g4 + 1] * rs * mg[1]); w.y = cvt_pk_bf16(acc[mt][n2][4 * g4 + 2] * rs * mg[2], acc[mt][n2][4 * g4 + 3] * rs * mg[3]);
                *(u32x2*)(op + 32 * mt + 8 * g4) = w; } }
    __syncthreads();
}

constexpr int AT_KROW = 144, AT_VROW = 776, AT_V_OFF = 384 * AT_KROW;
static_assert(AT_V_OFF + 64 * AT_VROW <= RING_BYTES, "attention LDS");
__device__ __forceinline__ void attn_unit(Frame& F, int u) {
    const int bh = u / 48, rem = u % 48, p = rem >> 4, idx = rem & 15, b = bh >> 3, h = bh & 7;
    const int d = (p == 0) ? 1 : (p == 1) ? 4 : 16, r = (p == 0) ? 0 : (p == 1) ? (idx >> 2) : idx, blk = (p == 0) ? idx : (p == 1) ? (idx & 3) : 0;
    const int q0 = blk * 256; const int lane = F.lane, i = lane & 31, hh = lane >> 5, w = F.wave;
    const bf16_t* base = F.P1 + (size_t)b * SEQ * INC + h * HD;
    LAS unsigned char* kl = F.lds; LAS unsigned char* vl = F.lds + AT_V_OFF;
#pragma unroll
    for (int it = 0; it < 6; ++it) { const int ch = F.tid + 512 * it, key = ch >> 3, c = ch & 7, s = q0 - 128 + key;
        u32x4 kv = (u32x4){0u, 0u, 0u, 0u}, vv = (u32x4){0u, 0u, 0u, 0u};
        if (s >= 0) { const bf16_t* rp = base + (size_t)(s * d + r) * INC + c * 8; kv = *(const u32x4*)(rp + 1536); vv = *(const u32x4*)(rp + 2048); }
        *(LAS u32x4*)(kl + key * AT_KROW + c * 16) = kv;
        const unsigned vw[4] = {vv.x, vv.y, vv.z, vv.w};
#pragma unroll
        for (int j = 0; j < 4; ++j) { *(LAS bf16_t*)(vl + (8 * c + 2 * j) * AT_VROW + key * 2) = (bf16_t)(vw[j] & 0xffffu); *(LAS bf16_t*)(vl + (8 * c + 2 * j + 1) * AT_VROW + key * 2) = (bf16_t)(vw[j] >> 16); } }
    const int qs = q0 + 32 * w + i; const size_t qrow = (size_t)qs * d + r;
    bf16x8 qf[4];
#pragma unroll
    for (int ks = 0; ks < 4; ++ks) qf[ks] = *(const bf16x8*)(base + qrow * INC + 1024 + 16 * ks + 8 * hh);
    __syncthreads();
    f32x16 s[5];
#pragma unroll
    for (int kt = 0; kt < 5; ++kt) { f32x16 a;
#pragma unroll
        for (int rr = 0; rr < 16; ++rr) a[rr] = 0.f;
#pragma unroll
        for (int ks = 0; ks < 4; ++ks) { const bf16x8 kf = *(const LAS bf16x8*)(kl + (32 * w + 32 * kt + i) * AT_KROW + (16 * ks + 8 * hh) * 2);
            a = __builtin_amdgcn_mfma_f32_32x32x16_bf16(kf, qf[ks], a, 0, 0, 0); }
        s[kt] = a; }
    const float sc = 0.125f * 1.4426950408889634f; const int ksub0 = q0 + 32 * w - 128;
    float m = -INFINITY;
#pragma unroll
    for (int kt = 0; kt < 5; ++kt)
#pragma unroll
        for (int rr = 0; rr < 16; ++rr) { const int kk = (rr & 3) + 8 * (rr >> 2) + 4 * hh; bool ok = (ksub0 + 32 * kt + kk) >= 0;
            if (kt == 0) ok = ok && (kk >= i);
            if (kt == 4) ok = ok && (kk <= i);
            const float v = ok ? s[kt][rr] * sc : -INFINITY; s[kt][rr] = v; m = fmaxf(m, v); }
    m = fmaxf(m, __shfl_xor(m, 32));
    float lsum = 0.f;
#pragma unroll
    for (int kt = 0; kt < 5; ++kt)
#pragma unroll
        for (int rr = 0; rr < 16; ++rr) { const float pv = __builtin_amdgcn_exp2f(s[kt][rr] - m); s[kt][rr] = pv; lsum += pv; }
    lsum += __shfl_xor(lsum, 32);
    f32x16 o[2];
#pragma unroll
    for (int dt = 0; dt < 2; ++dt)
#pragma unroll
        for (int rr = 0; rr < 16; ++rr) o[dt][rr] = 0.f;
#pragma unroll
    for (int kt = 0; kt < 5; ++kt)
#pragma unroll
        for (int s2 = 0; s2 < 2; ++s2) { u32x4 pw; pw.x = cvt_pk_bf16(s[kt][8 * s2], s[kt][8 * s2 + 1]); pw.y = cvt_pk_bf16(s[kt][8 * s2 + 2], s[kt][8 * s2 + 3]);
            pw.z = cvt_pk_bf16(s[kt][8 * s2 + 4], s[kt][8 * s2 + 5]); pw.w = cvt_pk_bf16(s[kt][8 * s2 + 6], s[kt][8 * s2 + 7]);
            const bf16x8 pb = __builtin_bit_cast(bf16x8, pw);
#pragma unroll
            for (int dt = 0; dt < 2; ++dt) { const LAS unsigned char* ap = vl + (32 * dt + i) * AT_VROW + (32 * w + 32 * kt + 16 * s2 + 4 * hh) * 2;
                const s16x4 lo = *(const LAS s16x4*)ap, hi = *(const LAS s16x4*)(ap + 16);
                const bf16x8 af = __builtin_shufflevector(lo, hi, 0, 1, 2, 3, 4, 5, 6, 7);
                o[dt] = __builtin_amdgcn_mfma_f32_32x32x16_bf16(af, pb, o[dt], 0, 0, 0); } }
    const float inv = 1.0f / lsum; const size_t orow = (size_t)b * SEQ + qrow;
    bf16_t* op = F.Opart + ((size_t)p * T + orow) * AW + h * HD + 4 * hh;
#pragma unroll
    for (int dt = 0; dt < 2; ++dt)
#pragma unroll
        for (int g4 = 0; g4 < 4; ++g4) { u32x2 wv; wv.x = cvt_pk_bf16(o[dt][4 * g4] * inv, o[dt][4 * g4 + 1] * inv); wv.y = cvt_pk_bf16(o[dt][4 * g4 + 2] * inv, o[dt][4 * g4 + 3] * inv);
            *(u32x2*)(op + 32 * dt + 8 * g4) = wv; }
    if (hh == 0) *(f32x2*)(F.ML + (((size_t)p * T + orow) * NH + h) * 2) = (f32x2){m, lsum};
    __syncthreads();
}
__device__ __forceinline__ void p2_mixers(Frame& F) {
    constexpr int NSGU = 2 * BATCH * (SEQ / CHUNK), NATT = BATCH * NH * 48;
    for (int u = F.vcu; u < NSGU; u += F.G) sgu_unit(F, u >> 1, u & 1);
    for (int u = F.vcu; u < NATT; u += F.G) attn_unit(F, u);
}

__device__ __forceinline__ void p3_merge(Frame& F) {
    const int gw = blockIdx.x * 8 + F.wave, NGW = F.G * 8, h = F.lane >> 3;
    for (int row = gw; row < T; row += NGW) {
        f32x2 ml[3]; float mx = -INFINITY;
#pragma unroll
        for (int p = 0; p < 3; ++p) { ml[p] = *(const f32x2*)(F.ML + (((size_t)p * T + row) * NH + h) * 2); mx = fmaxf(mx, ml[p].x); }
        float wt[3], wsum = 0.f;
#pragma unroll
        for (int p = 0; p < 3; ++p) { wt[p] = ml[p].y * __builtin_amdgcn_exp2f(ml[p].x - mx); wsum += wt[p]; }
        const float iw = 1.0f / wsum; float bv[8];
#pragma unroll
        for (int j = 0; j < 8; ++j) bv[j] = 0.f;
#pragma unroll
        for (int p = 0; p < 3; ++p) { const u32x4 r = *(const u32x4*)(F.Opart + ((size_t)p * T + row) * AW + F.lane * 8); const unsigned w[4] = {r.x, r.y, r.z, r.w}; const float f = wt[p] * iw;
#pragma unroll
            for (int j = 0; j < 4; ++j) { bv[2 * j] += f * bf_lo(w[j]); bv[2 * j + 1] += f * bf_hi(w[j]); } }
        float ss = 0.f;
#pragma unroll
        for (int j = 0; j < 8; ++j) ss += bv[j] * bv[j];
        ss = wave_sum(ss); const float rs = 1.0f / sqrtf(ss * (1.f / AW) + LN_EPS);
        const f32x4 g0 = *(const f32x4*)(F.mix_g + AW + F.lane * 8), g1 = *(const f32x4*)(F.mix_g + AW + F.lane * 8 + 4);
        u32x4 w; w.x = cvt_pk_bf16(bv[0] * rs * g0[0], bv[1] * rs * g0[1]); w.y = cvt_pk_bf16(bv[2] * rs * g0[2], bv[3] * rs * g0[3]);
        w.z = cvt_pk_bf16(bv[4] * rs * g1[0], bv[5] * rs * g1[1]); w.w = cvt_pk_bf16(bv[6] * rs * g1[2], bv[7] * rs * g1[3]);
        *(u32x4*)(F.Amix + (size_t)row * D + AW + F.lane * 8) = w;
    }
}

constexpr int RT_ROW = 2064, RT_IMG = 32 * RT_ROW, RT_LGT_OFF = 2 * RT_IMG, RT_SEL_OFF = RT_LGT_OFF + 32 * 33 * 4;
static_assert(RT_SEL_OFF + 2048 + 256 <= MISC_OFF && 8 * 32 * 32 * 4 <= RT_IMG, "route LDS");
__device__ __forceinline__ void p4_route(Frame& F) {
    const int lane = F.lane, w = F.wave;
    LAS unsigned char* img = F.lds; LAS float* part = (LAS float*)F.lds; LAS float* lgt = (LAS float*)(F.lds + RT_LGT_OFF);
    LAS int* sel_e = (LAS int*)(F.lds + RT_SEL_OFF); LAS float* sel_g = (LAS float*)(F.lds + RT_SEL_OFF + 1024);
    LAS int* lcnt = (LAS int*)(F.lds + RT_SEL_OFF + 2048); LAS int* lbase = lcnt + 32;
    if (F.tid < 32) lcnt[F.tid] = 0;
    f32x4 gg[4], bb[4];
#pragma unroll
    for (int j = 0; j < 4; ++j) { gg[j] = *(const f32x4*)(F.ln1_g + 4 * lane + 256 * j); bb[j] = *(const f32x4*)(F.ln1_b + 4 * lane + 256 * j); }
    bf16x8 bh[4][2], bl[4][2];
#pragma unroll
    for (int ks = 0; ks < 4; ++ks)
#pragma unroll
        for (int nt = 0; nt < 2; ++nt) { const bf16_t* bp = F.WrtHi + (size_t)(16 * nt + (lane & 15)) * D + 128 * w + 32 * ks + 8 * (lane >> 4);
            bh[ks][nt] = *(const bf16x8*)bp; bl[ks][nt] = *(const bf16x8*)(bp + (size_t)NE * D); }
    __syncthreads();
    for (int chunk = blockIdx.x; chunk < T / 64; chunk += F.G) {
#pragma unroll 1
        for (int half = 0; half < 2; ++half) {
            const int row0 = chunk * 64 + half * 32 + w * 4;
            f32x4 v[4][4]; float s[4], q[4];
#pragma unroll
            for (int tk = 0; tk < 4; ++tk) { s[tk] = 0.f;
#pragma unroll
                for (int j = 0; j < 4; ++j) { v[tk][j] = *(const f32x4*)(F.out + (size_t)(row0 + tk) * D + 4 * lane + 256 * j); s[tk] += (v[tk][j][0] + v[tk][j][1]) + (v[tk][j][2] + v[tk][j][3]); } }
#pragma unroll
            for (int o = 1; o < 64; o <<= 1) {
#pragma unroll
                for (int tk = 0; tk < 4; ++tk) s[tk] += __shfl_xor(s[tk], o); }
#pragma unroll
            for (int tk = 0; tk < 4; ++tk) { const float mu = s[tk] * (1.f / D); q[tk] = 0.f;
#pragma unroll
                for (int j = 0; j < 4; ++j) { v[tk][j] = v[tk][j] - mu; q[tk] += (v[tk][j][0] * v[tk][j][0] + v[tk][j][1] * v[tk][j][1]) + (v[tk][j][2] * v[tk][j][2] + v[tk][j][3] * v[tk][j][3]); } }
#pragma unroll
            for (int o = 1; o < 64; o <<= 1) {
#pragma unroll
                for (int tk = 0; tk < 4; ++tk) q[tk] += __shfl_xor(q[tk], o); }
#pragma unroll
            for (int tk = 0; tk < 4; ++tk) { const float rstd = 1.0f / sqrtf(q[tk] * (1.f / D) + LN_EPS);
#pragma unroll
                for (int j = 0; j < 4; ++j) { const f32x4 h = v[tk][j] * rstd * gg[j] + bb[j]; const size_t off = (size_t)(row0 + tk) * D + 4 * lane + 256 * j;
                    *(f32x4*)(F.out + off) = h;
                    *(unsigned*)(F.Hb + off) = cvt4_fp8(h[0], h[1], h[2], h[3]);
                    u32x2 hi; hi.x = cvt_pk_bf16(h[0], h[1]); hi.y = cvt_pk_bf16(h[2], h[3]);
                    u32x2 lo; lo.x = cvt_pk_bf16(h[0] - bf_lo(hi.x), h[1] - bf_hi(hi.x)); lo.y = cvt_pk_bf16(h[2] - bf_lo(hi.y), h[3] - bf_hi(hi.y));
                    LAS unsigned char* dp = img + (w * 4 + tk) * RT_ROW + (4 * lane + 256 * j) * 2;
                    *(LAS u32x2*)dp = hi; *(LAS u32x2*)(dp + RT_IMG) = lo; } }
            __syncthreads();
            f32x4 acc[2][2];
#pragma unroll
            for (int mt = 0; mt < 2; ++mt)
#pragma unroll
                for (int nt = 0; nt < 2; ++nt) acc[mt][nt] = (f32x4){0.f, 0.f, 0.f, 0.f};
#pragma unroll
            for (int mt = 0; mt < 2; ++mt) { const LAS unsigned char* ap = img + (16 * mt + (lane & 15)) * RT_ROW + (128 * w + 8 * (lane >> 4)) * 2;
#pragma unroll
                for (int ks = 0; ks < 4; ++ks) { const bf16x8 ah = *(const LAS bf16x8*)(ap + ks * 64), al = *(const LAS bf16x8*)(ap + RT_IMG + ks * 64);
#pragma unroll
                    for (int nt = 0; nt < 2; ++nt) {
                        acc[mt][nt] = __builtin_amdgcn_mfma_f32_16x16x32_bf16(ah, bh[ks][nt], acc[mt][nt], 0, 0, 0);
                        acc[mt][nt] = __builtin_amdgcn_mfma_f32_16x16x32_bf16(ah, bl[ks][nt], acc[mt][nt], 0, 0, 0);
                        acc[mt][nt] = __builtin_amdgcn_mfma_f32_16x16x32_bf16(al, bh[ks][nt], acc[mt][nt], 0, 0, 0); } } }
            __syncthreads();
#pragma unroll
            for (int mt = 0; mt < 2; ++mt)
#pragma unroll
                for (int nt = 0; nt < 2; ++nt)
#pragma unroll
                    for (int r = 0; r < 4; ++r) part[(w * 32 + 16 * mt + 4 * (lane >> 4) + r) * 32 + 16 * nt + (lane & 15)] = acc[mt][nt][r];
            __syncthreads();
#pragma unroll
            for (int qq = 0; qq < 2; ++qq) { const int p = F.tid + 512 * qq, tok = p >> 5, e = p & 31; float sum = F.b_router[e];
#pragma unroll
                for (int ww = 0; ww < 8; ++ww) sum += part[(ww * 32 + tok) * 32 + e];
                lgt[tok * 33 + e] = sum; }
            __syncthreads();
            if (F.tid < 32) {
                float lg[32];
#pragma unroll
                for (int e = 0; e < 32; ++e) lg[e] = lgt[F.tid * 33 + e];
                int idx[4]; float val[4]; unsigned taken = 0u;
#pragma unroll
                for (int r = 0; r < 4; ++r) { float best = -INFINITY; int bi = 0;
#pragma unroll
                    for (int e = 0; e < 32; ++e) { const bool ok = !((taken >> e) & 1u) && (lg[e] > best); best = ok ? lg[e] : best; bi = ok ? e : bi; }
                    idx[r] = bi; val[r] = best; taken |= 1u << bi; }
                const float e1 = __expf(val[1] - val[0]), e2 = __expf(val[2] - val[0]), e3 = __expf(val[3] - val[0]); const float inv = 1.0f / (1.0f + e1 + e2 + e3);
                const int tl = half * 32 + F.tid;
                sel_e[tl * 4 + 0] = idx[0]; sel_e[tl * 4 + 1] = idx[1]; sel_e[tl * 4 + 2] = idx[2]; sel_e[tl * 4 + 3] = idx[3];
                sel_g[tl * 4 + 0] = inv; sel_g[tl * 4 + 1] = e1 * inv; sel_g[tl * 4 + 2] = e2 * inv; sel_g[tl * 4 + 3] = e3 * inv; }
            __syncthreads();
        }
        int myrank = 0, mye = 0;
        if (F.tid < 256) { mye = sel_e[F.tid]; myrank = atomicAdd((int*)&lcnt[mye], 1); }
        __syncthreads();
        if (F.tid < 32) { const int c = lcnt[F.tid]; lbase[F.tid] = c ? (int)__hip_atomic_fetch_add(F.ctl + CW_CNT + F.tid, (unsigned)c, __ATOMIC_RELAXED, __HIP_MEMORY_SCOPE_AGENT) : 0; lcnt[F.tid] = 0; }
        __syncthreads();
        if (F.tid < 256) { const int slot = (chunk * 64 + (F.tid >> 2)) * 4 + (F.tid & 3); F.list[mye * T + lbase[mye] + myrank] = slot; F.gates[slot] = sel_g[F.tid]; F.einfo[slot] = mye | ((lbase[mye] + myrank) << 8); }
        __syncthreads();
    }
}

template <bool G1> __device__ __forceinline__ int moe_tables(Frame& F, int NPN) {
    LAS int* cnt = (LAS int*)(F.lds + TAB_OFF); LAS int* tstart = cnt + 32; LAS int* rowtab = (LAS int*)(F.lds + ROWTAB_OFF);
    if (F.tid < 32) cnt[F.tid] = (int)__hip_atomic_load(F.ctl + CW_CNT + F.tid, __ATOMIC_RELAXED, __HIP_MEMORY_SCOPE_AGENT);
    __syncthreads();
    if (F.tid == 0) { int acc = 0; for (int e = 0; e < NE; ++e) { tstart[e] = acc; acc += (cnt[e] + 255) >> 8; } tstart[NE] = acc; }
    __syncthreads();
    const int ntiles = tstart[NE], nU = ntiles * NPN;
    for (int i = 0; i < MAXU; ++i) { const int L = i * F.G + F.vcu; if (L >= nU) break;
        const int tl = L / NPN; int e = 0;
        for (int j = 1; j < NE; ++j) e += (tstart[j] <= tl) ? 1 : 0;
        const int mt = tl - tstart[e];
        if (F.tid < 256) { const int rank = mt * 256 + F.tid; const int slot = rank < cnt[e] ? F.list[e * T + rank] : -1;
            rowtab[i * 256 + F.tid] = G1 ? ((slot < 0 ? 0 : (slot >> 2)) * D) : slot; } }
    __syncthreads();
    return ntiles;
}

__device__ __forceinline__ void p7_final(Frame& F) {
    LAS int* cnt = (LAS int*)(F.lds + TAB_OFF); LAS int* tstart = cnt + 32;
    if (F.tid < 32) cnt[F.tid] = (int)__hip_atomic_load(F.ctl + CW_CNT + F.tid, __ATOMIC_RELAXED, __HIP_MEMORY_SCOPE_AGENT);
    __syncthreads();
    if (F.tid == 0) { int acc = 0; for (int e = 0; e < NE; ++e) { tstart[e] = acc; acc += (cnt[e] + 255) >> 8; } tstart[NE] = acc; }
    __syncthreads();
    const int gw = blockIdx.x * 8 + F.wave, NGW = F.G * 8;
    for (int row = gw; row < T; row += NGW) {
        float* hp = F.out + (size_t)row * D; float v[16];
#pragma unroll
        for (int j = 0; j < 2; ++j) { const f32x4 a = *(const f32x4*)(hp + 512 * j + F.lane * 8), b = *(const f32x4*)(hp + 512 * j + F.lane * 8 + 4);
#pragma unroll
            for (int i = 0; i < 4; ++i) { v[8 * j + i] = a[i] * DN_ALPHA; v[8 * j + 4 + i] = b[i] * DN_ALPHA; } }
#pragma unroll
        for (int k = 0; k < TOPK; ++k) { const int info = F.einfo[row * TOPK + k]; const float gt = F.gates[row * TOPK + k];
            const size_t pos = ((size_t)tstart[info & 255] << 8) + (size_t)(info >> 8);
#pragma unroll
            for (int j = 0; j < 2; ++j) { const u32x4 r = *(const u32x4*)(F.Y + pos * D + 512 * j + F.lane * 8); const unsigned w[4] = {r.x, r.y, r.z, r.w};
#pragma unroll
                for (int i = 0; i < 4; ++i) { v[8 * j + 2 * i] += gt * bf_lo(w[i]); v[8 * j + 2 * i + 1] += gt * bf_hi(w[i]); } } }
        float s = 0.f;
#pragma unroll
        for (int i = 0; i < 16; ++i) s += v[i];
        const float mu = wave_sum(s) * (1.f / D); float q = 0.f;
#pragma unroll
        for (int i = 0; i < 16; ++i) { v[i] -= mu; q += v[i] * v[i]; }
        const float rstd = 1.0f / sqrtf(wave_sum(q) * (1.f / D) + LN_EPS);
#pragma unroll
        for (int j = 0; j < 2; ++j) { const int c = 512 * j + F.lane * 8;
            const f32x4 g0 = *(const f32x4*)(F.ln2_g + c), g1 = *(const f32x4*)(F.ln2_g + c + 4), b0 = *(const f32x4*)(F.ln2_b + c), b1 = *(const f32x4*)(F.ln2_b + c + 4);
            f32x4 o0, o1;
#pragma unroll
            for (int i = 0; i < 4; ++i) { o0[i] = v[8 * j + i] * rstd * g0[i] + b0[i]; o1[i] = v[8 * j + 4 + i] * rstd * g1[i] + b1[i]; }
            *(f32x4*)(hp + c) = o0; *(f32x4*)(hp + c + 4) = o1; }
    }
}

__device__ __forceinline__ bool fresh(Frame& F) {
    int t = threadIdx.x; asm volatile("" : "+v"(t)); F.tid = t; F.lane = t & 63;
    const __attribute__((address_space(4))) Args* ap = (const __attribute__((address_space(4))) Args*)__builtin_amdgcn_kernarg_segment_ptr(); asm volatile("" : "+s"(ap));
    F.x = ap->in[0]; F.w_in = ap->in[1]; F.sgu_w = ap->in[2]; F.sgu_b = ap->in[3]; F.sgu_ln_g = ap->in[4]; F.sgu_ln_b = ap->in[5]; F.mix_g = ap->in[6]; F.w_out = ap->in[7];
    F.ln1_g = ap->in[8]; F.ln1_b = ap->in[9]; F.w_router = ap->in[10]; F.b_router = ap->in[11]; F.w_gate = ap->in[12]; F.b_gate = ap->in[13]; F.w_up = ap->in[14]; F.b_up = ap->in[15];
    F.w_down = ap->in[16]; F.b_down = ap->in[17]; F.ln2_g = ap->in[18]; F.ln2_b = ap->in[19]; F.out = ap->out; F.ws = ap->ws;
    unsigned char* ws = ap->ws;
    F.ctl = (unsigned*)(ws + WS_CTL); F.list = (int*)(ws + WS_LIST); F.einfo = (int*)(ws + WS_EINFO); F.gates = (float*)(ws + WS_GATES);
    F.Win_t = (bf16_t*)(ws + WS_WIN); F.Wout_t = (bf16_t*)(ws + WS_WOUT); F.Wd_t = (act_t*)(ws + WS_WD); F.Wgu_t = (fp8_t*)(ws + WS_WGU); F.Y = (bf16_t*)(ws + WS_Y);
    F.Hb = (fp8_t*)(ws + WS_HB); F.Xb = (bf16_t*)(ws + WS_XB); F.P1 = (bf16_t*)(ws + WS_P1); F.Amix = (bf16_t*)(ws + WS_AMIX); F.Act = (act_t*)(ws + WS_ACT);
    F.WrtHi = (bf16_t*)(ws + WS_WRT); F.Opart = (bf16_t*)(ws + WS_OPART); F.ML = (float*)(ws + WS_ML);
    return true; }
constexpr int N_PHASES = 8;
__global__ void __launch_bounds__(512, 2) mk_fwd(Args args) {
    extern __shared__ __attribute__((aligned(16))) unsigned char lds_raw[];
    Frame F;
    F.lds = (LAS unsigned char*)lds_raw; F.tid = threadIdx.x; F.lane = F.tid & 63; F.wave = __builtin_amdgcn_readfirstlane(F.tid >> 6);
    F.G = gridDim.x; { const int bx = blockIdx.x; F.vcu = (F.G % 8 == 0) ? (bx % 8) * (F.G / 8) + bx / 8 : bx; }
    fresh(F);
    unsigned char* ws = F.ws;
    const int lo = args.ph_lo, hi = args.ph_hi;
    volatile LAS unsigned* misc = (volatile LAS unsigned*)(F.lds + MISC_OFF);
    if (F.tid < 16) misc[F.tid] = 0u;
    __syncthreads();
    XcdBarrier bar; bar.bar = F.ctl + CW_BAR; bar.x = 0; bar.st = misc;
    if (hi - lo > 1) bar = xcd_barrier_post(F.ctl + CW_BAR, misc);
    const LAS int* rowtab = (const LAS int*)(F.lds + ROWTAB_OFF);
#ifndef PROBE_DUP
#define PROBE_DUP -1
#endif
#define IN(k) (lo <= (k) && (k) < hi && fresh(F))
#define SEAM(k) do { if (lo <= (k) && (k) + 1 < hi) { xcd_barrier(bar); } } while (0)
#define REP(k) for (int _rep = 0; _rep < ((PROBE_DUP == (k)) ? 2 : 1); ++_rep)
    if (IN(0)) REP(0) { p0_convert(F); }
    SEAM(0);
    if (IN(1)) REP(1) {
        pg8::Gemm g{F.Xb, F.Win_t, D * 2}; pg8::EpiP1 E{F.P1}; constexpr int NU1 = (T / 256) * (INC / 256);
        int nun = 0; for (int i = 0; i * F.G + F.vcu < NU1; ++i) ++nun;
        int pos = 0, first = (F.vcu * 8 + F.wave) * (MOE_ITEMS / (F.G * 8) + 1), count = MOE_ITEMS / (F.G * 8) + 1;
        if (F.G == 256) { if (nun == 3) { pos = F.vcu & 3; count = 9; first = (F.vcu * 8 + F.wave) * 9; } else { pos = F.vcu % 3; count = 15; first = 9216 + ((F.vcu - 128) * 8 + F.wave) * 15; } }
        { pg8::DenseOrder S{INC / 256, NU1, F.G, F.vcu, 0, pos}; pg8::gemm_phase<pg8::EpiP1, pg8::DenseOrder, false, false>(F.lds, rowtab, g, S, E); }
        moe_convert_items(F, first, count);
        __syncthreads();
        { pg8::DenseOrder S{INC / 256, NU1, F.G, F.vcu, pos, 1 << 20}; pg8::gemm_phase<pg8::EpiP1, pg8::DenseOrder, false, false>(F.lds, rowtab, g, S, E); } }
    SEAM(1);
    if (IN(2)) REP(2) { p2_mixers(F); }
    SEAM(2);
    if (IN(3)) REP(3) { p3_merge(F); }
    SEAM(3);
    if (IN(4)) REP(4) { pg8::Gemm g{F.Amix, F.Wout_t, D * 2}; pg8::DenseOrder S{D / 256, (T / 256) * (D / 256), F.G, F.vcu, 0, 1 << 20}; pg8::EpiZ E{F.x, F.out};
        pg8::gemm_phase<pg8::EpiZ, pg8::DenseOrder, false, false>(F.lds, rowtab, g, S, E); }
    SEAM(4);
    if (IN(5)) { p4_route(F); }
    SEAM(5);
    if (IN(6)) REP(6) { const int ntiles = moe_tables<true>(F, 8); pg8::Gemm g{F.Hb, F.Wgu_t, D}; pg8::MoeOrder S{8, ntiles * 8, F.G, F.vcu, (const LAS int*)(F.lds + TAB_OFF) + 32};
        pg8::EpiSwiglu E{F.Act, F.b_gate, F.b_up};
        pg8::gemm_phase<pg8::EpiSwiglu, pg8::MoeOrder, true, true>(F.lds, rowtab, g, S, E); }
    SEAM(6);
    if (IN(7)) REP(7) { const int ntiles = moe_tables<false>(F, 4); pg8::Gemm g{F.Act, F.Wd_t, FF * (int)sizeof(act_t)}; pg8::MoeOrder S{4, ntiles * 4, F.G, F.vcu, (const LAS int*)(F.lds + TAB_OFF) + 32};
        pg8::EpiY E{F.Y, F.b_down};
        pg8::gemm_phase<pg8::EpiY, pg8::MoeOrder, false, (G2_FP8 != 0)>(F.lds, rowtab, g, S, E); }
    SEAM(7);
    if (IN(8)) { p7_final(F); }
#undef IN
#undef SEAM
}

extern "C" void kernel_launch(void* const* d_in, const int* in_sizes, int n_in, void* d_out, int out_size, void* d_ws, size_t ws_size, hipStream_t stream) {
    static int grid = 0;
    if (grid == 0) {
        if (n_in != 20 || in_sizes[0] != T * D || out_size != T * D || ws_size < WS_END) { fprintf(stderr, "kernel_launch: unexpected shapes (n_in %d, in0 %d, out %d, ws %zu)\n", n_in, n_in > 0 ? in_sizes[0] : -1, out_size, ws_size); grid = -1; return; }
        int dev = 0, cus = 0, per_cu = 0;
        hipGetDevice(&dev); hipDeviceGetAttribute(&cus, hipDeviceAttributeMultiprocessorCount, dev);
        if (hipFuncSetAttribute((const void*)mk_fwd, hipFuncAttributeMaxDynamicSharedMemorySize, LDS_BYTES) != hipSuccess) { fprintf(stderr, "kernel_launch: hipFuncSetAttribute failed\n"); grid = -1; return; }
        hipOccupancyMaxActiveBlocksPerMultiprocessor(&per_cu, (const void*)mk_fwd, 512, LDS_BYTES);
        (void)hipGetLastError();
        if (per_cu < 1) { fprintf(stderr, "kernel_launch: occupancy query says %d blocks/CU: the grid would not be resident; nothing launched\n", per_cu); grid = -1; return; }
        grid = cus;
        if (grid != 256) fprintf(stderr, "kernel_launch: note: %d CUs (tuned for 256)\n", grid);
    }
    if (grid < 0) return;
    hipMemsetAsync((char*)d_ws + WS_CTL, 0, CTL_ZERO_BYTES, stream);
    Args a{};
    for (int i = 0; i < 20; ++i) a.in[i] = (const float*)d_in[i];
    a.out = (float*)d_out; a.ws = (unsigned char*)d_ws;
#if MK_N_LAUNCHES == 1
    a.ph_lo = 0; a.ph_hi = N_PHASES + 1;
    hipLaunchKernelGGL(mk_fwd, dim3(grid), dim3(512), LDS_BYTES, stream, a);
#else
    for (int p = 0; p <= N_PHASES; ++p) { a.ph_lo = p; a.ph_hi = p + 1; hipLaunchKernelGGL(mk_fwd, dim3(grid), dim3(512), LDS_BYTES, stream, a); }
#endif
}
```

```cpp
#include <hip/hip_runtime.h>
#include <hip/hip_cooperative_groups.h>
#include <cstdio>
#include <cstdint>
namespace cg = cooperative_groups;

#ifndef MK_N_LAUNCHES
#define MK_N_LAUNCHES 1
#endif

constexpr int BATCH = 4, SEQ = 4096, T = BATCH * SEQ, D = 1024, INC = 2560, NE = 32, FF = 1024, TOPK = 4;
constexpr int AW = 512, NGRP = 8, GD = 64, CHUNK = 128, NH = 8, HD = 64;
constexpr float LN_EPS = 1e-5f, DN_ALPHA = 1.189207115002721f;
constexpr int NSLOT = T * TOPK;
constexpr int MAXTILES = 288;
constexpr int MAXU = 12;

constexpr size_t MiB = 1u << 20;
constexpr size_t WS_CTL = 0, CTL_ZERO_BYTES = 64 * 1024;
constexpr size_t WS_LIST = 1 * MiB;
constexpr size_t WS_GATES = 3 * MiB;
constexpr size_t WS_EINFO = 3 * MiB + 256 * 1024;
constexpr size_t WS_WRT = 3 * MiB + 512 * 1024;
constexpr size_t WS_WIN = 4 * MiB;
constexpr size_t WS_WOUT = 9 * MiB;
constexpr size_t WS_WD = 11 * MiB;
constexpr size_t WS_WGU = 75 * MiB;
constexpr size_t WS_HB = 139 * MiB;
constexpr size_t WS_BIG = 155 * MiB;
constexpr size_t WS_XB = WS_BIG;
constexpr size_t WS_P1 = WS_BIG + 32 * MiB;
constexpr size_t WS_AMIX = WS_BIG + 112 * MiB;
constexpr size_t WS_ACT = WS_BIG;
constexpr size_t WS_Y = 299 * MiB;
constexpr size_t WS_OPART = 427 * MiB;
constexpr size_t WS_ML = 475 * MiB;
constexpr size_t WS_END = 478 * MiB;
#ifndef G2_FP8
#define G2_FP8 1
#endif
constexpr float WGU_SCALE = 32.0f, WD_SCALE = G2_FP8 ? 64.0f : 1.0f;
#if G2_FP8
typedef unsigned char act_t;
#else
typedef unsigned short act_t;
#endif
constexpr int CW_BAR = 1024;
constexpr int CW_CNT = 0;

constexpr int RING_BYTES = 131072;
constexpr int TAB_OFF = RING_BYTES + 1024;
constexpr int ROWTAB_OFF = RING_BYTES + 2048;
constexpr int MISC_OFF = 147456 - 64;
constexpr int LDS_BYTES = 147456;
static_assert(ROWTAB_OFF + MAXU * 1024 <= LDS_BYTES, "LDS map");

#define LAS __attribute__((address_space(3)))
typedef unsigned short bf16_t;
typedef unsigned char fp8_t;
typedef short bf16x8 __attribute__((ext_vector_type(8)));
typedef float f32x4 __attribute__((ext_vector_type(4)));
typedef float f32x2 __attribute__((ext_vector_type(2)));
typedef unsigned u32x4 __attribute__((ext_vector_type(4)));
typedef unsigned u32x2 __attribute__((ext_vector_type(2)));
typedef int v8i32 __attribute__((ext_vector_type(8)));
typedef int v4i32 __attribute__((ext_vector_type(4)));


__device__ __forceinline__ unsigned cvt_pk_bf16(float lo, float hi) { unsigned r; asm volatile("v_cvt_pk_bf16_f32 %0, %1, %2" : "=v"(r) : "v"(lo), "v"(hi)); return r; }
__device__ __forceinline__ unsigned cvt4_fp8(float a, float b, float c, float d) { int w = 0; w = __builtin_amdgcn_cvt_pk_fp8_f32(a, b, w, false); w = __builtin_amdgcn_cvt_pk_fp8_f32(c, d, w, true); return (unsigned)w; }
__device__ __forceinline__ float bf_lo(unsigned w) { return __uint_as_float(w << 16); }
__device__ __forceinline__ float bf_hi(unsigned w) { return __uint_as_float(w & 0xffff0000u); }
__device__ __forceinline__ float bf1(bf16_t b) { return __uint_as_float((unsigned)b << 16); }
__device__ __forceinline__ float wave_sum(float v) {
#pragma unroll
    for (int o = 1; o < 64; o <<= 1) v += __shfl_xor(v, o);
    return v;
}
__device__ __forceinline__ float gelu_tanh(float x) {
    const float y2 = x * (1.5957691216057308f + 0.07135481627260025f * x * x);
    return x * __builtin_amdgcn_rcpf(1.0f + __builtin_amdgcn_exp2f(-1.4426950408889634f * y2));
}

namespace pg8 {
constexpr int BM = 256, BK = 64, HALF = 128, HTB = HALF * BK * 2, STAGE_BYTES = 8 * HTB;
__host__ __device__ __forceinline__ int lds_byte(int r, int c) { const int st = (r >> 4) * 2 + (c >> 5), rr = r & 15, cc = c & 31, ob = rr * 64 + cc * 2; return st * 1024 + (ob ^ (((ob >> 9) & 1) << 5)); }
__host__ __device__ __forceinline__ void stage_rc(int b, int& R, int& C) { const int st = b / 1024, sb = b % 1024, swz = sb ^ (((sb >> 9) & 1) << 5); R = (st >> 1) * 16 + swz / 64; C = (st & 1) * 32 + (swz % 64) / 2; }
__host__ __device__ __forceinline__ int perm32(int rho) { const int n = rho >> 4, i = rho & 15; return 8 * (i >> 2) + 4 * n + (i & 3); }

struct Unit { int pm, pn, pb, e, mt, ui; };
struct Gemm { const void* A; const void* Bt; int KB; };

struct DenseOrder {
    int nN, nU, G, v, i0, i1;
    __device__ __forceinline__ bool next(int i, Unit& u) const {
        i += i0; if (i >= i1) return false;
        const int L = i * G + v; if (L >= nU) return false;
        u.pm = L / nN; u.pn = L % nN; u.pb = u.pn; u.e = 0; u.mt = 0; u.ui = i; return true; }
};
struct MoeOrder {
    int NPN, nU, G, v; const LAS int* tstart; int i0, i1;
    __device__ __forceinline__ bool next(int i, Unit& u) const {
        i += i0; if (i >= i1) return false;
        const int L = i * G + v; if (L >= nU) return false;
        const int tl = L / NPN, pn = L % NPN; int e = 0;
#pragma unroll
        for (int j = 1; j < NE; ++j) e += (tstart[j] <= tl) ? 1 : 0;
        e = __builtin_amdgcn_readfirstlane(e); const int ts = __builtin_amdgcn_readfirstlane(tstart[e]);
        u.pm = tl; u.pn = pn; u.pb = e * NPN + pn; u.e = e; u.mt = tl - ts; u.ui = i; return true; }
};

template <class Epi, class Sched, bool GATHER, bool FP8>
__device__ __forceinline__ void gemm_phase(LAS unsigned char* lds, const LAS int* rowtab, const Gemm g, const Sched& S, const Epi& E) {
    const int tid = threadIdx.x, wid = __builtin_amdgcn_readfirstlane(tid >> 6), lane = tid & 63, wr = wid >> 2, wc = wid & 3, fr = lane & 15, fq = lane >> 4;
    const int KB = g.KB, nt = KB / (BK * 2);
    unsigned voffA0[2], voffA1[2], voffB[2]; int Rr[2], Cc[2];
#pragma unroll
    for (int i = 0; i < 2; ++i) { int R, C; stage_rc(tid * 16 + i * 8192, R, C); const int Rb = Epi::PERM ? ((R & ~31) + perm32(R & 31)) : R; Rr[i] = R; Cc[i] = C;
        voffA0[i] = (unsigned)(R * KB + C * 2); voffA1[i] = (unsigned)((R + HALF) * KB + C * 2); voffB[i] = (unsigned)(Rb * KB + C * 2); }
    const unsigned kstep = (unsigned)(BK * 2);
    const unsigned hstep = (unsigned)HALF * (unsigned)KB;
    const unsigned tstep = 2u * hstep;
    const __amdgpu_buffer_rsrc_t rsA = __builtin_amdgcn_make_buffer_rsrc(const_cast<void*>(g.A), 0, -1, 0x00020000);
    const __amdgpu_buffer_rsrc_t rsB = __builtin_amdgcn_make_buffer_rsrc(const_cast<void*>(g.Bt), 0, -1, 0x00020000);
    const unsigned ldsw = (unsigned)wid * 1024u;
    const int aoff = lds_byte(wr * 64 + fr, fq * 8), boff = lds_byte(wc * 32 + fr, fq * 8);
#define PG8_SA(b, h) (((b) * 2 + (h)) * HTB)
#define PG8_SB(b, h) ((4 + (b) * 2 + (h)) * HTB)
#define PG8_STAGE(bufoff, rs, soff, voff) do { _Pragma("unroll") for (int _i = 0; _i < 2; ++_i) \
        __builtin_amdgcn_raw_ptr_buffer_load_lds(rs, (LAS void*)(lds + (bufoff) + ldsw + _i * 8192), 16, (int)(voff)[_i], (int)(soff), 0, 0); } while (0)
#define PG8_LDA(dst, b, h) do { if constexpr (FP8) { _Pragma("unroll") for (int m = 0; m < 4; ++m) dst##8[m] = __builtin_shufflevector(*(const LAS v4i32*)(lds + PG8_SA(b, h) + aoff + m * 2048), *(const LAS v4i32*)(lds + PG8_SA(b, h) + aoff + m * 2048 + 1024), 0, 1, 2, 3, 4, 5, 6, 7); } \
        else { _Pragma("unroll") for (int m = 0; m < 4; ++m) _Pragma("unroll") for (int k = 0; k < 2; ++k) dst[m][k] = *(const LAS bf16x8*)(lds + PG8_SA(b, h) + aoff + m * 2048 + k * 1024); } } while (0)
#define PG8_LDB(dst, b, h) do { if constexpr (FP8) { _Pragma("unroll") for (int n = 0; n < 2; ++n) dst##8[n] = __builtin_shufflevector(*(const LAS v4i32*)(lds + PG8_SB(b, h) + boff + n * 2048), *(const LAS v4i32*)(lds + PG8_SB(b, h) + boff + n * 2048 + 1024), 0, 1, 2, 3, 4, 5, 6, 7); } \
        else { _Pragma("unroll") for (int n = 0; n < 2; ++n) _Pragma("unroll") for (int k = 0; k < 2; ++k) dst[n][k] = *(const LAS bf16x8*)(lds + PG8_SB(b, h) + boff + n * 2048 + k * 1024); } } while (0)
#define PG8_MMA(ai, bj, At, Bt) do { __builtin_amdgcn_s_setprio(1); if constexpr (FP8) { _Pragma("unroll") for (int m = 0; m < 4; ++m) _Pragma("unroll") for (int n = 0; n < 2; ++n) \
        acc[ai][bj][m][n] = __builtin_amdgcn_mfma_scale_f32_16x16x128_f8f6f4(Bt##8[n], At##8[m], acc[ai][bj][m][n], 0, 0, 0, 0x7F7F7F7F, 0, 0x7F7F7F7F); } \
        else { _Pragma("unroll") for (int m = 0; m < 4; ++m) _Pragma("unroll") for (int n = 0; n < 2; ++n) _Pragma("unroll") for (int k = 0; k < 2; ++k) \
        acc[ai][bj][m][n] = __builtin_amdgcn_mfma_f32_16x16x32_bf16(Bt[n][k], At[m][k], acc[ai][bj][m][n], 0, 0, 0); } __builtin_amdgcn_s_setprio(0); } while (0)
#define PG8_WAIT_V(n) asm volatile("s_waitcnt vmcnt(" #n ")" ::: "memory")
#define PG8_WAIT_L(n) asm volatile("s_waitcnt lgkmcnt(" #n ")" ::: "memory")
#define PG8_BAR __builtin_amdgcn_s_barrier()
#define PG8_SCHED __builtin_amdgcn_sched_barrier(0)
#define PG8_LOADROWS(U) do { if constexpr (GATHER) { _Pragma("unroll") for (int _i = 0; _i < 2; ++_i) { \
        voffA0[_i] = (unsigned)rowtab[(U).ui * 256 + Rr[_i]] + (unsigned)Cc[_i] * 2u; voffA1[_i] = (unsigned)rowtab[(U).ui * 256 + HALF + Rr[_i]] + (unsigned)Cc[_i] * 2u; } } } while (0)
    Unit cur, nxt; int ui = 0;
    if (!S.next(0, cur)) return;
    f32x4 acc[2][2][4][2];
#pragma unroll
    for (int a = 0; a < 2; ++a)
#pragma unroll
        for (int b = 0; b < 2; ++b)
#pragma unroll
            for (int m = 0; m < 4; ++m)
#pragma unroll
                for (int n = 0; n < 2; ++n) acc[a][b][m][n] = (f32x4){0.f, 0.f, 0.f, 0.f};
    bf16x8 At[4][2], B0[2][2], B1[2][2]; v8i32 At8[4], B08[2], B18[2];
    unsigned cA = GATHER ? 0u : (unsigned)cur.pm * tstep, cB = (unsigned)cur.pb * tstep;
    PG8_LOADROWS(cur); PG8_WAIT_L(0);
    PG8_STAGE(PG8_SB(0, 0), rsB, cB, voffB); PG8_STAGE(PG8_SB(0, 1), rsB, cB + hstep, voffB); PG8_STAGE(PG8_SA(0, 0), rsA, cA, voffA0); PG8_STAGE(PG8_SA(0, 1), rsA, cA, voffA1);
    if (wr == 1) PG8_BAR;
    PG8_WAIT_V(2); PG8_BAR;
    PG8_STAGE(PG8_SB(1, 0), rsB, cB + kstep, voffB); PG8_STAGE(PG8_SA(1, 0), rsA, cA + kstep, voffA0); PG8_STAGE(PG8_SB(1, 1), rsB, cB + hstep + kstep, voffB);
    PG8_WAIT_V(6); PG8_BAR;
    for (;;) {
        const bool has_next = S.next(ui + 1, nxt);
        const unsigned nA = has_next ? (GATHER ? 0u : (unsigned)nxt.pm * tstep) : cA, nB = has_next ? (unsigned)nxt.pb * tstep : cB;
#pragma unroll 1
        for (int t = 0; t < nt; t += 2) {
            const bool last = (t == nt - 2);
            const unsigned a1 = cA + (unsigned)(t + 1) * kstep;
            const unsigned a2 = last ? nA : cA + (unsigned)(t + 2) * kstep, b2 = last ? nB : cB + (unsigned)(t + 2) * kstep;
            const unsigned a3 = a2 + kstep, b3 = b2 + kstep;
            PG8_LDB(B0, 0, 0); PG8_LDB(B1, 0, 1); PG8_SCHED; PG8_LDA(At, 0, 0); PG8_STAGE(PG8_SA(1, 1), rsA, a1, voffA1);
            if (last && has_next) PG8_LOADROWS(nxt);
            PG8_WAIT_V(8); PG8_WAIT_L(0); PG8_BAR; PG8_MMA(0, 0, At, B0); PG8_MMA(0, 1, At, B1); PG8_BAR; PG8_SCHED;
            PG8_LDA(At, 0, 1); PG8_STAGE(PG8_SB(0, 0), rsB, b2, voffB); PG8_STAGE(PG8_SB(0, 1), rsB, b2 + hstep, voffB); PG8_STAGE(PG8_SA(0, 0), rsA, a2, voffA0);
            PG8_WAIT_V(8); PG8_WAIT_L(0); PG8_BAR; PG8_MMA(1, 0, At, B0); PG8_MMA(1, 1, At, B1); PG8_BAR; PG8_SCHED;
            PG8_LDB(B0, 1, 0); PG8_LDB(B1, 1, 1); PG8_SCHED; PG8_LDA(At, 1, 0); PG8_STAGE(PG8_SA(0, 1), rsA, a2, voffA1);
            PG8_WAIT_V(8); PG8_WAIT_L(0); PG8_BAR; PG8_MMA(0, 0, At, B0); PG8_MMA(0, 1, At, B1); PG8_BAR; PG8_SCHED;
            PG8_LDA(At, 1, 1); PG8_STAGE(PG8_SB(1, 0), rsB, b3, voffB); PG8_STAGE(PG8_SB(1, 1), rsB, b3 + hstep, voffB); PG8_STAGE(PG8_SA(1, 0), rsA, a3, voffA0);
            PG8_WAIT_V(8); PG8_WAIT_L(0); PG8_BAR; PG8_MMA(1, 0, At, B0); PG8_MMA(1, 1, At, B1); PG8_BAR; PG8_SCHED;
        }
        if (wr == 0) PG8_BAR;
        { int t2 = threadIdx.x; asm volatile("" : "+v"(t2));
          const int w2 = __builtin_amdgcn_readfirstlane(t2 >> 6), l2 = t2 & 63; E(acc, cur, w2 >> 2, w2 & 3, l2 & 15, l2 >> 4); }
        if (!has_next) break;
#pragma unroll
        for (int a = 0; a < 2; ++a)
#pragma unroll
            for (int b = 0; b < 2; ++b)
#pragma unroll
                for (int m = 0; m < 4; ++m)
#pragma unroll
                    for (int n = 0; n < 2; ++n) acc[a][b][m][n] = (f32x4){0.f, 0.f, 0.f, 0.f};
        cur = nxt; cA = nA; cB = nB; ++ui;
        if (wr == 1) PG8_BAR;
    }
    PG8_WAIT_V(0);
    PG8_BAR;
#undef PG8_SA
#undef PG8_SB
#undef PG8_STAGE
#undef PG8_LDA
#undef PG8_LDB
#undef PG8_MMA
#undef PG8_WAIT_V
#undef PG8_WAIT_L
#undef PG8_BAR
#undef PG8_SCHED
#undef PG8_LOADROWS
}

struct EpiP1 {
    static constexpr bool PERM = true;
    bf16_t* O;
    __device__ __forceinline__ void operator()(const f32x4 (&acc)[2][2][4][2], const Unit& u, int wr, int wc, int fr, int fq) const {
        const int row0 = u.pm * BM + wr * 64 + fr, col0 = u.pn * BM + wc * 32 + 8 * fq; const bool act = u.pn < 4;
#pragma unroll
        for (int ai = 0; ai < 2; ++ai)
#pragma unroll
            for (int m = 0; m < 4; ++m) { bf16_t* rowp = O + (size_t)(row0 + ai * HALF + m * 16) * INC + col0;
#pragma unroll
                for (int bj = 0; bj < 2; ++bj) { f32x4 v0 = acc[ai][bj][m][0], v1 = acc[ai][bj][m][1];
                    if (act) {
#pragma unroll
                        for (int j = 0; j < 4; ++j) { v0[j] = gelu_tanh(v0[j]); v1[j] = gelu_tanh(v1[j]); } }
                    u32x4 w; w.x = cvt_pk_bf16(v0[0], v0[1]); w.y = cvt_pk_bf16(v0[2], v0[3]); w.z = cvt_pk_bf16(v1[0], v1[1]); w.w = cvt_pk_bf16(v1[2], v1[3]);
                    *(u32x4*)(rowp + bj * HALF) = w; } }
    }
};
struct EpiZ {
    static constexpr bool PERM = false;
    const float* X; float* Z;
    __device__ __forceinline__ void operator()(const f32x4 (&acc)[2][2][4][2], const Unit& u, int wr, int wc, int fr, int fq) const {
        const int col0 = u.pn * BM + wc * 32 + 4 * fq;
#pragma unroll
        for (int ai = 0; ai < 2; ++ai)
#pragma unroll
            for (int m = 0; m < 4; ++m) { const size_t off = (size_t)(u.pm * BM + ai * HALF + wr * 64 + m * 16 + fr) * D + col0;
#pragma unroll
                for (int bj = 0; bj < 2; ++bj)
#pragma unroll
                    for (int n = 0; n < 2; ++n) { const f32x4 xv = *(const f32x4*)(X + off + bj * HALF + n * 16); *(f32x4*)(Z + off + bj * HALF + n * 16) = xv * DN_ALPHA + acc[ai][bj][m][n]; } }
    }
};
struct EpiSwiglu {
    static constexpr bool PERM = true;
    act_t* Act; const float* bg; const float* bu;
    __device__ __forceinline__ void operator()(const f32x4 (&acc)[2][2][4][2], const Unit& u, int wr, int wc, int fr, int fq) const {
        const int f0 = u.pn * HALF + wc * 32 + 8 * fq; const int row0 = u.pm * BM + wr * 64 + fr;
        const f32x4 bg0 = *(const f32x4*)(bg + u.e * FF + f0), bg1 = *(const f32x4*)(bg + u.e * FF + f0 + 4);
        const f32x4 bu0 = *(const f32x4*)(bu + u.e * FF + f0), bu1 = *(const f32x4*)(bu + u.e * FF + f0 + 4);
#pragma unroll
        for (int ai = 0; ai < 2; ++ai)
#pragma unroll
            for (int m = 0; m < 4; ++m) {
                f32x4 g0 = acc[ai][0][m][0] * (1.0f / WGU_SCALE) + bg0, g1 = acc[ai][0][m][1] * (1.0f / WGU_SCALE) + bg1, u0 = acc[ai][1][m][0] * (1.0f / WGU_SCALE) + bu0, u1 = acc[ai][1][m][1] * (1.0f / WGU_SCALE) + bu1, r0, r1;
#pragma unroll
                for (int j = 0; j < 4; ++j) {
                    const float ga = fminf(g0[j], 7.0f), gb = fminf(g1[j], 7.0f);
                    const float ua = fminf(fmaxf(u0[j], -7.0f), 7.0f), ub = fminf(fmaxf(u1[j], -7.0f), 7.0f);
                    r0[j] = (ua + 1.0f) * ga * __builtin_amdgcn_rcpf(1.0f + __builtin_amdgcn_exp2f(-1.702f * 1.4426950408889634f * ga));
                    r1[j] = (ub + 1.0f) * gb * __builtin_amdgcn_rcpf(1.0f + __builtin_amdgcn_exp2f(-1.702f * 1.4426950408889634f * gb)); }
                if constexpr (G2_FP8) { u32x2 w; w.x = cvt4_fp8(r0[0], r0[1], r0[2], r0[3]); w.y = cvt4_fp8(r1[0], r1[1], r1[2], r1[3]); *(u32x2*)(Act + (size_t)(row0 + ai * HALF + m * 16) * FF + f0) = w; }
                else { u32x4 w; w.x = cvt_pk_bf16(r0[0], r0[1]); w.y = cvt_pk_bf16(r0[2], r0[3]); w.z = cvt_pk_bf16(r1[0], r1[1]); w.w = cvt_pk_bf16(r1[2], r1[3]); *(u32x4*)(Act + (size_t)(row0 + ai * HALF + m * 16) * FF + f0) = w; } }
    }
};
struct EpiY {
    static constexpr bool PERM = true;
    bf16_t* Y; const float* bd;
    __device__ __forceinline__ void operator()(const f32x4 (&acc)[2][2][4][2], const Unit& u, int wr, int wc, int fr, int fq) const {
        const int c0 = u.pn * BM + wc * 32 + 8 * fq; const int row0 = u.pm * BM + wr * 64 + fr;
        f32x4 b[2][2];
#pragma unroll
        for (int bj = 0; bj < 2; ++bj) { b[bj][0] = *(const f32x4*)(bd + u.e * D + c0 + bj * HALF); b[bj][1] = *(const f32x4*)(bd + u.e * D + c0 + bj * HALF + 4); }
#pragma unroll
        for (int ai = 0; ai < 2; ++ai)
#pragma unroll
            for (int m = 0; m < 4; ++m) { bf16_t* rowp = Y + (size_t)(row0 + ai * HALF + m * 16) * D + c0;
#pragma unroll
                for (int bj = 0; bj < 2; ++bj) { const f32x4 v0 = acc[ai][bj][m][0] * (1.0f / WD_SCALE) + b[bj][0], v1 = acc[ai][bj][m][1] * (1.0f / WD_SCALE) + b[bj][1];
                    u32x4 w; w.x = cvt_pk_bf16(v0[0], v0[1]); w.y = cvt_pk_bf16(v0[2], v0[3]); w.z = cvt_pk_bf16(v1[0], v1[1]); w.w = cvt_pk_bf16(v1[2], v1[3]);
                    *(u32x4*)(rowp + bj * HALF) = w; } }
    }
};
}


#define XB_TMO      128
#define XB_XCNT(j)  (256  + 64 * (j))
#define XB_XSUB(j)  (1280 + 64 * (j))
#define XB_XGEN(j)  (2304 + 64 * (j))
#define XB_TOP      3328
#define XB_TOPGEN   3392
#define XCD_BAR_WORDS 3456
#define XB_SPIN_CAP (1u << 22)
__device__ __forceinline__ unsigned xb_ld(unsigned* p)              { return __hip_atomic_load(p, __ATOMIC_RELAXED, __HIP_MEMORY_SCOPE_AGENT); }
__device__ __forceinline__ unsigned xb_add(unsigned* p, unsigned v) { return __hip_atomic_fetch_add(p, v, __ATOMIC_RELAXED, __HIP_MEMORY_SCOPE_AGENT); }
__device__ __forceinline__ unsigned xb_xcc_id() { return (unsigned)__builtin_amdgcn_s_getreg((3 << 11) | 20) & 0xFu; }
#define XB_SPIN(cond, bar) do { unsigned _sp = 0; while (cond) { __builtin_amdgcn_s_sleep(1); \
    if ((++_sp & 255u) == 0u) { if (xb_ld(&(bar)[XB_TMO])) break; if (_sp > XB_SPIN_CAP) { atomicAdd(&(bar)[XB_TMO], 1u); break; } } } } while (0)
struct XcdBarrier { unsigned* bar; unsigned x; volatile LAS unsigned* st; };
__device__ __forceinline__ XcdBarrier xcd_barrier_post(unsigned* bar, volatile LAS unsigned* st) {
    XcdBarrier b; b.bar = bar; b.x = xb_xcc_id(); b.st = st;
    if (threadIdx.x == 0) (void)xb_add(&bar[XB_XCNT(b.x)], 1u);
    return b;
}
__device__ __forceinline__ void xcd_barrier_complete(unsigned* bar, unsigned x, unsigned& nloc, unsigned& nx) {
    const unsigned G = gridDim.x * gridDim.y * gridDim.z;
    unsigned sum, cnt, mine, sp = 0u;
    for (;;) {
        sum = 0u; cnt = 0u; mine = 0u;
#pragma unroll
        for (unsigned j = 0; j < 16; ++j) { const unsigned c = xb_ld(&bar[XB_XCNT(j)]); sum += c; cnt += (c > 0u) ? 1u : 0u; mine = (j == x) ? c : mine; }
        if (sum == G) break;
        __builtin_amdgcn_s_sleep(1);
        if ((++sp & 255u) == 0u) { if (xb_ld(&bar[XB_TMO])) break; if (sp > XB_SPIN_CAP) { atomicAdd(&bar[XB_TMO], 1u); break; } }
    }
    nloc = mine > 0u ? mine : 1u; nx = cnt > 0u ? cnt : 1u;
}
__device__ __forceinline__ void xcd_barrier(const XcdBarrier& b) {
    asm volatile("s_waitcnt vmcnt(0)" ::: "memory");
    __syncthreads();
    if (threadIdx.x == 0) {
        unsigned* bar = b.bar;
        __builtin_amdgcn_s_waitcnt(0);
        unsigned nloc = b.st[0], nx = b.st[1];
        if (nloc == 0u) { xcd_barrier_complete(bar, b.x, nloc, nx); b.st[0] = nloc; b.st[1] = nx; }
        const unsigned old = xb_add(&bar[XB_XSUB(b.x)], 1u);
        const unsigned gen = old / nloc;
        if (old + 1u == (gen + 1u) * nloc) {
            __builtin_amdgcn_fence(__ATOMIC_RELEASE, "agent");
            asm volatile("s_waitcnt vmcnt(0)" ::: "memory");
            const unsigned og = xb_add(&bar[XB_TOP], 1u);
            const unsigned tg = og / nx;
            if (og + 1u == (tg + 1u) * nx) xb_add(&bar[XB_TOPGEN], 1u);
            else XB_SPIN(xb_ld(&bar[XB_TOPGEN]) == tg, bar);
            __builtin_amdgcn_fence(__ATOMIC_ACQUIRE, "agent");
            xb_add(&bar[XB_XGEN(b.x)], 1u);
            asm volatile("s_waitcnt vmcnt(0)" ::: "memory");
        } else {
            XB_SPIN(xb_ld(&bar[XB_XGEN(b.x)]) == gen, bar);
            __builtin_amdgcn_fence(__ATOMIC_ACQUIRE, "agent");
            asm volatile("s_waitcnt vmcnt(0)" ::: "memory");
        }
    }
    __syncthreads();
}

struct Args { const float* in[20]; float* out; unsigned char* ws; int ph_lo, ph_hi; };
struct Frame {
    LAS unsigned char* lds; int tid, lane, wave, G, vcu;
    const float *x, *w_in, *sgu_w, *sgu_b, *sgu_ln_g, *sgu_ln_b, *mix_g, *w_out, *ln1_g, *ln1_b, *w_router, *b_router, *w_gate, *b_gate, *w_up, *b_up, *w_down, *b_down, *ln2_g, *ln2_b;
    float* out; unsigned char* ws;
    unsigned* ctl; int* list; int* einfo; float* gates; bf16_t *Win_t, *Wout_t, *Y, *Xb, *P1, *Amix; act_t *Wd_t, *Act; fp8_t *Wgu_t, *Hb; bf16_t* Opart; float* ML; bf16_t* WrtHi;
};

__device__ __forceinline__ void transpose_item(const float* W, int N, int K, int k0, int n0, bf16_t* WT, size_t dst_row0, LAS float* scr, int lane) {
    const int kr = lane >> 3, c4 = lane & 7; f32x4 v[8];
#pragma unroll
    for (int i = 0; i < 8; ++i) v[i] = *(const f32x4*)(W + (size_t)(k0 + 8 * kr + i) * N + n0 + 4 * c4);
#pragma unroll
    for (int e = 0; e < 4; ++e) { u32x4 o; o.x = cvt_pk_bf16(v[0][e], v[1][e]); o.y = cvt_pk_bf16(v[2][e], v[3][e]); o.z = cvt_pk_bf16(v[4][e], v[5][e]); o.w = cvt_pk_bf16(v[6][e], v[7][e]);
        *(u32x4*)(WT + (dst_row0 + 4 * c4 + e) * K + k0 + 8 * kr) = o; }
}
__device__ __forceinline__ void transpose_item8(const float* W, int N, int K, int k0, int n0, fp8_t* WT, size_t dst_row0, float scale, LAS float* scr, int lane) {
    { const int kr = lane >> 3, c4 = lane & 7; f32x4 v[16];
#pragma unroll
      for (int i = 0; i < 16; ++i) v[i] = *(const f32x4*)(W + (size_t)(k0 + 8 * i + kr) * N + n0 + 4 * c4);
#pragma unroll
      for (int i = 0; i < 16; ++i) { LAS float* d = scr + (8 * i + kr) * 33 + 4 * c4; d[0] = v[i][0]; d[1] = v[i][1]; d[2] = v[i][2]; d[3] = v[i][3]; } }
    asm volatile("s_waitcnt lgkmcnt(0)" ::: "memory");
    const int c = lane & 7;
#pragma unroll
    for (int j = 0; j < 4; ++j) { const int n = (lane >> 3) + 8 * j; const LAS float* s = scr + (16 * c) * 33 + n;
        u32x4 o; o.x = cvt4_fp8(s[0 * 33] * scale, s[1 * 33] * scale, s[2 * 33] * scale, s[3 * 33] * scale); o.y = cvt4_fp8(s[4 * 33] * scale, s[5 * 33] * scale, s[6 * 33] * scale, s[7 * 33] * scale);
        o.z = cvt4_fp8(s[8 * 33] * scale, s[9 * 33] * scale, s[10 * 33] * scale, s[11 * 33] * scale); o.w = cvt4_fp8(s[12 * 33] * scale, s[13 * 33] * scale, s[14 * 33] * scale, s[15 * 33] * scale);
        *(u32x4*)(WT + (dst_row0 + n) * K + k0 + 16 * c) = o; }
    asm volatile("s_waitcnt lgkmcnt(0)" ::: "memory");
}
constexpr int MOE_ITEMS = NE * 3 * 8 * 32;
static_assert(G2_FP8, "the MoE item list below assumes fp8 copies of all three expert matrices");
struct MoeItem { const float* src; fp8_t* dst; float scale; };
__device__ __forceinline__ MoeItem moe_item(const Frame& F, int it) {
    const int nb = it & 31, kb = (it >> 5) & 7, e = (it >> 8) & 31, which = it >> 13, n0 = 32 * nb; MoeItem m;
    if (which < 2) { m.src = (which ? F.w_up : F.w_gate) + (size_t)e * D * FF + (size_t)(128 * kb) * FF + n0; m.dst = F.Wgu_t + ((size_t)e * 2048 + (n0 >> 7) * 256 + which * 128 + (n0 & 127)) * D + 128 * kb; m.scale = WGU_SCALE; }
    else { m.src = F.w_down + (size_t)e * FF * D + (size_t)(128 * kb) * D + n0; m.dst = (fp8_t*)F.Wd_t + ((size_t)e * 1024 + n0) * FF + 128 * kb; m.scale = WD_SCALE; }
    return m; }
__device__ __forceinline__ void moe_item_load(const MoeItem& m, f32x4 (&v)[16], int lane) {
    const int kr = lane >> 3, c4 = lane & 7;
#pragma unroll
    for (int i = 0; i < 16; ++i) v[i] = *(const f32x4*)(m.src + (size_t)(16 * kr + i) * 1024 + 4 * c4); }
__device__ __forceinline__ void moe_item_finish(const MoeItem& m, const f32x4 (&v)[16], LAS float* scr, int lane) {
    const int kr = lane >> 3, c4 = lane & 7; const float scale = m.scale;
#pragma unroll
    for (int e = 0; e < 4; ++e) { u32x4 o;
        o.x = cvt4_fp8(v[0][e] * scale, v[1][e] * scale, v[2][e] * scale, v[3][e] * scale); o.y = cvt4_fp8(v[4][e] * scale, v[5][e] * scale, v[6][e] * scale, v[7][e] * scale);
        o.z = cvt4_fp8(v[8][e] * scale, v[9][e] * scale, v[10][e] * scale, v[11][e] * scale); o.w = cvt4_fp8(v[12][e] * scale, v[13][e] * scale, v[14][e] * scale, v[15][e] * scale);
        *(u32x4*)(m.dst + (size_t)(4 * c4 + e) * 1024 + 16 * kr) = o; } }
__device__ __forceinline__ void moe_convert_items(Frame& F, int first, int count) {
    int end = first + count; if (end > MOE_ITEMS) end = MOE_ITEMS;
#pragma unroll 1
    for (int it = first; it < end; ++it) { f32x4 va[16]; const MoeItem ma = moe_item(F, it); moe_item_load(ma, va, F.lane); moe_item_finish(ma, va, nullptr, F.lane); }
}
__device__ __forceinline__ void p0_convert(Frame& F) {
    LAS float* scr = (LAS float*)(F.lds + F.wave * 17408);
    const int gw = F.vcu * 8 + F.wave, NGW = F.G * 8;
    constexpr int I_IN = (D / 64) * (INC / 32), I_OUT = (D / 64) * (D / 32);
    for (int it = gw; it < I_IN + I_OUT; it += NGW) {
        int r = it;
        if (r < I_IN) { const int kb = r / (INC / 32), nb = r % (INC / 32); transpose_item(F.w_in, INC, D, 64 * kb, 32 * nb, F.Win_t, (size_t)32 * nb, scr, F.lane); continue; } r -= I_IN;
        { const int kb = r / (D / 32), nb = r % (D / 32); transpose_item(F.w_out, D, D, 64 * kb, 32 * nb, F.Wout_t, (size_t)32 * nb, scr, F.lane); }
    }
    for (int i2 = blockIdx.x * 512 + F.tid; i2 < D * NE; i2 += F.G * 512) { const int k = i2 >> 5, e = i2 & 31; const float wv = F.w_router[i2];
        const unsigned hi = cvt_pk_bf16(wv, 0.f) & 0xffffu; const unsigned lo = cvt_pk_bf16(wv - bf_lo(hi), 0.f) & 0xffffu;
        F.WrtHi[(size_t)e * D + k] = (bf16_t)hi; F.WrtHi[(size_t)(NE + e) * D + k] = (bf16_t)lo; }
    const size_t nchunk = (size_t)T * D / 8, cstride = (size_t)F.G * 512;
    for (size_t i = (size_t)blockIdx.x * 512 + F.tid; i < nchunk; i += 4 * cstride) {
        f32x4 a[4], b[4];
#pragma unroll
        for (int j = 0; j < 4; ++j) { const size_t ii = i + j * cstride; if (ii < nchunk) { a[j] = *(const f32x4*)(F.x + ii * 8); b[j] = *(const f32x4*)(F.x + ii * 8 + 4); } }
#pragma unroll
        for (int j = 0; j < 4; ++j) { const size_t ii = i + j * cstride; if (ii < nchunk) {
            u32x4 w; w.x = cvt_pk_bf16(a[j][0], a[j][1]); w.y = cvt_pk_bf16(a[j][2], a[j][3]); w.z = cvt_pk_bf16(b[j][0], b[j][1]); w.w = cvt_pk_bf16(b[j][2], b[j][3]);
            *(u32x4*)(F.Xb + ii * 8) = w; } } }
}

typedef float f32x16 __attribute__((ext_vector_type(16)));
typedef short s16x4 __attribute__((ext_vector_type(4)));
constexpr int SG_ROW = 272, SG_WAVE = 64 * SG_ROW, SG_SSQ_OFF = 8 * SG_WAVE;
static_assert(SG_SSQ_OFF + 8 * 128 * 4 <= LDS_BYTES, "SGU LDS");
__device__ __forceinline__ void sgu_unit(Frame& F, int u, int half) {
    const int g = F.wave, lane = F.lane, i = lane & 31, hh = lane >> 5; const size_t row0 = (size_t)u * CHUNK;
    LAS unsigned char* vt = F.lds + g * SG_WAVE; LAS float* ssq = (LAS float*)(F.lds + SG_SSQ_OFF);
    { u32x4 raw[2][8];
#pragma unroll
      for (int tt = 0; tt < 2; ++tt) { if (tt <= half) { const bf16_t* vp = F.P1 + (row0 + lane + 64 * tt) * INC + AW + g * GD;
#pragma unroll
          for (int c8 = 0; c8 < 8; ++c8) raw[tt][c8] = *(const u32x4*)(vp + 8 * c8); } }
#pragma unroll
      for (int tt = 0; tt < 2; ++tt) { if (tt <= half) { const int t = lane + 64 * tt;
        float v[64];
#pragma unroll
        for (int c8 = 0; c8 < 8; ++c8) { const unsigned w[4] = {raw[tt][c8].x, raw[tt][c8].y, raw[tt][c8].z, raw[tt][c8].w};
#pragma unroll
            for (int j = 0; j < 4; ++j) { v[8 * c8 + 2 * j] = bf_lo(w[j]); v[8 * c8 + 2 * j + 1] = bf_hi(w[j]); } }
        float s = 0.f;
#pragma unroll
        for (int c = 0; c < 64; ++c) s += v[c];
        const float mu = s * (1.f / 64.f); float q = 0.f;
#pragma unroll
        for (int c = 0; c < 64; ++c) { v[c] -= mu; q += v[c] * v[c]; }
        const float rstd = 1.0f / sqrtf(q * (1.f / 64.f) + LN_EPS);
#pragma unroll
        for (int c = 0; c < 64; ++c) { const float val = v[c] * rstd * F.sgu_ln_g[g * GD + c] + F.sgu_ln_b[g * GD + c];
            *(LAS bf16_t*)(vt + c * SG_ROW + t * 2) = (bf16_t)(cvt_pk_bf16(val, 0.f) & 0xffffu); } } } }
    asm volatile("s_waitcnt lgkmcnt(0)" ::: "memory");
    unsigned ssq_base = (unsigned)(uintptr_t)(ssq + i); asm volatile("" : "+v"(ssq_base));
    LAS float* ssq_r = (LAS float*)(uintptr_t)ssq_base; LAS float* ssq_w = ssq_r + g * 64;
    f32x16 acc[2][2];
    f32x4 wq[2][8][2]; u32x2 uqa[2][2][4]; float bsa[2];
#pragma unroll
    for (int n2 = 0; n2 < 2; ++n2) { const int nt = 2 * half + n2, t = 32 * nt + i, nks = 2 * nt + 2;
#pragma unroll
        for (int ks = 0; ks < 8; ++ks) { if (ks < nks) { const float* wp = F.sgu_w + ((size_t)g * CHUNK + t) * CHUNK + 16 * ks + 8 * hh; wq[n2][ks][0] = *(const f32x4*)wp; wq[n2][ks][1] = *(const f32x4*)(wp + 4); } }
        const bf16_t* up = F.P1 + (row0 + t) * INC + g * GD + 4 * hh;
#pragma unroll
        for (int mt = 0; mt < 2; ++mt)
#pragma unroll
            for (int g4 = 0; g4 < 4; ++g4) uqa[n2][mt][g4] = *(const u32x2*)(up + 32 * mt + 8 * g4);
        bsa[n2] = F.sgu_b[g * CHUNK + t]; }
#pragma unroll
    for (int n2 = 0; n2 < 2; ++n2) { const int nt = 2 * half + n2, t = 32 * nt + i, nks = 2 * nt + 2;
#pragma unroll
        for (int mt = 0; mt < 2; ++mt)
#pragma unroll
            for (int r = 0; r < 16; ++r) acc[mt][n2][r] = 0.f;
        const float bs = bsa[n2];
#pragma unroll
        for (int ks = 0; ks < 8; ++ks) { if (ks < nks) { const int s0 = 16 * ks + 8 * hh;
            float wv[8] = {wq[n2][ks][0][0], wq[n2][ks][0][1], wq[n2][ks][0][2], wq[n2][ks][0][3], wq[n2][ks][1][0], wq[n2][ks][1][1], wq[n2][ks][1][2], wq[n2][ks][1][3]};
#pragma unroll
            for (int j = 0; j < 8; ++j) wv[j] = (s0 + j <= t) ? wv[j] : 0.f;
            u32x4 bw; bw.x = cvt_pk_bf16(wv[0], wv[1]); bw.y = cvt_pk_bf16(wv[2], wv[3]); bw.z = cvt_pk_bf16(wv[4], wv[5]); bw.w = cvt_pk_bf16(wv[6], wv[7]);
            const bf16x8 bfrag = __builtin_bit_cast(bf16x8, bw);
#pragma unroll
            for (int mt = 0; mt < 2; ++mt) { const bf16x8 afrag = *(const LAS bf16x8*)(vt + (32 * mt + i) * SG_ROW + s0 * 2);
                acc[mt][n2] = __builtin_amdgcn_mfma_f32_32x32x16_bf16(afrag, bfrag, acc[mt][n2], 0, 0, 0); } } }
        float ss = 0.f;
#pragma unroll
        for (int mt = 0; mt < 2; ++mt)
#pragma unroll
            for (int g4 = 0; g4 < 4; ++g4) { const u32x2 uw = uqa[n2][mt][g4];
                const float u0 = bf_lo(uw.x), u1 = bf_hi(uw.x), u2 = bf_lo(uw.y), u3 = bf_hi(uw.y);
                float a0 = u0 * (acc[mt][n2][4 * g4] + bs), a1 = u1 * (acc[mt][n2][4 * g4 + 1] + bs), a2 = u2 * (acc[mt][n2][4 * g4 + 2] + bs), a3 = u3 * (acc[mt][n2][4 * g4 + 3] + bs);
                acc[mt][n2][4 * g4] = a0; acc[mt][n2][4 * g4 + 1] = a1; acc[mt][n2][4 * g4 + 2] = a2; acc[mt][n2][4 * g4 + 3] = a3;
                ss += (a0 * a0 + a1 * a1) + (a2 * a2 + a3 * a3); }
        ss += __shfl_xor(ss, 32);
        if (hh == 0) ssq_w[32 * n2] = ss; }
    __syncthreads();
#pragma unroll
    for (int n2 = 0; n2 < 2; ++n2) { const int t = 64 * half + 32 * n2 + i; float tot = 0.f;
#pragma unroll
        for (int gg = 0; gg < 8; ++gg) tot += ssq_r[gg * 64 + 32 * n2];
        const float rs = 1.0f / sqrtf(tot * (1.f / AW) + LN_EPS);
        bf16_t* op = F.Amix + (row0 + t) * D + g * GD + 4 * hh;
#pragma unroll
        for (int mt = 0; mt < 2; ++mt)
#pragma unroll
            for (int g4 = 0; g4 < 4; ++g4) { const f32x4 mg = *(const f32x4*)(F.mix_g + g * GD + 32 * mt + 8 * g4 + 4 * hh);
                u32x2 w; w.x = cvt_pk_bf16(acc[mt][n2][4 * g4] * rs * mg[0], acc[mt][n2][4 * g4 + 1] * rs * mg[1]); w.y = cvt_pk_bf16(acc[mt][n2][4 * g4 + 2] * rs * mg[2], acc[mt][n2][4 * g4 + 3] * rs * mg[3]);
                *(u32x2*)(op + 32 * mt + 8 * g4) = w; } }
    __syncthreads();
}

constexpr int AT_KROW = 144, AT_VROW = 144, AT_V_OFF = 384 * AT_KROW;
static_assert(AT_V_OFF + 384 * AT_VROW <= RING_BYTES, "attention LDS");
struct AttnDesc { int b, h, p, d, r, q0; };
__device__ __forceinline__ AttnDesc attn_decode(int u) {
    AttnDesc a; const int bh = u / 48, rem = u % 48, idx = rem & 15; a.p = rem >> 4; a.b = bh >> 3; a.h = bh & 7;
    a.d = (a.p == 0) ? 1 : (a.p == 1) ? 4 : 16; a.r = (a.p == 0) ? 0 : (a.p == 1) ? (idx >> 2) : idx; a.q0 = 256 * ((a.p == 0) ? idx : (a.p == 1) ? (idx & 3) : 0); return a; }
__device__ __forceinline__ void attn_stage_load(const Frame& F, const AttnDesc& a, u32x4 (&kq)[6], u32x4 (&vq)[6]) {
    const bf16_t* base = F.P1 + (size_t)a.b * SEQ * INC + a.h * HD;
#pragma unroll
    for (int it = 0; it < 6; ++it) { const int ch = F.tid + 512 * it, key = ch >> 3, c = ch & 7, s = a.q0 - 128 + key;
        kq[it] = (u32x4){0u, 0u, 0u, 0u}; vq[it] = (u32x4){0u, 0u, 0u, 0u};
        if (s >= 0) { const bf16_t* rp = base + (size_t)(s * a.d + a.r) * INC + c * 8; kq[it] = *(const u32x4*)(rp + 1536); vq[it] = *(const u32x4*)(rp + 2048); } }
}
__device__ __forceinline__ void attn_stage_write(const Frame& F, const u32x4 (&kq)[6], const u32x4 (&vq)[6]) {
#pragma unroll
    for (int it = 0; it < 6; ++it) { const int ch = F.tid + 512 * it, key = ch >> 3, c = ch & 7;
        *(LAS u32x4*)(F.lds + key * AT_KROW + c * 16) = kq[it]; *(LAS u32x4*)(F.lds + AT_V_OFF + key * AT_VROW + c * 16) = vq[it]; }
}
typedef short v4i16_t __attribute__((ext_vector_type(4)));
__device__ __forceinline__ void attn_compute(Frame& F, const AttnDesc& a, const bf16x8 (&qf)[4]) {
    const int lane = F.lane, i = lane & 31, hh = lane >> 5, w = F.wave, q0 = a.q0;
    LAS unsigned char* kl = F.lds; LAS unsigned char* vl = F.lds + AT_V_OFF;
    f32x16 s[5];
#pragma unroll
    for (int kt = 0; kt < 5; ++kt) { f32x16 a;
#pragma unroll
        for (int rr = 0; rr < 16; ++rr) a[rr] = 0.f;
#pragma unroll
        for (int ks = 0; ks < 4; ++ks) { const bf16x8 kf = *(const LAS bf16x8*)(kl + (32 * w + 32 * kt + i) * AT_KROW + (16 * ks + 8 * hh) * 2);
            a = __builtin_amdgcn_mfma_f32_32x32x16_bf16(kf, qf[ks], a, 0, 0, 0); }
        s[kt] = a; }
    const float sc = 0.125f * 1.4426950408889634f; const int ksub0 = q0 + 32 * w - 128;
    float m = -INFINITY;
#pragma unroll
    for (int kt = 0; kt < 5; ++kt)
#pragma unroll
        for (int rr = 0; rr < 16; ++rr) { const int kk = (rr & 3) + 8 * (rr >> 2) + 4 * hh; bool ok = (ksub0 + 32 * kt + kk) >= 0;
            if (kt == 0) ok = ok && (kk >= i);
            if (kt == 4) ok = ok && (kk <= i);
            const float v = ok ? s[kt][rr] * sc : -INFINITY; s[kt][rr] = v; m = fmaxf(m, v); }
    m = fmaxf(m, __shfl_xor(m, 32));
    float lsum = 0.f;
#pragma unroll
    for (int kt = 0; kt < 5; ++kt)
#pragma unroll
        for (int rr = 0; rr < 16; ++rr) { const float pv = __builtin_amdgcn_exp2f(s[kt][rr] - m); s[kt][rr] = pv; lsum += pv; }
    lsum += __shfl_xor(lsum, 32);
    f32x16 o[2];
#pragma unroll
    for (int dt = 0; dt < 2; ++dt)
#pragma unroll
        for (int rr = 0; rr < 16; ++rr) o[dt][rr] = 0.f;
    const LAS unsigned char* vtp = vl + (32 * w + 4 * hh + ((lane & 15) >> 2)) * AT_VROW + (16 * ((lane >> 4) & 1) + 4 * (lane & 3)) * 2;
#pragma unroll
    for (int kt = 0; kt < 5; ++kt)
#pragma unroll
        for (int s2 = 0; s2 < 2; ++s2) { u32x4 pw; pw.x = cvt_pk_bf16(s[kt][8 * s2], s[kt][8 * s2 + 1]); pw.y = cvt_pk_bf16(s[kt][8 * s2 + 2], s[kt][8 * s2 + 3]);
            pw.z = cvt_pk_bf16(s[kt][8 * s2 + 4], s[kt][8 * s2 + 5]); pw.w = cvt_pk_bf16(s[kt][8 * s2 + 6], s[kt][8 * s2 + 7]);
            const bf16x8 pb = __builtin_bit_cast(bf16x8, pw);
#pragma unroll
            for (int dt = 0; dt < 2; ++dt) { const LAS unsigned char* ap = vtp + (32 * kt + 16 * s2) * AT_VROW + 64 * dt;
                const v4i16_t lo = __builtin_amdgcn_ds_read_tr16_b64_v4i16((LAS v4i16_t*)ap), hi = __builtin_amdgcn_ds_read_tr16_b64_v4i16((LAS v4i16_t*)(ap + 8 * AT_VROW));
                const bf16x8 af = __builtin_shufflevector(lo, hi, 0, 1, 2, 3, 4, 5, 6, 7);
                o[dt] = __builtin_amdgcn_mfma_f32_32x32x16_bf16(af, pb, o[dt], 0, 0, 0); } }
    const float inv = 1.0f / lsum; const size_t orow = (size_t)a.b * SEQ + ((size_t)(q0 + 32 * w + i) * a.d + a.r);
    bf16_t* op = F.Opart + ((size_t)a.p * T + orow) * AW + a.h * HD + 4 * hh;
#pragma unroll
    for (int dt = 0; dt < 2; ++dt)
#pragma unroll
        for (int g4 = 0; g4 < 4; ++g4) { u32x2 wv; wv.x = cvt_pk_bf16(o[dt][4 * g4] * inv, o[dt][4 * g4 + 1] * inv); wv.y = cvt_pk_bf16(o[dt][4 * g4 + 2] * inv, o[dt][4 * g4 + 3] * inv);
            *(u32x2*)(op + 32 * dt + 8 * g4) = wv; }
    if (hh == 0) *(f32x2*)(F.ML + (((size_t)a.p * T + orow) * NH + a.h) * 2) = (f32x2){m, lsum};
}
__device__ __forceinline__ void attn_units(Frame& F, int u0, int ustep, int uend) {
    if (u0 >= uend) return;
    u32x4 kq[6], vq[6]; bf16x8 qn[4]; AttnDesc cur = attn_decode(u0);
#define ATT_QLOAD(A, Q) do { const bf16_t* base_ = F.P1 + (size_t)(A).b * SEQ * INC + (A).h * HD; const size_t qrow_ = (size_t)((A).q0 + 32 * F.wave + (F.lane & 31)) * (A).d + (A).r; \
        _Pragma("unroll") for (int ks = 0; ks < 4; ++ks) Q[ks] = *(const bf16x8*)(base_ + qrow_ * INC + 1024 + 16 * ks + 8 * (F.lane >> 5)); } while (0)
    attn_stage_load(F, cur, kq, vq); ATT_QLOAD(cur, qn);
    for (int u = u0; u < uend; u += ustep) {
        attn_stage_write(F, kq, vq);
        bf16x8 qf[4];
#pragma unroll
        for (int ks = 0; ks < 4; ++ks) qf[ks] = qn[ks];
        __syncthreads();
        const AttnDesc nxt = attn_decode(u + ustep < uend ? u + ustep : u);
        if (u + ustep < uend) { attn_stage_load(F, nxt, kq, vq); ATT_QLOAD(nxt, qn); }
        attn_compute(F, cur, qf);
        __syncthreads();
        cur = nxt;
    }
#undef ATT_QLOAD
}
__device__ __forceinline__ void p2_mixers(Frame& F) {
    constexpr int NSGU = 2 * BATCH * (SEQ / CHUNK), NATT = BATCH * NH * 48;
    constexpr int SH = MOE_ITEMS / 3; const int cnt = SH / (F.G * 8) + ((SH % (F.G * 8)) ? 1 : 0); int first = SH + (F.vcu * 8 + F.wave) * cnt, count = cnt;
    if (first + count > 2 * SH) count = 2 * SH - first;
    const int slot = F.vcu & 3;
    const int split = (F.vcu + 3 * F.G < NATT) ? F.vcu + 3 * F.G : NATT;
    if (slot == 0) moe_convert_items(F, first, count);
    for (int u = F.vcu; u < NSGU; u += F.G) sgu_unit(F, u >> 1, u & 1);
    if (slot == 1) moe_convert_items(F, first, count);
    attn_units(F, F.vcu, F.G, split);
    if (slot == 2) moe_convert_items(F, first, count);
    attn_units(F, split, F.G, NATT);
    if (slot == 3) moe_convert_items(F, first, count);
}

__device__ __forceinline__ void p3_merge(Frame& F) {
    const int gw = blockIdx.x * 8 + F.wave, NGW = F.G * 8, h = F.lane >> 3;
    for (int row = gw; row < T; row += NGW) {
        f32x2 ml[3]; float mx = -INFINITY;
#pragma unroll
        for (int p = 0; p < 3; ++p) { ml[p] = *(const f32x2*)(F.ML + (((size_t)p * T + row) * NH + h) * 2); mx = fmaxf(mx, ml[p].x); }
        float wt[3], wsum = 0.f;
#pragma unroll
        for (int p = 0; p < 3; ++p) { wt[p] = ml[p].y * __builtin_amdgcn_exp2f(ml[p].x - mx); wsum += wt[p]; }
        const float iw = 1.0f / wsum; float bv[8];
#pragma unroll
        for (int j = 0; j < 8; ++j) bv[j] = 0.f;
#pragma unroll
        for (int p = 0; p < 3; ++p) { const u32x4 r = *(const u32x4*)(F.Opart + ((size_t)p * T + row) * AW + F.lane * 8); const unsigned w[4] = {r.x, r.y, r.z, r.w}; const float f = wt[p] * iw;
#pragma unroll
            for (int j = 0; j < 4; ++j) { bv[2 * j] += f * bf_lo(w[j]); bv[2 * j + 1] += f * bf_hi(w[j]); } }
        float ss = 0.f;
#pragma unroll
        for (int j = 0; j < 8; ++j) ss += bv[j] * bv[j];
        ss = wave_sum(ss); const float rs = 1.0f / sqrtf(ss * (1.f / AW) + LN_EPS);
        const f32x4 g0 = *(const f32x4*)(F.mix_g + AW + F.lane * 8), g1 = *(const f32x4*)(F.mix_g + AW + F.lane * 8 + 4);
        u32x4 w; w.x = cvt_pk_bf16(bv[0] * rs * g0[0], bv[1] * rs * g0[1]); w.y = cvt_pk_bf16(bv[2] * rs * g0[2], bv[3] * rs * g0[3]);
        w.z = cvt_pk_bf16(bv[4] * rs * g1[0], bv[5] * rs * g1[1]); w.w = cvt_pk_bf16(bv[6] * rs * g1[2], bv[7] * rs * g1[3]);
        *(u32x4*)(F.Amix + (size_t)row * D + AW + F.lane * 8) = w;
    }
}

constexpr int RT_ROW = 2064, RT_IMG = 32 * RT_ROW, RT_LGT_OFF = 2 * RT_IMG, RT_SEL_OFF = RT_LGT_OFF + 32 * 33 * 4;
static_assert(RT_SEL_OFF + 2048 + 256 <= MISC_OFF && 8 * 32 * 32 * 4 <= RT_IMG, "route LDS");
__device__ __forceinline__ void p4_route(Frame& F) {
    const int lane = F.lane, w = F.wave;
    LAS unsigned char* img = F.lds; LAS float* part = (LAS float*)F.lds; LAS float* lgt = (LAS float*)(F.lds + RT_LGT_OFF);
    LAS int* sel_e = (LAS int*)(F.lds + RT_SEL_OFF); LAS float* sel_g = (LAS float*)(F.lds + RT_SEL_OFF + 1024);
    LAS int* lcnt = (LAS int*)(F.lds + RT_SEL_OFF + 2048); LAS int* lbase = lcnt + 32;
    if (F.tid < 32) lcnt[F.tid] = 0;
    f32x4 gg[4], bb[4];
#pragma unroll
    for (int j = 0; j < 4; ++j) { gg[j] = *(const f32x4*)(F.ln1_g + 4 * lane + 256 * j); bb[j] = *(const f32x4*)(F.ln1_b + 4 * lane + 256 * j); }
    bf16x8 bh[4][2], bl[4][2];
#pragma unroll
    for (int ks = 0; ks < 4; ++ks)
#pragma unroll
        for (int nt = 0; nt < 2; ++nt) { const bf16_t* bp = F.WrtHi + (size_t)(16 * nt + (lane & 15)) * D + 128 * w + 32 * ks + 8 * (lane >> 4);
            bh[ks][nt] = *(const bf16x8*)bp; bl[ks][nt] = *(const bf16x8*)(bp + (size_t)NE * D); }
    __syncthreads();
    for (int chunk = blockIdx.x; chunk < T / 64; chunk += F.G) {
#pragma unroll 1
        for (int half = 0; half < 2; ++half) {
            const int row0 = chunk * 64 + half * 32 + w * 4;
            f32x4 v[4][4]; float s[4], q[4];
#pragma unroll
            for (int tk = 0; tk < 4; ++tk) { s[tk] = 0.f;
#pragma unroll
                for (int j = 0; j < 4; ++j) { v[tk][j] = *(const f32x4*)(F.out + (size_t)(row0 + tk) * D + 4 * lane + 256 * j); s[tk] += (v[tk][j][0] + v[tk][j][1]) + (v[tk][j][2] + v[tk][j][3]); } }
#pragma unroll
            for (int o = 1; o < 64; o <<= 1) {
#pragma unroll
                for (int tk = 0; tk < 4; ++tk) s[tk] += __shfl_xor(s[tk], o); }
#pragma unroll
            for (int tk = 0; tk < 4; ++tk) { const float mu = s[tk] * (1.f / D); q[tk] = 0.f;
#pragma unroll
                for (int j = 0; j < 4; ++j) { v[tk][j] = v[tk][j] - mu; q[tk] += (v[tk][j][0] * v[tk][j][0] + v[tk][j][1] * v[tk][j][1]) + (v[tk][j][2] * v[tk][j][2] + v[tk][j][3] * v[tk][j][3]); } }
#pragma unroll
            for (int o = 1; o < 64; o <<= 1) {
#pragma unroll
                for (int tk = 0; tk < 4; ++tk) q[tk] += __shfl_xor(q[tk], o); }
#pragma unroll
            for (int tk = 0; tk < 4; ++tk) { const float rstd = 1.0f / sqrtf(q[tk] * (1.f / D) + LN_EPS);
#pragma unroll
                for (int j = 0; j < 4; ++j) { const f32x4 h = v[tk][j] * rstd * gg[j] + bb[j]; const size_t off = (size_t)(row0 + tk) * D + 4 * lane + 256 * j;
                    *(f32x4*)(F.out + off) = h;
                    *(unsigned*)(F.Hb + off) = cvt4_fp8(h[0], h[1], h[2], h[3]);
                    u32x2 hi; hi.x = cvt_pk_bf16(h[0], h[1]); hi.y = cvt_pk_bf16(h[2], h[3]);
                    u32x2 lo; lo.x = cvt_pk_bf16(h[0] - bf_lo(hi.x), h[1] - bf_hi(hi.x)); lo.y = cvt_pk_bf16(h[2] - bf_lo(hi.y), h[3] - bf_hi(hi.y));
                    LAS unsigned char* dp = img + (w * 4 + tk) * RT_ROW + (4 * lane + 256 * j) * 2;
                    *(LAS u32x2*)dp = hi; *(LAS u32x2*)(dp + RT_IMG) = lo; } }
            __syncthreads();
            f32x4 acc[2][2];
#pragma unroll
            for (int mt = 0; mt < 2; ++mt)
#pragma unroll
                for (int nt = 0; nt < 2; ++nt) acc[mt][nt] = (f32x4){0.f, 0.f, 0.f, 0.f};
#pragma unroll
            for (int mt = 0; mt < 2; ++mt) { const LAS unsigned char* ap = img + (16 * mt + (lane & 15)) * RT_ROW + (128 * w + 8 * (lane >> 4)) * 2;
#pragma unroll
                for (int ks = 0; ks < 4; ++ks) { const bf16x8 ah = *(const LAS bf16x8*)(ap + ks * 64), al = *(const LAS bf16x8*)(ap + RT_IMG + ks * 64);
#pragma unroll
                    for (int nt = 0; nt < 2; ++nt) {
                        acc[mt][nt] = __builtin_amdgcn_mfma_f32_16x16x32_bf16(ah, bh[ks][nt], acc[mt][nt], 0, 0, 0);
                        acc[mt][nt] = __builtin_amdgcn_mfma_f32_16x16x32_bf16(ah, bl[ks][nt], acc[mt][nt], 0, 0, 0);
                        acc[mt][nt] = __builtin_amdgcn_mfma_f32_16x16x32_bf16(al, bh[ks][nt], acc[mt][nt], 0, 0, 0); } } }
            __syncthreads();
#pragma unroll
            for (int mt = 0; mt < 2; ++mt)
#pragma unroll
                for (int nt = 0; nt < 2; ++nt)
#pragma unroll
                    for (int r = 0; r < 4; ++r) part[(w * 32 + 16 * mt + 4 * (lane >> 4) + r) * 32 + 16 * nt + (lane & 15)] = acc[mt][nt][r];
            __syncthreads();
#pragma unroll
            for (int qq = 0; qq < 2; ++qq) { const int p = F.tid + 512 * qq, tok = p >> 5, e = p & 31; float sum = F.b_router[e];
#pragma unroll
                for (int ww = 0; ww < 8; ++ww) sum += part[(ww * 32 + tok) * 32 + e];
                lgt[tok * 33 + e] = sum; }
            __syncthreads();
            if (F.tid < 32) {
                float lg[32];
#pragma unroll
                for (int e = 0; e < 32; ++e) lg[e] = lgt[F.tid * 33 + e];
                int idx[4]; float val[4]; unsigned taken = 0u;
#pragma unroll
                for (int r = 0; r < 4; ++r) { float best = -INFINITY; int bi = 0;
#pragma unroll
                    for (int e = 0; e < 32; ++e) { const bool ok = !((taken >> e) & 1u) && (lg[e] > best); best = ok ? lg[e] : best; bi = ok ? e : bi; }
                    idx[r] = bi; val[r] = best; taken |= 1u << bi; }
                const float e1 = __expf(val[1] - val[0]), e2 = __expf(val[2] - val[0]), e3 = __expf(val[3] - val[0]); const float inv = 1.0f / (1.0f + e1 + e2 + e3);
                const int tl = half * 32 + F.tid;
                sel_e[tl * 4 + 0] = idx[0]; sel_e[tl * 4 + 1] = idx[1]; sel_e[tl * 4 + 2] = idx[2]; sel_e[tl * 4 + 3] = idx[3];
                sel_g[tl * 4 + 0] = inv; sel_g[tl * 4 + 1] = e1 * inv; sel_g[tl * 4 + 2] = e2 * inv; sel_g[tl * 4 + 3] = e3 * inv; }
            __syncthreads();
        }
        int myrank = 0, mye = 0;
        if (F.tid < 256) { mye = sel_e[F.tid]; myrank = atomicAdd((int*)&lcnt[mye], 1); }
        __syncthreads();
        if (F.tid < 32) { const int c = lcnt[F.tid]; lbase[F.tid] = c ? (int)__hip_atomic_fetch_add(F.ctl + CW_CNT + F.tid, (unsigned)c, __ATOMIC_RELAXED, __HIP_MEMORY_SCOPE_AGENT) : 0; lcnt[F.tid] = 0; }
        __syncthreads();
        if (F.tid < 256) { const int slot = (chunk * 64 + (F.tid >> 2)) * 4 + (F.tid & 3); F.list[mye * T + lbase[mye] + myrank] = slot; F.gates[slot] = sel_g[F.tid]; F.einfo[slot] = mye | ((lbase[mye] + myrank) << 8); }
        __syncthreads();
    }
}

template <bool G1> __device__ __forceinline__ int moe_tables(Frame& F, int NPN) {
    LAS int* cnt = (LAS int*)(F.lds + TAB_OFF); LAS int* tstart = cnt + 32; LAS int* rowtab = (LAS int*)(F.lds + ROWTAB_OFF);
    if (F.tid < 32) cnt[F.tid] = (int)__hip_atomic_load(F.ctl + CW_CNT + F.tid, __ATOMIC_RELAXED, __HIP_MEMORY_SCOPE_AGENT);
    __syncthreads();
    if (F.tid == 0) { int acc = 0; for (int e = 0; e < NE; ++e) { tstart[e] = acc; acc += (cnt[e] + 255) >> 8; } tstart[NE] = acc; }
    __syncthreads();
    const int ntiles = tstart[NE], nU = ntiles * NPN;
    for (int i = 0; i < MAXU; ++i) { const int L = i * F.G + F.vcu; if (L >= nU) break;
        const int tl = L / NPN; int e = 0;
        for (int j = 1; j < NE; ++j) e += (tstart[j] <= tl) ? 1 : 0;
        const int mt = tl - tstart[e];
        if (F.tid < 256) { const int rank = mt * 256 + F.tid; const int slot = rank < cnt[e] ? F.list[e * T + rank] : -1;
            rowtab[i * 256 + F.tid] = G1 ? ((slot < 0 ? 0 : (slot >> 2)) * D) : slot; } }
    __syncthreads();
    return ntiles;
}

__device__ __forceinline__ void p7_final(Frame& F) {
    LAS int* cnt = (LAS int*)(F.lds + TAB_OFF); LAS int* tstart = cnt + 32;
    if (F.tid < 32) cnt[F.tid] = (int)__hip_atomic_load(F.ctl + CW_CNT + F.tid, __ATOMIC_RELAXED, __HIP_MEMORY_SCOPE_AGENT);
    __syncthreads();
    if (F.tid == 0) { int acc = 0; for (int e = 0; e < NE; ++e) { tstart[e] = acc; acc += (cnt[e] + 255) >> 8; } tstart[NE] = acc; }
    __syncthreads();
    const int gw = blockIdx.x * 8 + F.wave, NGW = F.G * 8;
    for (int row = gw; row < T; row += NGW) {
        float* hp = F.out + (size_t)row * D; float v[16];
#pragma unroll
        for (int j = 0; j < 2; ++j) { const f32x4 a = *(const f32x4*)(hp + 512 * j + F.lane * 8), b = *(const f32x4*)(hp + 512 * j + F.lane * 8 + 4);
#pragma unroll
            for (int i = 0; i < 4; ++i) { v[8 * j + i] = a[i] * DN_ALPHA; v[8 * j + 4 + i] = b[i] * DN_ALPHA; } }
#pragma unroll
        for (int k = 0; k < TOPK; ++k) { const int info = F.einfo[row * TOPK + k]; const float gt = F.gates[row * TOPK + k];
            const size_t pos = ((size_t)tstart[info & 255] << 8) + (size_t)(info >> 8);
#pragma unroll
            for (int j = 0; j < 2; ++j) { const u32x4 r = *(const u32x4*)(F.Y + pos * D + 512 * j + F.lane * 8); const unsigned w[4] = {r.x, r.y, r.z, r.w};
#pragma unroll
                for (int i = 0; i < 4; ++i) { v[8 * j + 2 * i] += gt * bf_lo(w[i]); v[8 * j + 2 * i + 1] += gt * bf_hi(w[i]); } } }
        float s = 0.f;
#pragma unroll
        for (int i = 0; i < 16; ++i) s += v[i];
        const float mu = wave_sum(s) * (1.f / D); float q = 0.f;
#pragma unroll
        for (int i = 0; i < 16; ++i) { v[i] -= mu; q += v[i] * v[i]; }
        const float rstd = 1.0f / sqrtf(wave_sum(q) * (1.f / D) + LN_EPS);
#pragma unroll
        for (int j = 0; j < 2; ++j) { const int c = 512 * j + F.lane * 8;
            const f32x4 g0 = *(const f32x4*)(F.ln2_g + c), g1 = *(const f32x4*)(F.ln2_g + c + 4), b0 = *(const f32x4*)(F.ln2_b + c), b1 = *(const f32x4*)(F.ln2_b + c + 4);
            f32x4 o0, o1;
#pragma unroll
            for (int i = 0; i < 4; ++i) { o0[i] = v[8 * j + i] * rstd * g0[i] + b0[i]; o1[i] = v[8 * j + 4 + i] * rstd * g1[i] + b1[i]; }
            *(f32x4*)(hp + c) = o0; *(f32x4*)(hp + c + 4) = o1; }
    }
}

__device__ __forceinline__ bool fresh(Frame& F) {
    int t = threadIdx.x; asm volatile("" : "+v"(t)); F.tid = t; F.lane = t & 63;
    const __attribute__((address_space(4))) Args* ap = (const __attribute__((address_space(4))) Args*)__builtin_amdgcn_kernarg_segment_ptr(); asm volatile("" : "+s"(ap));
    F.x = ap->in[0]; F.w_in = ap->in[1]; F.sgu_w = ap->in[2]; F.sgu_b = ap->in[3]; F.sgu_ln_g = ap->in[4]; F.sgu_ln_b = ap->in[5]; F.mix_g = ap->in[6]; F.w_out = ap->in[7];
    F.ln1_g = ap->in[8]; F.ln1_b = ap->in[9]; F.w_router = ap->in[10]; F.b_router = ap->in[11]; F.w_gate = ap->in[12]; F.b_gate = ap->in[13]; F.w_up = ap->in[14]; F.b_up = ap->in[15];
    F.w_down = ap->in[16]; F.b_down = ap->in[17]; F.ln2_g = ap->in[18]; F.ln2_b = ap->in[19]; F.out = ap->out; F.ws = ap->ws;
    unsigned char* ws = ap->ws;
    F.ctl = (unsigned*)(ws + WS_CTL); F.list = (int*)(ws + WS_LIST); F.einfo = (int*)(ws + WS_EINFO); F.gates = (float*)(ws + WS_GATES);
    F.Win_t = (bf16_t*)(ws + WS_WIN); F.Wout_t = (bf16_t*)(ws + WS_WOUT); F.Wd_t = (act_t*)(ws + WS_WD); F.Wgu_t = (fp8_t*)(ws + WS_WGU); F.Y = (bf16_t*)(ws + WS_Y);
    F.Hb = (fp8_t*)(ws + WS_HB); F.Xb = (bf16_t*)(ws + WS_XB); F.P1 = (bf16_t*)(ws + WS_P1); F.Amix = (bf16_t*)(ws + WS_AMIX); F.Act = (act_t*)(ws + WS_ACT);
    F.WrtHi = (bf16_t*)(ws + WS_WRT); F.Opart = (bf16_t*)(ws + WS_OPART); F.ML = (float*)(ws + WS_ML);
    return true; }
constexpr int N_PHASES = 8;
__global__ void __launch_bounds__(512, 2) mk_fwd(Args args) {
    extern __shared__ __attribute__((aligned(16))) unsigned char lds_raw[];
    Frame F;
    F.lds = (LAS unsigned char*)lds_raw; F.tid = threadIdx.x; F.lane = F.tid & 63; F.wave = __builtin_amdgcn_readfirstlane(F.tid >> 6);
    F.G = gridDim.x; { const int bx = blockIdx.x; F.vcu = (F.G % 8 == 0) ? (bx % 8) * (F.G / 8) + bx / 8 : bx; }
    fresh(F);
    unsigned char* ws = F.ws;
    const int lo = args.ph_lo, hi = args.ph_hi;
    volatile LAS unsigned* misc = (volatile LAS unsigned*)(F.lds + MISC_OFF);
    if (F.tid < 16) misc[F.tid] = 0u;
    __syncthreads();
    XcdBarrier bar; bar.bar = F.ctl + CW_BAR; bar.x = 0; bar.st = misc;
    if (hi - lo > 1) bar = xcd_barrier_post(F.ctl + CW_BAR, misc);
    const LAS int* rowtab = (const LAS int*)(F.lds + ROWTAB_OFF);
#ifndef PROBE_DUP
#define PROBE_DUP -1
#endif
#define IN(k) (lo <= (k) && (k) < hi && fresh(F))
#define SEAM(k) do { if (lo <= (k) && (k) + 1 < hi) { xcd_barrier(bar); } } while (0)
#define REP(k) for (int _rep = 0; _rep < ((PROBE_DUP == (k)) ? 2 : 1); ++_rep)
    if (IN(0)) REP(0) { p0_convert(F); }
    SEAM(0);
    if (IN(1)) REP(1) {
        pg8::Gemm g{F.Xb, F.Win_t, D * 2}; pg8::EpiP1 E{F.P1}; constexpr int NU1 = (T / 256) * (INC / 256);
        int nun = 0; for (int i = 0; i * F.G + F.vcu < NU1; ++i) ++nun;
        constexpr int SH = MOE_ITEMS / 3;
        int pos = 0, count = SH / (F.G * 8) + 1, first = (F.vcu * 8 + F.wave) * count, lim = SH;
        if (F.G == 256) { if (nun == 3) { pos = F.vcu & 3; count = 1; first = F.vcu * 8 + F.wave; } else { pos = F.vcu % 3; count = 7; first = 1024 + ((F.vcu - 128) * 8 + F.wave) * 7; } }
        if (first + count > lim) count = lim - first;
        { pg8::DenseOrder S{INC / 256, NU1, F.G, F.vcu, 0, pos}; pg8::gemm_phase<pg8::EpiP1, pg8::DenseOrder, false, false>(F.lds, rowtab, g, S, E); }
        moe_convert_items(F, first, count);
        __syncthreads();
        { pg8::DenseOrder S{INC / 256, NU1, F.G, F.vcu, pos, 1 << 20}; pg8::gemm_phase<pg8::EpiP1, pg8::DenseOrder, false, false>(F.lds, rowtab, g, S, E); } }
    SEAM(1);
    if (IN(2)) REP(2) { p2_mixers(F); }
    SEAM(2);
    if (IN(3)) REP(3) { p3_merge(F); }
    SEAM(3);
    if (IN(4)) REP(4) { pg8::Gemm g{F.Amix, F.Wout_t, D * 2}; pg8::DenseOrder S{D / 256, (T / 256) * (D / 256), F.G, F.vcu, 0, 1 << 20}; pg8::EpiZ E{F.x, F.out};
        pg8::gemm_phase<pg8::EpiZ, pg8::DenseOrder, false, false>(F.lds, rowtab, g, S, E); }
    SEAM(4);
    if (IN(5)) { p4_route(F); }
    SEAM(5);
    if (IN(6)) REP(6) { const int ntiles = moe_tables<true>(F, 8); pg8::Gemm g{F.Hb, F.Wgu_t, D}; pg8::EpiSwiglu E{F.Act, F.b_gate, F.b_up};
        constexpr int SH = MOE_ITEMS / 3; const int cnt = SH / (F.G * 8) + ((SH % (F.G * 8)) ? 1 : 0); int first = 2 * SH + (F.vcu * 8 + F.wave) * cnt, count = cnt;
        if (first + count > 3 * SH) count = 3 * SH - first;
        const int pos = 2 * (F.vcu & 3);
        { pg8::MoeOrder S{8, ntiles * 8, F.G, F.vcu, (const LAS int*)(F.lds + TAB_OFF) + 32, 0, pos}; pg8::gemm_phase<pg8::EpiSwiglu, pg8::MoeOrder, true, true>(F.lds, rowtab, g, S, E); }
        moe_convert_items(F, first, count);
        __syncthreads();
        { pg8::MoeOrder S{8, ntiles * 8, F.G, F.vcu, (const LAS int*)(F.lds + TAB_OFF) + 32, pos, 1 << 20}; pg8::gemm_phase<pg8::EpiSwiglu, pg8::MoeOrder, true, true>(F.lds, rowtab, g, S, E); } }
    SEAM(6);
    if (IN(7)) REP(7) { const int ntiles = moe_tables<false>(F, 4); pg8::Gemm g{F.Act, F.Wd_t, FF * (int)sizeof(act_t)}; pg8::MoeOrder S{4, ntiles * 4, F.G, F.vcu, (const LAS int*)(F.lds + TAB_OFF) + 32, 0, 1 << 20};
        pg8::EpiY E{F.Y, F.b_down};
        pg8::gemm_phase<pg8::EpiY, pg8::MoeOrder, false, (G2_FP8 != 0)>(F.lds, rowtab, g, S, E); }
    SEAM(7);
    if (IN(8)) { p7_final(F); }
#undef IN
#undef SEAM
}

extern "C" void kernel_launch(void* const* d_in, const int* in_sizes, int n_in, void* d_out, int out_size, void* d_ws, size_t ws_size, hipStream_t stream) {
    static int grid = 0;
    if (grid == 0) {
        if (n_in != 20 || in_sizes[0] != T * D || out_size != T * D || ws_size < WS_END) { fprintf(stderr, "kernel_launch: unexpected shapes (n_in %d, in0 %d, out %d, ws %zu)\n", n_in, n_in > 0 ? in_sizes[0] : -1, out_size, ws_size); grid = -1; return; }
        int dev = 0, cus = 0, per_cu = 0;
        hipGetDevice(&dev); hipDeviceGetAttribute(&cus, hipDeviceAttributeMultiprocessorCount, dev);
        if (hipFuncSetAttribute((const void*)mk_fwd, hipFuncAttributeMaxDynamicSharedMemorySize, LDS_BYTES) != hipSuccess) { fprintf(stderr, "kernel_launch: hipFuncSetAttribute failed\n"); grid = -1; return; }
        hipOccupancyMaxActiveBlocksPerMultiprocessor(&per_cu, (const void*)mk_fwd, 512, LDS_BYTES);
        (void)hipGetLastError();
        if (per_cu < 1) { fprintf(stderr, "kernel_launch: occupancy query says %d blocks/CU: the grid would not be resident; nothing launched\n", per_cu); grid = -1; return; }
        grid = cus;
        if (grid != 256) fprintf(stderr, "kernel_launch: note: %d CUs (tuned for 256)\n", grid);
    }
    if (grid < 0) return;
    hipMemsetAsync((char*)d_ws + WS_CTL, 0, CTL_ZERO_BYTES, stream);
    Args a{};
    for (int i = 0; i < 20; ++i) a.in[i] = (const float*)d_in[i];
    a.out = (float*)d_out; a.ws = (unsigned char*)d_ws;
#if MK_N_LAUNCHES == 1
    a.ph_lo = 0; a.ph_hi = N_PHASES + 1;
    hipLaunchKernelGGL(mk_fwd, dim3(grid), dim3(512), LDS_BYTES, stream, a);
#else
    for (int p = 0; p <= N_PHASES; ++p) { a.ph_lo = p; a.ph_hi = p + 1; hipLaunchKernelGGL(mk_fwd, dim3(grid), dim3(512), LDS_BYTES, stream, a); }
#endif
}
```

```cpp
#include <hip/hip_runtime.h>
#include <hip/hip_cooperative_groups.h>
#include <cstdio>
#include <cstdint>
namespace cg = cooperative_groups;

#ifndef MK_N_LAUNCHES
#define MK_N_LAUNCHES 1
#endif

constexpr int BATCH = 4, SEQ = 4096, T = BATCH * SEQ, D = 1024, INC = 2560, NE = 32, FF = 1024, TOPK = 4;
constexpr int AW = 512, NGRP = 8, GD = 64, CHUNK = 128, NH = 8, HD = 64;
constexpr float LN_EPS = 1e-5f, DN_ALPHA = 1.189207115002721f;
constexpr int NSLOT = T * TOPK;
constexpr int MAXTILES = 288;
constexpr int MAXU = 12;

constexpr size_t MiB = 1u << 20;
constexpr size_t WS_CTL = 0, CTL_ZERO_BYTES = 64 * 1024;
constexpr size_t WS_LIST = 1 * MiB;
constexpr size_t WS_GATES = 3 * MiB;
constexpr size_t WS_EINFO = 3 * MiB + 256 * 1024;
constexpr size_t WS_WRT = 3 * MiB + 512 * 1024;
constexpr size_t WS_WIN = 4 * MiB;
constexpr size_t WS_WOUT = 9 * MiB;
constexpr size_t WS_WD = 11 * MiB;
constexpr size_t WS_WGU = 75 * MiB;
constexpr size_t WS_HB = 139 * MiB;
constexpr size_t WS_BIG = 155 * MiB;
constexpr size_t WS_XB = WS_BIG;
constexpr size_t WS_P1 = WS_BIG + 32 * MiB;
constexpr size_t WS_AMIX = WS_BIG + 112 * MiB;
constexpr size_t WS_ACT = WS_BIG;
constexpr size_t WS_Y = 299 * MiB;
constexpr size_t WS_OPART = 427 * MiB;
constexpr size_t WS_ML = 475 * MiB;
constexpr size_t WS_END = 478 * MiB;
#ifndef G2_FP8
#define G2_FP8 1
#endif
constexpr float WGU_SCALE = 32.0f, WD_SCALE = G2_FP8 ? 64.0f : 1.0f;
#if G2_FP8
typedef unsigned char act_t;
#else
typedef unsigned short act_t;
#endif
constexpr int CW_BAR = 1024;
constexpr int CW_CNT = 0;

constexpr int RING_BYTES = 131072;
constexpr int TAB_OFF = RING_BYTES + 1024;
constexpr int ROWTAB_OFF = RING_BYTES + 2048;
constexpr int MISC_OFF = 147456 - 64;
constexpr int LDS_BYTES = 147456;
static_assert(ROWTAB_OFF + MAXU * 1024 <= LDS_BYTES, "LDS map");

#define LAS __attribute__((address_space(3)))
typedef unsigned short bf16_t;
typedef unsigned char fp8_t;
typedef short bf16x8 __attribute__((ext_vector_type(8)));
typedef float f32x4 __attribute__((ext_vector_type(4)));
typedef float f32x2 __attribute__((ext_vector_type(2)));
typedef unsigned u32x4 __attribute__((ext_vector_type(4)));
typedef unsigned u32x2 __attribute__((ext_vector_type(2)));
typedef int v8i32 __attribute__((ext_vector_type(8)));
typedef int v4i32 __attribute__((ext_vector_type(4)));


__device__ __forceinline__ unsigned cvt_pk_bf16(float lo, float hi) { unsigned r; asm volatile("v_cvt_pk_bf16_f32 %0, %1, %2" : "=v"(r) : "v"(lo), "v"(hi)); return r; }
__device__ __forceinline__ unsigned cvt4_fp8(float a, float b, float c, float d) { int w = 0; w = __builtin_amdgcn_cvt_pk_fp8_f32(a, b, w, false); w = __builtin_amdgcn_cvt_pk_fp8_f32(c, d, w, true); return (unsigned)w; }
__device__ __forceinline__ float bf_lo(unsigned w) { return __uint_as_float(w << 16); }
__device__ __forceinline__ float bf_hi(unsigned w) { return __uint_as_float(w & 0xffff0000u); }
__device__ __forceinline__ float bf1(bf16_t b) { return __uint_as_float((unsigned)b << 16); }
__device__ __forceinline__ float wave_sum(float v) {
#pragma unroll
    for (int o = 1; o < 64; o <<= 1) v += __shfl_xor(v, o);
    return v;
}
__device__ __forceinline__ float gelu_tanh(float x) {
    const float y2 = x * (1.5957691216057308f + 0.07135481627260025f * x * x);
    return x * __builtin_amdgcn_rcpf(1.0f + __builtin_amdgcn_exp2f(-1.4426950408889634f * y2));
}

namespace pg8 {
constexpr int BM = 256, BK = 64, HALF = 128, HTB = HALF * BK * 2, STAGE_BYTES = 8 * HTB;
__host__ __device__ __forceinline__ int lds_byte(int r, int c) { const int st = (r >> 4) * 2 + (c >> 5), rr = r & 15, cc = c & 31, ob = rr * 64 + cc * 2; return st * 1024 + (ob ^ (((ob >> 9) & 1) << 5)); }
__host__ __device__ __forceinline__ void stage_rc(int b, int& R, int& C) { const int st = b / 1024, sb = b % 1024, swz = sb ^ (((sb >> 9) & 1) << 5); R = (st >> 1) * 16 + swz / 64; C = (st & 1) * 32 + (swz % 64) / 2; }
__host__ __device__ __forceinline__ int perm32(int rho) { const int n = rho >> 4, i = rho & 15; return 8 * (i >> 2) + 4 * n + (i & 3); }

struct Unit { int pm, pn, pb, e, mt, ui; };
struct Gemm { const void* A; const void* Bt; int KB; };

struct DenseOrder {
    int nN, nU, G, v, i0, i1;
    __device__ __forceinline__ bool next(int i, Unit& u) const {
        i += i0; if (i >= i1) return false;
        const int L = i * G + v; if (L >= nU) return false;
        u.pm = L / nN; u.pn = L % nN; u.pb = u.pn; u.e = 0; u.mt = 0; u.ui = i; return true; }
};
struct MoeOrder {
    int NPN, nU, G, v; const LAS int* tstart; int i0, i1;
    __device__ __forceinline__ bool next(int i, Unit& u) const {
        i += i0; if (i >= i1) return false;
        const int L = i * G + v; if (L >= nU) return false;
        const int tl = L / NPN, pn = L % NPN; int e = 0;
#pragma unroll
        for (int j = 1; j < NE; ++j) e += (tstart[j] <= tl) ? 1 : 0;
        e = __builtin_amdgcn_readfirstlane(e); const int ts = __builtin_amdgcn_readfirstlane(tstart[e]);
        u.pm = tl; u.pn = pn; u.pb = e * NPN + pn; u.e = e; u.mt = tl - ts; u.ui = i; return true; }
};

template <class Epi, class Sched, bool GATHER, bool FP8>
__device__ __forceinline__ void gemm_phase(LAS unsigned char* lds, const LAS int* rowtab, const Gemm g, const Sched& S, const Epi& E) {
    const int tid = threadIdx.x, wid = __builtin_amdgcn_readfirstlane(tid >> 6), lane = tid & 63, wr = wid >> 2, wc = wid & 3, fr = lane & 15, fq = lane >> 4;
    const int KB = g.KB, nt = KB / (BK * 2);
    unsigned voffA0[2], voffA1[2], voffB[2]; int Rr[2], Cc[2];
#pragma unroll
    for (int i = 0; i < 2; ++i) { int R, C; stage_rc(tid * 16 + i * 8192, R, C); const int Rb = Epi::PERM ? ((R & ~31) + perm32(R & 31)) : R; Rr[i] = R; Cc[i] = C;
        voffA0[i] = (unsigned)(R * KB + C * 2); voffA1[i] = (unsigned)((R + HALF) * KB + C * 2); voffB[i] = (unsigned)(Rb * KB + C * 2); }
    const unsigned kstep = (unsigned)(BK * 2);
    const unsigned hstep = (unsigned)HALF * (unsigned)KB;
    const unsigned tstep = 2u * hstep;
    const __amdgpu_buffer_rsrc_t rsA = __builtin_amdgcn_make_buffer_rsrc(const_cast<void*>(g.A), 0, -1, 0x00020000);
    const __amdgpu_buffer_rsrc_t rsB = __builtin_amdgcn_make_buffer_rsrc(const_cast<void*>(g.Bt), 0, -1, 0x00020000);
    const unsigned ldsw = (unsigned)wid * 1024u;
    const int aoff = lds_byte(wr * 64 + fr, fq * 8), boff = lds_byte(wc * 32 + fr, fq * 8);
#define PG8_SA(b, h) (((b) * 2 + (h)) * HTB)
#define PG8_SB(b, h) ((4 + (b) * 2 + (h)) * HTB)
#define PG8_STAGE(bufoff, rs, soff, voff) do { _Pragma("unroll") for (int _i = 0; _i < 2; ++_i) \
        __builtin_amdgcn_raw_ptr_buffer_load_lds(rs, (LAS void*)(lds + (bufoff) + ldsw + _i * 8192), 16, (int)(voff)[_i], (int)(soff), 0, 0); } while (0)
#define PG8_LDA(dst, b, h) do { if constexpr (FP8) { _Pragma("unroll") for (int m = 0; m < 4; ++m) dst##8[m] = __builtin_shufflevector(*(const LAS v4i32*)(lds + PG8_SA(b, h) + aoff + m * 2048), *(const LAS v4i32*)(lds + PG8_SA(b, h) + aoff + m * 2048 + 1024), 0, 1, 2, 3, 4, 5, 6, 7); } \
        else { _Pragma("unroll") for (int m = 0; m < 4; ++m) _Pragma("unroll") for (int k = 0; k < 2; ++k) dst[m][k] = *(const LAS bf16x8*)(lds + PG8_SA(b, h) + aoff + m * 2048 + k * 1024); } } while (0)
#define PG8_LDB(dst, b, h) do { if constexpr (FP8) { _Pragma("unroll") for (int n = 0; n < 2; ++n) dst##8[n] = __builtin_shufflevector(*(const LAS v4i32*)(lds + PG8_SB(b, h) + boff + n * 2048), *(const LAS v4i32*)(lds + PG8_SB(b, h) + boff + n * 2048 + 1024), 0, 1, 2, 3, 4, 5, 6, 7); } \
        else { _Pragma("unroll") for (int n = 0; n < 2; ++n) _Pragma("unroll") for (int k = 0; k < 2; ++k) dst[n][k] = *(const LAS bf16x8*)(lds + PG8_SB(b, h) + boff + n * 2048 + k * 1024); } } while (0)
#define PG8_MMA(ai, bj, At, Bt) do { __builtin_amdgcn_s_setprio(1); if constexpr (FP8) { _Pragma("unroll") for (int m = 0; m < 4; ++m) _Pragma("unroll") for (int n = 0; n < 2; ++n) \
        acc[ai][bj][m][n] = __builtin_amdgcn_mfma_scale_f32_16x16x128_f8f6f4(Bt##8[n], At##8[m], acc[ai][bj][m][n], 0, 0, 0, 0x7F7F7F7F, 0, 0x7F7F7F7F); } \
        else { _Pragma("unroll") for (int m = 0; m < 4; ++m) _Pragma("unroll") for (int n = 0; n < 2; ++n) _Pragma("unroll") for (int k = 0; k < 2; ++k) \
        acc[ai][bj][m][n] = __builtin_amdgcn_mfma_f32_16x16x32_bf16(Bt[n][k], At[m][k], acc[ai][bj][m][n], 0, 0, 0); } __builtin_amdgcn_s_setprio(0); } while (0)
#define PG8_WAIT_V(n) asm volatile("s_waitcnt vmcnt(" #n ")" ::: "memory")
#define PG8_WAIT_L(n) asm volatile("s_waitcnt lgkmcnt(" #n ")" ::: "memory")
#define PG8_BAR __builtin_amdgcn_s_barrier()
#define PG8_SCHED __builtin_amdgcn_sched_barrier(0)
#define PG8_LOADROWS(U) do { if constexpr (GATHER) { _Pragma("unroll") for (int _i = 0; _i < 2; ++_i) { \
        voffA0[_i] = (unsigned)rowtab[(U).ui * 256 + Rr[_i]] + (unsigned)Cc[_i] * 2u; voffA1[_i] = (unsigned)rowtab[(U).ui * 256 + HALF + Rr[_i]] + (unsigned)Cc[_i] * 2u; } } } while (0)
    Unit cur, nxt; int ui = 0;
    if (!S.next(0, cur)) return;
    f32x4 acc[2][2][4][2];
#pragma unroll
    for (int a = 0; a < 2; ++a)
#pragma unroll
        for (int b = 0; b < 2; ++b)
#pragma unroll
            for (int m = 0; m < 4; ++m)
#pragma unroll
                for (int n = 0; n < 2; ++n) acc[a][b][m][n] = (f32x4){0.f, 0.f, 0.f, 0.f};
    bf16x8 At[4][2], B0[2][2], B1[2][2]; v8i32 At8[4], B08[2], B18[2];
    unsigned cA = GATHER ? 0u : (unsigned)cur.pm * tstep, cB = (unsigned)cur.pb * tstep;
    PG8_LOADROWS(cur); PG8_WAIT_L(0);
    PG8_STAGE(PG8_SB(0, 0), rsB, cB, voffB); PG8_STAGE(PG8_SB(0, 1), rsB, cB + hstep, voffB); PG8_STAGE(PG8_SA(0, 0), rsA, cA, voffA0); PG8_STAGE(PG8_SA(0, 1), rsA, cA, voffA1);
    if (wr == 1) PG8_BAR;
    PG8_WAIT_V(2); PG8_BAR;
    PG8_STAGE(PG8_SB(1, 0), rsB, cB + kstep, voffB); PG8_STAGE(PG8_SA(1, 0), rsA, cA + kstep, voffA0); PG8_STAGE(PG8_SB(1, 1), rsB, cB + hstep + kstep, voffB);
    PG8_WAIT_V(6); PG8_BAR;
    for (;;) {
        const bool has_next = S.next(ui + 1, nxt);
        const unsigned nA = has_next ? (GATHER ? 0u : (unsigned)nxt.pm * tstep) : cA, nB = has_next ? (unsigned)nxt.pb * tstep : cB;
#pragma unroll 1
        for (int t = 0; t < nt; t += 2) {
            const bool last = (t == nt - 2);
            const unsigned a1 = cA + (unsigned)(t + 1) * kstep;
            const unsigned a2 = last ? nA : cA + (unsigned)(t + 2) * kstep, b2 = last ? nB : cB + (unsigned)(t + 2) * kstep;
            const unsigned a3 = a2 + kstep, b3 = b2 + kstep;
            PG8_LDB(B0, 0, 0); PG8_LDB(B1, 0, 1); PG8_SCHED; PG8_LDA(At, 0, 0); PG8_STAGE(PG8_SA(1, 1), rsA, a1, voffA1);
            if (last && has_next) PG8_LOADROWS(nxt);
            PG8_WAIT_V(8); PG8_WAIT_L(0); PG8_BAR; PG8_MMA(0, 0, At, B0); PG8_MMA(0, 1, At, B1); PG8_BAR; PG8_SCHED;
            PG8_LDA(At, 0, 1); PG8_STAGE(PG8_SB(0, 0), rsB, b2, voffB); PG8_STAGE(PG8_SB(0, 1), rsB, b2 + hstep, voffB); PG8_STAGE(PG8_SA(0, 0), rsA, a2, voffA0);
            PG8_WAIT_V(8); PG8_WAIT_L(0); PG8_BAR; PG8_MMA(1, 0, At, B0); PG8_MMA(1, 1, At, B1); PG8_BAR; PG8_SCHED;
            PG8_LDB(B0, 1, 0); PG8_LDB(B1, 1, 1); PG8_SCHED; PG8_LDA(At, 1, 0); PG8_STAGE(PG8_SA(0, 1), rsA, a2, voffA1);
            PG8_WAIT_V(8); PG8_WAIT_L(0); PG8_BAR; PG8_MMA(0, 0, At, B0); PG8_MMA(0, 1, At, B1); PG8_BAR; PG8_SCHED;
            PG8_LDA(At, 1, 1); PG8_STAGE(PG8_SB(1, 0), rsB, b3, voffB); PG8_STAGE(PG8_SB(1, 1), rsB, b3 + hstep, voffB); PG8_STAGE(PG8_SA(1, 0), rsA, a3, voffA0);
            PG8_WAIT_V(8); PG8_WAIT_L(0); PG8_BAR; PG8_MMA(1, 0, At, B0); PG8_MMA(1, 1, At, B1); PG8_BAR; PG8_SCHED;
        }
        if (wr == 0) PG8_BAR;
        { int t2 = threadIdx.x; asm volatile("" : "+v"(t2));
          const int w2 = __builtin_amdgcn_readfirstlane(t2 >> 6), l2 = t2 & 63; E(acc, cur, w2 >> 2, w2 & 3, l2 & 15, l2 >> 4); }
        if (!has_next) break;
#pragma unroll
        for (int a = 0; a < 2; ++a)
#pragma unroll
            for (int b = 0; b < 2; ++b)
#pragma unroll
                for (int m = 0; m < 4; ++m)
#pragma unroll
                    for (int n = 0; n < 2; ++n) acc[a][b][m][n] = (f32x4){0.f, 0.f, 0.f, 0.f};
        cur = nxt; cA = nA; cB = nB; ++ui;
        if (wr == 1) PG8_BAR;
    }
    PG8_WAIT_V(0);
    PG8_BAR;
#undef PG8_SA
#undef PG8_SB
#undef PG8_STAGE
#undef PG8_LDA
#undef PG8_LDB
#undef PG8_MMA
#undef PG8_WAIT_V
#undef PG8_WAIT_L
#undef PG8_BAR
#undef PG8_SCHED
#undef PG8_LOADROWS
}

struct EpiP1 {
    static constexpr bool PERM = true;
    bf16_t* O;
    __device__ __forceinline__ void operator()(const f32x4 (&acc)[2][2][4][2], const Unit& u, int wr, int wc, int fr, int fq) const {
        const int row0 = u.pm * BM + wr * 64 + fr, col0 = u.pn * BM + wc * 32 + 8 * fq; const bool act = u.pn < 4;
#pragma unroll
        for (int ai = 0; ai < 2; ++ai)
#pragma unroll
            for (int m = 0; m < 4; ++m) { bf16_t* rowp = O + (size_t)(row0 + ai * HALF + m * 16) * INC + col0;
#pragma unroll
                for (int bj = 0; bj < 2; ++bj) { f32x4 v0 = acc[ai][bj][m][0], v1 = acc[ai][bj][m][1];
                    if (act) {
#pragma unroll
                        for (int j = 0; j < 4; ++j) { v0[j] = gelu_tanh(v0[j]); v1[j] = gelu_tanh(v1[j]); } }
                    u32x4 w; w.x = cvt_pk_bf16(v0[0], v0[1]); w.y = cvt_pk_bf16(v0[2], v0[3]); w.z = cvt_pk_bf16(v1[0], v1[1]); w.w = cvt_pk_bf16(v1[2], v1[3]);
                    *(u32x4*)(rowp + bj * HALF) = w; } }
    }
};
struct EpiZ {
    static constexpr bool PERM = true;
    const float* X; bf16_t* Z;
    __device__ __forceinline__ void operator()(const f32x4 (&acc)[2][2][4][2], const Unit& u, int wr, int wc, int fr, int fq) const {
        const int col0 = u.pn * BM + wc * 32 + 8 * fq;
#pragma unroll
        for (int ai = 0; ai < 2; ++ai)
#pragma unroll
            for (int m = 0; m < 4; ++m) { const size_t off = (size_t)(u.pm * BM + ai * HALF + wr * 64 + m * 16 + fr) * D + col0;
#pragma unroll
                for (int bj = 0; bj < 2; ++bj) { const f32x4 x0 = *(const f32x4*)(X + off + bj * HALF), x1 = *(const f32x4*)(X + off + bj * HALF + 4);
                    const f32x4 v0 = x0 * DN_ALPHA + acc[ai][bj][m][0], v1 = x1 * DN_ALPHA + acc[ai][bj][m][1];
                    u32x4 w; w.x = cvt_pk_bf16(v0[0], v0[1]); w.y = cvt_pk_bf16(v0[2], v0[3]); w.z = cvt_pk_bf16(v1[0], v1[1]); w.w = cvt_pk_bf16(v1[2], v1[3]);
                    *(u32x4*)(Z + off + bj * HALF) = w; } }
    }
};
struct EpiSwiglu {
    static constexpr bool PERM = true;
    act_t* Act; const float* bg; const float* bu;
    __device__ __forceinline__ void operator()(const f32x4 (&acc)[2][2][4][2], const Unit& u, int wr, int wc, int fr, int fq) const {
        const int f0 = u.pn * HALF + wc * 32 + 8 * fq; const int row0 = u.pm * BM + wr * 64 + fr;
        const f32x4 bg0 = *(const f32x4*)(bg + u.e * FF + f0), bg1 = *(const f32x4*)(bg + u.e * FF + f0 + 4);
        const f32x4 bu0 = *(const f32x4*)(bu + u.e * FF + f0), bu1 = *(const f32x4*)(bu + u.e * FF + f0 + 4);
#pragma unroll
        for (int ai = 0; ai < 2; ++ai)
#pragma unroll
            for (int m = 0; m < 4; ++m) {
                f32x4 g0 = acc[ai][0][m][0] * (1.0f / WGU_SCALE) + bg0, g1 = acc[ai][0][m][1] * (1.0f / WGU_SCALE) + bg1, u0 = acc[ai][1][m][0] * (1.0f / WGU_SCALE) + bu0, u1 = acc[ai][1][m][1] * (1.0f / WGU_SCALE) + bu1, r0, r1;
#pragma unroll
                for (int j = 0; j < 4; ++j) {
                    const float ga = fminf(g0[j], 7.0f), gb = fminf(g1[j], 7.0f);
                    const float ua = fminf(fmaxf(u0[j], -7.0f), 7.0f), ub = fminf(fmaxf(u1[j], -7.0f), 7.0f);
                    r0[j] = (ua + 1.0f) * ga * __builtin_amdgcn_rcpf(1.0f + __builtin_amdgcn_exp2f(-1.702f * 1.4426950408889634f * ga));
                    r1[j] = (ub + 1.0f) * gb * __builtin_amdgcn_rcpf(1.0f + __builtin_amdgcn_exp2f(-1.702f * 1.4426950408889634f * gb)); }
                if constexpr (G2_FP8) { u32x2 w; w.x = cvt4_fp8(r0[0], r0[1], r0[2], r0[3]); w.y = cvt4_fp8(r1[0], r1[1], r1[2], r1[3]); *(u32x2*)(Act + (size_t)(row0 + ai * HALF + m * 16) * FF + f0) = w; }
                else { u32x4 w; w.x = cvt_pk_bf16(r0[0], r0[1]); w.y = cvt_pk_bf16(r0[2], r0[3]); w.z = cvt_pk_bf16(r1[0], r1[1]); w.w = cvt_pk_bf16(r1[2], r1[3]); *(u32x4*)(Act + (size_t)(row0 + ai * HALF + m * 16) * FF + f0) = w; } }
    }
};
struct EpiY {
    static constexpr bool PERM = true;
    bf16_t* Y; const float* bd;
    __device__ __forceinline__ void operator()(const f32x4 (&acc)[2][2][4][2], const Unit& u, int wr, int wc, int fr, int fq) const {
        const int c0 = u.pn * BM + wc * 32 + 8 * fq; const int row0 = u.pm * BM + wr * 64 + fr;
        f32x4 b[2][2];
#pragma unroll
        for (int bj = 0; bj < 2; ++bj) { b[bj][0] = *(const f32x4*)(bd + u.e * D + c0 + bj * HALF); b[bj][1] = *(const f32x4*)(bd + u.e * D + c0 + bj * HALF + 4); }
#pragma unroll
        for (int ai = 0; ai < 2; ++ai)
#pragma unroll
            for (int m = 0; m < 4; ++m) { bf16_t* rowp = Y + (size_t)(row0 + ai * HALF + m * 16) * D + c0;
#pragma unroll
                for (int bj = 0; bj < 2; ++bj) { const f32x4 v0 = acc[ai][bj][m][0] * (1.0f / WD_SCALE) + b[bj][0], v1 = acc[ai][bj][m][1] * (1.0f / WD_SCALE) + b[bj][1];
                    u32x4 w; w.x = cvt_pk_bf16(v0[0], v0[1]); w.y = cvt_pk_bf16(v0[2], v0[3]); w.z = cvt_pk_bf16(v1[0], v1[1]); w.w = cvt_pk_bf16(v1[2], v1[3]);
                    *(u32x4*)(rowp + bj * HALF) = w; } }
    }
};
}


#define XB_TMO      128
#define XB_XCNT(j)  (256  + 64 * (j))
#define XB_XSUB(j)  (1280 + 64 * (j))
#define XB_XGEN(j)  (2304 + 64 * (j))
#define XB_TOP      3328
#define XB_TOPGEN   3392
#define XCD_BAR_WORDS 3456
#define XB_SPIN_CAP (1u << 22)
__device__ __forceinline__ unsigned xb_ld(unsigned* p)              { return __hip_atomic_load(p, __ATOMIC_RELAXED, __HIP_MEMORY_SCOPE_AGENT); }
__device__ __forceinline__ unsigned xb_add(unsigned* p, unsigned v) { return __hip_atomic_fetch_add(p, v, __ATOMIC_RELAXED, __HIP_MEMORY_SCOPE_AGENT); }
__device__ __forceinline__ unsigned xb_xcc_id() { return (unsigned)__builtin_amdgcn_s_getreg((3 << 11) | 20) & 0xFu; }
#define XB_SPIN(cond, bar) do { unsigned _sp = 0; while (cond) { __builtin_amdgcn_s_sleep(1); \
    if ((++_sp & 255u) == 0u) { if (xb_ld(&(bar)[XB_TMO])) break; if (_sp > XB_SPIN_CAP) { atomicAdd(&(bar)[XB_TMO], 1u); break; } } } } while (0)
struct XcdBarrier { unsigned* bar; unsigned x; volatile LAS unsigned* st; };
__device__ __forceinline__ XcdBarrier xcd_barrier_post(unsigned* bar, volatile LAS unsigned* st) {
    XcdBarrier b; b.bar = bar; b.x = xb_xcc_id(); b.st = st;
    if (threadIdx.x == 0) (void)xb_add(&bar[XB_XCNT(b.x)], 1u);
    return b;
}
__device__ __forceinline__ void xcd_barrier_complete(unsigned* bar, unsigned x, unsigned& nloc, unsigned& nx) {
    const unsigned G = gridDim.x * gridDim.y * gridDim.z;
    unsigned sum, cnt, mine, sp = 0u;
    for (;;) {
        sum = 0u; cnt = 0u; mine = 0u;
#pragma unroll
        for (unsigned j = 0; j < 16; ++j) { const unsigned c = xb_ld(&bar[XB_XCNT(j)]); sum += c; cnt += (c > 0u) ? 1u : 0u; mine = (j == x) ? c : mine; }
        if (sum == G) break;
        __builtin_amdgcn_s_sleep(1);
        if ((++sp & 255u) == 0u) { if (xb_ld(&bar[XB_TMO])) break; if (sp > XB_SPIN_CAP) { atomicAdd(&bar[XB_TMO], 1u); break; } }
    }
    nloc = mine > 0u ? mine : 1u; nx = cnt > 0u ? cnt : 1u;
}
__device__ __forceinline__ void xcd_barrier(const XcdBarrier& b) {
    asm volatile("s_waitcnt vmcnt(0)" ::: "memory");
    __syncthreads();
    if (threadIdx.x == 0) {
        unsigned* bar = b.bar;
        __builtin_amdgcn_s_waitcnt(0);
        unsigned nloc = b.st[0], nx = b.st[1];
        if (nloc == 0u) { xcd_barrier_complete(bar, b.x, nloc, nx); b.st[0] = nloc; b.st[1] = nx; }
        const unsigned old = xb_add(&bar[XB_XSUB(b.x)], 1u);
        const unsigned gen = old / nloc;
        if (old + 1u == (gen + 1u) * nloc) {
            __builtin_amdgcn_fence(__ATOMIC_RELEASE, "agent");
            asm volatile("s_waitcnt vmcnt(0)" ::: "memory");
            const unsigned og = xb_add(&bar[XB_TOP], 1u);
            const unsigned tg = og / nx;
            if (og + 1u == (tg + 1u) * nx) xb_add(&bar[XB_TOPGEN], 1u);
            else XB_SPIN(xb_ld(&bar[XB_TOPGEN]) == tg, bar);
            __builtin_amdgcn_fence(__ATOMIC_ACQUIRE, "agent");
            xb_add(&bar[XB_XGEN(b.x)], 1u);
            asm volatile("s_waitcnt vmcnt(0)" ::: "memory");
        } else {
            XB_SPIN(xb_ld(&bar[XB_XGEN(b.x)]) == gen, bar);
            __builtin_amdgcn_fence(__ATOMIC_ACQUIRE, "agent");
            asm volatile("s_waitcnt vmcnt(0)" ::: "memory");
        }
    }
    __syncthreads();
}

struct Args { const float* in[20]; float* out; unsigned char* ws; int ph_lo, ph_hi; };
struct Frame {
    LAS unsigned char* lds; int tid, lane, wave, G, vcu;
    const float *x, *w_in, *sgu_w, *sgu_b, *sgu_ln_g, *sgu_ln_b, *mix_g, *w_out, *ln1_g, *ln1_b, *w_router, *b_router, *w_gate, *b_gate, *w_up, *b_up, *w_down, *b_down, *ln2_g, *ln2_b;
    float* out; unsigned char* ws;
    unsigned* ctl; int* list; int* einfo; float* gates; bf16_t *Win_t, *Wout_t, *Y, *Xb, *P1, *Amix; act_t *Wd_t, *Act; fp8_t *Wgu_t, *Hb; bf16_t* Opart; float* ML; bf16_t* WrtHi; bf16_t* Zb; bf16_t* Hh;
};

__device__ __forceinline__ void transpose_item(const float* W, int N, int K, int k0, int n0, bf16_t* WT, size_t dst_row0, LAS float* scr, int lane) {
    const int kr = lane >> 3, c4 = lane & 7; f32x4 v[8];
#pragma unroll
    for (int i = 0; i < 8; ++i) v[i] = *(const f32x4*)(W + (size_t)(k0 + 8 * kr + i) * N + n0 + 4 * c4);
#pragma unroll
    for (int e = 0; e < 4; ++e) { u32x4 o; o.x = cvt_pk_bf16(v[0][e], v[1][e]); o.y = cvt_pk_bf16(v[2][e], v[3][e]); o.z = cvt_pk_bf16(v[4][e], v[5][e]); o.w = cvt_pk_bf16(v[6][e], v[7][e]);
        *(u32x4*)(WT + (dst_row0 + 4 * c4 + e) * K + k0 + 8 * kr) = o; }
}
__device__ __forceinline__ void transpose_item8(const float* W, int N, int K, int k0, int n0, fp8_t* WT, size_t dst_row0, float scale, LAS float* scr, int lane) {
    { const int kr = lane >> 3, c4 = lane & 7; f32x4 v[16];
#pragma unroll
      for (int i = 0; i < 16; ++i) v[i] = *(const f32x4*)(W + (size_t)(k0 + 8 * i + kr) * N + n0 + 4 * c4);
#pragma unroll
      for (int i = 0; i < 16; ++i) { LAS float* d = scr + (8 * i + kr) * 33 + 4 * c4; d[0] = v[i][0]; d[1] = v[i][1]; d[2] = v[i][2]; d[3] = v[i][3]; } }
    asm volatile("s_waitcnt lgkmcnt(0)" ::: "memory");
    const int c = lane & 7;
#pragma unroll
    for (int j = 0; j < 4; ++j) { const int n = (lane >> 3) + 8 * j; const LAS float* s = scr + (16 * c) * 33 + n;
        u32x4 o; o.x = cvt4_fp8(s[0 * 33] * scale, s[1 * 33] * scale, s[2 * 33] * scale, s[3 * 33] * scale); o.y = cvt4_fp8(s[4 * 33] * scale, s[5 * 33] * scale, s[6 * 33] * scale, s[7 * 33] * scale);
        o.z = cvt4_fp8(s[8 * 33] * scale, s[9 * 33] * scale, s[10 * 33] * scale, s[11 * 33] * scale); o.w = cvt4_fp8(s[12 * 33] * scale, s[13 * 33] * scale, s[14 * 33] * scale, s[15 * 33] * scale);
        *(u32x4*)(WT + (dst_row0 + n) * K + k0 + 16 * c) = o; }
    asm volatile("s_waitcnt lgkmcnt(0)" ::: "memory");
}
constexpr int MOE_ITEMS = NE * 3 * 8 * 32;
static_assert(G2_FP8, "the MoE item list below assumes fp8 copies of all three expert matrices");
struct MoeItem { const float* src; fp8_t* dst; float scale; };
__device__ __forceinline__ MoeItem moe_item(const Frame& F, int it) {
    const int nb = it & 31, kb = (it >> 5) & 7, e = (it >> 8) & 31, which = it >> 13, n0 = 32 * nb; MoeItem m;
    if (which < 2) { m.src = (which ? F.w_up : F.w_gate) + (size_t)e * D * FF + (size_t)(128 * kb) * FF + n0; m.dst = F.Wgu_t + ((size_t)e * 2048 + (n0 >> 7) * 256 + which * 128 + (n0 & 127)) * D + 128 * kb; m.scale = WGU_SCALE; }
    else { m.src = F.w_down + (size_t)e * FF * D + (size_t)(128 * kb) * D + n0; m.dst = (fp8_t*)F.Wd_t + ((size_t)e * 1024 + n0) * FF + 128 * kb; m.scale = WD_SCALE; }
    return m; }
__device__ __forceinline__ void moe_item_load(const MoeItem& m, f32x4 (&v)[16], int lane) {
    const int kr = lane >> 3, c4 = lane & 7;
#pragma unroll
    for (int i = 0; i < 16; ++i) v[i] = *(const f32x4*)(m.src + (size_t)(16 * kr + i) * 1024 + 4 * c4); }
__device__ __forceinline__ void moe_item_finish(const MoeItem& m, const f32x4 (&v)[16], LAS float* scr, int lane) {
    const int kr = lane >> 3, c4 = lane & 7; const float scale = m.scale;
#pragma unroll
    for (int e = 0; e < 4; ++e) { u32x4 o;
        o.x = cvt4_fp8(v[0][e] * scale, v[1][e] * scale, v[2][e] * scale, v[3][e] * scale); o.y = cvt4_fp8(v[4][e] * scale, v[5][e] * scale, v[6][e] * scale, v[7][e] * scale);
        o.z = cvt4_fp8(v[8][e] * scale, v[9][e] * scale, v[10][e] * scale, v[11][e] * scale); o.w = cvt4_fp8(v[12][e] * scale, v[13][e] * scale, v[14][e] * scale, v[15][e] * scale);
        *(u32x4*)(m.dst + (size_t)(4 * c4 + e) * 1024 + 16 * kr) = o; } }
__device__ __forceinline__ void moe_convert_items(Frame& F, int first, int count) {
    int end = first + count; if (end > MOE_ITEMS) end = MOE_ITEMS;
#pragma unroll 1
    for (int it = first; it < end; ++it) { f32x4 va[16]; const MoeItem ma = moe_item(F, it); moe_item_load(ma, va, F.lane); moe_item_finish(ma, va, nullptr, F.lane); }
}
__device__ __forceinline__ void p0_convert(Frame& F) {
    LAS float* scr = (LAS float*)(F.lds + F.wave * 17408);
    const int gw = F.vcu * 8 + F.wave, NGW = F.G * 8;
    constexpr int I_IN = (D / 64) * (INC / 32), I_OUT = (D / 64) * (D / 32);
    for (int it = gw; it < I_IN + I_OUT; it += NGW) {
        int r = it;
        if (r < I_IN) { const int kb = r / (INC / 32), nb = r % (INC / 32); transpose_item(F.w_in, INC, D, 64 * kb, 32 * nb, F.Win_t, (size_t)32 * nb, scr, F.lane); continue; } r -= I_IN;
        { const int kb = r / (D / 32), nb = r % (D / 32); transpose_item(F.w_out, D, D, 64 * kb, 32 * nb, F.Wout_t, (size_t)32 * nb, scr, F.lane); }
    }
    for (int i2 = blockIdx.x * 512 + F.tid; i2 < D * NE; i2 += F.G * 512) { const int k = i2 >> 5, e = i2 & 31; const float wv = F.w_router[i2];
        const unsigned hi = cvt_pk_bf16(wv, 0.f) & 0xffffu; const unsigned lo = cvt_pk_bf16(wv - bf_lo(hi), 0.f) & 0xffffu;
        F.WrtHi[(size_t)e * D + k] = (bf16_t)hi; F.WrtHi[(size_t)(NE + e) * D + k] = (bf16_t)lo; }
    const size_t nchunk = (size_t)T * D / 8, cstride = (size_t)F.G * 512;
    for (size_t i = (size_t)blockIdx.x * 512 + F.tid; i < nchunk; i += 4 * cstride) {
        f32x4 a[4], b[4];
#pragma unroll
        for (int j = 0; j < 4; ++j) { const size_t ii = i + j * cstride; if (ii < nchunk) { a[j] = *(const f32x4*)(F.x + ii * 8); b[j] = *(const f32x4*)(F.x + ii * 8 + 4); } }
#pragma unroll
        for (int j = 0; j < 4; ++j) { const size_t ii = i + j * cstride; if (ii < nchunk) {
            u32x4 w; w.x = cvt_pk_bf16(a[j][0], a[j][1]); w.y = cvt_pk_bf16(a[j][2], a[j][3]); w.z = cvt_pk_bf16(b[j][0], b[j][1]); w.w = cvt_pk_bf16(b[j][2], b[j][3]);
            *(u32x4*)(F.Xb + ii * 8) = w; } } }
}

typedef float f32x16 __attribute__((ext_vector_type(16)));
typedef short s16x4 __attribute__((ext_vector_type(4)));
constexpr int SG_ROW = 272, SG_WAVE = 64 * SG_ROW, SG_SSQ_OFF = 8 * SG_WAVE;
static_assert(SG_SSQ_OFF + 8 * 128 * 4 <= LDS_BYTES, "SGU LDS");
__device__ __forceinline__ void sgu_unit(Frame& F, int u, int half) {
    const int g = F.wave, lane = F.lane, i = lane & 31, hh = lane >> 5; const size_t row0 = (size_t)u * CHUNK;
    LAS unsigned char* vt = F.lds + g * SG_WAVE; LAS float* ssq = (LAS float*)(F.lds + SG_SSQ_OFF);
    { u32x4 raw[2][8];
#pragma unroll
      for (int tt = 0; tt < 2; ++tt) { if (tt <= half) { const bf16_t* vp = F.P1 + (row0 + lane + 64 * tt) * INC + AW + g * GD;
#pragma unroll
          for (int c8 = 0; c8 < 8; ++c8) raw[tt][c8] = *(const u32x4*)(vp + 8 * c8); } }
#pragma unroll
      for (int tt = 0; tt < 2; ++tt) { if (tt <= half) { const int t = lane + 64 * tt;
        float v[64];
#pragma unroll
        for (int c8 = 0; c8 < 8; ++c8) { const unsigned w[4] = {raw[tt][c8].x, raw[tt][c8].y, raw[tt][c8].z, raw[tt][c8].w};
#pragma unroll
            for (int j = 0; j < 4; ++j) { v[8 * c8 + 2 * j] = bf_lo(w[j]); v[8 * c8 + 2 * j + 1] = bf_hi(w[j]); } }
        float s = 0.f;
#pragma unroll
        for (int c = 0; c < 64; ++c) s += v[c];
        const float mu = s * (1.f / 64.f); float q = 0.f;
#pragma unroll
        for (int c = 0; c < 64; ++c) { v[c] -= mu; q += v[c] * v[c]; }
        const float rstd = 1.0f / sqrtf(q * (1.f / 64.f) + LN_EPS);
#pragma unroll
        for (int c = 0; c < 64; ++c) { const float val = v[c] * rstd * F.sgu_ln_g[g * GD + c] + F.sgu_ln_b[g * GD + c];
            *(LAS bf16_t*)(vt + c * SG_ROW + t * 2) = (bf16_t)(cvt_pk_bf16(val, 0.f) & 0xffffu); } } } }
    asm volatile("s_waitcnt lgkmcnt(0)" ::: "memory");
    unsigned ssq_base = (unsigned)(uintptr_t)(ssq + i); asm volatile("" : "+v"(ssq_base));
    LAS float* ssq_r = (LAS float*)(uintptr_t)ssq_base; LAS float* ssq_w = ssq_r + g * 64;
    f32x16 acc[2][2];
    f32x4 wq[2][8][2]; u32x2 uqa[2][2][4]; float bsa[2];
#pragma unroll
    for (int n2 = 0; n2 < 2; ++n2) { const int nt = 2 * half + n2, t = 32 * nt + i, nks = 2 * nt + 2;
#pragma unroll
        for (int ks = 0; ks < 8; ++ks) { if (ks < nks) { const float* wp = F.sgu_w + ((size_t)g * CHUNK + t) * CHUNK + 16 * ks + 8 * hh; wq[n2][ks][0] = *(const f32x4*)wp; wq[n2][ks][1] = *(const f32x4*)(wp + 4); } }
        const bf16_t* up = F.P1 + (row0 + t) * INC + g * GD + 4 * hh;
#pragma unroll
        for (int mt = 0; mt < 2; ++mt)
#pragma unroll
            for (int g4 = 0; g4 < 4; ++g4) uqa[n2][mt][g4] = *(const u32x2*)(up + 32 * mt + 8 * g4);
        bsa[n2] = F.sgu_b[g * CHUNK + t]; }
#pragma unroll
    for (int n2 = 0; n2 < 2; ++n2) { const int nt = 2 * half + n2, t = 32 * nt + i, nks = 2 * nt + 2;
#pragma unroll
        for (int mt = 0; mt < 2; ++mt)
#pragma unroll
            for (int r = 0; r < 16; ++r) acc[mt][n2][r] = 0.f;
        const float bs = bsa[n2];
#pragma unroll
        for (int ks = 0; ks < 8; ++ks) { if (ks < nks) { const int s0 = 16 * ks + 8 * hh;
            float wv[8] = {wq[n2][ks][0][0], wq[n2][ks][0][1], wq[n2][ks][0][2], wq[n2][ks][0][3], wq[n2][ks][1][0], wq[n2][ks][1][1], wq[n2][ks][1][2], wq[n2][ks][1][3]};
#pragma unroll
            for (int j = 0; j < 8; ++j) wv[j] = (s0 + j <= t) ? wv[j] : 0.f;
            u32x4 bw; bw.x = cvt_pk_bf16(wv[0], wv[1]); bw.y = cvt_pk_bf16(wv[2], wv[3]); bw.z = cvt_pk_bf16(wv[4], wv[5]); bw.w = cvt_pk_bf16(wv[6], wv[7]);
            const bf16x8 bfrag = __builtin_bit_cast(bf16x8, bw);
#pragma unroll
            for (int mt = 0; mt < 2; ++mt) { const bf16x8 afrag = *(const LAS bf16x8*)(vt + (32 * mt + i) * SG_ROW + s0 * 2);
                acc[mt][n2] = __builtin_amdgcn_mfma_f32_32x32x16_bf16(afrag, bfrag, acc[mt][n2], 0, 0, 0); } } }
        float ss = 0.f;
#pragma unroll
        for (int mt = 0; mt < 2; ++mt)
#pragma unroll
            for (int g4 = 0; g4 < 4; ++g4) { const u32x2 uw = uqa[n2][mt][g4];
                const float u0 = bf_lo(uw.x), u1 = bf_hi(uw.x), u2 = bf_lo(uw.y), u3 = bf_hi(uw.y);
                float a0 = u0 * (acc[mt][n2][4 * g4] + bs), a1 = u1 * (acc[mt][n2][4 * g4 + 1] + bs), a2 = u2 * (acc[mt][n2][4 * g4 + 2] + bs), a3 = u3 * (acc[mt][n2][4 * g4 + 3] + bs);
                acc[mt][n2][4 * g4] = a0; acc[mt][n2][4 * g4 + 1] = a1; acc[mt][n2][4 * g4 + 2] = a2; acc[mt][n2][4 * g4 + 3] = a3;
                ss += (a0 * a0 + a1 * a1) + (a2 * a2 + a3 * a3); }
        ss += __shfl_xor(ss, 32);
        if (hh == 0) ssq_w[32 * n2] = ss; }
    __syncthreads();
#pragma unroll
    for (int n2 = 0; n2 < 2; ++n2) { const int t = 64 * half + 32 * n2 + i; float tot = 0.f;
#pragma unroll
        for (int gg = 0; gg < 8; ++gg) tot += ssq_r[gg * 64 + 32 * n2];
        const float rs = 1.0f / sqrtf(tot * (1.f / AW) + LN_EPS);
        bf16_t* op = F.Amix + (row0 + t) * D + g * GD + 4 * hh;
#pragma unroll
        for (int mt = 0; mt < 2; ++mt)
#pragma unroll
            for (int g4 = 0; g4 < 4; ++g4) { const f32x4 mg = *(const f32x4*)(F.mix_g + g * GD + 32 * mt + 8 * g4 + 4 * hh);
                u32x2 w; w.x = cvt_pk_bf16(acc[mt][n2][4 * g4] * rs * mg[0], acc[mt][n2][4 * g4 + 1] * rs * mg[1]); w.y = cvt_pk_bf16(acc[mt][n2][4 * g4 + 2] * rs * mg[2], acc[mt][n2][4 * g4 + 3] * rs * mg[3]);
                *(u32x2*)(op + 32 * mt + 8 * g4) = w; } }
    __syncthreads();
}

constexpr int AT_KROW = 144, AT_VROW = 144, AT_V_OFF = 384 * AT_KROW;
static_assert(AT_V_OFF + 384 * AT_VROW <= RING_BYTES, "attention LDS");
struct AttnDesc { int b, h, p, d, r, q0; };
__device__ __forceinline__ AttnDesc attn_decode(int u) {
    AttnDesc a; const int bh = u / 48, rem = u % 48, idx = rem & 15; a.p = rem >> 4; a.b = bh >> 3; a.h = bh & 7;
    a.d = (a.p == 0) ? 1 : (a.p == 1) ? 4 : 16; a.r = (a.p == 0) ? 0 : (a.p == 1) ? (idx >> 2) : idx; a.q0 = 256 * ((a.p == 0) ? idx : (a.p == 1) ? (idx & 3) : 0); return a; }
__device__ __forceinline__ void attn_stage_load(const Frame& F, const AttnDesc& a, u32x4 (&kq)[6], u32x4 (&vq)[6]) {
    const bf16_t* base = F.P1 + (size_t)a.b * SEQ * INC + a.h * HD;
#pragma unroll
    for (int it = 0; it < 6; ++it) { const int ch = F.tid + 512 * it, key = ch >> 3, c = ch & 7, s = a.q0 - 128 + key;
        kq[it] = (u32x4){0u, 0u, 0u, 0u}; vq[it] = (u32x4){0u, 0u, 0u, 0u};
        if (s >= 0) { const bf16_t* rp = base + (size_t)(s * a.d + a.r) * INC + c * 8; kq[it] = *(const u32x4*)(rp + 1536); vq[it] = *(const u32x4*)(rp + 2048); } }
}
__device__ __forceinline__ void attn_stage_write(const Frame& F, const u32x4 (&kq)[6], const u32x4 (&vq)[6]) {
#pragma unroll
    for (int it = 0; it < 6; ++it) { const int ch = F.tid + 512 * it, key = ch >> 3, c = ch & 7;
        *(LAS u32x4*)(F.lds + key * AT_KROW + c * 16) = kq[it]; *(LAS u32x4*)(F.lds + AT_V_OFF + key * AT_VROW + c * 16) = vq[it]; }
}
typedef short v4i16_t __attribute__((ext_vector_type(4)));
__device__ __forceinline__ void attn_compute(Frame& F, const AttnDesc& a, const bf16x8 (&qf)[4]) {
    const int lane = F.lane, i = lane & 31, hh = lane >> 5, w = F.wave, q0 = a.q0;
    LAS unsigned char* kl = F.lds; LAS unsigned char* vl = F.lds + AT_V_OFF;
    f32x16 s[5];
#pragma unroll
    for (int kt = 0; kt < 5; ++kt) { f32x16 a;
#pragma unroll
        for (int rr = 0; rr < 16; ++rr) a[rr] = 0.f;
#pragma unroll
        for (int ks = 0; ks < 4; ++ks) { const bf16x8 kf = *(const LAS bf16x8*)(kl + (32 * w + 32 * kt + i) * AT_KROW + (16 * ks + 8 * hh) * 2);
            a = __builtin_amdgcn_mfma_f32_32x32x16_bf16(kf, qf[ks], a, 0, 0, 0); }
        s[kt] = a; }
    const float sc = 0.125f * 1.4426950408889634f; const int ksub0 = q0 + 32 * w - 128;
    float m = -INFINITY;
#pragma unroll
    for (int kt = 0; kt < 5; ++kt)
#pragma unroll
        for (int rr = 0; rr < 16; ++rr) { const int kk = (rr & 3) + 8 * (rr >> 2) + 4 * hh; bool ok = (ksub0 + 32 * kt + kk) >= 0;
            if (kt == 0) ok = ok && (kk >= i);
            if (kt == 4) ok = ok && (kk <= i);
            const float v = ok ? s[kt][rr] * sc : -INFINITY; s[kt][rr] = v; m = fmaxf(m, v); }
    m = fmaxf(m, __shfl_xor(m, 32));
    float lsum = 0.f;
#pragma unroll
    for (int kt = 0; kt < 5; ++kt)
#pragma unroll
        for (int rr = 0; rr < 16; ++rr) { const float pv = __builtin_amdgcn_exp2f(s[kt][rr] - m); s[kt][rr] = pv; lsum += pv; }
    lsum += __shfl_xor(lsum, 32);
    f32x16 o[2];
#pragma unroll
    for (int dt = 0; dt < 2; ++dt)
#pragma unroll
        for (int rr = 0; rr < 16; ++rr) o[dt][rr] = 0.f;
    const LAS unsigned char* vtp = vl + (32 * w + 4 * hh + ((lane & 15) >> 2)) * AT_VROW + (16 * ((lane >> 4) & 1) + 4 * (lane & 3)) * 2;
#pragma unroll
    for (int kt = 0; kt < 5; ++kt)
#pragma unroll
        for (int s2 = 0; s2 < 2; ++s2) { u32x4 pw; pw.x = cvt_pk_bf16(s[kt][8 * s2], s[kt][8 * s2 + 1]); pw.y = cvt_pk_bf16(s[kt][8 * s2 + 2], s[kt][8 * s2 + 3]);
            pw.z = cvt_pk_bf16(s[kt][8 * s2 + 4], s[kt][8 * s2 + 5]); pw.w = cvt_pk_bf16(s[kt][8 * s2 + 6], s[kt][8 * s2 + 7]);
            const bf16x8 pb = __builtin_bit_cast(bf16x8, pw);
#pragma unroll
            for (int dt = 0; dt < 2; ++dt) { const LAS unsigned char* ap = vtp + (32 * kt + 16 * s2) * AT_VROW + 64 * dt;
                const v4i16_t lo = __builtin_amdgcn_ds_read_tr16_b64_v4i16((LAS v4i16_t*)ap), hi = __builtin_amdgcn_ds_read_tr16_b64_v4i16((LAS v4i16_t*)(ap + 8 * AT_VROW));
                const bf16x8 af = __builtin_shufflevector(lo, hi, 0, 1, 2, 3, 4, 5, 6, 7);
                o[dt] = __builtin_amdgcn_mfma_f32_32x32x16_bf16(af, pb, o[dt], 0, 0, 0); } }
    const float inv = 1.0f / lsum; const size_t orow = (size_t)a.b * SEQ + ((size_t)(q0 + 32 * w + i) * a.d + a.r);
    bf16_t* op = F.Opart + ((size_t)a.p * T + orow) * AW + a.h * HD + 4 * hh;
#pragma unroll
    for (int dt = 0; dt < 2; ++dt)
#pragma unroll
        for (int g4 = 0; g4 < 4; ++g4) { u32x2 wv; wv.x = cvt_pk_bf16(o[dt][4 * g4] * inv, o[dt][4 * g4 + 1] * inv); wv.y = cvt_pk_bf16(o[dt][4 * g4 + 2] * inv, o[dt][4 * g4 + 3] * inv);
            *(u32x2*)(op + 32 * dt + 8 * g4) = wv; }
    if (hh == 0) *(f32x2*)(F.ML + (((size_t)a.p * T + orow) * NH + a.h) * 2) = (f32x2){m, lsum};
}
__device__ __forceinline__ void attn_units(Frame& F, int u0, int ustep, int uend) {
    if (u0 >= uend) return;
    u32x4 kq[6], vq[6]; bf16x8 qn[4]; AttnDesc cur = attn_decode(u0);
#define ATT_QLOAD(A, Q) do { const bf16_t* base_ = F.P1 + (size_t)(A).b * SEQ * INC + (A).h * HD; const size_t qrow_ = (size_t)((A).q0 + 32 * F.wave + (F.lane & 31)) * (A).d + (A).r; \
        _Pragma("unroll") for (int ks = 0; ks < 4; ++ks) Q[ks] = *(const bf16x8*)(base_ + qrow_ * INC + 1024 + 16 * ks + 8 * (F.lane >> 5)); } while (0)
    attn_stage_load(F, cur, kq, vq); ATT_QLOAD(cur, qn);
    for (int u = u0; u < uend; u += ustep) {
        attn_stage_write(F, kq, vq);
        bf16x8 qf[4];
#pragma unroll
        for (int ks = 0; ks < 4; ++ks) qf[ks] = qn[ks];
        __syncthreads();
        const AttnDesc nxt = attn_decode(u + ustep < uend ? u + ustep : u);
        if (u + ustep < uend) { attn_stage_load(F, nxt, kq, vq); ATT_QLOAD(nxt, qn); }
        attn_compute(F, cur, qf);
        __syncthreads();
        cur = nxt;
    }
#undef ATT_QLOAD
}
__device__ __forceinline__ void p2_mixers(Frame& F) {
    constexpr int NSGU = 2 * BATCH * (SEQ / CHUNK), NATT = BATCH * NH * 48;
    constexpr int SH = MOE_ITEMS / 3; const int cnt = SH / (F.G * 8) + ((SH % (F.G * 8)) ? 1 : 0); int first = SH + (F.vcu * 8 + F.wave) * cnt, count = cnt;
    if (first + count > 2 * SH) count = 2 * SH - first;
    const int slot = F.vcu & 3;
    const int split = (F.vcu + 3 * F.G < NATT) ? F.vcu + 3 * F.G : NATT;
    if (slot == 0) moe_convert_items(F, first, count);
    for (int u = F.vcu; u < NSGU; u += F.G) sgu_unit(F, u >> 1, u & 1);
    if (slot == 1) moe_convert_items(F, first, count);
    attn_units(F, F.vcu, F.G, split);
    if (slot == 2) moe_convert_items(F, first, count);
    attn_units(F, split, F.G, NATT);
    if (slot == 3) moe_convert_items(F, first, count);
}

__device__ __forceinline__ void p3_merge(Frame& F) {
    const int gw = blockIdx.x * 8 + F.wave, NGW = F.G * 8, h = F.lane >> 3;
    for (int row = gw; row < T; row += NGW) {
        f32x2 ml[3]; float mx = -INFINITY;
#pragma unroll
        for (int p = 0; p < 3; ++p) { ml[p] = *(const f32x2*)(F.ML + (((size_t)p * T + row) * NH + h) * 2); mx = fmaxf(mx, ml[p].x); }
        float wt[3], wsum = 0.f;
#pragma unroll
        for (int p = 0; p < 3; ++p) { wt[p] = ml[p].y * __builtin_amdgcn_exp2f(ml[p].x - mx); wsum += wt[p]; }
        const float iw = 1.0f / wsum; float bv[8];
#pragma unroll
        for (int j = 0; j < 8; ++j) bv[j] = 0.f;
#pragma unroll
        for (int p = 0; p < 3; ++p) { const u32x4 r = *(const u32x4*)(F.Opart + ((size_t)p * T + row) * AW + F.lane * 8); const unsigned w[4] = {r.x, r.y, r.z, r.w}; const float f = wt[p] * iw;
#pragma unroll
            for (int j = 0; j < 4; ++j) { bv[2 * j] += f * bf_lo(w[j]); bv[2 * j + 1] += f * bf_hi(w[j]); } }
        float ss = 0.f;
#pragma unroll
        for (int j = 0; j < 8; ++j) ss += bv[j] * bv[j];
        ss = wave_sum(ss); const float rs = 1.0f / sqrtf(ss * (1.f / AW) + LN_EPS);
        const f32x4 g0 = *(const f32x4*)(F.mix_g + AW + F.lane * 8), g1 = *(const f32x4*)(F.mix_g + AW + F.lane * 8 + 4);
        u32x4 w; w.x = cvt_pk_bf16(bv[0] * rs * g0[0], bv[1] * rs * g0[1]); w.y = cvt_pk_bf16(bv[2] * rs * g0[2], bv[3] * rs * g0[3]);
        w.z = cvt_pk_bf16(bv[4] * rs * g1[0], bv[5] * rs * g1[1]); w.w = cvt_pk_bf16(bv[6] * rs * g1[2], bv[7] * rs * g1[3]);
        *(u32x4*)(F.Amix + (size_t)row * D + AW + F.lane * 8) = w;
    }
}

constexpr int RT_ROW = 2064, RT_IMG = 32 * RT_ROW, RT_LGT_OFF = 2 * RT_IMG, RT_SEL_OFF = RT_LGT_OFF + 32 * 33 * 4;
static_assert(RT_SEL_OFF + 2048 + 256 <= MISC_OFF && 8 * 32 * 32 * 4 <= RT_IMG, "route LDS");
__device__ __forceinline__ void p4_route(Frame& F) {
    const int lane = F.lane, w = F.wave;
    LAS unsigned char* img = F.lds; LAS float* part = (LAS float*)F.lds; LAS float* lgt = (LAS float*)(F.lds + RT_LGT_OFF);
    LAS int* sel_e = (LAS int*)(F.lds + RT_SEL_OFF); LAS float* sel_g = (LAS float*)(F.lds + RT_SEL_OFF + 1024);
    LAS int* lcnt = (LAS int*)(F.lds + RT_SEL_OFF + 2048); LAS int* lbase = lcnt + 32;
    if (F.tid < 32) lcnt[F.tid] = 0;
    f32x4 gg[4], bb[4];
#pragma unroll
    for (int j = 0; j < 4; ++j) { gg[j] = *(const f32x4*)(F.ln1_g + 4 * lane + 256 * j); bb[j] = *(const f32x4*)(F.ln1_b + 4 * lane + 256 * j); }
    bf16x8 bh[4][2], bl[4][2];
#pragma unroll
    for (int ks = 0; ks < 4; ++ks)
#pragma unroll
        for (int nt = 0; nt < 2; ++nt) { const bf16_t* bp = F.WrtHi + (size_t)(16 * nt + (lane & 15)) * D + 128 * w + 32 * ks + 8 * (lane >> 4);
            bh[ks][nt] = *(const bf16x8*)bp; bl[ks][nt] = *(const bf16x8*)(bp + (size_t)NE * D); }
    __syncthreads();
    for (int chunk = blockIdx.x; chunk < T / 64; chunk += F.G) {
#pragma unroll 1
        for (int half = 0; half < 2; ++half) {
            const int row0 = chunk * 64 + half * 32 + w * 4;
            f32x4 v[4][4]; float s[4], q[4];
#pragma unroll
            for (int tk = 0; tk < 4; ++tk) { s[tk] = 0.f;
#pragma unroll
                for (int j = 0; j < 4; ++j) { const u32x2 zr = *(const u32x2*)(F.Zb + (size_t)(row0 + tk) * D + 4 * lane + 256 * j); v[tk][j] = (f32x4){bf_lo(zr.x), bf_hi(zr.x), bf_lo(zr.y), bf_hi(zr.y)}; s[tk] += (v[tk][j][0] + v[tk][j][1]) + (v[tk][j][2] + v[tk][j][3]); } }
#pragma unroll
            for (int o = 1; o < 64; o <<= 1) {
#pragma unroll
                for (int tk = 0; tk < 4; ++tk) s[tk] += __shfl_xor(s[tk], o); }
#pragma unroll
            for (int tk = 0; tk < 4; ++tk) { const float mu = s[tk] * (1.f / D); q[tk] = 0.f;
#pragma unroll
                for (int j = 0; j < 4; ++j) { v[tk][j] = v[tk][j] - mu; q[tk] += (v[tk][j][0] * v[tk][j][0] + v[tk][j][1] * v[tk][j][1]) + (v[tk][j][2] * v[tk][j][2] + v[tk][j][3] * v[tk][j][3]); } }
#pragma unroll
            for (int o = 1; o < 64; o <<= 1) {
#pragma unroll
                for (int tk = 0; tk < 4; ++tk) q[tk] += __shfl_xor(q[tk], o); }
#pragma unroll
            for (int tk = 0; tk < 4; ++tk) { const float rstd = 1.0f / sqrtf(q[tk] * (1.f / D) + LN_EPS);
#pragma unroll
                for (int j = 0; j < 4; ++j) { const f32x4 h = v[tk][j] * rstd * gg[j] + bb[j]; const size_t off = (size_t)(row0 + tk) * D + 4 * lane + 256 * j;
                    *(unsigned*)(F.Hb + off) = cvt4_fp8(h[0], h[1], h[2], h[3]);
                    u32x2 hi; hi.x = cvt_pk_bf16(h[0], h[1]); hi.y = cvt_pk_bf16(h[2], h[3]);
                    *(u32x2*)(F.Hh + off) = hi;
                    u32x2 lo; lo.x = cvt_pk_bf16(h[0] - bf_lo(hi.x), h[1] - bf_hi(hi.x)); lo.y = cvt_pk_bf16(h[2] - bf_lo(hi.y), h[3] - bf_hi(hi.y));
                    LAS unsigned char* dp = img + (w * 4 + tk) * RT_ROW + (4 * lane + 256 * j) * 2;
                    *(LAS u32x2*)dp = hi; *(LAS u32x2*)(dp + RT_IMG) = lo; } }
            __syncthreads();
            f32x4 acc[2][2];
#pragma unroll
            for (int mt = 0; mt < 2; ++mt)
#pragma unroll
                for (int nt = 0; nt < 2; ++nt) acc[mt][nt] = (f32x4){0.f, 0.f, 0.f, 0.f};
#pragma unroll
            for (int mt = 0; mt < 2; ++mt) { const LAS unsigned char* ap = img + (16 * mt + (lane & 15)) * RT_ROW + (128 * w + 8 * (lane >> 4)) * 2;
#pragma unroll
                for (int ks = 0; ks < 4; ++ks) { const bf16x8 ah = *(const LAS bf16x8*)(ap + ks * 64), al = *(const LAS bf16x8*)(ap + RT_IMG + ks * 64);
#pragma unroll
                    for (int nt = 0; nt < 2; ++nt) {
                        acc[mt][nt] = __builtin_amdgcn_mfma_f32_16x16x32_bf16(ah, bh[ks][nt], acc[mt][nt], 0, 0, 0);
                        acc[mt][nt] = __builtin_amdgcn_mfma_f32_16x16x32_bf16(ah, bl[ks][nt], acc[mt][nt], 0, 0, 0);
                        acc[mt][nt] = __builtin_amdgcn_mfma_f32_16x16x32_bf16(al, bh[ks][nt], acc[mt][nt], 0, 0, 0); } } }
            __syncthreads();
#pragma unroll
            for (int mt = 0; mt < 2; ++mt)
#pragma unroll
                for (int nt = 0; nt < 2; ++nt)
#pragma unroll
                    for (int r = 0; r < 4; ++r) part[(w * 32 + 16 * mt + 4 * (lane >> 4) + r) * 32 + 16 * nt + (lane & 15)] = acc[mt][nt][r];
            __syncthreads();
#pragma unroll
            for (int qq = 0; qq < 2; ++qq) { const int p = F.tid + 512 * qq, tok = p >> 5, e = p & 31; float sum = F.b_router[e];
#pragma unroll
                for (int ww = 0; ww < 8; ++ww) sum += part[(ww * 32 + tok) * 32 + e];
                lgt[tok * 33 + e] = sum; }
            __syncthreads();
            if (F.tid < 32) {
                float lg[32];
#pragma unroll
                for (int e = 0; e < 32; ++e) lg[e] = lgt[F.tid * 33 + e];
                int idx[4]; float val[4]; unsigned taken = 0u;
#pragma unroll
                for (int r = 0; r < 4; ++r) { float best = -INFINITY; int bi = 0;
#pragma unroll
                    for (int e = 0; e < 32; ++e) { const bool ok = !((taken >> e) & 1u) && (lg[e] > best); best = ok ? lg[e] : best; bi = ok ? e : bi; }
                    idx[r] = bi; val[r] = best; taken |= 1u << bi; }
                const float e1 = __expf(val[1] - val[0]), e2 = __expf(val[2] - val[0]), e3 = __expf(val[3] - val[0]); const float inv = 1.0f / (1.0f + e1 + e2 + e3);
                const int tl = half * 32 + F.tid;
                sel_e[tl * 4 + 0] = idx[0]; sel_e[tl * 4 + 1] = idx[1]; sel_e[tl * 4 + 2] = idx[2]; sel_e[tl * 4 + 3] = idx[3];
                sel_g[tl * 4 + 0] = inv; sel_g[tl * 4 + 1] = e1 * inv; sel_g[tl * 4 + 2] = e2 * inv; sel_g[tl * 4 + 3] = e3 * inv; }
            __syncthreads();
        }
        int myrank = 0, mye = 0;
        if (F.tid < 256) { mye = sel_e[F.tid]; myrank = atomicAdd((int*)&lcnt[mye], 1); }
        __syncthreads();
        if (F.tid < 32) { const int c = lcnt[F.tid]; lbase[F.tid] = c ? (int)__hip_atomic_fetch_add(F.ctl + CW_CNT + F.tid, (unsigned)c, __ATOMIC_RELAXED, __HIP_MEMORY_SCOPE_AGENT) : 0; lcnt[F.tid] = 0; }
        __syncthreads();
        if (F.tid < 256) { const int slot = (chunk * 64 + (F.tid >> 2)) * 4 + (F.tid & 3); F.list[mye * T + lbase[mye] + myrank] = slot; F.gates[slot] = sel_g[F.tid]; F.einfo[slot] = mye | ((lbase[mye] + myrank) << 8); }
        __syncthreads();
    }
}

template <bool G1> __device__ __forceinline__ int moe_tables(Frame& F, int NPN) {
    LAS int* cnt = (LAS int*)(F.lds + TAB_OFF); LAS int* tstart = cnt + 32; LAS int* rowtab = (LAS int*)(F.lds + ROWTAB_OFF);
    if (F.tid < 32) cnt[F.tid] = (int)__hip_atomic_load(F.ctl + CW_CNT + F.tid, __ATOMIC_RELAXED, __HIP_MEMORY_SCOPE_AGENT);
    __syncthreads();
    if (F.tid == 0) { int acc = 0; for (int e = 0; e < NE; ++e) { tstart[e] = acc; acc += (cnt[e] + 255) >> 8; } tstart[NE] = acc; }
    __syncthreads();
    const int ntiles = tstart[NE], nU = ntiles * NPN;
    for (int i = 0; i < MAXU; ++i) { const int L = i * F.G + F.vcu; if (L >= nU) break;
        const int tl = L / NPN; int e = 0;
        for (int j = 1; j < NE; ++j) e += (tstart[j] <= tl) ? 1 : 0;
        const int mt = tl - tstart[e];
        if (F.tid < 256) { const int rank = mt * 256 + F.tid; const int slot = rank < cnt[e] ? F.list[e * T + rank] : -1;
            rowtab[i * 256 + F.tid] = G1 ? ((slot < 0 ? 0 : (slot >> 2)) * D) : slot; } }
    __syncthreads();
    return ntiles;
}

__device__ __forceinline__ void p7_final(Frame& F) {
    LAS int* cnt = (LAS int*)(F.lds + TAB_OFF); LAS int* tstart = cnt + 32;
    if (F.tid < 32) cnt[F.tid] = (int)__hip_atomic_load(F.ctl + CW_CNT + F.tid, __ATOMIC_RELAXED, __HIP_MEMORY_SCOPE_AGENT);
    __syncthreads();
    if (F.tid == 0) { int acc = 0; for (int e = 0; e < NE; ++e) { tstart[e] = acc; acc += (cnt[e] + 255) >> 8; } tstart[NE] = acc; }
    __syncthreads();
    const int gw = blockIdx.x * 8 + F.wave, NGW = F.G * 8;
    for (int row = gw; row < T; row += NGW) {
        float* hp = F.out + (size_t)row * D; float v[16];
#pragma unroll
        for (int j = 0; j < 2; ++j) { const u32x4 r = *(const u32x4*)(F.Hh + (size_t)row * D + 512 * j + F.lane * 8); const unsigned w[4] = {r.x, r.y, r.z, r.w};
#pragma unroll
            for (int i = 0; i < 4; ++i) { v[8 * j + 2 * i] = bf_lo(w[i]) * DN_ALPHA; v[8 * j + 2 * i + 1] = bf_hi(w[i]) * DN_ALPHA; } }
#pragma unroll
        for (int k = 0; k < TOPK; ++k) { const int info = F.einfo[row * TOPK + k]; const float gt = F.gates[row * TOPK + k];
            const size_t pos = ((size_t)tstart[info & 255] << 8) + (size_t)(info >> 8);
#pragma unroll
            for (int j = 0; j < 2; ++j) { const u32x4 r = *(const u32x4*)(F.Y + pos * D + 512 * j + F.lane * 8); const unsigned w[4] = {r.x, r.y, r.z, r.w};
#pragma unroll
                for (int i = 0; i < 4; ++i) { v[8 * j + 2 * i] += gt * bf_lo(w[i]); v[8 * j + 2 * i + 1] += gt * bf_hi(w[i]); } } }
        float s = 0.f;
#pragma unroll
        for (int i = 0; i < 16; ++i) s += v[i];
        const float mu = wave_sum(s) * (1.f / D); float q = 0.f;
#pragma unroll
        for (int i = 0; i < 16; ++i) { v[i] -= mu; q += v[i] * v[i]; }
        const float rstd = 1.0f / sqrtf(wave_sum(q) * (1.f / D) + LN_EPS);
#pragma unroll
        for (int j = 0; j < 2; ++j) { const int c = 512 * j + F.lane * 8;
            const f32x4 g0 = *(const f32x4*)(F.ln2_g + c), g1 = *(const f32x4*)(F.ln2_g + c + 4), b0 = *(const f32x4*)(F.ln2_b + c), b1 = *(const f32x4*)(F.ln2_b + c + 4);
            f32x4 o0, o1;
#pragma unroll
            for (int i = 0; i < 4; ++i) { o0[i] = v[8 * j + i] * rstd * g0[i] + b0[i]; o1[i] = v[8 * j + 4 + i] * rstd * g1[i] + b1[i]; }
            *(f32x4*)(hp + c) = o0; *(f32x4*)(hp + c + 4) = o1; }
    }
}

__device__ __forceinline__ bool fresh(Frame& F) {
    int t = threadIdx.x; asm volatile("" : "+v"(t)); F.tid = t; F.lane = t & 63;
    const __attribute__((address_space(4))) Args* ap = (const __attribute__((address_space(4))) Args*)__builtin_amdgcn_kernarg_segment_ptr(); asm volatile("" : "+s"(ap));
    F.x = ap->in[0]; F.w_in = ap->in[1]; F.sgu_w = ap->in[2]; F.sgu_b = ap->in[3]; F.sgu_ln_g = ap->in[4]; F.sgu_ln_b = ap->in[5]; F.mix_g = ap->in[6]; F.w_out = ap->in[7];
    F.ln1_g = ap->in[8]; F.ln1_b = ap->in[9]; F.w_router = ap->in[10]; F.b_router = ap->in[11]; F.w_gate = ap->in[12]; F.b_gate = ap->in[13]; F.w_up = ap->in[14]; F.b_up = ap->in[15];
    F.w_down = ap->in[16]; F.b_down = ap->in[17]; F.ln2_g = ap->in[18]; F.ln2_b = ap->in[19]; F.out = ap->out; F.ws = ap->ws;
    unsigned char* ws = ap->ws;
    F.ctl = (unsigned*)(ws + WS_CTL); F.list = (int*)(ws + WS_LIST); F.einfo = (int*)(ws + WS_EINFO); F.gates = (float*)(ws + WS_GATES);
    F.Win_t = (bf16_t*)(ws + WS_WIN); F.Wout_t = (bf16_t*)(ws + WS_WOUT); F.Wd_t = (act_t*)(ws + WS_WD); F.Wgu_t = (fp8_t*)(ws + WS_WGU); F.Y = (bf16_t*)(ws + WS_Y);
    F.Hb = (fp8_t*)(ws + WS_HB); F.Xb = (bf16_t*)(ws + WS_XB); F.P1 = (bf16_t*)(ws + WS_P1); F.Amix = (bf16_t*)(ws + WS_AMIX); F.Act = (act_t*)(ws + WS_ACT);
    F.WrtHi = (bf16_t*)(ws + WS_WRT); F.Zb = (bf16_t*)(ws + WS_XB); F.Hh = (bf16_t*)(ws + WS_AMIX);
    F.Opart = (bf16_t*)(ws + WS_OPART); F.ML = (float*)(ws + WS_ML);
    return true; }
constexpr int N_PHASES = 8;
__global__ void __launch_bounds__(512, 2) mk_fwd(Args args) {
    extern __shared__ __attribute__((aligned(16))) unsigned char lds_raw[];
    Frame F;
    F.lds = (LAS unsigned char*)lds_raw; F.tid = threadIdx.x; F.lane = F.tid & 63; F.wave = __builtin_amdgcn_readfirstlane(F.tid >> 6);
    F.G = gridDim.x; { const int bx = blockIdx.x; F.vcu = (F.G % 8 == 0) ? (bx % 8) * (F.G / 8) + bx / 8 : bx; }
    fresh(F);
    unsigned char* ws = F.ws;
    const int lo = args.ph_lo, hi = args.ph_hi;
    volatile LAS unsigned* misc = (volatile LAS unsigned*)(F.lds + MISC_OFF);
    if (F.tid < 16) misc[F.tid] = 0u;
    __syncthreads();
    XcdBarrier bar; bar.bar = F.ctl + CW_BAR; bar.x = 0; bar.st = misc;
    if (hi - lo > 1) bar = xcd_barrier_post(F.ctl + CW_BAR, misc);
    const LAS int* rowtab = (const LAS int*)(F.lds + ROWTAB_OFF);
#ifndef PROBE_DUP
#define PROBE_DUP -1
#endif
#define IN(k) (lo <= (k) && (k) < hi && fresh(F))
#define SEAM(k) do { if (lo <= (k) && (k) + 1 < hi) { xcd_barrier(bar); } } while (0)
#define REP(k) for (int _rep = 0; _rep < ((PROBE_DUP == (k)) ? 2 : 1); ++_rep)
    if (IN(0)) REP(0) { p0_convert(F); }
    SEAM(0);
    if (IN(1)) REP(1) {
        pg8::Gemm g{F.Xb, F.Win_t, D * 2}; pg8::EpiP1 E{F.P1}; constexpr int NU1 = (T / 256) * (INC / 256);
        int nun = 0; for (int i = 0; i * F.G + F.vcu < NU1; ++i) ++nun;
        constexpr int SH = MOE_ITEMS / 3;
        int pos = 0, count = SH / (F.G * 8) + 1, first = (F.vcu * 8 + F.wave) * count, lim = SH;
        if (F.G == 256) { if (nun == 3) { pos = F.vcu & 3; count = 1; first = F.vcu * 8 + F.wave; } else { pos = F.vcu % 3; count = 7; first = 1024 + ((F.vcu - 128) * 8 + F.wave) * 7; } }
        if (first + count > lim) count = lim - first;
        { pg8::DenseOrder S{INC / 256, NU1, F.G, F.vcu, 0, pos}; pg8::gemm_phase<pg8::EpiP1, pg8::DenseOrder, false, false>(F.lds, rowtab, g, S, E); }
        moe_convert_items(F, first, count);
        __syncthreads();
        { pg8::DenseOrder S{INC / 256, NU1, F.G, F.vcu, pos, 1 << 20}; pg8::gemm_phase<pg8::EpiP1, pg8::DenseOrder, false, false>(F.lds, rowtab, g, S, E); } }
    SEAM(1);
    if (IN(2)) REP(2) { p2_mixers(F); }
    SEAM(2);
    if (IN(3)) REP(3) { p3_merge(F); }
    SEAM(3);
    if (IN(4)) REP(4) { pg8::Gemm g{F.Amix, F.Wout_t, D * 2}; pg8::DenseOrder S{D / 256, (T / 256) * (D / 256), F.G, F.vcu, 0, 1 << 20}; pg8::EpiZ E{F.x, F.Zb};
        pg8::gemm_phase<pg8::EpiZ, pg8::DenseOrder, false, false>(F.lds, rowtab, g, S, E); }
    SEAM(4);
    if (IN(5)) { p4_route(F); }
    SEAM(5);
    if (IN(6)) REP(6) { const int ntiles = moe_tables<true>(F, 8); pg8::Gemm g{F.Hb, F.Wgu_t, D}; pg8::EpiSwiglu E{F.Act, F.b_gate, F.b_up};
        constexpr int SH = MOE_ITEMS / 3; const int cnt = SH / (F.G * 8) + ((SH % (F.G * 8)) ? 1 : 0); int first = 2 * SH + (F.vcu * 8 + F.wave) * cnt, count = cnt;
        if (first + count > 3 * SH) count = 3 * SH - first;
        const int pos = 2 * (F.vcu & 3);
        { pg8::MoeOrder S{8, ntiles * 8, F.G, F.vcu, (const LAS int*)(F.lds + TAB_OFF) + 32, 0, pos}; pg8::gemm_phase<pg8::EpiSwiglu, pg8::MoeOrder, true, true>(F.lds, rowtab, g, S, E); }
        moe_convert_items(F, first, count);
        __syncthreads();
        { pg8::MoeOrder S{8, ntiles * 8, F.G, F.vcu, (const LAS int*)(F.lds + TAB_OFF) + 32, pos, 1 << 20}; pg8::gemm_phase<pg8::EpiSwiglu, pg8::MoeOrder, true, true>(F.lds, rowtab, g, S, E); } }
    SEAM(6);
    if (IN(7)) REP(7) { const int ntiles = moe_tables<false>(F, 4); pg8::Gemm g{F.Act, F.Wd_t, FF * (int)sizeof(act_t)}; pg8::MoeOrder S{4, ntiles * 4, F.G, F.vcu, (const LAS int*)(F.lds + TAB_OFF) + 32, 0, 1 << 20};
        pg8::EpiY E{F.Y, F.b_down};
        pg8::gemm_phase<pg8::EpiY, pg8::MoeOrder, false, (G2_FP8 != 0)>(F.lds, rowtab, g, S, E); }
    SEAM(7);
    if (IN(8)) { p7_final(F); }
#undef IN
#undef SEAM
}

extern "C" void kernel_launch(void* const* d_in, const int* in_sizes, int n_in, void* d_out, int out_size, void* d_ws, size_t ws_size, hipStream_t stream) {
    static int grid = 0;
    if (grid == 0) {
        if (n_in != 20 || in_sizes[0] != T * D || out_size != T * D || ws_size < WS_END) { fprintf(stderr, "kernel_launch: unexpected shapes (n_in %d, in0 %d, out %d, ws %zu)\n", n_in, n_in > 0 ? in_sizes[0] : -1, out_size, ws_size); grid = -1; return; }
        int dev = 0, cus = 0, per_cu = 0;
        hipGetDevice(&dev); hipDeviceGetAttribute(&cus, hipDeviceAttributeMultiprocessorCount, dev);
        if (hipFuncSetAttribute((const void*)mk_fwd, hipFuncAttributeMaxDynamicSharedMemorySize, LDS_BYTES) != hipSuccess) { fprintf(stderr, "kernel_launch: hipFuncSetAttribute failed\n"); grid = -1; return; }
        hipOccupancyMaxActiveBlocksPerMultiprocessor(&per_cu, (const void*)mk_fwd, 512, LDS_BYTES);
        (void)hipGetLastError();
        if (per_cu < 1) { fprintf(stderr, "kernel_launch: occupancy query says %d blocks/CU: the grid would not be resident; nothing launched\n", per_cu); grid = -1; return; }
        grid = cus;
        if (grid != 256) fprintf(stderr, "kernel_launch: note: %d CUs (tuned for 256)\n", grid);
    }
    if (grid < 0) return;
    hipMemsetAsync((char*)d_ws + WS_CTL, 0, CTL_ZERO_BYTES, stream);
    Args a{};
    for (int i = 0; i < 20; ++i) a.in[i] = (const float*)d_in[i];
    a.out = (float*)d_out; a.ws = (unsigned char*)d_ws;
#if MK_N_LAUNCHES == 1
    a.ph_lo = 0; a.ph_hi = N_PHASES + 1;
    hipLaunchKernelGGL(mk_fwd, dim3(grid), dim3(512), LDS_BYTES, stream, a);
#else
    for (int p = 0; p <= N_PHASES; ++p) { a.ph_lo = p; a.ph_hi = p + 1; hipLaunchKernelGGL(mk_fwd, dim3(grid), dim3(512), LDS_BYTES, stream, a); }
#endif
}
```

```cpp
#include <hip/hip_runtime.h>
#include <hip/hip_cooperative_groups.h>
#include <cstdio>
#include <cstdint>
namespace cg = cooperative_groups;

#ifndef MK_N_LAUNCHES
#define MK_N_LAUNCHES 1
#endif

constexpr int BATCH = 4, SEQ = 4096, T = BATCH * SEQ, D = 1024, INC = 2560, NE = 32, FF = 1024, TOPK = 4;
constexpr int AW = 512, NGRP = 8, GD = 64, CHUNK = 128, NH = 8, HD = 64;
constexpr float LN_EPS = 1e-5f, DN_ALPHA = 1.189207115002721f;
constexpr int NSLOT = T * TOPK;
constexpr int MAXTILES = 288;
constexpr int MAXU = 12;

constexpr size_t MiB = 1u << 20;
constexpr size_t WS_CTL = 0, CTL_ZERO_BYTES = 64 * 1024;
constexpr size_t WS_LIST = 1 * MiB;
constexpr size_t WS_GATES = 3 * MiB;
constexpr size_t WS_EINFO = 3 * MiB + 256 * 1024;
constexpr size_t WS_WRT = 3 * MiB + 512 * 1024;
constexpr size_t WS_WIN = 4 * MiB;
constexpr size_t WS_WOUT = 9 * MiB;
constexpr size_t WS_WD = 11 * MiB;
constexpr size_t WS_WGU = 75 * MiB;
constexpr size_t WS_HB = 139 * MiB;
constexpr size_t WS_BIG = 155 * MiB;
constexpr size_t WS_XB = WS_BIG;
constexpr size_t WS_P1 = WS_BIG + 32 * MiB;
constexpr size_t WS_AMIX = WS_BIG + 112 * MiB;
constexpr size_t WS_ACT = WS_BIG;
constexpr size_t WS_Y = 299 * MiB;
constexpr size_t WS_OPART = 427 * MiB;
constexpr size_t WS_ML = 475 * MiB;
constexpr size_t WS_END = 478 * MiB;
#ifndef G2_FP8
#define G2_FP8 1
#endif
constexpr float WGU_SCALE = 32.0f, WD_SCALE = G2_FP8 ? 64.0f : 1.0f, Y_SCALE = 8.0f;
#if G2_FP8
typedef unsigned char act_t;
#else
typedef unsigned short act_t;
#endif
constexpr int CW_BAR = 1024;
constexpr int CW_CNT = 0;

constexpr int RING_BYTES = 131072;
constexpr int TAB_OFF = RING_BYTES + 1024;
constexpr int ROWTAB_OFF = RING_BYTES + 2048;
constexpr int MISC_OFF = 147456 - 64;
constexpr int LDS_BYTES = 147456;
static_assert(ROWTAB_OFF + MAXU * 1024 <= LDS_BYTES, "LDS map");

#define LAS __attribute__((address_space(3)))
typedef unsigned short bf16_t;
typedef unsigned char fp8_t;
typedef short bf16x8 __attribute__((ext_vector_type(8)));
typedef float f32x4 __attribute__((ext_vector_type(4)));
typedef float f32x2 __attribute__((ext_vector_type(2)));
typedef unsigned u32x4 __attribute__((ext_vector_type(4)));
typedef unsigned u32x2 __attribute__((ext_vector_type(2)));
typedef int v8i32 __attribute__((ext_vector_type(8)));
typedef int v4i32 __attribute__((ext_vector_type(4)));


__device__ __forceinline__ unsigned cvt_pk_bf16(float lo, float hi) { unsigned r; asm volatile("v_cvt_pk_bf16_f32 %0, %1, %2" : "=v"(r) : "v"(lo), "v"(hi)); return r; }
__device__ __forceinline__ unsigned cvt4_fp8(float a, float b, float c, float d) { int w = 0; w = __builtin_amdgcn_cvt_pk_fp8_f32(a, b, w, false); w = __builtin_amdgcn_cvt_pk_fp8_f32(c, d, w, true); return (unsigned)w; }
__device__ __forceinline__ float bf_lo(unsigned w) { return __uint_as_float(w << 16); }
__device__ __forceinline__ float bf_hi(unsigned w) { return __uint_as_float(w & 0xffff0000u); }
__device__ __forceinline__ float bf1(bf16_t b) { return __uint_as_float((unsigned)b << 16); }
__device__ __forceinline__ float wave_sum(float v) {
#pragma unroll
    for (int o = 1; o < 64; o <<= 1) v += __shfl_xor(v, o);
    return v;
}
__device__ __forceinline__ float gelu_tanh(float x) {
    const float y2 = x * (1.5957691216057308f + 0.07135481627260025f * x * x);
    return x * __builtin_amdgcn_rcpf(1.0f + __builtin_amdgcn_exp2f(-1.4426950408889634f * y2));
}

namespace pg8 {
constexpr int BM = 256, BK = 64, HALF = 128, HTB = HALF * BK * 2, STAGE_BYTES = 8 * HTB;
__host__ __device__ __forceinline__ int lds_byte(int r, int c) { const int st = (r >> 4) * 2 + (c >> 5), rr = r & 15, cc = c & 31, ob = rr * 64 + cc * 2; return st * 1024 + (ob ^ (((ob >> 9) & 1) << 5)); }
__host__ __device__ __forceinline__ void stage_rc(int b, int& R, int& C) { const int st = b / 1024, sb = b % 1024, swz = sb ^ (((sb >> 9) & 1) << 5); R = (st >> 1) * 16 + swz / 64; C = (st & 1) * 32 + (swz % 64) / 2; }
__host__ __device__ __forceinline__ int perm32(int rho) { const int n = rho >> 4, i = rho & 15; return 8 * (i >> 2) + 4 * n + (i & 3); }

struct Unit { int pm, pn, pb, e, mt, ui; };
struct Gemm { const void* A; const void* Bt; int KB; };

struct DenseOrder {
    int nN, nU, G, v, i0, i1;
    __device__ __forceinline__ bool next(int i, Unit& u) const {
        i += i0; if (i >= i1) return false;
        const int L = i * G + v; if (L >= nU) return false;
        u.pm = L / nN; u.pn = L % nN; u.pb = u.pn; u.e = 0; u.mt = 0; u.ui = i; return true; }
};
struct MoeOrder {
    int NPN, nU, G, v; const LAS int* tstart; int i0, i1;
    __device__ __forceinline__ bool next(int i, Unit& u) const {
        i += i0; if (i >= i1) return false;
        const int L = i * G + v; if (L >= nU) return false;
        const int tl = L / NPN, pn = L % NPN; int e = 0;
#pragma unroll
        for (int j = 1; j < NE; ++j) e += (tstart[j] <= tl) ? 1 : 0;
        e = __builtin_amdgcn_readfirstlane(e); const int ts = __builtin_amdgcn_readfirstlane(tstart[e]);
        u.pm = tl; u.pn = pn; u.pb = e * NPN + pn; u.e = e; u.mt = tl - ts; u.ui = i; return true; }
};

template <class Epi, class Sched, bool GATHER, bool FP8>
__device__ __forceinline__ void gemm_phase(LAS unsigned char* lds, const LAS int* rowtab, const Gemm g, const Sched& S, const Epi& E) {
    const int tid = threadIdx.x, wid = __builtin_amdgcn_readfirstlane(tid >> 6), lane = tid & 63, wr = wid >> 2, wc = wid & 3, fr = lane & 15, fq = lane >> 4;
    const int KB = g.KB, nt = KB / (BK * 2);
    unsigned voffA0[2], voffA1[2], voffB[2]; int Rr[2], Cc[2];
#pragma unroll
    for (int i = 0; i < 2; ++i) { int R, C; stage_rc(tid * 16 + i * 8192, R, C); const int Rb = Epi::PERM ? ((R & ~31) + perm32(R & 31)) : R; Rr[i] = R; Cc[i] = C;
        voffA0[i] = (unsigned)(R * KB + C * 2); voffA1[i] = (unsigned)((R + HALF) * KB + C * 2); voffB[i] = (unsigned)(Rb * KB + C * 2); }
    const unsigned kstep = (unsigned)(BK * 2);
    const unsigned hstep = (unsigned)HALF * (unsigned)KB;
    const unsigned tstep = 2u * hstep;
    const __amdgpu_buffer_rsrc_t rsA = __builtin_amdgcn_make_buffer_rsrc(const_cast<void*>(g.A), 0, -1, 0x00020000);
    const __amdgpu_buffer_rsrc_t rsB = __builtin_amdgcn_make_buffer_rsrc(const_cast<void*>(g.Bt), 0, -1, 0x00020000);
    const unsigned ldsw = (unsigned)wid * 1024u;
    const int aoff = lds_byte(wr * 64 + fr, fq * 8), boff = lds_byte(wc * 32 + fr, fq * 8);
#define PG8_SA(b, h) (((b) * 2 + (h)) * HTB)
#define PG8_SB(b, h) ((4 + (b) * 2 + (h)) * HTB)
#define PG8_STAGE(bufoff, rs, soff, voff) do { _Pragma("unroll") for (int _i = 0; _i < 2; ++_i) \
        __builtin_amdgcn_raw_ptr_buffer_load_lds(rs, (LAS void*)(lds + (bufoff) + ldsw + _i * 8192), 16, (int)(voff)[_i], (int)(soff), 0, 0); } while (0)
#define PG8_LDA(dst, b, h) do { if constexpr (FP8) { _Pragma("unroll") for (int m = 0; m < 4; ++m) dst##8[m] = __builtin_shufflevector(*(const LAS v4i32*)(lds + PG8_SA(b, h) + aoff + m * 2048), *(const LAS v4i32*)(lds + PG8_SA(b, h) + aoff + m * 2048 + 1024), 0, 1, 2, 3, 4, 5, 6, 7); } \
        else { _Pragma("unroll") for (int m = 0; m < 4; ++m) _Pragma("unroll") for (int k = 0; k < 2; ++k) dst[m][k] = *(const LAS bf16x8*)(lds + PG8_SA(b, h) + aoff + m * 2048 + k * 1024); } } while (0)
#define PG8_LDB(dst, b, h) do { if constexpr (FP8) { _Pragma("unroll") for (int n = 0; n < 2; ++n) dst##8[n] = __builtin_shufflevector(*(const LAS v4i32*)(lds + PG8_SB(b, h) + boff + n * 2048), *(const LAS v4i32*)(lds + PG8_SB(b, h) + boff + n * 2048 + 1024), 0, 1, 2, 3, 4, 5, 6, 7); } \
        else { _Pragma("unroll") for (int n = 0; n < 2; ++n) _Pragma("unroll") for (int k = 0; k < 2; ++k) dst[n][k] = *(const LAS bf16x8*)(lds + PG8_SB(b, h) + boff + n * 2048 + k * 1024); } } while (0)
#define PG8_MMA(ai, bj, At, Bt) do { __builtin_amdgcn_s_setprio(1); if constexpr (FP8) { _Pragma("unroll") for (int m = 0; m < 4; ++m) _Pragma("unroll") for (int n = 0; n < 2; ++n) \
        acc[ai][bj][m][n] = __builtin_amdgcn_mfma_scale_f32_16x16x128_f8f6f4(Bt##8[n], At##8[m], acc[ai][bj][m][n], 0, 0, 0, 0x7F7F7F7F, 0, 0x7F7F7F7F); } \
        else { _Pragma("unroll") for (int m = 0; m < 4; ++m) _Pragma("unroll") for (int n = 0; n < 2; ++n) _Pragma("unroll") for (int k = 0; k < 2; ++k) \
        acc[ai][bj][m][n] = __builtin_amdgcn_mfma_f32_16x16x32_bf16(Bt[n][k], At[m][k], acc[ai][bj][m][n], 0, 0, 0); } __builtin_amdgcn_s_setprio(0); } while (0)
#define PG8_WAIT_V(n) asm volatile("s_waitcnt vmcnt(" #n ")" ::: "memory")
#define PG8_WAIT_L(n) asm volatile("s_waitcnt lgkmcnt(" #n ")" ::: "memory")
#define PG8_BAR __builtin_amdgcn_s_barrier()
#define PG8_SCHED __builtin_amdgcn_sched_barrier(0)
#define PG8_LOADROWS(U) do { if constexpr (GATHER) { _Pragma("unroll") for (int _i = 0; _i < 2; ++_i) { \
        voffA0[_i] = (unsigned)rowtab[(U).ui * 256 + Rr[_i]] + (unsigned)Cc[_i] * 2u; voffA1[_i] = (unsigned)rowtab[(U).ui * 256 + HALF + Rr[_i]] + (unsigned)Cc[_i] * 2u; } } } while (0)
    Unit cur, nxt; int ui = 0;
    if (!S.next(0, cur)) return;
    f32x4 acc[2][2][4][2];
#pragma unroll
    for (int a = 0; a < 2; ++a)
#pragma unroll
        for (int b = 0; b < 2; ++b)
#pragma unroll
            for (int m = 0; m < 4; ++m)
#pragma unroll
                for (int n = 0; n < 2; ++n) acc[a][b][m][n] = (f32x4){0.f, 0.f, 0.f, 0.f};
    bf16x8 At[4][2], B0[2][2], B1[2][2]; v8i32 At8[4], B08[2], B18[2];
    unsigned cA = GATHER ? 0u : (unsigned)cur.pm * tstep, cB = (unsigned)cur.pb * tstep;
    PG8_LOADROWS(cur); PG8_WAIT_L(0);
    PG8_STAGE(PG8_SB(0, 0), rsB, cB, voffB); PG8_STAGE(PG8_SB(0, 1), rsB, cB + hstep, voffB); PG8_STAGE(PG8_SA(0, 0), rsA, cA, voffA0); PG8_STAGE(PG8_SA(0, 1), rsA, cA, voffA1);
    if (wr == 1) PG8_BAR;
    PG8_WAIT_V(2); PG8_BAR;
    PG8_STAGE(PG8_SB(1, 0), rsB, cB + kstep, voffB); PG8_STAGE(PG8_SA(1, 0), rsA, cA + kstep, voffA0); PG8_STAGE(PG8_SB(1, 1), rsB, cB + hstep + kstep, voffB);
    PG8_WAIT_V(6); PG8_BAR;
    for (;;) {
        const bool has_next = S.next(ui + 1, nxt);
        const unsigned nA = has_next ? (GATHER ? 0u : (unsigned)nxt.pm * tstep) : cA, nB = has_next ? (unsigned)nxt.pb * tstep : cB;
#pragma unroll 1
        for (int t = 0; t < nt; t += 2) {
            const bool last = (t == nt - 2);
            const unsigned a1 = cA + (unsigned)(t + 1) * kstep;
            const unsigned a2 = last ? nA : cA + (unsigned)(t + 2) * kstep, b2 = last ? nB : cB + (unsigned)(t + 2) * kstep;
            const unsigned a3 = a2 + kstep, b3 = b2 + kstep;
            PG8_LDB(B0, 0, 0); PG8_LDB(B1, 0, 1); PG8_SCHED; PG8_LDA(At, 0, 0); PG8_STAGE(PG8_SA(1, 1), rsA, a1, voffA1);
            if (last && has_next) PG8_LOADROWS(nxt);
            PG8_WAIT_V(8); PG8_WAIT_L(0); PG8_BAR; PG8_MMA(0, 0, At, B0); PG8_MMA(0, 1, At, B1); PG8_BAR; PG8_SCHED;
            PG8_LDA(At, 0, 1); PG8_STAGE(PG8_SB(0, 0), rsB, b2, voffB); PG8_STAGE(PG8_SB(0, 1), rsB, b2 + hstep, voffB); PG8_STAGE(PG8_SA(0, 0), rsA, a2, voffA0);
            PG8_WAIT_V(8); PG8_WAIT_L(0); PG8_BAR; PG8_MMA(1, 0, At, B0); PG8_MMA(1, 1, At, B1); PG8_BAR; PG8_SCHED;
            PG8_LDB(B0, 1, 0); PG8_LDB(B1, 1, 1); PG8_SCHED; PG8_LDA(At, 1, 0); PG8_STAGE(PG8_SA(0, 1), rsA, a2, voffA1);
            PG8_WAIT_V(8); PG8_WAIT_L(0); PG8_BAR; PG8_MMA(0, 0, At, B0); PG8_MMA(0, 1, At, B1); PG8_BAR; PG8_SCHED;
            PG8_LDA(At, 1, 1); PG8_STAGE(PG8_SB(1, 0), rsB, b3, voffB); PG8_STAGE(PG8_SB(1, 1), rsB, b3 + hstep, voffB); PG8_STAGE(PG8_SA(1, 0), rsA, a3, voffA0);
            PG8_WAIT_V(8); PG8_WAIT_L(0); PG8_BAR; PG8_MMA(1, 0, At, B0); PG8_MMA(1, 1, At, B1); PG8_BAR; PG8_SCHED;
        }
        if (wr == 0) PG8_BAR;
        { int t2 = threadIdx.x; asm volatile("" : "+v"(t2));
          const int w2 = __builtin_amdgcn_readfirstlane(t2 >> 6), l2 = t2 & 63; E(acc, cur, w2 >> 2, w2 & 3, l2 & 15, l2 >> 4); }
        if (!has_next) break;
#pragma unroll
        for (int a = 0; a < 2; ++a)
#pragma unroll
            for (int b = 0; b < 2; ++b)
#pragma unroll
                for (int m = 0; m < 4; ++m)
#pragma unroll
                    for (int n = 0; n < 2; ++n) acc[a][b][m][n] = (f32x4){0.f, 0.f, 0.f, 0.f};
        cur = nxt; cA = nA; cB = nB; ++ui;
        if (wr == 1) PG8_BAR;
    }
    PG8_WAIT_V(0);
    PG8_BAR;
#undef PG8_SA
#undef PG8_SB
#undef PG8_STAGE
#undef PG8_LDA
#undef PG8_LDB
#undef PG8_MMA
#undef PG8_WAIT_V
#undef PG8_WAIT_L
#undef PG8_BAR
#undef PG8_SCHED
#undef PG8_LOADROWS
}

struct EpiP1 {
    static constexpr bool PERM = true;
    bf16_t* O;
    __device__ __forceinline__ void operator()(const f32x4 (&acc)[2][2][4][2], const Unit& u, int wr, int wc, int fr, int fq) const {
        const int row0 = u.pm * BM + wr * 64 + fr, col0 = u.pn * BM + wc * 32 + 8 * fq; const bool act = u.pn < 4;
#pragma unroll
        for (int ai = 0; ai < 2; ++ai)
#pragma unroll
            for (int m = 0; m < 4; ++m) { bf16_t* rowp = O + (size_t)(row0 + ai * HALF + m * 16) * INC + col0;
#pragma unroll
                for (int bj = 0; bj < 2; ++bj) { f32x4 v0 = acc[ai][bj][m][0], v1 = acc[ai][bj][m][1];
                    if (act) {
#pragma unroll
                        for (int j = 0; j < 4; ++j) { v0[j] = gelu_tanh(v0[j]); v1[j] = gelu_tanh(v1[j]); } }
                    u32x4 w; w.x = cvt_pk_bf16(v0[0], v0[1]); w.y = cvt_pk_bf16(v0[2], v0[3]); w.z = cvt_pk_bf16(v1[0], v1[1]); w.w = cvt_pk_bf16(v1[2], v1[3]);
                    *(u32x4*)(rowp + bj * HALF) = w; } }
    }
};
struct EpiZ {
    static constexpr bool PERM = true;
    const float* X; bf16_t* Z;
    __device__ __forceinline__ void operator()(const f32x4 (&acc)[2][2][4][2], const Unit& u, int wr, int wc, int fr, int fq) const {
        const int col0 = u.pn * BM + wc * 32 + 8 * fq;
#pragma unroll
        for (int ai = 0; ai < 2; ++ai)
#pragma unroll
            for (int m = 0; m < 4; ++m) { const size_t off = (size_t)(u.pm * BM + ai * HALF + wr * 64 + m * 16 + fr) * D + col0;
#pragma unroll
                for (int bj = 0; bj < 2; ++bj) { const f32x4 x0 = *(const f32x4*)(X + off + bj * HALF), x1 = *(const f32x4*)(X + off + bj * HALF + 4);
                    const f32x4 v0 = x0 * DN_ALPHA + acc[ai][bj][m][0], v1 = x1 * DN_ALPHA + acc[ai][bj][m][1];
                    u32x4 w; w.x = cvt_pk_bf16(v0[0], v0[1]); w.y = cvt_pk_bf16(v0[2], v0[3]); w.z = cvt_pk_bf16(v1[0], v1[1]); w.w = cvt_pk_bf16(v1[2], v1[3]);
                    *(u32x4*)(Z + off + bj * HALF) = w; } }
    }
};
struct EpiSwiglu {
    static constexpr bool PERM = true;
    act_t* Act; const float* bg; const float* bu;
    __device__ __forceinline__ void operator()(const f32x4 (&acc)[2][2][4][2], const Unit& u, int wr, int wc, int fr, int fq) const {
        const int f0 = u.pn * HALF + wc * 32 + 8 * fq; const int row0 = u.pm * BM + wr * 64 + fr;
        const f32x4 bg0 = *(const f32x4*)(bg + u.e * FF + f0), bg1 = *(const f32x4*)(bg + u.e * FF + f0 + 4);
        const f32x4 bu0 = *(const f32x4*)(bu + u.e * FF + f0), bu1 = *(const f32x4*)(bu + u.e * FF + f0 + 4);
#pragma unroll
        for (int ai = 0; ai < 2; ++ai)
#pragma unroll
            for (int m = 0; m < 4; ++m) {
                f32x4 g0 = acc[ai][0][m][0] * (1.0f / WGU_SCALE) + bg0, g1 = acc[ai][0][m][1] * (1.0f / WGU_SCALE) + bg1, u0 = acc[ai][1][m][0] * (1.0f / WGU_SCALE) + bu0, u1 = acc[ai][1][m][1] * (1.0f / WGU_SCALE) + bu1, r0, r1;
#pragma unroll
                for (int j = 0; j < 4; ++j) {
                    const float ga = fminf(g0[j], 7.0f), gb = fminf(g1[j], 7.0f);
                    const float ua = fminf(fmaxf(u0[j], -7.0f), 7.0f), ub = fminf(fmaxf(u1[j], -7.0f), 7.0f);
                    r0[j] = (ua + 1.0f) * ga * __builtin_amdgcn_rcpf(1.0f + __builtin_amdgcn_exp2f(-1.702f * 1.4426950408889634f * ga));
                    r1[j] = (ub + 1.0f) * gb * __builtin_amdgcn_rcpf(1.0f + __builtin_amdgcn_exp2f(-1.702f * 1.4426950408889634f * gb)); }
                if constexpr (G2_FP8) { u32x2 w; w.x = cvt4_fp8(r0[0], r0[1], r0[2], r0[3]); w.y = cvt4_fp8(r1[0], r1[1], r1[2], r1[3]); *(u32x2*)(Act + (size_t)(row0 + ai * HALF + m * 16) * FF + f0) = w; }
                else { u32x4 w; w.x = cvt_pk_bf16(r0[0], r0[1]); w.y = cvt_pk_bf16(r0[2], r0[3]); w.z = cvt_pk_bf16(r1[0], r1[1]); w.w = cvt_pk_bf16(r1[2], r1[3]); *(u32x4*)(Act + (size_t)(row0 + ai * HALF + m * 16) * FF + f0) = w; } }
    }
};
struct EpiY {
    static constexpr bool PERM = true;
    fp8_t* Y; const float* bd;
    __device__ __forceinline__ void operator()(const f32x4 (&acc)[2][2][4][2], const Unit& u, int wr, int wc, int fr, int fq) const {
        const int c0 = u.pn * BM + wc * 32 + 8 * fq; const int row0 = u.pm * BM + wr * 64 + fr;
        f32x4 b[2][2];
#pragma unroll
        for (int bj = 0; bj < 2; ++bj) { b[bj][0] = *(const f32x4*)(bd + u.e * D + c0 + bj * HALF); b[bj][1] = *(const f32x4*)(bd + u.e * D + c0 + bj * HALF + 4); }
#pragma unroll
        for (int ai = 0; ai < 2; ++ai)
#pragma unroll
            for (int m = 0; m < 4; ++m) { fp8_t* rowp = Y + (size_t)(row0 + ai * HALF + m * 16) * D + c0;
#pragma unroll
                for (int bj = 0; bj < 2; ++bj) { const f32x4 v0 = (acc[ai][bj][m][0] * (1.0f / WD_SCALE) + b[bj][0]) * Y_SCALE, v1 = (acc[ai][bj][m][1] * (1.0f / WD_SCALE) + b[bj][1]) * Y_SCALE;
                    u32x2 w; w.x = cvt4_fp8(v0[0], v0[1], v0[2], v0[3]); w.y = cvt4_fp8(v1[0], v1[1], v1[2], v1[3]);
                    *(u32x2*)(rowp + bj * HALF) = w; } }
    }
};
}


#define XB_TMO      128
#define XB_XCNT(j)  (256  + 64 * (j))
#define XB_XSUB(j)  (1280 + 64 * (j))
#define XB_XGEN(j)  (2304 + 64 * (j))
#define XB_TOP      3328
#define XB_TOPGEN   3392
#define XCD_BAR_WORDS 3456
#define XB_SPIN_CAP (1u << 22)
__device__ __forceinline__ unsigned xb_ld(unsigned* p)              { return __hip_atomic_load(p, __ATOMIC_RELAXED, __HIP_MEMORY_SCOPE_AGENT); }
__device__ __forceinline__ unsigned xb_add(unsigned* p, unsigned v) { return __hip_atomic_fetch_add(p, v, __ATOMIC_RELAXED, __HIP_MEMORY_SCOPE_AGENT); }
__device__ __forceinline__ unsigned xb_xcc_id() { return (unsigned)__builtin_amdgcn_s_getreg((3 << 11) | 20) & 0xFu; }
#define XB_SPIN(cond, bar) do { unsigned _sp = 0; while (cond) { __builtin_amdgcn_s_sleep(1); \
    if ((++_sp & 255u) == 0u) { if (xb_ld(&(bar)[XB_TMO])) break; if (_sp > XB_SPIN_CAP) { atomicAdd(&(bar)[XB_TMO], 1u); break; } } } } while (0)
struct XcdBarrier { unsigned* bar; unsigned x; volatile LAS unsigned* st; };
__device__ __forceinline__ XcdBarrier xcd_barrier_post(unsigned* bar, volatile LAS unsigned* st) {
    XcdBarrier b; b.bar = bar; b.x = xb_xcc_id(); b.st = st;
    if (threadIdx.x == 0) (void)xb_add(&bar[XB_XCNT(b.x)], 1u);
    return b;
}
__device__ __forceinline__ void xcd_barrier_complete(unsigned* bar, unsigned x, unsigned& nloc, unsigned& nx) {
    const unsigned G = gridDim.x * gridDim.y * gridDim.z;
    unsigned sum, cnt, mine, sp = 0u;
    for (;;) {
        sum = 0u; cnt = 0u; mine = 0u;
#pragma unroll
        for (unsigned j = 0; j < 16; ++j) { const unsigned c = xb_ld(&bar[XB_XCNT(j)]); sum += c; cnt += (c > 0u) ? 1u : 0u; mine = (j == x) ? c : mine; }
        if (sum == G) break;
        __builtin_amdgcn_s_sleep(1);
        if ((++sp & 255u) == 0u) { if (xb_ld(&bar[XB_TMO])) break; if (sp > XB_SPIN_CAP) { atomicAdd(&bar[XB_TMO], 1u); break; } }
    }
    nloc = mine > 0u ? mine : 1u; nx = cnt > 0u ? cnt : 1u;
}
__device__ __forceinline__ void xcd_barrier(const XcdBarrier& b) {
    asm volatile("s_waitcnt vmcnt(0)" ::: "memory");
    __syncthreads();
    if (threadIdx.x == 0) {
        unsigned* bar = b.bar;
        __builtin_amdgcn_s_waitcnt(0);
        unsigned nloc = b.st[0], nx = b.st[1];
        if (nloc == 0u) { xcd_barrier_complete(bar, b.x, nloc, nx); b.st[0] = nloc; b.st[1] = nx; }
        const unsigned old = xb_add(&bar[XB_XSUB(b.x)], 1u);
        const unsigned gen = old / nloc;
        if (old + 1u == (gen + 1u) * nloc) {
            __builtin_amdgcn_fence(__ATOMIC_RELEASE, "agent");
            asm volatile("s_waitcnt vmcnt(0)" ::: "memory");
            const unsigned og = xb_add(&bar[XB_TOP], 1u);
            const unsigned tg = og / nx;
            if (og + 1u == (tg + 1u) * nx) xb_add(&bar[XB_TOPGEN], 1u);
            else XB_SPIN(xb_ld(&bar[XB_TOPGEN]) == tg, bar);
            __builtin_amdgcn_fence(__ATOMIC_ACQUIRE, "agent");
            xb_add(&bar[XB_XGEN(b.x)], 1u);
            asm volatile("s_waitcnt vmcnt(0)" ::: "memory");
        } else {
            XB_SPIN(xb_ld(&bar[XB_XGEN(b.x)]) == gen, bar);
            __builtin_amdgcn_fence(__ATOMIC_ACQUIRE, "agent");
            asm volatile("s_waitcnt vmcnt(0)" ::: "memory");
        }
    }
    __syncthreads();
}

struct Args { const float* in[20]; float* out; unsigned char* ws; int ph_lo, ph_hi; };
struct Frame {
    LAS unsigned char* lds; int tid, lane, wave, G, vcu;
    const float *x, *w_in, *sgu_w, *sgu_b, *sgu_ln_g, *sgu_ln_b, *mix_g, *w_out, *ln1_g, *ln1_b, *w_router, *b_router, *w_gate, *b_gate, *w_up, *b_up, *w_down, *b_down, *ln2_g, *ln2_b;
    float* out; unsigned char* ws;
    unsigned* ctl; int* list; int* einfo; float* gates; bf16_t *Win_t, *Wout_t, *Xb, *P1, *Amix; fp8_t* Y; act_t *Wd_t, *Act; fp8_t *Wgu_t, *Hb; bf16_t* Opart; float* ML; bf16_t* WrtHi; bf16_t* Zb; bf16_t* Hh;
};

__device__ __forceinline__ void transpose_item(const float* W, int N, int K, int k0, int n0, bf16_t* WT, size_t dst_row0, LAS float* scr, int lane) {
    const int kr = lane >> 3, c4 = lane & 7; f32x4 v[8];
#pragma unroll
    for (int i = 0; i < 8; ++i) v[i] = *(const f32x4*)(W + (size_t)(k0 + 8 * kr + i) * N + n0 + 4 * c4);
#pragma unroll
    for (int e = 0; e < 4; ++e) { u32x4 o; o.x = cvt_pk_bf16(v[0][e], v[1][e]); o.y = cvt_pk_bf16(v[2][e], v[3][e]); o.z = cvt_pk_bf16(v[4][e], v[5][e]); o.w = cvt_pk_bf16(v[6][e], v[7][e]);
        *(u32x4*)(WT + (dst_row0 + 4 * c4 + e) * K + k0 + 8 * kr) = o; }
}
__device__ __forceinline__ void transpose_item8(const float* W, int N, int K, int k0, int n0, fp8_t* WT, size_t dst_row0, float scale, LAS float* scr, int lane) {
    { const int kr = lane >> 3, c4 = lane & 7; f32x4 v[16];
#pragma unroll
      for (int i = 0; i < 16; ++i) v[i] = *(const f32x4*)(W + (size_t)(k0 + 8 * i + kr) * N + n0 + 4 * c4);
#pragma unroll
      for (int i = 0; i < 16; ++i) { LAS float* d = scr + (8 * i + kr) * 33 + 4 * c4; d[0] = v[i][0]; d[1] = v[i][1]; d[2] = v[i][2]; d[3] = v[i][3]; } }
    asm volatile("s_waitcnt lgkmcnt(0)" ::: "memory");
    const int c = lane & 7;
#pragma unroll
    for (int j = 0; j < 4; ++j) { const int n = (lane >> 3) + 8 * j; const LAS float* s = scr + (16 * c) * 33 + n;
        u32x4 o; o.x = cvt4_fp8(s[0 * 33] * scale, s[1 * 33] * scale, s[2 * 33] * scale, s[3 * 33] * scale); o.y = cvt4_fp8(s[4 * 33] * scale, s[5 * 33] * scale, s[6 * 33] * scale, s[7 * 33] * scale);
        o.z = cvt4_fp8(s[8 * 33] * scale, s[9 * 33] * scale, s[10 * 33] * scale, s[11 * 33] * scale); o.w = cvt4_fp8(s[12 * 33] * scale, s[13 * 33] * scale, s[14 * 33] * scale, s[15 * 33] * scale);
        *(u32x4*)(WT + (dst_row0 + n) * K + k0 + 16 * c) = o; }
    asm volatile("s_waitcnt lgkmcnt(0)" ::: "memory");
}
constexpr int MOE_ITEMS = NE * 3 * 8 * 32;
static_assert(G2_FP8, "the MoE item list below assumes fp8 copies of all three expert matrices");
struct MoeItem { const float* src; fp8_t* dst; float scale; };
__device__ __forceinline__ MoeItem moe_item(const Frame& F, int it) {
    const int nb = it & 31, kb = (it >> 5) & 7, e = (it >> 8) & 31, which = it >> 13, n0 = 32 * nb; MoeItem m;
    if (which < 2) { m.src = (which ? F.w_up : F.w_gate) + (size_t)e * D * FF + (size_t)(128 * kb) * FF + n0; m.dst = F.Wgu_t + ((size_t)e * 2048 + (n0 >> 7) * 256 + which * 128 + (n0 & 127)) * D + 128 * kb; m.scale = WGU_SCALE; }
    else { m.src = F.w_down + (size_t)e * FF * D + (size_t)(128 * kb) * D + n0; m.dst = (fp8_t*)F.Wd_t + ((size_t)e * 1024 + n0) * FF + 128 * kb; m.scale = WD_SCALE; }
    return m; }
__device__ __forceinline__ void moe_item_load(const MoeItem& m, f32x4 (&v)[16], int lane) {
    const int kr = lane >> 3, c4 = lane & 7;
#pragma unroll
    for (int i = 0; i < 16; ++i) v[i] = *(const f32x4*)(m.src + (size_t)(16 * kr + i) * 1024 + 4 * c4); }
__device__ __forceinline__ void moe_item_finish(const MoeItem& m, const f32x4 (&v)[16], LAS float* scr, int lane) {
    const int kr = lane >> 3, c4 = lane & 7; const float scale = m.scale;
#pragma unroll
    for (int e = 0; e < 4; ++e) { u32x4 o;
        o.x = cvt4_fp8(v[0][e] * scale, v[1][e] * scale, v[2][e] * scale, v[3][e] * scale); o.y = cvt4_fp8(v[4][e] * scale, v[5][e] * scale, v[6][e] * scale, v[7][e] * scale);
        o.z = cvt4_fp8(v[8][e] * scale, v[9][e] * scale, v[10][e] * scale, v[11][e] * scale); o.w = cvt4_fp8(v[12][e] * scale, v[13][e] * scale, v[14][e] * scale, v[15][e] * scale);
        *(u32x4*)(m.dst + (size_t)(4 * c4 + e) * 1024 + 16 * kr) = o; } }
__device__ __forceinline__ void moe_convert_items(Frame& F, int first, int count) {
    int end = first + count; if (end > MOE_ITEMS) end = MOE_ITEMS;
#pragma unroll 1
    for (int it = first; it < end; ++it) { f32x4 va[16]; const MoeItem ma = moe_item(F, it); moe_item_load(ma, va, F.lane); moe_item_finish(ma, va, nullptr, F.lane); }
}
__device__ __forceinline__ void p0_convert(Frame& F) {
    LAS float* scr = (LAS float*)(F.lds + F.wave * 17408);
    const int gw = F.vcu * 8 + F.wave, NGW = F.G * 8;
    constexpr int I_IN = (D / 64) * (INC / 32), I_OUT = (D / 64) * (D / 32);
    for (int it = gw; it < I_IN + I_OUT; it += NGW) {
        int r = it;
        if (r < I_IN) { const int kb = r / (INC / 32), nb = r % (INC / 32); transpose_item(F.w_in, INC, D, 64 * kb, 32 * nb, F.Win_t, (size_t)32 * nb, scr, F.lane); continue; } r -= I_IN;
        { const int kb = r / (D / 32), nb = r % (D / 32); transpose_item(F.w_out, D, D, 64 * kb, 32 * nb, F.Wout_t, (size_t)32 * nb, scr, F.lane); }
    }
    for (int i2 = blockIdx.x * 512 + F.tid; i2 < D * NE; i2 += F.G * 512) { const int k = i2 >> 5, e = i2 & 31; const float wv = F.w_router[i2];
        const unsigned hi = cvt_pk_bf16(wv, 0.f) & 0xffffu; const unsigned lo = cvt_pk_bf16(wv - bf_lo(hi), 0.f) & 0xffffu;
        F.WrtHi[(size_t)e * D + k] = (bf16_t)hi; F.WrtHi[(size_t)(NE + e) * D + k] = (bf16_t)lo; }
    const size_t nchunk = (size_t)T * D / 8, cstride = (size_t)F.G * 512;
    for (size_t i = (size_t)blockIdx.x * 512 + F.tid; i < nchunk; i += 4 * cstride) {
        f32x4 a[4], b[4];
#pragma unroll
        for (int j = 0; j < 4; ++j) { const size_t ii = i + j * cstride; if (ii < nchunk) { a[j] = *(const f32x4*)(F.x + ii * 8); b[j] = *(const f32x4*)(F.x + ii * 8 + 4); } }
#pragma unroll
        for (int j = 0; j < 4; ++j) { const size_t ii = i + j * cstride; if (ii < nchunk) {
            u32x4 w; w.x = cvt_pk_bf16(a[j][0], a[j][1]); w.y = cvt_pk_bf16(a[j][2], a[j][3]); w.z = cvt_pk_bf16(b[j][0], b[j][1]); w.w = cvt_pk_bf16(b[j][2], b[j][3]);
            *(u32x4*)(F.Xb + ii * 8) = w; } } }
}

typedef float f32x16 __attribute__((ext_vector_type(16)));
typedef short s16x4 __attribute__((ext_vector_type(4)));
constexpr int SG_ROW = 272, SG_WAVE = 64 * SG_ROW, SG_SSQ_OFF = 8 * SG_WAVE;
static_assert(SG_SSQ_OFF + 8 * 128 * 4 <= LDS_BYTES, "SGU LDS");
__device__ __forceinline__ void sgu_unit(Frame& F, int u, int half) {
    const int g = F.wave, lane = F.lane, i = lane & 31, hh = lane >> 5; const size_t row0 = (size_t)u * CHUNK;
    LAS unsigned char* vt = F.lds + g * SG_WAVE; LAS float* ssq = (LAS float*)(F.lds + SG_SSQ_OFF);
    { u32x4 raw[2][8];
#pragma unroll
      for (int tt = 0; tt < 2; ++tt) { if (tt <= half) { const bf16_t* vp = F.P1 + (row0 + lane + 64 * tt) * INC + AW + g * GD;
#pragma unroll
          for (int c8 = 0; c8 < 8; ++c8) raw[tt][c8] = *(const u32x4*)(vp + 8 * c8); } }
#pragma unroll
      for (int tt = 0; tt < 2; ++tt) { if (tt <= half) { const int t = lane + 64 * tt;
        float v[64];
#pragma unroll
        for (int c8 = 0; c8 < 8; ++c8) { const unsigned w[4] = {raw[tt][c8].x, raw[tt][c8].y, raw[tt][c8].z, raw[tt][c8].w};
#pragma unroll
            for (int j = 0; j < 4; ++j) { v[8 * c8 + 2 * j] = bf_lo(w[j]); v[8 * c8 + 2 * j + 1] = bf_hi(w[j]); } }
        float s = 0.f;
#pragma unroll
        for (int c = 0; c < 64; ++c) s += v[c];
        const float mu = s * (1.f / 64.f); float q = 0.f;
#pragma unroll
        for (int c = 0; c < 64; ++c) { v[c] -= mu; q += v[c] * v[c]; }
        const float rstd = 1.0f / sqrtf(q * (1.f / 64.f) + LN_EPS);
#pragma unroll
        for (int c = 0; c < 64; ++c) { const float val = v[c] * rstd * F.sgu_ln_g[g * GD + c] + F.sgu_ln_b[g * GD + c];
            *(LAS bf16_t*)(vt + c * SG_ROW + t * 2) = (bf16_t)(cvt_pk_bf16(val, 0.f) & 0xffffu); } } } }
    asm volatile("s_waitcnt lgkmcnt(0)" ::: "memory");
    unsigned ssq_base = (unsigned)(uintptr_t)(ssq + i); asm volatile("" : "+v"(ssq_base));
    LAS float* ssq_r = (LAS float*)(uintptr_t)ssq_base; LAS float* ssq_w = ssq_r + g * 64;
    f32x16 acc[2][2];
    f32x4 wq[2][8][2]; u32x2 uqa[2][2][4]; float bsa[2];
#pragma unroll
    for (int n2 = 0; n2 < 2; ++n2) { const int nt = 2 * half + n2, t = 32 * nt + i, nks = 2 * nt + 2;
#pragma unroll
        for (int ks = 0; ks < 8; ++ks) { if (ks < nks) { const float* wp = F.sgu_w + ((size_t)g * CHUNK + t) * CHUNK + 16 * ks + 8 * hh; wq[n2][ks][0] = *(const f32x4*)wp; wq[n2][ks][1] = *(const f32x4*)(wp + 4); } }
        const bf16_t* up = F.P1 + (row0 + t) * INC + g * GD + 4 * hh;
#pragma unroll
        for (int mt = 0; mt < 2; ++mt)
#pragma unroll
            for (int g4 = 0; g4 < 4; ++g4) uqa[n2][mt][g4] = *(const u32x2*)(up + 32 * mt + 8 * g4);
        bsa[n2] = F.sgu_b[g * CHUNK + t]; }
#pragma unroll
    for (int n2 = 0; n2 < 2; ++n2) { const int nt = 2 * half + n2, t = 32 * nt + i, nks = 2 * nt + 2;
#pragma unroll
        for (int mt = 0; mt < 2; ++mt)
#pragma unroll
            for (int r = 0; r < 16; ++r) acc[mt][n2][r] = 0.f;
        const float bs = bsa[n2];
#pragma unroll
        for (int ks = 0; ks < 8; ++ks) { if (ks < nks) { const int s0 = 16 * ks + 8 * hh;
            float wv[8] = {wq[n2][ks][0][0], wq[n2][ks][0][1], wq[n2][ks][0][2], wq[n2][ks][0][3], wq[n2][ks][1][0], wq[n2][ks][1][1], wq[n2][ks][1][2], wq[n2][ks][1][3]};
#pragma unroll
            for (int j = 0; j < 8; ++j) wv[j] = (s0 + j <= t) ? wv[j] : 0.f;
            u32x4 bw; bw.x = cvt_pk_bf16(wv[0], wv[1]); bw.y = cvt_pk_bf16(wv[2], wv[3]); bw.z = cvt_pk_bf16(wv[4], wv[5]); bw.w = cvt_pk_bf16(wv[6], wv[7]);
            const bf16x8 bfrag = __builtin_bit_cast(bf16x8, bw);
#pragma unroll
            for (int mt = 0; mt < 2; ++mt) { const bf16x8 afrag = *(const LAS bf16x8*)(vt + (32 * mt + i) * SG_ROW + s0 * 2);
                acc[mt][n2] = __builtin_amdgcn_mfma_f32_32x32x16_bf16(afrag, bfrag, acc[mt][n2], 0, 0, 0); } } }
        float ss = 0.f;
#pragma unroll
        for (int mt = 0; mt < 2; ++mt)
#pragma unroll
            for (int g4 = 0; g4 < 4; ++g4) { const u32x2 uw = uqa[n2][mt][g4];
                const float u0 = bf_lo(uw.x), u1 = bf_hi(uw.x), u2 = bf_lo(uw.y), u3 = bf_hi(uw.y);
                float a0 = u0 * (acc[mt][n2][4 * g4] + bs), a1 = u1 * (acc[mt][n2][4 * g4 + 1] + bs), a2 = u2 * (acc[mt][n2][4 * g4 + 2] + bs), a3 = u3 * (acc[mt][n2][4 * g4 + 3] + bs);
                acc[mt][n2][4 * g4] = a0; acc[mt][n2][4 * g4 + 1] = a1; acc[mt][n2][4 * g4 + 2] = a2; acc[mt][n2][4 * g4 + 3] = a3;
                ss += (a0 * a0 + a1 * a1) + (a2 * a2 + a3 * a3); }
        ss += __shfl_xor(ss, 32);
        if (hh == 0) ssq_w[32 * n2] = ss; }
    __syncthreads();
#pragma unroll
    for (int n2 = 0; n2 < 2; ++n2) { const int t = 64 * half + 32 * n2 + i; float tot = 0.f;
#pragma unroll
        for (int gg = 0; gg < 8; ++gg) tot += ssq_r[gg * 64 + 32 * n2];
        const float rs = 1.0f / sqrtf(tot * (1.f / AW) + LN_EPS);
        bf16_t* op = F.Amix + (row0 + t) * D + g * GD + 4 * hh;
#pragma unroll
        for (int mt = 0; mt < 2; ++mt)
#pragma unroll
            for (int g4 = 0; g4 < 4; ++g4) { const f32x4 mg = *(const f32x4*)(F.mix_g + g * GD + 32 * mt + 8 * g4 + 4 * hh);
                u32x2 w; w.x = cvt_pk_bf16(acc[mt][n2][4 * g4] * rs * mg[0], acc[mt][n2][4 * g4 + 1] * rs * mg[1]); w.y = cvt_pk_bf16(acc[mt][n2][4 * g4 + 2] * rs * mg[2], acc[mt][n2][4 * g4 + 3] * rs * mg[3]);
                *(u32x2*)(op + 32 * mt + 8 * g4) = w; } }
    __syncthreads();
}

constexpr int AT_KROW = 144, AT_VROW = 144, AT_V_OFF = 384 * AT_KROW;
static_assert(AT_V_OFF + 384 * AT_VROW <= RING_BYTES, "attention LDS");
struct AttnDesc { int b, h, p, d, r, q0; };
__device__ __forceinline__ AttnDesc attn_decode(int u) {
    AttnDesc a; const int bh = u / 48, rem = u % 48, idx = rem & 15; a.p = rem >> 4; a.b = bh >> 3; a.h = bh & 7;
    a.d = (a.p == 0) ? 1 : (a.p == 1) ? 4 : 16; a.r = (a.p == 0) ? 0 : (a.p == 1) ? (idx >> 2) : idx; a.q0 = 256 * ((a.p == 0) ? idx : (a.p == 1) ? (idx & 3) : 0); return a; }
__device__ __forceinline__ void attn_stage_load(const Frame& F, const AttnDesc& a, u32x4 (&kq)[6], u32x4 (&vq)[6]) {
    const bf16_t* base = F.P1 + (size_t)a.b * SEQ * INC + a.h * HD;
#pragma unroll
    for (int it = 0; it < 6; ++it) { const int ch = F.tid + 512 * it, key = ch >> 3, c = ch & 7, s = a.q0 - 128 + key;
        kq[it] = (u32x4){0u, 0u, 0u, 0u}; vq[it] = (u32x4){0u, 0u, 0u, 0u};
        if (s >= 0) { const bf16_t* rp = base + (size_t)(s * a.d + a.r) * INC + c * 8; kq[it] = *(const u32x4*)(rp + 1536); vq[it] = *(const u32x4*)(rp + 2048); } }
}
__device__ __forceinline__ void attn_stage_write(const Frame& F, const u32x4 (&kq)[6], const u32x4 (&vq)[6]) {
#pragma unroll
    for (int it = 0; it < 6; ++it) { const int ch = F.tid + 512 * it, key = ch >> 3, c = ch & 7;
        *(LAS u32x4*)(F.lds + key * AT_KROW + c * 16) = kq[it]; *(LAS u32x4*)(F.lds + AT_V_OFF + key * AT_VROW + c * 16) = vq[it]; }
}
typedef short v4i16_t __attribute__((ext_vector_type(4)));
__device__ __forceinline__ void attn_compute(Frame& F, const AttnDesc& a, const bf16x8 (&qf)[4]) {
    const int lane = F.lane, i = lane & 31, hh = lane >> 5, w = F.wave, q0 = a.q0;
    LAS unsigned char* kl = F.lds; LAS unsigned char* vl = F.lds + AT_V_OFF;
    f32x16 s[5];
#pragma unroll
    for (int kt = 0; kt < 5; ++kt) { f32x16 a;
#pragma unroll
        for (int rr = 0; rr < 16; ++rr) a[rr] = 0.f;
#pragma unroll
        for (int ks = 0; ks < 4; ++ks) { const bf16x8 kf = *(const LAS bf16x8*)(kl + (32 * w + 32 * kt + i) * AT_KROW + (16 * ks + 8 * hh) * 2);
            a = __builtin_amdgcn_mfma_f32_32x32x16_bf16(kf, qf[ks], a, 0, 0, 0); }
        s[kt] = a; }
    const float sc = 0.125f * 1.4426950408889634f; const int ksub0 = q0 + 32 * w - 128;
    float m = -INFINITY;
#pragma unroll
    for (int kt = 0; kt < 5; ++kt)
#pragma unroll
        for (int rr = 0; rr < 16; ++rr) { const int kk = (rr & 3) + 8 * (rr >> 2) + 4 * hh; bool ok = (ksub0 + 32 * kt + kk) >= 0;
            if (kt == 0) ok = ok && (kk >= i);
            if (kt == 4) ok = ok && (kk <= i);
            const float v = ok ? s[kt][rr] * sc : -INFINITY; s[kt][rr] = v; m = fmaxf(m, v); }
    m = fmaxf(m, __shfl_xor(m, 32));
    float lsum = 0.f;
#pragma unroll
    for (int kt = 0; kt < 5; ++kt)
#pragma unroll
        for (int rr = 0; rr < 16; ++rr) { const float pv = __builtin_amdgcn_exp2f(s[kt][rr] - m); s[kt][rr] = pv; lsum += pv; }
    lsum += __shfl_xor(lsum, 32);
    f32x16 o[2];
#pragma unroll
    for (int dt = 0; dt < 2; ++dt)
#pragma unroll
        for (int rr = 0; rr < 16; ++rr) o[dt][rr] = 0.f;
    const LAS unsigned char* vtp = vl + (32 * w + 4 * hh + ((lane & 15) >> 2)) * AT_VROW + (16 * ((lane >> 4) & 1) + 4 * (lane & 3)) * 2;
#pragma unroll
    for (int kt = 0; kt < 5; ++kt)
#pragma unroll
        for (int s2 = 0; s2 < 2; ++s2) { u32x4 pw; pw.x = cvt_pk_bf16(s[kt][8 * s2], s[kt][8 * s2 + 1]); pw.y = cvt_pk_bf16(s[kt][8 * s2 + 2], s[kt][8 * s2 + 3]);
            pw.z = cvt_pk_bf16(s[kt][8 * s2 + 4], s[kt][8 * s2 + 5]); pw.w = cvt_pk_bf16(s[kt][8 * s2 + 6], s[kt][8 * s2 + 7]);
            const bf16x8 pb = __builtin_bit_cast(bf16x8, pw);
#pragma unroll
            for (int dt = 0; dt < 2; ++dt) { const LAS unsigned char* ap = vtp + (32 * kt + 16 * s2) * AT_VROW + 64 * dt;
                const v4i16_t lo = __builtin_amdgcn_ds_read_tr16_b64_v4i16((LAS v4i16_t*)ap), hi = __builtin_amdgcn_ds_read_tr16_b64_v4i16((LAS v4i16_t*)(ap + 8 * AT_VROW));
                const bf16x8 af = __builtin_shufflevector(lo, hi, 0, 1, 2, 3, 4, 5, 6, 7);
                o[dt] = __builtin_amdgcn_mfma_f32_32x32x16_bf16(af, pb, o[dt], 0, 0, 0); } }
    const float inv = 1.0f / lsum; const size_t orow = (size_t)a.b * SEQ + ((size_t)(q0 + 32 * w + i) * a.d + a.r);
    bf16_t* op = F.Opart + ((size_t)a.p * T + orow) * AW + a.h * HD + 4 * hh;
#pragma unroll
    for (int dt = 0; dt < 2; ++dt)
#pragma unroll
        for (int g4 = 0; g4 < 4; ++g4) { u32x2 wv; wv.x = cvt_pk_bf16(o[dt][4 * g4] * inv, o[dt][4 * g4 + 1] * inv); wv.y = cvt_pk_bf16(o[dt][4 * g4 + 2] * inv, o[dt][4 * g4 + 3] * inv);
            *(u32x2*)(op + 32 * dt + 8 * g4) = wv; }
    if (hh == 0) *(f32x2*)(F.ML + (((size_t)a.p * T + orow) * NH + a.h) * 2) = (f32x2){m, lsum};
}
__device__ __forceinline__ void attn_units(Frame& F, int u0, int ustep, int uend) {
    if (u0 >= uend) return;
    u32x4 kq[6], vq[6]; bf16x8 qn[4]; AttnDesc cur = attn_decode(u0);
#define ATT_QLOAD(A, Q) do { const bf16_t* base_ = F.P1 + (size_t)(A).b * SEQ * INC + (A).h * HD; const size_t qrow_ = (size_t)((A).q0 + 32 * F.wave + (F.lane & 31)) * (A).d + (A).r; \
        _Pragma("unroll") for (int ks = 0; ks < 4; ++ks) Q[ks] = *(const bf16x8*)(base_ + qrow_ * INC + 1024 + 16 * ks + 8 * (F.lane >> 5)); } while (0)
    attn_stage_load(F, cur, kq, vq); ATT_QLOAD(cur, qn);
    for (int u = u0; u < uend; u += ustep) {
        attn_stage_write(F, kq, vq);
        bf16x8 qf[4];
#pragma unroll
        for (int ks = 0; ks < 4; ++ks) qf[ks] = qn[ks];
        __syncthreads();
        const AttnDesc nxt = attn_decode(u + ustep < uend ? u + ustep : u);
        if (u + ustep < uend) { attn_stage_load(F, nxt, kq, vq); ATT_QLOAD(nxt, qn); }
        attn_compute(F, cur, qf);
        __syncthreads();
        cur = nxt;
    }
#undef ATT_QLOAD
}
__device__ __forceinline__ void p2_mixers(Frame& F) {
    constexpr int NSGU = 2 * BATCH * (SEQ / CHUNK), NATT = BATCH * NH * 48;
    constexpr int SH = MOE_ITEMS / 3; const int cnt = SH / (F.G * 8) + ((SH % (F.G * 8)) ? 1 : 0); int first = SH + (F.vcu * 8 + F.wave) * cnt, count = cnt;
    if (first + count > 2 * SH) count = 2 * SH - first;
    const int slot = F.vcu & 3;
    const int split = (F.vcu + 3 * F.G < NATT) ? F.vcu + 3 * F.G : NATT;
    if (slot == 0) moe_convert_items(F, first, count);
    for (int u = F.vcu; u < NSGU; u += F.G) sgu_unit(F, u >> 1, u & 1);
    if (slot == 1) moe_convert_items(F, first, count);
    attn_units(F, F.vcu, F.G, split);
    if (slot == 2) moe_convert_items(F, first, count);
    attn_units(F, split, F.G, NATT);
    if (slot == 3) moe_convert_items(F, first, count);
}

__device__ __forceinline__ void p3_merge(Frame& F) {
    const int gw = blockIdx.x * 8 + F.wave, NGW = F.G * 8, h = F.lane >> 3;
    for (int row = gw; row < T; row += NGW) {
        f32x2 ml[3]; float mx = -INFINITY;
#pragma unroll
        for (int p = 0; p < 3; ++p) { ml[p] = *(const f32x2*)(F.ML + (((size_t)p * T + row) * NH + h) * 2); mx = fmaxf(mx, ml[p].x); }
        float wt[3], wsum = 0.f;
#pragma unroll
        for (int p = 0; p < 3; ++p) { wt[p] = ml[p].y * __builtin_amdgcn_exp2f(ml[p].x - mx); wsum += wt[p]; }
        const float iw = 1.0f / wsum; float bv[8];
#pragma unroll
        for (int j = 0; j < 8; ++j) bv[j] = 0.f;
#pragma unroll
        for (int p = 0; p < 3; ++p) { const u32x4 r = *(const u32x4*)(F.Opart + ((size_t)p * T + row) * AW + F.lane * 8); const unsigned w[4] = {r.x, r.y, r.z, r.w}; const float f = wt[p] * iw;
#pragma unroll
            for (int j = 0; j < 4; ++j) { bv[2 * j] += f * bf_lo(w[j]); bv[2 * j + 1] += f * bf_hi(w[j]); } }
        float ss = 0.f;
#pragma unroll
        for (int j = 0; j < 8; ++j) ss += bv[j] * bv[j];
        ss = wave_sum(ss); const float rs = 1.0f / sqrtf(ss * (1.f / AW) + LN_EPS);
        const f32x4 g0 = *(const f32x4*)(F.mix_g + AW + F.lane * 8), g1 = *(const f32x4*)(F.mix_g + AW + F.lane * 8 + 4);
        u32x4 w; w.x = cvt_pk_bf16(bv[0] * rs * g0[0], bv[1] * rs * g0[1]); w.y = cvt_pk_bf16(bv[2] * rs * g0[2], bv[3] * rs * g0[3]);
        w.z = cvt_pk_bf16(bv[4] * rs * g1[0], bv[5] * rs * g1[1]); w.w = cvt_pk_bf16(bv[6] * rs * g1[2], bv[7] * rs * g1[3]);
        *(u32x4*)(F.Amix + (size_t)row * D + AW + F.lane * 8) = w;
    }
}

constexpr int RT_ROW = 2064, RT_IMG = 32 * RT_ROW, RT_LGT_OFF = 2 * RT_IMG, RT_SEL_OFF = RT_LGT_OFF + 32 * 33 * 4;
static_assert(RT_SEL_OFF + 2048 + 256 <= MISC_OFF && 8 * 32 * 32 * 4 <= RT_IMG, "route LDS");
__device__ __forceinline__ void p4_route(Frame& F) {
    const int lane = F.lane, w = F.wave;
    LAS unsigned char* img = F.lds; LAS float* part = (LAS float*)F.lds; LAS float* lgt = (LAS float*)(F.lds + RT_LGT_OFF);
    LAS int* sel_e = (LAS int*)(F.lds + RT_SEL_OFF); LAS float* sel_g = (LAS float*)(F.lds + RT_SEL_OFF + 1024);
    LAS int* lcnt = (LAS int*)(F.lds + RT_SEL_OFF + 2048); LAS int* lbase = lcnt + 32;
    if (F.tid < 32) lcnt[F.tid] = 0;
    f32x4 gg[4], bb[4];
#pragma unroll
    for (int j = 0; j < 4; ++j) { gg[j] = *(const f32x4*)(F.ln1_g + 4 * lane + 256 * j); bb[j] = *(const f32x4*)(F.ln1_b + 4 * lane + 256 * j); }
    bf16x8 bh[4][2], bl[4][2];
#pragma unroll
    for (int ks = 0; ks < 4; ++ks)
#pragma unroll
        for (int nt = 0; nt < 2; ++nt) { const bf16_t* bp = F.WrtHi + (size_t)(16 * nt + (lane & 15)) * D + 128 * w + 32 * ks + 8 * (lane >> 4);
            bh[ks][nt] = *(const bf16x8*)bp; bl[ks][nt] = *(const bf16x8*)(bp + (size_t)NE * D); }
    __syncthreads();
    for (int chunk = blockIdx.x; chunk < T / 64; chunk += F.G) {
#pragma unroll 1
        for (int half = 0; half < 2; ++half) {
            const int row0 = chunk * 64 + half * 32 + w * 4;
            f32x4 v[4][4]; float s[4], q[4];
#pragma unroll
            for (int tk = 0; tk < 4; ++tk) { s[tk] = 0.f;
#pragma unroll
                for (int j = 0; j < 4; ++j) { const u32x2 zr = *(const u32x2*)(F.Zb + (size_t)(row0 + tk) * D + 4 * lane + 256 * j); v[tk][j] = (f32x4){bf_lo(zr.x), bf_hi(zr.x), bf_lo(zr.y), bf_hi(zr.y)}; s[tk] += (v[tk][j][0] + v[tk][j][1]) + (v[tk][j][2] + v[tk][j][3]); } }
#pragma unroll
            for (int o = 1; o < 64; o <<= 1) {
#pragma unroll
                for (int tk = 0; tk < 4; ++tk) s[tk] += __shfl_xor(s[tk], o); }
#pragma unroll
            for (int tk = 0; tk < 4; ++tk) { const float mu = s[tk] * (1.f / D); q[tk] = 0.f;
#pragma unroll
                for (int j = 0; j < 4; ++j) { v[tk][j] = v[tk][j] - mu; q[tk] += (v[tk][j][0] * v[tk][j][0] + v[tk][j][1] * v[tk][j][1]) + (v[tk][j][2] * v[tk][j][2] + v[tk][j][3] * v[tk][j][3]); } }
#pragma unroll
            for (int o = 1; o < 64; o <<= 1) {
#pragma unroll
                for (int tk = 0; tk < 4; ++tk) q[tk] += __shfl_xor(q[tk], o); }
#pragma unroll
            for (int tk = 0; tk < 4; ++tk) { const float rstd = 1.0f / sqrtf(q[tk] * (1.f / D) + LN_EPS);
#pragma unroll
                for (int j = 0; j < 4; ++j) { const f32x4 h = v[tk][j] * rstd * gg[j] + bb[j]; const size_t off = (size_t)(row0 + tk) * D + 4 * lane + 256 * j;
                    *(unsigned*)(F.Hb + off) = cvt4_fp8(h[0], h[1], h[2], h[3]);
                    u32x2 hi; hi.x = cvt_pk_bf16(h[0], h[1]); hi.y = cvt_pk_bf16(h[2], h[3]);
                    *(u32x2*)(F.Hh + off) = hi;
                    u32x2 lo; lo.x = cvt_pk_bf16(h[0] - bf_lo(hi.x), h[1] - bf_hi(hi.x)); lo.y = cvt_pk_bf16(h[2] - bf_lo(hi.y), h[3] - bf_hi(hi.y));
                    LAS unsigned char* dp = img + (w * 4 + tk) * RT_ROW + (4 * lane + 256 * j) * 2;
                    *(LAS u32x2*)dp = hi; *(LAS u32x2*)(dp + RT_IMG) = lo; } }
            __syncthreads();
            f32x4 acc[2][2];
#pragma unroll
            for (int mt = 0; mt < 2; ++mt)
#pragma unroll
                for (int nt = 0; nt < 2; ++nt) acc[mt][nt] = (f32x4){0.f, 0.f, 0.f, 0.f};
#pragma unroll
            for (int mt = 0; mt < 2; ++mt) { const LAS unsigned char* ap = img + (16 * mt + (lane & 15)) * RT_ROW + (128 * w + 8 * (lane >> 4)) * 2;
#pragma unroll
                for (int ks = 0; ks < 4; ++ks) { const bf16x8 ah = *(const LAS bf16x8*)(ap + ks * 64), al = *(const LAS bf16x8*)(ap + RT_IMG + ks * 64);
#pragma unroll
                    for (int nt = 0; nt < 2; ++nt) {
                        acc[mt][nt] = __builtin_amdgcn_mfma_f32_16x16x32_bf16(ah, bh[ks][nt], acc[mt][nt], 0, 0, 0);
                        acc[mt][nt] = __builtin_amdgcn_mfma_f32_16x16x32_bf16(ah, bl[ks][nt], acc[mt][nt], 0, 0, 0);
                        acc[mt][nt] = __builtin_amdgcn_mfma_f32_16x16x32_bf16(al, bh[ks][nt], acc[mt][nt], 0, 0, 0); } } }
            __syncthreads();
#pragma unroll
            for (int mt = 0; mt < 2; ++mt)
#pragma unroll
                for (int nt = 0; nt < 2; ++nt)
#pragma unroll
                    for (int r = 0; r < 4; ++r) part[(w * 32 + 16 * mt + 4 * (lane >> 4) + r) * 32 + 16 * nt + (lane & 15)] = acc[mt][nt][r];
            __syncthreads();
#pragma unroll
            for (int qq = 0; qq < 2; ++qq) { const int p = F.tid + 512 * qq, tok = p >> 5, e = p & 31; float sum = F.b_router[e];
#pragma unroll
                for (int ww = 0; ww < 8; ++ww) sum += part[(ww * 32 + tok) * 32 + e];
                lgt[tok * 33 + e] = sum; }
            __syncthreads();
            if (F.tid < 32) {
                float lg[32];
#pragma unroll
                for (int e = 0; e < 32; ++e) lg[e] = lgt[F.tid * 33 + e];
                int idx[4]; float val[4]; unsigned taken = 0u;
#pragma unroll
                for (int r = 0; r < 4; ++r) { float best = -INFINITY; int bi = 0;
#pragma unroll
                    for (int e = 0; e < 32; ++e) { const bool ok = !((taken >> e) & 1u) && (lg[e] > best); best = ok ? lg[e] : best; bi = ok ? e : bi; }
                    idx[r] = bi; val[r] = best; taken |= 1u << bi; }
                const float e1 = __expf(val[1] - val[0]), e2 = __expf(val[2] - val[0]), e3 = __expf(val[3] - val[0]); const float inv = 1.0f / (1.0f + e1 + e2 + e3);
                const int tl = half * 32 + F.tid;
                sel_e[tl * 4 + 0] = idx[0]; sel_e[tl * 4 + 1] = idx[1]; sel_e[tl * 4 + 2] = idx[2]; sel_e[tl * 4 + 3] = idx[3];
                sel_g[tl * 4 + 0] = inv; sel_g[tl * 4 + 1] = e1 * inv; sel_g[tl * 4 + 2] = e2 * inv; sel_g[tl * 4 + 3] = e3 * inv; }
            __syncthreads();
        }
        int myrank = 0, mye = 0;
        if (F.tid < 256) { mye = sel_e[F.tid]; myrank = atomicAdd((int*)&lcnt[mye], 1); }
        __syncthreads();
        if (F.tid < 32) { const int c = lcnt[F.tid]; lbase[F.tid] = c ? (int)__hip_atomic_fetch_add(F.ctl + CW_CNT + F.tid, (unsigned)c, __ATOMIC_RELAXED, __HIP_MEMORY_SCOPE_AGENT) : 0; lcnt[F.tid] = 0; }
        __syncthreads();
        if (F.tid < 256) { const int slot = (chunk * 64 + (F.tid >> 2)) * 4 + (F.tid & 3); F.list[mye * T + lbase[mye] + myrank] = slot; F.gates[slot] = sel_g[F.tid]; F.einfo[slot] = mye | ((lbase[mye] + myrank) << 8); }
        __syncthreads();
    }
}

template <bool G1> __device__ __forceinline__ int moe_tables(Frame& F, int NPN) {
    LAS int* cnt = (LAS int*)(F.lds + TAB_OFF); LAS int* tstart = cnt + 32; LAS int* rowtab = (LAS int*)(F.lds + ROWTAB_OFF);
    if (F.tid < 32) cnt[F.tid] = (int)__hip_atomic_load(F.ctl + CW_CNT + F.tid, __ATOMIC_RELAXED, __HIP_MEMORY_SCOPE_AGENT);
    __syncthreads();
    if (F.tid == 0) { int acc = 0; for (int e = 0; e < NE; ++e) { tstart[e] = acc; acc += (cnt[e] + 255) >> 8; } tstart[NE] = acc; }
    __syncthreads();
    const int ntiles = tstart[NE], nU = ntiles * NPN;
    for (int i = 0; i < MAXU; ++i) { const int L = i * F.G + F.vcu; if (L >= nU) break;
        const int tl = L / NPN; int e = 0;
        for (int j = 1; j < NE; ++j) e += (tstart[j] <= tl) ? 1 : 0;
        const int mt = tl - tstart[e];
        if (F.tid < 256) { const int rank = mt * 256 + F.tid; const int slot = rank < cnt[e] ? F.list[e * T + rank] : -1;
            rowtab[i * 256 + F.tid] = G1 ? ((slot < 0 ? 0 : (slot >> 2)) * D) : slot; } }
    __syncthreads();
    return ntiles;
}

__device__ __forceinline__ void p7_final(Frame& F) {
    LAS int* cnt = (LAS int*)(F.lds + TAB_OFF); LAS int* tstart = cnt + 32;
    if (F.tid < 32) cnt[F.tid] = (int)__hip_atomic_load(F.ctl + CW_CNT + F.tid, __ATOMIC_RELAXED, __HIP_MEMORY_SCOPE_AGENT);
    __syncthreads();
    if (F.tid == 0) { int acc = 0; for (int e = 0; e < NE; ++e) { tstart[e] = acc; acc += (cnt[e] + 255) >> 8; } tstart[NE] = acc; }
    __syncthreads();
    const int gw = blockIdx.x * 8 + F.wave, NGW = F.G * 8;
    for (int row = gw; row < T; row += NGW) {
        float* hp = F.out + (size_t)row * D; float v[16];
#pragma unroll
        for (int j = 0; j < 2; ++j) { const u32x4 r = *(const u32x4*)(F.Hh + (size_t)row * D + 512 * j + F.lane * 8); const unsigned w[4] = {r.x, r.y, r.z, r.w};
#pragma unroll
            for (int i = 0; i < 4; ++i) { v[8 * j + 2 * i] = bf_lo(w[i]) * DN_ALPHA; v[8 * j + 2 * i + 1] = bf_hi(w[i]) * DN_ALPHA; } }
#pragma unroll
        for (int k = 0; k < TOPK; ++k) { const int info = F.einfo[row * TOPK + k]; const float gt = F.gates[row * TOPK + k];
            const size_t pos = ((size_t)tstart[info & 255] << 8) + (size_t)(info >> 8);
#pragma unroll
            for (int j = 0; j < 2; ++j) { const u32x2 r = *(const u32x2*)(F.Y + pos * D + 512 * j + F.lane * 8); const float gs = gt * (1.0f / Y_SCALE);
                const f32x2 p0 = __builtin_amdgcn_cvt_pk_f32_fp8((int)r.x, false), p1 = __builtin_amdgcn_cvt_pk_f32_fp8((int)r.x, true), p2 = __builtin_amdgcn_cvt_pk_f32_fp8((int)r.y, false), p3 = __builtin_amdgcn_cvt_pk_f32_fp8((int)r.y, true);
                v[8 * j + 0] += gs * p0.x; v[8 * j + 1] += gs * p0.y; v[8 * j + 2] += gs * p1.x; v[8 * j + 3] += gs * p1.y; v[8 * j + 4] += gs * p2.x; v[8 * j + 5] += gs * p2.y; v[8 * j + 6] += gs * p3.x; v[8 * j + 7] += gs * p3.y; } }
        float s = 0.f;
#pragma unroll
        for (int i = 0; i < 16; ++i) s += v[i];
        const float mu = wave_sum(s) * (1.f / D); float q = 0.f;
#pragma unroll
        for (int i = 0; i < 16; ++i) { v[i] -= mu; q += v[i] * v[i]; }
        const float rstd = 1.0f / sqrtf(wave_sum(q) * (1.f / D) + LN_EPS);
#pragma unroll
        for (int j = 0; j < 2; ++j) { const int c = 512 * j + F.lane * 8;
            const f32x4 g0 = *(const f32x4*)(F.ln2_g + c), g1 = *(const f32x4*)(F.ln2_g + c + 4), b0 = *(const f32x4*)(F.ln2_b + c), b1 = *(const f32x4*)(F.ln2_b + c + 4);
            f32x4 o0, o1;
#pragma unroll
            for (int i = 0; i < 4; ++i) { o0[i] = v[8 * j + i] * rstd * g0[i] + b0[i]; o1[i] = v[8 * j + 4 + i] * rstd * g1[i] + b1[i]; }
            *(f32x4*)(hp + c) = o0; *(f32x4*)(hp + c + 4) = o1; }
    }
}

__device__ __forceinline__ bool fresh(Frame& F) {
    int t = threadIdx.x; asm volatile("" : "+v"(t)); F.tid = t; F.lane = t & 63;
    const __attribute__((address_space(4))) Args* ap = (const __attribute__((address_space(4))) Args*)__builtin_amdgcn_kernarg_segment_ptr(); asm volatile("" : "+s"(ap));
    F.x = ap->in[0]; F.w_in = ap->in[1]; F.sgu_w = ap->in[2]; F.sgu_b = ap->in[3]; F.sgu_ln_g = ap->in[4]; F.sgu_ln_b = ap->in[5]; F.mix_g = ap->in[6]; F.w_out = ap->in[7];
    F.ln1_g = ap->in[8]; F.ln1_b = ap->in[9]; F.w_router = ap->in[10]; F.b_router = ap->in[11]; F.w_gate = ap->in[12]; F.b_gate = ap->in[13]; F.w_up = ap->in[14]; F.b_up = ap->in[15];
    F.w_down = ap->in[16]; F.b_down = ap->in[17]; F.ln2_g = ap->in[18]; F.ln2_b = ap->in[19]; F.out = ap->out; F.ws = ap->ws;
    unsigned char* ws = ap->ws;
    F.ctl = (unsigned*)(ws + WS_CTL); F.list = (int*)(ws + WS_LIST); F.einfo = (int*)(ws + WS_EINFO); F.gates = (float*)(ws + WS_GATES);
    F.Win_t = (bf16_t*)(ws + WS_WIN); F.Wout_t = (bf16_t*)(ws + WS_WOUT); F.Wd_t = (act_t*)(ws + WS_WD); F.Wgu_t = (fp8_t*)(ws + WS_WGU); F.Y = (fp8_t*)(ws + WS_Y);
    F.Hb = (fp8_t*)(ws + WS_HB); F.Xb = (bf16_t*)(ws + WS_XB); F.P1 = (bf16_t*)(ws + WS_P1); F.Amix = (bf16_t*)(ws + WS_AMIX); F.Act = (act_t*)(ws + WS_ACT);
    F.WrtHi = (bf16_t*)(ws + WS_WRT); F.Zb = (bf16_t*)(ws + WS_XB); F.Hh = (bf16_t*)(ws + WS_AMIX);
    F.Opart = (bf16_t*)(ws + WS_OPART); F.ML = (float*)(ws + WS_ML);
    return true; }
constexpr int N_PHASES = 8;
__global__ void __launch_bounds__(512, 2) mk_fwd(Args args) {
    extern __shared__ __attribute__((aligned(16))) unsigned char lds_raw[];
    Frame F;
    F.lds = (LAS unsigned char*)lds_raw; F.tid = threadIdx.x; F.lane = F.tid & 63; F.wave = __builtin_amdgcn_readfirstlane(F.tid >> 6);
    F.G = gridDim.x; { const int bx = blockIdx.x; F.vcu = (F.G % 8 == 0) ? (bx % 8) * (F.G / 8) + bx / 8 : bx; }
    fresh(F);
    unsigned char* ws = F.ws;
    const int lo = args.ph_lo, hi = args.ph_hi;
    volatile LAS unsigned* misc = (volatile LAS unsigned*)(F.lds + MISC_OFF);
    if (F.tid < 16) misc[F.tid] = 0u;
    __syncthreads();
    XcdBarrier bar; bar.bar = F.ctl + CW_BAR; bar.x = 0; bar.st = misc;
    if (hi - lo > 1) bar = xcd_barrier_post(F.ctl + CW_BAR, misc);
    const LAS int* rowtab = (const LAS int*)(F.lds + ROWTAB_OFF);
#ifndef PROBE_DUP
#define PROBE_DUP -1
#endif
#define IN(k) (lo <= (k) && (k) < hi && fresh(F))
#define SEAM(k) do { if (lo <= (k) && (k) + 1 < hi) { xcd_barrier(bar); } } while (0)
#define REP(k) for (int _rep = 0; _rep < ((PROBE_DUP == (k)) ? 2 : 1); ++_rep)
    if (IN(0)) REP(0) { p0_convert(F); }
    SEAM(0);
    if (IN(1)) REP(1) {
        pg8::Gemm g{F.Xb, F.Win_t, D * 2}; pg8::EpiP1 E{F.P1}; constexpr int NU1 = (T / 256) * (INC / 256);
        int nun = 0; for (int i = 0; i * F.G + F.vcu < NU1; ++i) ++nun;
        constexpr int SH = MOE_ITEMS / 3;
        int pos = 0, count = SH / (F.G * 8) + 1, first = (F.vcu * 8 + F.wave) * count, lim = SH;
        if (F.G == 256) { if (nun == 3) { pos = F.vcu & 3; count = 1; first = F.vcu * 8 + F.wave; } else { pos = F.vcu % 3; count = 7; first = 1024 + ((F.vcu - 128) * 8 + F.wave) * 7; } }
        if (first + count > lim) count = lim - first;
        { pg8::DenseOrder S{INC / 256, NU1, F.G, F.vcu, 0, pos}; pg8::gemm_phase<pg8::EpiP1, pg8::DenseOrder, false, false>(F.lds, rowtab, g, S, E); }
        moe_convert_items(F, first, count);
        __syncthreads();
        { pg8::DenseOrder S{INC / 256, NU1, F.G, F.vcu, pos, 1 << 20}; pg8::gemm_phase<pg8::EpiP1, pg8::DenseOrder, false, false>(F.lds, rowtab, g, S, E); } }
    SEAM(1);
    if (IN(2)) REP(2) { p2_mixers(F); }
    SEAM(2);
    if (IN(3)) REP(3) { p3_merge(F); }
    SEAM(3);
    if (IN(4)) REP(4) { pg8::Gemm g{F.Amix, F.Wout_t, D * 2}; pg8::DenseOrder S{D / 256, (T / 256) * (D / 256), F.G, F.vcu, 0, 1 << 20}; pg8::EpiZ E{F.x, F.Zb};
        pg8::gemm_phase<pg8::EpiZ, pg8::DenseOrder, false, false>(F.lds, rowtab, g, S, E); }
    SEAM(4);
    if (IN(5)) { p4_route(F); }
    SEAM(5);
    if (IN(6)) REP(6) { const int ntiles = moe_tables<true>(F, 8); pg8::Gemm g{F.Hb, F.Wgu_t, D}; pg8::EpiSwiglu E{F.Act, F.b_gate, F.b_up};
        constexpr int SH = MOE_ITEMS / 3; const int cnt = SH / (F.G * 8) + ((SH % (F.G * 8)) ? 1 : 0); int first = 2 * SH + (F.vcu * 8 + F.wave) * cnt, count = cnt;
        if (first + count > 3 * SH) count = 3 * SH - first;
        const int pos = 2 * (F.vcu & 3);
        { pg8::MoeOrder S{8, ntiles * 8, F.G, F.vcu, (const LAS int*)(F.lds + TAB_OFF) + 32, 0, pos}; pg8::gemm_phase<pg8::EpiSwiglu, pg8::MoeOrder, true, true>(F.lds, rowtab, g, S, E); }
        moe_convert_items(F, first, count);
        __syncthreads();
        { pg8::MoeOrder S{8, ntiles * 8, F.G, F.vcu, (const LAS int*)(F.lds + TAB_OFF) + 32, pos, 1 << 20}; pg8::gemm_phase<pg8::EpiSwiglu, pg8::MoeOrder, true, true>(F.lds, rowtab, g, S, E); } }
    SEAM(6);
    if (IN(7)) REP(7) { const int ntiles = moe_tables<false>(F, 4); pg8::Gemm g{F.Act, F.Wd_t, FF * (int)sizeof(act_t)}; pg8::MoeOrder S{4, ntiles * 4, F.G, F.vcu, (const LAS int*)(F.lds + TAB_OFF) + 32, 0, 1 << 20};
        pg8::EpiY E{F.Y, F.b_down};
        pg8::gemm_phase<pg8::EpiY, pg8::MoeOrder, false, (G2_FP8 != 0)>(F.lds, rowtab, g, S, E); }
    SEAM(7);
    if (IN(8)) { p7_final(F); }
#undef IN
#undef SEAM
}

extern "C" void kernel_launch(void* const* d_in, const int* in_sizes, int n_in, void* d_out, int out_size, void* d_ws, size_t ws_size, hipStream_t stream) {
    static int grid = 0;
    if (grid == 0) {
        if (n_in != 20 || in_sizes[0] != T * D || out_size != T * D || ws_size < WS_END) { fprintf(stderr, "kernel_launch: unexpected shapes (n_in %d, in0 %d, out %d, ws %zu)\n", n_in, n_in > 0 ? in_sizes[0] : -1, out_size, ws_size); grid = -1; return; }
        int dev = 0, cus = 0, per_cu = 0;
        hipGetDevice(&dev); hipDeviceGetAttribute(&cus, hipDeviceAttributeMultiprocessorCount, dev);
        if (hipFuncSetAttribute((const void*)mk_fwd, hipFuncAttributeMaxDynamicSharedMemorySize, LDS_BYTES) != hipSuccess) { fprintf(stderr, "kernel_launch: hipFuncSetAttribute failed\n"); grid = -1; return; }
        hipOccupancyMaxActiveBlocksPerMultiprocessor(&per_cu, (const void*)mk_fwd, 512, LDS_BYTES);
        (void)hipGetLastError();
        if (per_cu < 1) { fprintf(stderr, "kernel_launch: occupancy query says %d blocks/CU: the grid would not be resident; nothing launched\n", per_cu); grid = -1; return; }
        grid = cus;
        if (grid != 256) fprintf(stderr, "kernel_launch: note: %d CUs (tuned for 256)\n", grid);
    }
    if (grid < 0) return;
    hipMemsetAsync((char*)d_ws + WS_CTL, 0, CTL_ZERO_BYTES, stream);
    Args a{};
    for (int i = 0; i < 20; ++i) a.in[i] = (const float*)d_in[i];
    a.out = (float*)d_out; a.ws = (unsigned char*)d_ws;
#if MK_N_LAUNCHES == 1
    a.ph_lo = 0; a.ph_hi = N_PHASES + 1;
    hipLaunchKernelGGL(mk_fwd, dim3(grid), dim3(512), LDS_BYTES, stream, a);
#else
    for (int p = 0; p <= N_PHASES; ++p) { a.ph_lo = p; a.ph_hi = p + 1; hipLaunchKernelGGL(mk_fwd, dim3(grid), dim3(512), LDS_BYTES, stream, a); }
#endif
}
```

```cpp
#include <hip/hip_runtime.h>
#include <hip/hip_cooperative_groups.h>
#include <cstdio>
#include <cstdint>
namespace cg = cooperative_groups;

#ifndef MK_N_LAUNCHES
#define MK_N_LAUNCHES 1
#endif

constexpr int BATCH = 4, SEQ = 4096, T = BATCH * SEQ, D = 1024, INC = 2560, NE = 32, FF = 1024, TOPK = 4;
constexpr int AW = 512, NGRP = 8, GD = 64, CHUNK = 128, NH = 8, HD = 64;
constexpr float LN_EPS = 1e-5f, DN_ALPHA = 1.189207115002721f;
constexpr int NSLOT = T * TOPK;
constexpr int MAXTILES = 288;
constexpr int MAXU = 12;

constexpr size_t MiB = 1u << 20;
constexpr size_t WS_CTL = 0, CTL_ZERO_BYTES = 64 * 1024;
constexpr size_t WS_LIST = 1 * MiB;
constexpr size_t WS_GATES = 3 * MiB;
constexpr size_t WS_EINFO = 3 * MiB + 256 * 1024;
constexpr size_t WS_WRT = 3 * MiB + 512 * 1024;
constexpr size_t WS_WIN = 4 * MiB;
constexpr size_t WS_WOUT = 9 * MiB;
constexpr size_t WS_WD = 11 * MiB;
constexpr size_t WS_WGU = 75 * MiB;
constexpr size_t WS_HB = 139 * MiB;
constexpr size_t WS_BIG = 155 * MiB;
constexpr size_t WS_XB = WS_BIG;
constexpr size_t WS_P1 = WS_BIG + 32 * MiB;
constexpr size_t WS_AMIX = WS_BIG + 112 * MiB;
constexpr size_t WS_ACT = WS_BIG;
constexpr size_t WS_Y = 299 * MiB;
constexpr size_t WS_OPART = 427 * MiB;
constexpr size_t WS_ML = 475 * MiB;
constexpr size_t WS_END = 478 * MiB;
#ifndef G2_FP8
#define G2_FP8 1
#endif
constexpr float WGU_SCALE = 32.0f, WD_SCALE = G2_FP8 ? 64.0f : 1.0f, Y_SCALE = 8.0f;
#if G2_FP8
typedef unsigned char act_t;
#else
typedef unsigned short act_t;
#endif
constexpr int CW_BAR = 1024;
constexpr int CW_CNT = 0;

constexpr int RING_BYTES = 131072;
constexpr int TAB_OFF = RING_BYTES + 1024;
constexpr int ROWTAB_OFF = RING_BYTES + 2048;
constexpr int MISC_OFF = 147456 - 64;
constexpr int LDS_BYTES = 147456;
static_assert(ROWTAB_OFF + MAXU * 1024 <= LDS_BYTES, "LDS map");

#define LAS __attribute__((address_space(3)))
typedef unsigned short bf16_t;
typedef unsigned char fp8_t;
typedef short bf16x8 __attribute__((ext_vector_type(8)));
typedef float f32x4 __attribute__((ext_vector_type(4)));
typedef float f32x2 __attribute__((ext_vector_type(2)));
typedef unsigned u32x4 __attribute__((ext_vector_type(4)));
typedef unsigned u32x2 __attribute__((ext_vector_type(2)));
typedef int v8i32 __attribute__((ext_vector_type(8)));
typedef int v4i32 __attribute__((ext_vector_type(4)));


__device__ __forceinline__ unsigned cvt_pk_bf16(float lo, float hi) { unsigned r; asm volatile("v_cvt_pk_bf16_f32 %0, %1, %2" : "=v"(r) : "v"(lo), "v"(hi)); return r; }
__device__ __forceinline__ unsigned cvt4_fp8(float a, float b, float c, float d) { int w = 0; w = __builtin_amdgcn_cvt_pk_fp8_f32(a, b, w, false); w = __builtin_amdgcn_cvt_pk_fp8_f32(c, d, w, true); return (unsigned)w; }
__device__ __forceinline__ float bf_lo(unsigned w) { return __uint_as_float(w << 16); }
__device__ __forceinline__ float bf_hi(unsigned w) { return __uint_as_float(w & 0xffff0000u); }
__device__ __forceinline__ float bf1(bf16_t b) { return __uint_as_float((unsigned)b << 16); }
__device__ __forceinline__ float wave_sum(float v) {
#pragma unroll
    for (int o = 1; o < 64; o <<= 1) v += __shfl_xor(v, o);
    return v;
}
__device__ __forceinline__ float gelu_tanh(float x) {
    const float y2 = x * (1.5957691216057308f + 0.07135481627260025f * x * x);
    return x * __builtin_amdgcn_rcpf(1.0f + __builtin_amdgcn_exp2f(-1.4426950408889634f * y2));
}

namespace pg8 {
constexpr int BM = 256, BK = 64, HALF = 128, HTB = HALF * BK * 2, STAGE_BYTES = 8 * HTB;
__host__ __device__ __forceinline__ int lds_byte(int r, int c) { const int st = (r >> 4) * 2 + (c >> 5), rr = r & 15, cc = c & 31, ob = rr * 64 + cc * 2; return st * 1024 + (ob ^ (((ob >> 9) & 1) << 5)); }
__host__ __device__ __forceinline__ void stage_rc(int b, int& R, int& C) { const int st = b / 1024, sb = b % 1024, swz = sb ^ (((sb >> 9) & 1) << 5); R = (st >> 1) * 16 + swz / 64; C = (st & 1) * 32 + (swz % 64) / 2; }
__host__ __device__ __forceinline__ int perm32(int rho) { const int n = rho >> 4, i = rho & 15; return 8 * (i >> 2) + 4 * n + (i & 3); }

struct Unit { int pm, pn, pb, e, mt, ui; };
struct Gemm { const void* A; const void* Bt; int KB; };

struct DenseOrder {
    int nN, nU, G, v, i0, i1;
    __device__ __forceinline__ bool next(int i, Unit& u) const {
        i += i0; if (i >= i1) return false;
        const int L = i * G + v; if (L >= nU) return false;
        u.pm = L / nN; u.pn = L % nN; u.pb = u.pn; u.e = 0; u.mt = 0; u.ui = i; return true; }
};
struct MoeOrder {
    int NPN, nU, G, v; const LAS int* tstart; int i0, i1;
    __device__ __forceinline__ bool next(int i, Unit& u) const {
        i += i0; if (i >= i1) return false;
        const int L = i * G + v; if (L >= nU) return false;
        const int tl = L / NPN, pn = L % NPN; int e = 0;
#pragma unroll
        for (int j = 1; j < NE; ++j) e += (tstart[j] <= tl) ? 1 : 0;
        e = __builtin_amdgcn_readfirstlane(e); const int ts = __builtin_amdgcn_readfirstlane(tstart[e]);
        u.pm = tl; u.pn = pn; u.pb = e * NPN + pn; u.e = e; u.mt = tl - ts; u.ui = i; return true; }
};

template <class Epi, class Sched, bool GATHER, bool FP8, class Hook>
__device__ __forceinline__ void gemm_phase(LAS unsigned char* lds, const LAS int* rowtab, const Gemm g, const Sched& S, const Epi& E, const Hook& H) {
    const int tid = threadIdx.x, wid = __builtin_amdgcn_readfirstlane(tid >> 6), lane = tid & 63, wr = wid >> 2, wc = wid & 3, fr = lane & 15, fq = lane >> 4;
    const int KB = g.KB, nt = KB / (BK * 2);
    unsigned voffA0[2], voffA1[2], voffB[2]; int Rr[2], Cc[2];
#pragma unroll
    for (int i = 0; i < 2; ++i) { int R, C; stage_rc(tid * 16 + i * 8192, R, C); const int Rb = Epi::PERM ? ((R & ~31) + perm32(R & 31)) : R; Rr[i] = R; Cc[i] = C;
        voffA0[i] = (unsigned)(R * KB + C * 2); voffA1[i] = (unsigned)((R + HALF) * KB + C * 2); voffB[i] = (unsigned)(Rb * KB + C * 2); }
    const unsigned kstep = (unsigned)(BK * 2);
    const unsigned hstep = (unsigned)HALF * (unsigned)KB;
    const unsigned tstep = 2u * hstep;
    const __amdgpu_buffer_rsrc_t rsA = __builtin_amdgcn_make_buffer_rsrc(const_cast<void*>(g.A), 0, -1, 0x00020000);
    const __amdgpu_buffer_rsrc_t rsB = __builtin_amdgcn_make_buffer_rsrc(const_cast<void*>(g.Bt), 0, -1, 0x00020000);
    const unsigned ldsw = (unsigned)wid * 1024u;
    const int aoff = lds_byte(wr * 64 + fr, fq * 8), boff = lds_byte(wc * 32 + fr, fq * 8);
#define PG8_SA(b, h) (((b) * 2 + (h)) * HTB)
#define PG8_SB(b, h) ((4 + (b) * 2 + (h)) * HTB)
#define PG8_STAGE(bufoff, rs, soff, voff) do { _Pragma("unroll") for (int _i = 0; _i < 2; ++_i) \
        __builtin_amdgcn_raw_ptr_buffer_load_lds(rs, (LAS void*)(lds + (bufoff) + ldsw + _i * 8192), 16, (int)(voff)[_i], (int)(soff), 0, 0); } while (0)
#define PG8_LDA(dst, b, h) do { if constexpr (FP8) { _Pragma("unroll") for (int m = 0; m < 4; ++m) dst##8[m] = __builtin_shufflevector(*(const LAS v4i32*)(lds + PG8_SA(b, h) + aoff + m * 2048), *(const LAS v4i32*)(lds + PG8_SA(b, h) + aoff + m * 2048 + 1024), 0, 1, 2, 3, 4, 5, 6, 7); } \
        else { _Pragma("unroll") for (int m = 0; m < 4; ++m) _Pragma("unroll") for (int k = 0; k < 2; ++k) dst[m][k] = *(const LAS bf16x8*)(lds + PG8_SA(b, h) + aoff + m * 2048 + k * 1024); } } while (0)
#define PG8_LDB(dst, b, h) do { if constexpr (FP8) { _Pragma("unroll") for (int n = 0; n < 2; ++n) dst##8[n] = __builtin_shufflevector(*(const LAS v4i32*)(lds + PG8_SB(b, h) + boff + n * 2048), *(const LAS v4i32*)(lds + PG8_SB(b, h) + boff + n * 2048 + 1024), 0, 1, 2, 3, 4, 5, 6, 7); } \
        else { _Pragma("unroll") for (int n = 0; n < 2; ++n) _Pragma("unroll") for (int k = 0; k < 2; ++k) dst[n][k] = *(const LAS bf16x8*)(lds + PG8_SB(b, h) + boff + n * 2048 + k * 1024); } } while (0)
#define PG8_MMA(ai, bj, At, Bt) do { __builtin_amdgcn_s_setprio(1); if constexpr (FP8) { _Pragma("unroll") for (int m = 0; m < 4; ++m) _Pragma("unroll") for (int n = 0; n < 2; ++n) \
        acc[ai][bj][m][n] = __builtin_amdgcn_mfma_scale_f32_16x16x128_f8f6f4(Bt##8[n], At##8[m], acc[ai][bj][m][n], 0, 0, 0, 0x7F7F7F7F, 0, 0x7F7F7F7F); } \
        else { _Pragma("unroll") for (int m = 0; m < 4; ++m) _Pragma("unroll") for (int n = 0; n < 2; ++n) _Pragma("unroll") for (int k = 0; k < 2; ++k) \
        acc[ai][bj][m][n] = __builtin_amdgcn_mfma_f32_16x16x32_bf16(Bt[n][k], At[m][k], acc[ai][bj][m][n], 0, 0, 0); } __builtin_amdgcn_s_setprio(0); } while (0)
#define PG8_WAIT_V(n) asm volatile("s_waitcnt vmcnt(" #n ")" ::: "memory")
#define PG8_WAIT_L(n) asm volatile("s_waitcnt lgkmcnt(" #n ")" ::: "memory")
#define PG8_BAR __builtin_amdgcn_s_barrier()
#define PG8_SCHED __builtin_amdgcn_sched_barrier(0)
#define PG8_LOADROWS(U) do { if constexpr (GATHER) { _Pragma("unroll") for (int _i = 0; _i < 2; ++_i) { \
        voffA0[_i] = (unsigned)rowtab[(U).ui * 256 + Rr[_i]] + (unsigned)Cc[_i] * 2u; voffA1[_i] = (unsigned)rowtab[(U).ui * 256 + HALF + Rr[_i]] + (unsigned)Cc[_i] * 2u; } } } while (0)
    Unit cur, nxt; int ui = 0;
    if (!S.next(0, cur)) return;
    f32x4 acc[2][2][4][2];
#pragma unroll
    for (int a = 0; a < 2; ++a)
#pragma unroll
        for (int b = 0; b < 2; ++b)
#pragma unroll
            for (int m = 0; m < 4; ++m)
#pragma unroll
                for (int n = 0; n < 2; ++n) acc[a][b][m][n] = (f32x4){0.f, 0.f, 0.f, 0.f};
    bf16x8 At[4][2], B0[2][2], B1[2][2]; v8i32 At8[4], B08[2], B18[2];
    unsigned cA = GATHER ? 0u : (unsigned)cur.pm * tstep, cB = (unsigned)cur.pb * tstep;
    PG8_LOADROWS(cur); PG8_WAIT_L(0);
    PG8_STAGE(PG8_SB(0, 0), rsB, cB, voffB); PG8_STAGE(PG8_SB(0, 1), rsB, cB + hstep, voffB); PG8_STAGE(PG8_SA(0, 0), rsA, cA, voffA0); PG8_STAGE(PG8_SA(0, 1), rsA, cA, voffA1);
    if (wr == 1) PG8_BAR;
    PG8_WAIT_V(2); PG8_BAR;
    PG8_STAGE(PG8_SB(1, 0), rsB, cB + kstep, voffB); PG8_STAGE(PG8_SA(1, 0), rsA, cA + kstep, voffA0); PG8_STAGE(PG8_SB(1, 1), rsB, cB + hstep + kstep, voffB);
    PG8_WAIT_V(6); PG8_BAR;
    for (;;) {
        const bool has_next = S.next(ui + 1, nxt);
        const unsigned nA = has_next ? (GATHER ? 0u : (unsigned)nxt.pm * tstep) : cA, nB = has_next ? (unsigned)nxt.pb * tstep : cB;
#pragma unroll 1
        for (int t = 0; t < nt; t += 2) {
            const bool last = (t == nt - 2);
            const unsigned a1 = cA + (unsigned)(t + 1) * kstep;
            const unsigned a2 = last ? nA : cA + (unsigned)(t + 2) * kstep, b2 = last ? nB : cB + (unsigned)(t + 2) * kstep;
            const unsigned a3 = a2 + kstep, b3 = b2 + kstep;
            PG8_LDB(B0, 0, 0); PG8_LDB(B1, 0, 1); PG8_SCHED; PG8_LDA(At, 0, 0); PG8_STAGE(PG8_SA(1, 1), rsA, a1, voffA1);
            if (last && has_next) PG8_LOADROWS(nxt);
            PG8_WAIT_V(8); PG8_WAIT_L(0); PG8_BAR; PG8_MMA(0, 0, At, B0); PG8_MMA(0, 1, At, B1); PG8_BAR; PG8_SCHED;
            PG8_LDA(At, 0, 1); PG8_STAGE(PG8_SB(0, 0), rsB, b2, voffB); PG8_STAGE(PG8_SB(0, 1), rsB, b2 + hstep, voffB); PG8_STAGE(PG8_SA(0, 0), rsA, a2, voffA0);
            PG8_WAIT_V(8); PG8_WAIT_L(0); PG8_BAR; PG8_MMA(1, 0, At, B0); PG8_MMA(1, 1, At, B1); PG8_BAR; PG8_SCHED;
            PG8_LDB(B0, 1, 0); PG8_LDB(B1, 1, 1); PG8_SCHED; PG8_LDA(At, 1, 0); PG8_STAGE(PG8_SA(0, 1), rsA, a2, voffA1);
            PG8_WAIT_V(8); PG8_WAIT_L(0); PG8_BAR; PG8_MMA(0, 0, At, B0); PG8_MMA(0, 1, At, B1); PG8_BAR; PG8_SCHED;
            PG8_LDA(At, 1, 1); PG8_STAGE(PG8_SB(1, 0), rsB, b3, voffB); PG8_STAGE(PG8_SB(1, 1), rsB, b3 + hstep, voffB); PG8_STAGE(PG8_SA(1, 0), rsA, a3, voffA0);
            PG8_WAIT_V(8); PG8_WAIT_L(0); PG8_BAR; PG8_MMA(1, 0, At, B0); PG8_MMA(1, 1, At, B1); PG8_BAR; PG8_SCHED;
        }
        if (wr == 0) PG8_BAR;
        { int t2 = threadIdx.x; asm volatile("" : "+v"(t2));
          const int w2 = __builtin_amdgcn_readfirstlane(t2 >> 6), l2 = t2 & 63; E(acc, cur, w2 >> 2, w2 & 3, l2 & 15, l2 >> 4); }
        if (H.after == ui) { H(); PG8_WAIT_V(0); }
        if (!has_next) break;
#pragma unroll
        for (int a = 0; a < 2; ++a)
#pragma unroll
            for (int b = 0; b < 2; ++b)
#pragma unroll
                for (int m = 0; m < 4; ++m)
#pragma unroll
                    for (int n = 0; n < 2; ++n) acc[a][b][m][n] = (f32x4){0.f, 0.f, 0.f, 0.f};
        cur = nxt; cA = nA; cB = nB; ++ui;
        if (wr == 1) PG8_BAR;
    }
    PG8_WAIT_V(0);
    PG8_BAR;
#undef PG8_SA
#undef PG8_SB
#undef PG8_STAGE
#undef PG8_LDA
#undef PG8_LDB
#undef PG8_MMA
#undef PG8_WAIT_V
#undef PG8_WAIT_L
#undef PG8_BAR
#undef PG8_SCHED
#undef PG8_LOADROWS
}

struct EpiP1 {
    static constexpr bool PERM = true;
    bf16_t* O;
    __device__ __forceinline__ void operator()(const f32x4 (&acc)[2][2][4][2], const Unit& u, int wr, int wc, int fr, int fq) const {
        const int row0 = u.pm * BM + wr * 64 + fr, col0 = u.pn * BM + wc * 32 + 8 * fq; const bool act = u.pn < 4;
#pragma unroll
        for (int ai = 0; ai < 2; ++ai)
#pragma unroll
            for (int m = 0; m < 4; ++m) { bf16_t* rowp = O + (size_t)(row0 + ai * HALF + m * 16) * INC + col0;
#pragma unroll
                for (int bj = 0; bj < 2; ++bj) { f32x4 v0 = acc[ai][bj][m][0], v1 = acc[ai][bj][m][1];
                    if (act) {
#pragma unroll
                        for (int j = 0; j < 4; ++j) { v0[j] = gelu_tanh(v0[j]); v1[j] = gelu_tanh(v1[j]); } }
                    u32x4 w; w.x = cvt_pk_bf16(v0[0], v0[1]); w.y = cvt_pk_bf16(v0[2], v0[3]); w.z = cvt_pk_bf16(v1[0], v1[1]); w.w = cvt_pk_bf16(v1[2], v1[3]);
                    *(u32x4*)(rowp + bj * HALF) = w; } }
    }
};
struct EpiZ {
    static constexpr bool PERM = true;
    const float* X; bf16_t* Z;
    __device__ __forceinline__ void operator()(const f32x4 (&acc)[2][2][4][2], const Unit& u, int wr, int wc, int fr, int fq) const {
        const int col0 = u.pn * BM + wc * 32 + 8 * fq;
#pragma unroll
        for (int ai = 0; ai < 2; ++ai)
#pragma unroll
            for (int m = 0; m < 4; ++m) { const size_t off = (size_t)(u.pm * BM + ai * HALF + wr * 64 + m * 16 + fr) * D + col0;
#pragma unroll
                for (int bj = 0; bj < 2; ++bj) { const f32x4 x0 = __builtin_nontemporal_load((const f32x4*)(X + off + bj * HALF)), x1 = __builtin_nontemporal_load((const f32x4*)(X + off + bj * HALF + 4));
                    const f32x4 v0 = x0 * DN_ALPHA + acc[ai][bj][m][0], v1 = x1 * DN_ALPHA + acc[ai][bj][m][1];
                    u32x4 w; w.x = cvt_pk_bf16(v0[0], v0[1]); w.y = cvt_pk_bf16(v0[2], v0[3]); w.z = cvt_pk_bf16(v1[0], v1[1]); w.w = cvt_pk_bf16(v1[2], v1[3]);
                    *(u32x4*)(Z + off + bj * HALF) = w; } }
    }
};
struct EpiSwiglu {
    static constexpr bool PERM = true;
    act_t* Act; const float* bg; const float* bu;
    __device__ __forceinline__ void operator()(const f32x4 (&acc)[2][2][4][2], const Unit& u, int wr, int wc, int fr, int fq) const {
        const int f0 = u.pn * HALF + wc * 32 + 8 * fq; const int row0 = u.pm * BM + wr * 64 + fr;
        const f32x4 bg0 = *(const f32x4*)(bg + u.e * FF + f0), bg1 = *(const f32x4*)(bg + u.e * FF + f0 + 4);
        const f32x4 bu0 = *(const f32x4*)(bu + u.e * FF + f0), bu1 = *(const f32x4*)(bu + u.e * FF + f0 + 4);
#pragma unroll
        for (int ai = 0; ai < 2; ++ai)
#pragma unroll
            for (int m = 0; m < 4; ++m) {
                f32x4 g0 = acc[ai][0][m][0] * (1.0f / WGU_SCALE) + bg0, g1 = acc[ai][0][m][1] * (1.0f / WGU_SCALE) + bg1, u0 = acc[ai][1][m][0] * (1.0f / WGU_SCALE) + bu0, u1 = acc[ai][1][m][1] * (1.0f / WGU_SCALE) + bu1, r0, r1;
#pragma unroll
                for (int j = 0; j < 4; ++j) {
                    const float ga = fminf(g0[j], 7.0f), gb = fminf(g1[j], 7.0f);
                    const float ua = fminf(fmaxf(u0[j], -7.0f), 7.0f), ub = fminf(fmaxf(u1[j], -7.0f), 7.0f);
                    r0[j] = (ua + 1.0f) * ga * __builtin_amdgcn_rcpf(1.0f + __builtin_amdgcn_exp2f(-1.702f * 1.4426950408889634f * ga));
                    r1[j] = (ub + 1.0f) * gb * __builtin_amdgcn_rcpf(1.0f + __builtin_amdgcn_exp2f(-1.702f * 1.4426950408889634f * gb)); }
                if constexpr (G2_FP8) { u32x2 w; w.x = cvt4_fp8(r0[0], r0[1], r0[2], r0[3]); w.y = cvt4_fp8(r1[0], r1[1], r1[2], r1[3]); *(u32x2*)(Act + (size_t)(row0 + ai * HALF + m * 16) * FF + f0) = w; }
                else { u32x4 w; w.x = cvt_pk_bf16(r0[0], r0[1]); w.y = cvt_pk_bf16(r0[2], r0[3]); w.z = cvt_pk_bf16(r1[0], r1[1]); w.w = cvt_pk_bf16(r1[2], r1[3]); *(u32x4*)(Act + (size_t)(row0 + ai * HALF + m * 16) * FF + f0) = w; } }
    }
};
struct EpiY {
    static constexpr bool PERM = true;
    fp8_t* Y; const float* bd;
    __device__ __forceinline__ void operator()(const f32x4 (&acc)[2][2][4][2], const Unit& u, int wr, int wc, int fr, int fq) const {
        const int c0 = u.pn * BM + wc * 32 + 8 * fq; const int row0 = u.pm * BM + wr * 64 + fr;
        f32x4 b[2][2];
#pragma unroll
        for (int bj = 0; bj < 2; ++bj) { b[bj][0] = *(const f32x4*)(bd + u.e * D + c0 + bj * HALF); b[bj][1] = *(const f32x4*)(bd + u.e * D + c0 + bj * HALF + 4); }
#pragma unroll
        for (int ai = 0; ai < 2; ++ai)
#pragma unroll
            for (int m = 0; m < 4; ++m) { fp8_t* rowp = Y + (size_t)(row0 + ai * HALF + m * 16) * D + c0;
#pragma unroll
                for (int bj = 0; bj < 2; ++bj) { const f32x4 v0 = (acc[ai][bj][m][0] * (1.0f / WD_SCALE) + b[bj][0]) * Y_SCALE, v1 = (acc[ai][bj][m][1] * (1.0f / WD_SCALE) + b[bj][1]) * Y_SCALE;
                    u32x2 w; w.x = cvt4_fp8(v0[0], v0[1], v0[2], v0[3]); w.y = cvt4_fp8(v1[0], v1[1], v1[2], v1[3]);
                    *(u32x2*)(rowp + bj * HALF) = w; } }
    }
};
}


#define XB_TMO      128
#define XB_XCNT(j)  (256  + 64 * (j))
#define XB_XSUB(j)  (1280 + 64 * (j))
#define XB_XGEN(j)  (2304 + 64 * (j))
#define XB_TOP      3328
#define XB_TOPGEN   3392
#define XCD_BAR_WORDS 3456
#define XB_SPIN_CAP (1u << 22)
__device__ __forceinline__ unsigned xb_ld(unsigned* p)              { return __hip_atomic_load(p, __ATOMIC_RELAXED, __HIP_MEMORY_SCOPE_AGENT); }
__device__ __forceinline__ unsigned xb_add(unsigned* p, unsigned v) { return __hip_atomic_fetch_add(p, v, __ATOMIC_RELAXED, __HIP_MEMORY_SCOPE_AGENT); }
__device__ __forceinline__ unsigned xb_xcc_id() { return (unsigned)__builtin_amdgcn_s_getreg((3 << 11) | 20) & 0xFu; }
#define XB_SPIN(cond, bar) do { unsigned _sp = 0; while (cond) { __builtin_amdgcn_s_sleep(1); \
    if ((++_sp & 255u) == 0u) { if (xb_ld(&(bar)[XB_TMO])) break; if (_sp > XB_SPIN_CAP) { atomicAdd(&(bar)[XB_TMO], 1u); break; } } } } while (0)
struct XcdBarrier { unsigned* bar; unsigned x; volatile LAS unsigned* st; };
__device__ __forceinline__ XcdBarrier xcd_barrier_post(unsigned* bar, volatile LAS unsigned* st) {
    XcdBarrier b; b.bar = bar; b.x = xb_xcc_id(); b.st = st;
    if (threadIdx.x == 0) (void)xb_add(&bar[XB_XCNT(b.x)], 1u);
    return b;
}
__device__ __forceinline__ void xcd_barrier_complete(unsigned* bar, unsigned x, unsigned& nloc, unsigned& nx) {
    const unsigned G = gridDim.x * gridDim.y * gridDim.z;
    unsigned sum, cnt, mine, sp = 0u;
    for (;;) {
        sum = 0u; cnt = 0u; mine = 0u;
#pragma unroll
        for (unsigned j = 0; j < 16; ++j) { const unsigned c = xb_ld(&bar[XB_XCNT(j)]); sum += c; cnt += (c > 0u) ? 1u : 0u; mine = (j == x) ? c : mine; }
        if (sum == G) break;
        __builtin_amdgcn_s_sleep(1);
        if ((++sp & 255u) == 0u) { if (xb_ld(&bar[XB_TMO])) break; if (sp > XB_SPIN_CAP) { atomicAdd(&bar[XB_TMO], 1u); break; } }
    }
    nloc = mine > 0u ? mine : 1u; nx = cnt > 0u ? cnt : 1u;
}
__device__ __forceinline__ void xcd_barrier(const XcdBarrier& b) {
    asm volatile("s_waitcnt vmcnt(0)" ::: "memory");
    __syncthreads();
    if (threadIdx.x == 0) {
        unsigned* bar = b.bar;
        __builtin_amdgcn_s_waitcnt(0);
        unsigned nloc = b.st[0], nx = b.st[1];
        if (nloc == 0u) { xcd_barrier_complete(bar, b.x, nloc, nx); b.st[0] = nloc; b.st[1] = nx; }
        const unsigned old = xb_add(&bar[XB_XSUB(b.x)], 1u);
        const unsigned gen = old / nloc;
        if (old + 1u == (gen + 1u) * nloc) {
            __builtin_amdgcn_fence(__ATOMIC_RELEASE, "agent");
            asm volatile("s_waitcnt vmcnt(0)" ::: "memory");
            const unsigned og = xb_add(&bar[XB_TOP], 1u);
            const unsigned tg = og / nx;
            if (og + 1u == (tg + 1u) * nx) xb_add(&bar[XB_TOPGEN], 1u);
            else XB_SPIN(xb_ld(&bar[XB_TOPGEN]) == tg, bar);
            __builtin_amdgcn_fence(__ATOMIC_ACQUIRE, "agent");
            xb_add(&bar[XB_XGEN(b.x)], 1u);
            asm volatile("s_waitcnt vmcnt(0)" ::: "memory");
        } else {
            XB_SPIN(xb_ld(&bar[XB_XGEN(b.x)]) == gen, bar);
            __builtin_amdgcn_fence(__ATOMIC_ACQUIRE, "agent");
            asm volatile("s_waitcnt vmcnt(0)" ::: "memory");
        }
    }
    __syncthreads();
}

struct NoHook { static constexpr int after = -1000; __device__ __forceinline__ void operator()() const {} };
struct Args { const float* in[20]; float* out; unsigned char* ws; int ph_lo, ph_hi; };
struct Frame {
    LAS unsigned char* lds; int tid, lane, wave, G, vcu;
    const float *x, *w_in, *sgu_w, *sgu_b, *sgu_ln_g, *sgu_ln_b, *mix_g, *w_out, *ln1_g, *ln1_b, *w_router, *b_router, *w_gate, *b_gate, *w_up, *b_up, *w_down, *b_down, *ln2_g, *ln2_b;
    float* out; unsigned char* ws;
    unsigned* ctl; int* list; int* einfo; float* gates; bf16_t *Win_t, *Wout_t, *Xb, *P1, *Amix; fp8_t* Y; act_t *Wd_t, *Act; fp8_t *Wgu_t, *Hb; bf16_t* Opart; float* ML; bf16_t* WrtHi; bf16_t* Zb; bf16_t* Hh;
};

__device__ __forceinline__ void transpose_item(const float* W, int N, int K, int k0, int n0, bf16_t* WT, size_t dst_row0, LAS float* scr, int lane) {
    const int kr = lane >> 3, c4 = lane & 7; f32x4 v[8];
#pragma unroll
    for (int i = 0; i < 8; ++i) v[i] = __builtin_nontemporal_load((const f32x4*)(W + (size_t)(k0 + 8 * kr + i) * N + n0 + 4 * c4));
#pragma unroll
    for (int e = 0; e < 4; ++e) { u32x4 o; o.x = cvt_pk_bf16(v[0][e], v[1][e]); o.y = cvt_pk_bf16(v[2][e], v[3][e]); o.z = cvt_pk_bf16(v[4][e], v[5][e]); o.w = cvt_pk_bf16(v[6][e], v[7][e]);
        *(u32x4*)(WT + (dst_row0 + 4 * c4 + e) * K + k0 + 8 * kr) = o; }
}
__device__ __forceinline__ void transpose_item8(const float* W, int N, int K, int k0, int n0, fp8_t* WT, size_t dst_row0, float scale, LAS float* scr, int lane) {
    { const int kr = lane >> 3, c4 = lane & 7; f32x4 v[16];
#pragma unroll
      for (int i = 0; i < 16; ++i) v[i] = *(const f32x4*)(W + (size_t)(k0 + 8 * i + kr) * N + n0 + 4 * c4);
#pragma unroll
      for (int i = 0; i < 16; ++i) { LAS float* d = scr + (8 * i + kr) * 33 + 4 * c4; d[0] = v[i][0]; d[1] = v[i][1]; d[2] = v[i][2]; d[3] = v[i][3]; } }
    asm volatile("s_waitcnt lgkmcnt(0)" ::: "memory");
    const int c = lane & 7;
#pragma unroll
    for (int j = 0; j < 4; ++j) { const int n = (lane >> 3) + 8 * j; const LAS float* s = scr + (16 * c) * 33 + n;
        u32x4 o; o.x = cvt4_fp8(s[0 * 33] * scale, s[1 * 33] * scale, s[2 * 33] * scale, s[3 * 33] * scale); o.y = cvt4_fp8(s[4 * 33] * scale, s[5 * 33] * scale, s[6 * 33] * scale, s[7 * 33] * scale);
        o.z = cvt4_fp8(s[8 * 33] * scale, s[9 * 33] * scale, s[10 * 33] * scale, s[11 * 33] * scale); o.w = cvt4_fp8(s[12 * 33] * scale, s[13 * 33] * scale, s[14 * 33] * scale, s[15 * 33] * scale);
        *(u32x4*)(WT + (dst_row0 + n) * K + k0 + 16 * c) = o; }
    asm volatile("s_waitcnt lgkmcnt(0)" ::: "memory");
}
constexpr int MOE_ITEMS = NE * 3 * 8 * 32;
static_assert(G2_FP8, "the MoE item list below assumes fp8 copies of all three expert matrices");
struct MoeItem { const float* src; fp8_t* dst; float scale; };
__device__ __forceinline__ MoeItem moe_item(const Frame& F, int it) {
    const int nb = it & 31, kb = (it >> 5) & 7, e = (it >> 8) & 31, which = it >> 13, n0 = 32 * nb; MoeItem m;
    if (which < 2) { m.src = (which ? F.w_up : F.w_gate) + (size_t)e * D * FF + (size_t)(128 * kb) * FF + n0; m.dst = F.Wgu_t + ((size_t)e * 2048 + (n0 >> 7) * 256 + which * 128 + (n0 & 127)) * D + 128 * kb; m.scale = WGU_SCALE; }
    else { m.src = F.w_down + (size_t)e * FF * D + (size_t)(128 * kb) * D + n0; m.dst = (fp8_t*)F.Wd_t + ((size_t)e * 1024 + n0) * FF + 128 * kb; m.scale = WD_SCALE; }
    return m; }
__device__ __forceinline__ void moe_item_load(const MoeItem& m, f32x4 (&v)[16], int lane) {
    const int kr = lane >> 3, c4 = lane & 7;
#pragma unroll
    for (int i = 0; i < 16; ++i) v[i] = __builtin_nontemporal_load((const f32x4*)(m.src + (size_t)(16 * kr + i) * 1024 + 4 * c4)); }
__device__ __forceinline__ void moe_item_finish(const MoeItem& m, const f32x4 (&v)[16], LAS float* scr, int lane) {
    const int kr = lane >> 3, c4 = lane & 7; const float scale = m.scale;
#pragma unroll
    for (int e = 0; e < 4; ++e) { u32x4 o;
        o.x = cvt4_fp8(v[0][e] * scale, v[1][e] * scale, v[2][e] * scale, v[3][e] * scale); o.y = cvt4_fp8(v[4][e] * scale, v[5][e] * scale, v[6][e] * scale, v[7][e] * scale);
        o.z = cvt4_fp8(v[8][e] * scale, v[9][e] * scale, v[10][e] * scale, v[11][e] * scale); o.w = cvt4_fp8(v[12][e] * scale, v[13][e] * scale, v[14][e] * scale, v[15][e] * scale);
        *(u32x4*)(m.dst + (size_t)(4 * c4 + e) * 1024 + 16 * kr) = o; } }
__device__ __forceinline__ void moe_convert_items(Frame& F, int first, int count) {
    int end = first + count; if (end > MOE_ITEMS) end = MOE_ITEMS;
#pragma unroll 1
    for (int it = first; it < end; ++it) { f32x4 va[16]; const MoeItem ma = moe_item(F, it); moe_item_load(ma, va, F.lane); moe_item_finish(ma, va, nullptr, F.lane); }
}
struct ConvHook { Frame* F; int first, count, after; __device__ __forceinline__ void operator()() const { moe_convert_items(*F, first, count); } };
__device__ __forceinline__ void p0_convert(Frame& F) {
    LAS float* scr = (LAS float*)(F.lds + F.wave * 17408);
    const int gw = F.vcu * 8 + F.wave, NGW = F.G * 8;
    constexpr int I_IN = (D / 64) * (INC / 32), I_OUT = (D / 64) * (D / 32);
    for (int it = gw; it < I_IN + I_OUT; it += NGW) {
        int r = it;
        if (r < I_IN) { const int kb = r / (INC / 32), nb = r % (INC / 32); transpose_item(F.w_in, INC, D, 64 * kb, 32 * nb, F.Win_t, (size_t)32 * nb, scr, F.lane); continue; } r -= I_IN;
        { const int kb = r / (D / 32), nb = r % (D / 32); transpose_item(F.w_out, D, D, 64 * kb, 32 * nb, F.Wout_t, (size_t)32 * nb, scr, F.lane); }
    }
    for (int i2 = blockIdx.x * 512 + F.tid; i2 < D * NE; i2 += F.G * 512) { const int k = i2 >> 5, e = i2 & 31; const float wv = F.w_router[i2];
        const unsigned hi = cvt_pk_bf16(wv, 0.f) & 0xffffu; const unsigned lo = cvt_pk_bf16(wv - bf_lo(hi), 0.f) & 0xffffu;
        F.WrtHi[(size_t)e * D + k] = (bf16_t)hi; F.WrtHi[(size_t)(NE + e) * D + k] = (bf16_t)lo; }
    const size_t nchunk = (size_t)T * D / 8, cstride = (size_t)F.G * 512;
    for (size_t i = (size_t)blockIdx.x * 512 + F.tid; i < nchunk; i += 4 * cstride) {
        f32x4 a[4], b[4];
#pragma unroll
        for (int j = 0; j < 4; ++j) { const size_t ii = i + j * cstride; if (ii < nchunk) { a[j] = __builtin_nontemporal_load((const f32x4*)(F.x + ii * 8)); b[j] = __builtin_nontemporal_load((const f32x4*)(F.x + ii * 8 + 4)); } }
#pragma unroll
        for (int j = 0; j < 4; ++j) { const size_t ii = i + j * cstride; if (ii < nchunk) {
            u32x4 w; w.x = cvt_pk_bf16(a[j][0], a[j][1]); w.y = cvt_pk_bf16(a[j][2], a[j][3]); w.z = cvt_pk_bf16(b[j][0], b[j][1]); w.w = cvt_pk_bf16(b[j][2], b[j][3]);
            *(u32x4*)(F.Xb + ii * 8) = w; } } }
}

typedef float f32x16 __attribute__((ext_vector_type(16)));
typedef short s16x4 __attribute__((ext_vector_type(4)));
constexpr int SG_ROW = 272, SG_WAVE = 64 * SG_ROW, SG_SSQ_OFF = 8 * SG_WAVE, SG_PRM_OFF = SG_SSQ_OFF + 8 * 64 * 4;
static_assert(SG_PRM_OFF + 2 * AW * 4 <= MISC_OFF, "SGU LDS");
__device__ __forceinline__ void sgu_unit(Frame& F, int u, int half) {
    const int g = F.wave, lane = F.lane, i = lane & 31, hh = lane >> 5; const size_t row0 = (size_t)u * CHUNK;
    LAS unsigned char* vt = F.lds + g * SG_WAVE; LAS float* ssq = (LAS float*)(F.lds + SG_SSQ_OFF); const LAS f32x4* prm = (const LAS f32x4*)(F.lds + SG_PRM_OFF);
    { u32x4 raw[2][8];
#pragma unroll
      for (int tt = 0; tt < 2; ++tt) { if (tt <= half) { const bf16_t* vp = F.P1 + (row0 + lane + 64 * tt) * INC + AW + g * GD;
#pragma unroll
          for (int c8 = 0; c8 < 8; ++c8) raw[tt][c8] = *(const u32x4*)(vp + 8 * c8); } }
#pragma unroll
      for (int tt = 0; tt < 2; ++tt) { if (tt <= half) { const int t = lane + 64 * tt;
        float v[64];
#pragma unroll
        for (int c8 = 0; c8 < 8; ++c8) { const unsigned w[4] = {raw[tt][c8].x, raw[tt][c8].y, raw[tt][c8].z, raw[tt][c8].w};
#pragma unroll
            for (int j = 0; j < 4; ++j) { v[8 * c8 + 2 * j] = bf_lo(w[j]); v[8 * c8 + 2 * j + 1] = bf_hi(w[j]); } }
        float s = 0.f;
#pragma unroll
        for (int c = 0; c < 64; ++c) s += v[c];
        const float mu = s * (1.f / 64.f); float q = 0.f;
#pragma unroll
        for (int c = 0; c < 64; ++c) { v[c] -= mu; q += v[c] * v[c]; }
        const float rstd = 1.0f / sqrtf(q * (1.f / 64.f) + LN_EPS);
#pragma unroll
        for (int c4 = 0; c4 < 16; ++c4) { const f32x4 lg = prm[g * 16 + c4], lb = prm[128 + g * 16 + c4];
#pragma unroll
            for (int e = 0; e < 4; ++e) { const int c = 4 * c4 + e; const float val = v[c] * rstd * lg[e] + lb[e];
                *(LAS bf16_t*)(vt + c * SG_ROW + t * 2) = (bf16_t)(cvt_pk_bf16(val, 0.f) & 0xffffu); } } } } }
    asm volatile("s_waitcnt lgkmcnt(0)" ::: "memory");
    unsigned ssq_base = (unsigned)(uintptr_t)(ssq + i); asm volatile("" : "+v"(ssq_base));
    LAS float* ssq_r = (LAS float*)(uintptr_t)ssq_base; LAS float* ssq_w = ssq_r + g * 64;
    f32x16 acc[2][2];
    f32x4 wq[2][8][2]; u32x2 uqa[2][2][4]; float bsa[2];
#pragma unroll
    for (int n2 = 0; n2 < 2; ++n2) { const int nt = 2 * half + n2, t = 32 * nt + i, nks = 2 * nt + 2;
#pragma unroll
        for (int ks = 0; ks < 8; ++ks) { if (ks < nks) { const float* wp = F.sgu_w + ((size_t)g * CHUNK + t) * CHUNK + 16 * ks + 8 * hh; wq[n2][ks][0] = *(const f32x4*)wp; wq[n2][ks][1] = *(const f32x4*)(wp + 4); } }
        const bf16_t* up = F.P1 + (row0 + t) * INC + g * GD + 4 * hh;
#pragma unroll
        for (int mt = 0; mt < 2; ++mt)
#pragma unroll
            for (int g4 = 0; g4 < 4; ++g4) uqa[n2][mt][g4] = *(const u32x2*)(up + 32 * mt + 8 * g4);
        bsa[n2] = F.sgu_b[g * CHUNK + t]; }
#pragma unroll
    for (int n2 = 0; n2 < 2; ++n2) { const int nt = 2 * half + n2, t = 32 * nt + i, nks = 2 * nt + 2;
#pragma unroll
        for (int mt = 0; mt < 2; ++mt)
#pragma unroll
            for (int r = 0; r < 16; ++r) acc[mt][n2][r] = 0.f;
        const float bs = bsa[n2];
#pragma unroll
        for (int ks = 0; ks < 8; ++ks) { if (ks < nks) { const int s0 = 16 * ks + 8 * hh;
            float wv[8] = {wq[n2][ks][0][0], wq[n2][ks][0][1], wq[n2][ks][0][2], wq[n2][ks][0][3], wq[n2][ks][1][0], wq[n2][ks][1][1], wq[n2][ks][1][2], wq[n2][ks][1][3]};
#pragma unroll
            for (int j = 0; j < 8; ++j) wv[j] = (s0 + j <= t) ? wv[j] : 0.f;
            u32x4 bw; bw.x = cvt_pk_bf16(wv[0], wv[1]); bw.y = cvt_pk_bf16(wv[2], wv[3]); bw.z = cvt_pk_bf16(wv[4], wv[5]); bw.w = cvt_pk_bf16(wv[6], wv[7]);
            const bf16x8 bfrag = __builtin_bit_cast(bf16x8, bw);
#pragma unroll
            for (int mt = 0; mt < 2; ++mt) { const bf16x8 afrag = *(const LAS bf16x8*)(vt + (32 * mt + i) * SG_ROW + s0 * 2);
                acc[mt][n2] = __builtin_amdgcn_mfma_f32_32x32x16_bf16(afrag, bfrag, acc[mt][n2], 0, 0, 0); } } }
        float ss = 0.f;
#pragma unroll
        for (int mt = 0; mt < 2; ++mt)
#pragma unroll
            for (int g4 = 0; g4 < 4; ++g4) { const u32x2 uw = uqa[n2][mt][g4];
                const float u0 = bf_lo(uw.x), u1 = bf_hi(uw.x), u2 = bf_lo(uw.y), u3 = bf_hi(uw.y);
                float a0 = u0 * (acc[mt][n2][4 * g4] + bs), a1 = u1 * (acc[mt][n2][4 * g4 + 1] + bs), a2 = u2 * (acc[mt][n2][4 * g4 + 2] + bs), a3 = u3 * (acc[mt][n2][4 * g4 + 3] + bs);
                acc[mt][n2][4 * g4] = a0; acc[mt][n2][4 * g4 + 1] = a1; acc[mt][n2][4 * g4 + 2] = a2; acc[mt][n2][4 * g4 + 3] = a3;
                ss += (a0 * a0 + a1 * a1) + (a2 * a2 + a3 * a3); }
        ss += __shfl_xor(ss, 32);
        if (hh == 0) ssq_w[32 * n2] = ss; }
    __syncthreads();
#pragma unroll
    for (int n2 = 0; n2 < 2; ++n2) { const int t = 64 * half + 32 * n2 + i; float tot = 0.f;
#pragma unroll
        for (int gg = 0; gg < 8; ++gg) tot += ssq_r[gg * 64 + 32 * n2];
        const float rs = 1.0f / sqrtf(tot * (1.f / AW) + LN_EPS);
        bf16_t* op = F.Amix + (row0 + t) * D + g * GD + 4 * hh;
#pragma unroll
        for (int mt = 0; mt < 2; ++mt)
#pragma unroll
            for (int g4 = 0; g4 < 4; ++g4) { const f32x4 mg = *(const f32x4*)(F.mix_g + g * GD + 32 * mt + 8 * g4 + 4 * hh);
                u32x2 w; w.x = cvt_pk_bf16(acc[mt][n2][4 * g4] * rs * mg[0], acc[mt][n2][4 * g4 + 1] * rs * mg[1]); w.y = cvt_pk_bf16(acc[mt][n2][4 * g4 + 2] * rs * mg[2], acc[mt][n2][4 * g4 + 3] * rs * mg[3]);
                *(u32x2*)(op + 32 * mt + 8 * g4) = w; } }
    __syncthreads();
}

constexpr int AT_KROW = 144, AT_VROW = 144, AT_V_OFF = 384 * AT_KROW;
static_assert(AT_V_OFF + 384 * AT_VROW <= RING_BYTES, "attention LDS");
struct AttnDesc { int b, h, p, d, r, q0; };
__device__ __forceinline__ AttnDesc attn_decode(int u) {
    AttnDesc a; const int bh = u / 48, rem = u % 48, idx = rem & 15; a.p = rem >> 4; a.b = bh >> 3; a.h = bh & 7;
    a.d = (a.p == 0) ? 1 : (a.p == 1) ? 4 : 16; a.r = (a.p == 0) ? 0 : (a.p == 1) ? (idx >> 2) : idx; a.q0 = 256 * ((a.p == 0) ? idx : (a.p == 1) ? (idx & 3) : 0); return a; }
__device__ __forceinline__ void attn_stage_load(const Frame& F, const AttnDesc& a, u32x4 (&kq)[6], u32x4 (&vq)[6]) {
    const bf16_t* base = F.P1 + (size_t)a.b * SEQ * INC + a.h * HD;
#pragma unroll
    for (int it = 0; it < 6; ++it) { const int ch = F.tid + 512 * it, key = ch >> 3, c = ch & 7, s = a.q0 - 128 + key;
        kq[it] = (u32x4){0u, 0u, 0u, 0u}; vq[it] = (u32x4){0u, 0u, 0u, 0u};
        if (s >= 0) { const bf16_t* rp = base + (size_t)(s * a.d + a.r) * INC + c * 8; kq[it] = *(const u32x4*)(rp + 1536); vq[it] = *(const u32x4*)(rp + 2048); } }
}
__device__ __forceinline__ void attn_stage_write(const Frame& F, const u32x4 (&kq)[6], const u32x4 (&vq)[6]) {
#pragma unroll
    for (int it = 0; it < 6; ++it) { const int ch = F.tid + 512 * it, key = ch >> 3, c = ch & 7;
        *(LAS u32x4*)(F.lds + key * AT_KROW + c * 16) = kq[it]; *(LAS u32x4*)(F.lds + AT_V_OFF + key * AT_VROW + c * 16) = vq[it]; }
}
typedef short v4i16_t __attribute__((ext_vector_type(4)));
__device__ __forceinline__ void attn_compute(Frame& F, const AttnDesc& a, const bf16x8 (&qf)[4]) {
    const int lane = F.lane, i = lane & 31, hh = lane >> 5, w = F.wave, q0 = a.q0;
    LAS unsigned char* kl = F.lds; LAS unsigned char* vl = F.lds + AT_V_OFF;
    f32x16 s[5];
#pragma unroll
    for (int kt = 0; kt < 5; ++kt) { f32x16 a;
#pragma unroll
        for (int rr = 0; rr < 16; ++rr) a[rr] = 0.f;
#pragma unroll
        for (int ks = 0; ks < 4; ++ks) { const bf16x8 kf = *(const LAS bf16x8*)(kl + (32 * w + 32 * kt + i) * AT_KROW + (16 * ks + 8 * hh) * 2);
            a = __builtin_amdgcn_mfma_f32_32x32x16_bf16(kf, qf[ks], a, 0, 0, 0); }
        s[kt] = a; }
    const float sc = 0.125f * 1.4426950408889634f; const int ksub0 = q0 + 32 * w - 128;
    float m = -INFINITY;
#pragma unroll
    for (int kt = 0; kt < 5; ++kt)
#pragma unroll
        for (int rr = 0; rr < 16; ++rr) { const int kk = (rr & 3) + 8 * (rr >> 2) + 4 * hh; bool ok = (ksub0 + 32 * kt + kk) >= 0;
            if (kt == 0) ok = ok && (kk >= i);
            if (kt == 4) ok = ok && (kk <= i);
            const float v = ok ? s[kt][rr] * sc : -INFINITY; s[kt][rr] = v; m = fmaxf(m, v); }
    m = fmaxf(m, __shfl_xor(m, 32));
    float lsum = 0.f;
#pragma unroll
    for (int kt = 0; kt < 5; ++kt)
#pragma unroll
        for (int rr = 0; rr < 16; ++rr) { const float pv = __builtin_amdgcn_exp2f(s[kt][rr] - m); s[kt][rr] = pv; lsum += pv; }
    lsum += __shfl_xor(lsum, 32);
    f32x16 o[2];
#pragma unroll
    for (int dt = 0; dt < 2; ++dt)
#pragma unroll
        for (int rr = 0; rr < 16; ++rr) o[dt][rr] = 0.f;
    const LAS unsigned char* vtp = vl + (32 * w + 4 * hh + ((lane & 15) >> 2)) * AT_VROW + (16 * ((lane >> 4) & 1) + 4 * (lane & 3)) * 2;
#pragma unroll
    for (int kt = 0; kt < 5; ++kt)
#pragma unroll
        for (int s2 = 0; s2 < 2; ++s2) { u32x4 pw; pw.x = cvt_pk_bf16(s[kt][8 * s2], s[kt][8 * s2 + 1]); pw.y = cvt_pk_bf16(s[kt][8 * s2 + 2], s[kt][8 * s2 + 3]);
            pw.z = cvt_pk_bf16(s[kt][8 * s2 + 4], s[kt][8 * s2 + 5]); pw.w = cvt_pk_bf16(s[kt][8 * s2 + 6], s[kt][8 * s2 + 7]);
            const bf16x8 pb = __builtin_bit_cast(bf16x8, pw);
#pragma unroll
            for (int dt = 0; dt < 2; ++dt) { const LAS unsigned char* ap = vtp + (32 * kt + 16 * s2) * AT_VROW + 64 * dt;
                const v4i16_t lo = __builtin_amdgcn_ds_read_tr16_b64_v4i16((LAS v4i16_t*)ap), hi = __builtin_amdgcn_ds_read_tr16_b64_v4i16((LAS v4i16_t*)(ap + 8 * AT_VROW));
                const bf16x8 af = __builtin_shufflevector(lo, hi, 0, 1, 2, 3, 4, 5, 6, 7);
                o[dt] = __builtin_amdgcn_mfma_f32_32x32x16_bf16(af, pb, o[dt], 0, 0, 0); } }
    const float inv = 1.0f / lsum; const size_t orow = (size_t)a.b * SEQ + ((size_t)(q0 + 32 * w + i) * a.d + a.r);
    bf16_t* op = F.Opart + ((size_t)a.p * T + orow) * AW + a.h * HD + 4 * hh;
#pragma unroll
    for (int dt = 0; dt < 2; ++dt)
#pragma unroll
        for (int g4 = 0; g4 < 4; ++g4) { u32x2 wv; wv.x = cvt_pk_bf16(o[dt][4 * g4] * inv, o[dt][4 * g4 + 1] * inv); wv.y = cvt_pk_bf16(o[dt][4 * g4 + 2] * inv, o[dt][4 * g4 + 3] * inv);
            *(u32x2*)(op + 32 * dt + 8 * g4) = wv; }
    if (hh == 0) *(f32x2*)(F.ML + (((size_t)a.p * T + orow) * NH + a.h) * 2) = (f32x2){m, lsum};
}
__device__ __forceinline__ void attn_units(Frame& F, int u0, int ustep, int uend) {
    if (u0 >= uend) return;
    u32x4 kq[6], vq[6]; bf16x8 qn[4]; AttnDesc cur = attn_decode(u0);
#define ATT_QLOAD(A, Q) do { const bf16_t* base_ = F.P1 + (size_t)(A).b * SEQ * INC + (A).h * HD; const size_t qrow_ = (size_t)((A).q0 + 32 * F.wave + (F.lane & 31)) * (A).d + (A).r; \
        _Pragma("unroll") for (int ks = 0; ks < 4; ++ks) Q[ks] = *(const bf16x8*)(base_ + qrow_ * INC + 1024 + 16 * ks + 8 * (F.lane >> 5)); } while (0)
    attn_stage_load(F, cur, kq, vq); ATT_QLOAD(cur, qn);
    for (int u = u0; u < uend; u += ustep) {
        attn_stage_write(F, kq, vq);
        bf16x8 qf[4];
#pragma unroll
        for (int ks = 0; ks < 4; ++ks) qf[ks] = qn[ks];
        __syncthreads();
        const AttnDesc nxt = attn_decode(u + ustep < uend ? u + ustep : u);
        if (u + ustep < uend) { attn_stage_load(F, nxt, kq, vq); ATT_QLOAD(nxt, qn); }
        attn_compute(F, cur, qf);
        __syncthreads();
        cur = nxt;
    }
#undef ATT_QLOAD
}
__device__ __forceinline__ void p2_mixers(Frame& F) {
    constexpr int NSGU = 2 * BATCH * (SEQ / CHUNK), NATT = BATCH * NH * 48;
    constexpr int SH = MOE_ITEMS / 3; const int cnt = SH / (F.G * 8) + ((SH % (F.G * 8)) ? 1 : 0); int first = SH + (F.vcu * 8 + F.wave) * cnt, count = cnt;
    if (first + count > 2 * SH) count = 2 * SH - first;
    const int slot = F.vcu & 3;
    const int split = (F.vcu + 3 * F.G < NATT) ? F.vcu + 3 * F.G : NATT;
    if (slot == 0) moe_convert_items(F, first, count);
    { LAS float* prm = (LAS float*)(F.lds + SG_PRM_OFF); for (int i2 = F.tid; i2 < 2 * AW; i2 += 512) prm[i2] = (i2 < AW) ? F.sgu_ln_g[i2] : F.sgu_ln_b[i2 - AW]; __syncthreads(); }
    for (int u = F.vcu; u < NSGU; u += F.G) sgu_unit(F, u >> 1, u & 1);
    if (slot == 1) moe_convert_items(F, first, count);
    attn_units(F, F.vcu, F.G, split);
    if (slot == 2) moe_convert_items(F, first, count);
    attn_units(F, split, F.G, NATT);
    if (slot == 3) moe_convert_items(F, first, count);
}

__device__ __forceinline__ void p3_merge(Frame& F) {
    const int gw = blockIdx.x * 8 + F.wave, NGW = F.G * 8, h = F.lane >> 3;
    for (int row = gw; row < T; row += NGW) {
        f32x2 ml[3]; float mx = -INFINITY;
#pragma unroll
        for (int p = 0; p < 3; ++p) { ml[p] = *(const f32x2*)(F.ML + (((size_t)p * T + row) * NH + h) * 2); mx = fmaxf(mx, ml[p].x); }
        float wt[3], wsum = 0.f;
#pragma unroll
        for (int p = 0; p < 3; ++p) { wt[p] = ml[p].y * __builtin_amdgcn_exp2f(ml[p].x - mx); wsum += wt[p]; }
        const float iw = 1.0f / wsum; float bv[8];
#pragma unroll
        for (int j = 0; j < 8; ++j) bv[j] = 0.f;
#pragma unroll
        for (int p = 0; p < 3; ++p) { const u32x4 r = __builtin_nontemporal_load((const u32x4*)(F.Opart + ((size_t)p * T + row) * AW + F.lane * 8)); const unsigned w[4] = {r.x, r.y, r.z, r.w}; const float f = wt[p] * iw;
#pragma unroll
            for (int j = 0; j < 4; ++j) { bv[2 * j] += f * bf_lo(w[j]); bv[2 * j + 1] += f * bf_hi(w[j]); } }
        float ss = 0.f;
#pragma unroll
        for (int j = 0; j < 8; ++j) ss += bv[j] * bv[j];
        ss = wave_sum(ss); const float rs = 1.0f / sqrtf(ss * (1.f / AW) + LN_EPS);
        const f32x4 g0 = *(const f32x4*)(F.mix_g + AW + F.lane * 8), g1 = *(const f32x4*)(F.mix_g + AW + F.lane * 8 + 4);
        u32x4 w; w.x = cvt_pk_bf16(bv[0] * rs * g0[0], bv[1] * rs * g0[1]); w.y = cvt_pk_bf16(bv[2] * rs * g0[2], bv[3] * rs * g0[3]);
        w.z = cvt_pk_bf16(bv[4] * rs * g1[0], bv[5] * rs * g1[1]); w.w = cvt_pk_bf16(bv[6] * rs * g1[2], bv[7] * rs * g1[3]);
        *(u32x4*)(F.Amix + (size_t)row * D + AW + F.lane * 8) = w;
    }
}

constexpr int RT_ROW = 2064, RT_IMG = 32 * RT_ROW, RT_LGT_OFF = 2 * RT_IMG, RT_SEL_OFF = RT_LGT_OFF + 32 * 33 * 4;
static_assert(RT_SEL_OFF + 2048 + 256 <= MISC_OFF && 8 * 32 * 32 * 4 <= RT_IMG, "route LDS");
__device__ __forceinline__ void p4_route(Frame& F) {
    const int lane = F.lane, w = F.wave;
    LAS unsigned char* img = F.lds; LAS float* part = (LAS float*)F.lds; LAS float* lgt = (LAS float*)(F.lds + RT_LGT_OFF);
    LAS int* sel_e = (LAS int*)(F.lds + RT_SEL_OFF); LAS float* sel_g = (LAS float*)(F.lds + RT_SEL_OFF + 1024);
    LAS int* lcnt = (LAS int*)(F.lds + RT_SEL_OFF + 2048); LAS int* lbase = lcnt + 32;
    if (F.tid < 32) lcnt[F.tid] = 0;
    f32x4 gg[4], bb[4];
#pragma unroll
    for (int j = 0; j < 4; ++j) { gg[j] = *(const f32x4*)(F.ln1_g + 4 * lane + 256 * j); bb[j] = *(const f32x4*)(F.ln1_b + 4 * lane + 256 * j); }
    bf16x8 bh[4][2], bl[4][2];
#pragma unroll
    for (int ks = 0; ks < 4; ++ks)
#pragma unroll
        for (int nt = 0; nt < 2; ++nt) { const bf16_t* bp = F.WrtHi + (size_t)(16 * nt + (lane & 15)) * D + 128 * w + 32 * ks + 8 * (lane >> 4);
            bh[ks][nt] = *(const bf16x8*)bp; bl[ks][nt] = *(const bf16x8*)(bp + (size_t)NE * D); }
    __syncthreads();
    for (int chunk = blockIdx.x; chunk < T / 64; chunk += F.G) {
#pragma unroll 1
        for (int half = 0; half < 2; ++half) {
            const int row0 = chunk * 64 + half * 32 + w * 4;
            f32x4 v[4][4]; float s[4], q[4];
#pragma unroll
            for (int tk = 0; tk < 4; ++tk) { s[tk] = 0.f;
#pragma unroll
                for (int j = 0; j < 4; ++j) { const u32x2 zr = __builtin_nontemporal_load((const u32x2*)(F.Zb + (size_t)(row0 + tk) * D + 4 * lane + 256 * j)); v[tk][j] = (f32x4){bf_lo(zr.x), bf_hi(zr.x), bf_lo(zr.y), bf_hi(zr.y)}; s[tk] += (v[tk][j][0] + v[tk][j][1]) + (v[tk][j][2] + v[tk][j][3]); } }
#pragma unroll
            for (int o = 1; o < 64; o <<= 1) {
#pragma unroll
                for (int tk = 0; tk < 4; ++tk) s[tk] += __shfl_xor(s[tk], o); }
#pragma unroll
            for (int tk = 0; tk < 4; ++tk) { const float mu = s[tk] * (1.f / D); q[tk] = 0.f;
#pragma unroll
                for (int j = 0; j < 4; ++j) { v[tk][j] = v[tk][j] - mu; q[tk] += (v[tk][j][0] * v[tk][j][0] + v[tk][j][1] * v[tk][j][1]) + (v[tk][j][2] * v[tk][j][2] + v[tk][j][3] * v[tk][j][3]); } }
#pragma unroll
            for (int o = 1; o < 64; o <<= 1) {
#pragma unroll
                for (int tk = 0; tk < 4; ++tk) q[tk] += __shfl_xor(q[tk], o); }
#pragma unroll
            for (int tk = 0; tk < 4; ++tk) { const float rstd = 1.0f / sqrtf(q[tk] * (1.f / D) + LN_EPS);
#pragma unroll
                for (int j = 0; j < 4; ++j) { const f32x4 h = v[tk][j] * rstd * gg[j] + bb[j]; const size_t off = (size_t)(row0 + tk) * D + 4 * lane + 256 * j;
                    *(unsigned*)(F.Hb + off) = cvt4_fp8(h[0], h[1], h[2], h[3]);
                    u32x2 hi; hi.x = cvt_pk_bf16(h[0], h[1]); hi.y = cvt_pk_bf16(h[2], h[3]);
                    __builtin_nontemporal_store(hi, (u32x2*)(F.Hh + off));
                    u32x2 lo; lo.x = cvt_pk_bf16(h[0] - bf_lo(hi.x), h[1] - bf_hi(hi.x)); lo.y = cvt_pk_bf16(h[2] - bf_lo(hi.y), h[3] - bf_hi(hi.y));
                    LAS unsigned char* dp = img + (w * 4 + tk) * RT_ROW + (4 * lane + 256 * j) * 2;
                    *(LAS u32x2*)dp = hi; *(LAS u32x2*)(dp + RT_IMG) = lo; } }
            __syncthreads();
            f32x4 acc[2][2];
#pragma unroll
            for (int mt = 0; mt < 2; ++mt)
#pragma unroll
                for (int nt = 0; nt < 2; ++nt) acc[mt][nt] = (f32x4){0.f, 0.f, 0.f, 0.f};
#pragma unroll
            for (int mt = 0; mt < 2; ++mt) { const LAS unsigned char* ap = img + (16 * mt + (lane & 15)) * RT_ROW + (128 * w + 8 * (lane >> 4)) * 2;
#pragma unroll
                for (int ks = 0; ks < 4; ++ks) { const bf16x8 ah = *(const LAS bf16x8*)(ap + ks * 64), al = *(const LAS bf16x8*)(ap + RT_IMG + ks * 64);
#pragma unroll
                    for (int nt = 0; nt < 2; ++nt) {
                        acc[mt][nt] = __builtin_amdgcn_mfma_f32_16x16x32_bf16(ah, bh[ks][nt], acc[mt][nt], 0, 0, 0);
                        acc[mt][nt] = __builtin_amdgcn_mfma_f32_16x16x32_bf16(ah, bl[ks][nt], acc[mt][nt], 0, 0, 0);
                        acc[mt][nt] = __builtin_amdgcn_mfma_f32_16x16x32_bf16(al, bh[ks][nt], acc[mt][nt], 0, 0, 0); } } }
            __syncthreads();
#pragma unroll
            for (int mt = 0; mt < 2; ++mt)
#pragma unroll
                for (int nt = 0; nt < 2; ++nt)
#pragma unroll
                    for (int r = 0; r < 4; ++r) part[(w * 32 + 16 * mt + 4 * (lane >> 4) + r) * 32 + 16 * nt + (lane & 15)] = acc[mt][nt][r];
            __syncthreads();
#pragma unroll
            for (int qq = 0; qq < 2; ++qq) { const int p = F.tid + 512 * qq, tok = p >> 5, e = p & 31; float sum = F.b_router[e];
#pragma unroll
                for (int ww = 0; ww < 8; ++ww) sum += part[(ww * 32 + tok) * 32 + e];
                lgt[tok * 33 + e] = sum; }
            __syncthreads();
            if (F.tid < 32) {
                float lg[32];
#pragma unroll
                for (int e = 0; e < 32; ++e) lg[e] = lgt[F.tid * 33 + e];
                int idx[4]; float val[4]; unsigned taken = 0u;
#pragma unroll
                for (int r = 0; r < 4; ++r) { float best = -INFINITY; int bi = 0;
#pragma unroll
                    for (int e = 0; e < 32; ++e) { const bool ok = !((taken >> e) & 1u) && (lg[e] > best); best = ok ? lg[e] : best; bi = ok ? e : bi; }
                    idx[r] = bi; val[r] = best; taken |= 1u << bi; }
                const float e1 = __expf(val[1] - val[0]), e2 = __expf(val[2] - val[0]), e3 = __expf(val[3] - val[0]); const float inv = 1.0f / (1.0f + e1 + e2 + e3);
                const int tl = half * 32 + F.tid;
                sel_e[tl * 4 + 0] = idx[0]; sel_e[tl * 4 + 1] = idx[1]; sel_e[tl * 4 + 2] = idx[2]; sel_e[tl * 4 + 3] = idx[3];
                sel_g[tl * 4 + 0] = inv; sel_g[tl * 4 + 1] = e1 * inv; sel_g[tl * 4 + 2] = e2 * inv; sel_g[tl * 4 + 3] = e3 * inv; }
            __syncthreads();
        }
        int myrank = 0, mye = 0;
        if (F.tid < 256) { mye = sel_e[F.tid]; myrank = atomicAdd((int*)&lcnt[mye], 1); }
        __syncthreads();
        if (F.tid < 32) { const int c = lcnt[F.tid]; lbase[F.tid] = c ? (int)__hip_atomic_fetch_add(F.ctl + CW_CNT + F.tid, (unsigned)c, __ATOMIC_RELAXED, __HIP_MEMORY_SCOPE_AGENT) : 0; lcnt[F.tid] = 0; }
        __syncthreads();
        if (F.tid < 256) { const int slot = (chunk * 64 + (F.tid >> 2)) * 4 + (F.tid & 3); F.list[mye * T + lbase[mye] + myrank] = slot; F.gates[slot] = sel_g[F.tid]; F.einfo[slot] = mye | ((lbase[mye] + myrank) << 8); }
        __syncthreads();
    }
}

template <bool G1> __device__ __forceinline__ int moe_tables(Frame& F, int NPN) {
    LAS int* cnt = (LAS int*)(F.lds + TAB_OFF); LAS int* tstart = cnt + 32; LAS int* rowtab = (LAS int*)(F.lds + ROWTAB_OFF);
    if (F.tid < 32) cnt[F.tid] = (int)__hip_atomic_load(F.ctl + CW_CNT + F.tid, __ATOMIC_RELAXED, __HIP_MEMORY_SCOPE_AGENT);
    __syncthreads();
    if (F.tid == 0) { int acc = 0; for (int e = 0; e < NE; ++e) { tstart[e] = acc; acc += (cnt[e] + 255) >> 8; } tstart[NE] = acc; }
    __syncthreads();
    const int ntiles = tstart[NE], nU = ntiles * NPN;
    for (int i = 0; i < MAXU; ++i) { const int L = i * F.G + F.vcu; if (L >= nU) break;
        const int tl = L / NPN; int e = 0;
        for (int j = 1; j < NE; ++j) e += (tstart[j] <= tl) ? 1 : 0;
        const int mt = tl - tstart[e];
        if (F.tid < 256) { const int rank = mt * 256 + F.tid; const int slot = rank < cnt[e] ? F.list[e * T + rank] : -1;
            rowtab[i * 256 + F.tid] = G1 ? ((slot < 0 ? 0 : (slot >> 2)) * D) : slot; } }
    __syncthreads();
    return ntiles;
}

__device__ __forceinline__ void p7_final(Frame& F) {
    LAS int* cnt = (LAS int*)(F.lds + TAB_OFF); LAS int* tstart = cnt + 32;
    if (F.tid < 32) cnt[F.tid] = (int)__hip_atomic_load(F.ctl + CW_CNT + F.tid, __ATOMIC_RELAXED, __HIP_MEMORY_SCOPE_AGENT);
    __syncthreads();
    if (F.tid == 0) { int acc = 0; for (int e = 0; e < NE; ++e) { tstart[e] = acc; acc += (cnt[e] + 255) >> 8; } tstart[NE] = acc; }
    __syncthreads();
    const int gw = blockIdx.x * 8 + F.wave, NGW = F.G * 8;
    for (int row = gw; row < T; row += NGW) {
        float* hp = F.out + (size_t)row * D; float v[16];
#pragma unroll
        for (int j = 0; j < 2; ++j) { const u32x4 r = __builtin_nontemporal_load((const u32x4*)(F.Hh + (size_t)row * D + 512 * j + F.lane * 8)); const unsigned w[4] = {r.x, r.y, r.z, r.w};
#pragma unroll
            for (int i = 0; i < 4; ++i) { v[8 * j + 2 * i] = bf_lo(w[i]) * DN_ALPHA; v[8 * j + 2 * i + 1] = bf_hi(w[i]) * DN_ALPHA; } }
#pragma unroll
        for (int k = 0; k < TOPK; ++k) { const int info = F.einfo[row * TOPK + k]; const float gt = F.gates[row * TOPK + k];
            const size_t pos = ((size_t)tstart[info & 255] << 8) + (size_t)(info >> 8);
#pragma unroll
            for (int j = 0; j < 2; ++j) { const u32x2 r = __builtin_nontemporal_load((const u32x2*)(F.Y + pos * D + 512 * j + F.lane * 8)); const float gs = gt * (1.0f / Y_SCALE);
                const f32x2 p0 = __builtin_amdgcn_cvt_pk_f32_fp8((int)r.x, false), p1 = __builtin_amdgcn_cvt_pk_f32_fp8((int)r.x, true), p2 = __builtin_amdgcn_cvt_pk_f32_fp8((int)r.y, false), p3 = __builtin_amdgcn_cvt_pk_f32_fp8((int)r.y, true);
                v[8 * j + 0] += gs * p0.x; v[8 * j + 1] += gs * p0.y; v[8 * j + 2] += gs * p1.x; v[8 * j + 3] += gs * p1.y; v[8 * j + 4] += gs * p2.x; v[8 * j + 5] += gs * p2.y; v[8 * j + 6] += gs * p3.x; v[8 * j + 7] += gs * p3.y; } }
        float s = 0.f;
#pragma unroll
        for (int i = 0; i < 16; ++i) s += v[i];
        const float mu = wave_sum(s) * (1.f / D); float q = 0.f;
#pragma unroll
        for (int i = 0; i < 16; ++i) { v[i] -= mu; q += v[i] * v[i]; }
        const float rstd = 1.0f / sqrtf(wave_sum(q) * (1.f / D) + LN_EPS);
#pragma unroll
        for (int j = 0; j < 2; ++j) { const int c = 512 * j + F.lane * 8;
            const f32x4 g0 = *(const f32x4*)(F.ln2_g + c), g1 = *(const f32x4*)(F.ln2_g + c + 4), b0 = *(const f32x4*)(F.ln2_b + c), b1 = *(const f32x4*)(F.ln2_b + c + 4);
            f32x4 o0, o1;
#pragma unroll
            for (int i = 0; i < 4; ++i) { o0[i] = v[8 * j + i] * rstd * g0[i] + b0[i]; o1[i] = v[8 * j + 4 + i] * rstd * g1[i] + b1[i]; }
            __builtin_nontemporal_store(o0, (f32x4*)(hp + c)); __builtin_nontemporal_store(o1, (f32x4*)(hp + c + 4)); }
    }
}

__device__ __forceinline__ bool fresh(Frame& F) {
    int t = threadIdx.x; asm volatile("" : "+v"(t)); F.tid = t; F.lane = t & 63;
    const __attribute__((address_space(4))) Args* ap = (const __attribute__((address_space(4))) Args*)__builtin_amdgcn_kernarg_segment_ptr(); asm volatile("" : "+s"(ap));
    F.x = ap->in[0]; F.w_in = ap->in[1]; F.sgu_w = ap->in[2]; F.sgu_b = ap->in[3]; F.sgu_ln_g = ap->in[4]; F.sgu_ln_b = ap->in[5]; F.mix_g = ap->in[6]; F.w_out = ap->in[7];
    F.ln1_g = ap->in[8]; F.ln1_b = ap->in[9]; F.w_router = ap->in[10]; F.b_router = ap->in[11]; F.w_gate = ap->in[12]; F.b_gate = ap->in[13]; F.w_up = ap->in[14]; F.b_up = ap->in[15];
    F.w_down = ap->in[16]; F.b_down = ap->in[17]; F.ln2_g = ap->in[18]; F.ln2_b = ap->in[19]; F.out = ap->out; F.ws = ap->ws;
    unsigned char* ws = ap->ws;
    F.ctl = (unsigned*)(ws + WS_CTL); F.list = (int*)(ws + WS_LIST); F.einfo = (int*)(ws + WS_EINFO); F.gates = (float*)(ws + WS_GATES);
    F.Win_t = (bf16_t*)(ws + WS_WIN); F.Wout_t = (bf16_t*)(ws + WS_WOUT); F.Wd_t = (act_t*)(ws + WS_WD); F.Wgu_t = (fp8_t*)(ws + WS_WGU); F.Y = (fp8_t*)(ws + WS_Y);
    F.Hb = (fp8_t*)(ws + WS_HB); F.Xb = (bf16_t*)(ws + WS_XB); F.P1 = (bf16_t*)(ws + WS_P1); F.Amix = (bf16_t*)(ws + WS_AMIX); F.Act = (act_t*)(ws + WS_ACT);
    F.WrtHi = (bf16_t*)(ws + WS_WRT); F.Zb = (bf16_t*)(ws + WS_XB); F.Hh = (bf16_t*)(ws + WS_AMIX);
    F.Opart = (bf16_t*)(ws + WS_OPART); F.ML = (float*)(ws + WS_ML);
    return true; }
constexpr int N_PHASES = 8;
__global__ void __launch_bounds__(512, 2) mk_fwd(Args args) {
    extern __shared__ __attribute__((aligned(16))) unsigned char lds_raw[];
    Frame F;
    F.lds = (LAS unsigned char*)lds_raw; F.tid = threadIdx.x; F.lane = F.tid & 63; F.wave = __builtin_amdgcn_readfirstlane(F.tid >> 6);
    F.G = gridDim.x; { const int bx = blockIdx.x; F.vcu = (F.G % 8 == 0) ? (bx % 8) * (F.G / 8) + bx / 8 : bx; }
    fresh(F);
    unsigned char* ws = F.ws;
    const int lo = args.ph_lo, hi = args.ph_hi;
    volatile LAS unsigned* misc = (volatile LAS unsigned*)(F.lds + MISC_OFF);
    if (F.tid < 16) misc[F.tid] = 0u;
    __syncthreads();
    XcdBarrier bar; bar.bar = F.ctl + CW_BAR; bar.x = 0; bar.st = misc;
    if (hi - lo > 1) bar = xcd_barrier_post(F.ctl + CW_BAR, misc);
    const LAS int* rowtab = (const LAS int*)(F.lds + ROWTAB_OFF);
#ifndef PROBE_DUP
#define PROBE_DUP -1
#endif
#define IN(k) (lo <= (k) && (k) < hi && fresh(F))
#define SEAM(k) do { if (lo <= (k) && (k) + 1 < hi) { xcd_barrier(bar); } } while (0)
#define REP(k) for (int _rep = 0; _rep < ((PROBE_DUP == (k)) ? 2 : 1); ++_rep)
    if (IN(0)) REP(0) { p0_convert(F); }
    SEAM(0);
    if (IN(1)) REP(1) {
        pg8::Gemm g{F.Xb, F.Win_t, D * 2}; pg8::EpiP1 E{F.P1}; constexpr int NU1 = (T / 256) * (INC / 256);
        int nun = 0; for (int i = 0; i * F.G + F.vcu < NU1; ++i) ++nun;
        constexpr int SH = MOE_ITEMS / 3;
        int pos = 0, count = SH / (F.G * 8) + 1, first = (F.vcu * 8 + F.wave) * count, lim = SH;
        if (F.G == 256) { if (nun == 3) { pos = F.vcu & 3; count = 1; first = F.vcu * 8 + F.wave; } else { pos = F.vcu % 3; count = 7; first = 1024 + ((F.vcu - 128) * 8 + F.wave) * 7; } }
        if (first + count > lim) count = lim - first;
        if (pos == 0) moe_convert_items(F, first, count);
        ConvHook H{&F, first, count, pos - 1};
        { pg8::DenseOrder S{INC / 256, NU1, F.G, F.vcu, 0, 1 << 20}; pg8::gemm_phase<pg8::EpiP1, pg8::DenseOrder, false, false>(F.lds, rowtab, g, S, E, H); } }
    SEAM(1);
    if (IN(2)) REP(2) { p2_mixers(F); }
    SEAM(2);
    if (IN(3)) REP(3) { p3_merge(F); }
    SEAM(3);
    if (IN(4)) REP(4) { pg8::Gemm g{F.Amix, F.Wout_t, D * 2}; pg8::DenseOrder S{D / 256, (T / 256) * (D / 256), F.G, F.vcu, 0, 1 << 20}; pg8::EpiZ E{F.x, F.Zb};
        pg8::gemm_phase<pg8::EpiZ, pg8::DenseOrder, false, false>(F.lds, rowtab, g, S, E, NoHook{}); }
    SEAM(4);
    if (IN(5)) { p4_route(F); }
    SEAM(5);
    if (IN(6)) REP(6) { const int ntiles = moe_tables<true>(F, 8); pg8::Gemm g{F.Hb, F.Wgu_t, D}; pg8::EpiSwiglu E{F.Act, F.b_gate, F.b_up};
        constexpr int SH = MOE_ITEMS / 3; const int cnt = SH / (F.G * 8) + ((SH % (F.G * 8)) ? 1 : 0); int first = 2 * SH + (F.vcu * 8 + F.wave) * cnt, count = cnt;
        if (first + count > 3 * SH) count = 3 * SH - first;
        const int pos = 2 * (F.vcu & 3);
        if (pos == 0) moe_convert_items(F, first, count);
        ConvHook H{&F, first, count, pos - 1};
        { pg8::MoeOrder S{8, ntiles * 8, F.G, F.vcu, (const LAS int*)(F.lds + TAB_OFF) + 32, 0, 1 << 20}; pg8::gemm_phase<pg8::EpiSwiglu, pg8::MoeOrder, true, true>(F.lds, rowtab, g, S, E, H); } }
    SEAM(6);
    if (IN(7)) REP(7) { const int ntiles = moe_tables<false>(F, 4); pg8::Gemm g{F.Act, F.Wd_t, FF * (int)sizeof(act_t)}; pg8::MoeOrder S{4, ntiles * 4, F.G, F.vcu, (const LAS int*)(F.lds + TAB_OFF) + 32, 0, 1 << 20};
        pg8::EpiY E{F.Y, F.b_down};
        pg8::gemm_phase<pg8::EpiY, pg8::MoeOrder, false, (G2_FP8 != 0)>(F.lds, rowtab, g, S, E, NoHook{}); }
    SEAM(7);
    if (IN(8)) { p7_final(F); }
#undef IN
#undef SEAM
}

extern "C" void kernel_launch(void* const* d_in, const int* in_sizes, int n_in, void* d_out, int out_size, void* d_ws, size_t ws_size, hipStream_t stream) {
    static int grid = 0;
    if (grid == 0) {
        if (n_in != 20 || in_sizes[0] != T * D || out_size != T * D || ws_size < WS_END) { fprintf(stderr, "kernel_launch: unexpected shapes (n_in %d, in0 %d, out %d, ws %zu)\n", n_in, n_in > 0 ? in_sizes[0] : -1, out_size, ws_size); grid = -1; return; }
        int dev = 0, cus = 0, per_cu = 0;
        hipGetDevice(&dev); hipDeviceGetAttribute(&cus, hipDeviceAttributeMultiprocessorCount, dev);
        if (hipFuncSetAttribute((const void*)mk_fwd, hipFuncAttributeMaxDynamicSharedMemorySize, LDS_BYTES) != hipSuccess) { fprintf(stderr, "kernel_launch: hipFuncSetAttribute failed\n"); grid = -1; return; }
        hipOccupancyMaxActiveBlocksPerMultiprocessor(&per_cu, (const void*)mk_fwd, 512, LDS_BYTES);
        (void)hipGetLastError();
        if (per_cu < 1) { fprintf(stderr, "kernel_launch: occupancy query says %d blocks/CU: the grid would not be resident; nothing launched\n", per_cu); grid = -1; return; }
        grid = cus;
        if (grid != 256) fprintf(stderr, "kernel_launch: note: %d CUs (tuned for 256)\n", grid);
    }
    if (grid < 0) return;
    hipMemsetAsync((char*)d_ws + WS_CTL, 0, CTL_ZERO_BYTES, stream);
    Args a{};
    for (int i = 0; i < 20; ++i) a.in[i] = (const float*)d_in[i];
    a.out = (float*)d_out; a.ws = (unsigned char*)d_ws;
#if MK_N_LAUNCHES == 1
    a.ph_lo = 0; a.ph_hi = N_PHASES + 1;
    hipLaunchKernelGGL(mk_fwd, dim3(grid), dim3(512), LDS_BYTES, stream, a);
#else
    for (int p = 0; p <= N_PHASES; ++p) { a.ph_lo = p; a.ph_hi = p + 1; hipLaunchKernelGGL(mk_fwd, dim3(grid), dim3(512), LDS_BYTES, stream, a); }
#endif
}
```
